# Optimizing an MI355X kernel written in HIP

```python
import math
import jax, jax.numpy as jnp
from jax import lax
import numpy as np

D_MODEL = 1024
BATCH = 32
SEQ = 256
DEPTH = 1
DEC_BATCH = 4
DEC_SEQ = 1024
PAST_LEN = 256

GRID_W = 64
NA_HEADS = 8
HEAD_DIM = 64
NA_WIDTH = NA_HEADS * HEAD_DIM
WIN_R = 8
WIN_C = 16
ROPE_BASE = 10000.0
DN_HEADS = 8
DN_DK = 64
DN_DV = 64
DN_QK_WIDTH = DN_HEADS * DN_DK
DN_V_WIDTH = DN_HEADS * DN_DV
DN_CONV_CH = 2 * DN_QK_WIDTH + DN_V_WIDTH
CONV_W = 5
CHUNK = 64
D_FF = 4 * D_MODEL
N_MOD = 6
EPS = 1e-6
NEG_INF = -1e30
IN_SIZES = (NA_WIDTH, NA_WIDTH, NA_WIDTH, DN_CONV_CH, 2 * DN_HEADS, 2 * DN_HEADS, DN_V_WIDTH, D_MODEL, D_MODEL)
IN_COLS = 3 * NA_WIDTH + DN_CONV_CH + 4 * DN_HEADS + DN_V_WIDTH + 2 * D_MODEL

kernel_name = 'neighbourhood_deltanet_flow_step'


def _rms(x, w):
    xf = x.astype(jnp.float32)
    y = xf * lax.rsqrt(jnp.mean(xf * xf, axis=-1, keepdims=True) + EPS)
    return (y * w.astype(jnp.float32)).astype(x.dtype)


def _l2n(x):
    xf = x.astype(jnp.float32)
    return xf * lax.rsqrt(jnp.sum(xf * xf, axis=-1, keepdims=True) + EPS)


def _adaln(cvec, w_ada, b_ada):
    m = jax.nn.silu(cvec) @ w_ada + b_ada
    m = m.reshape(m.shape[:-1] + (1, N_MOD, D_MODEL))
    return [m[..., i, :] for i in range(N_MOD)]


def _axial_rope(x):
    T = x.shape[1]
    pos = jnp.arange(T)
    half = HEAD_DIM // 2
    nf = half // 2
    inv = ROPE_BASE ** (-jnp.arange(nf, dtype=jnp.float32) / nf)

    def rot(xa, p):
        ang = p.astype(jnp.float32)[:, None] * inv
        cos = jnp.cos(ang)[None, :, None, :]
        sin = jnp.sin(ang)[None, :, None, :]
        x1, x2 = xa[..., :nf], xa[..., nf:]
        return jnp.concatenate([x1 * cos - x2 * sin, x1 * sin + x2 * cos], axis=-1)

    xf = x.astype(jnp.float32)
    out = jnp.concatenate([rot(xf[..., :half], pos // GRID_W), rot(xf[..., half:], pos % GRID_W)], axis=-1)
    return out.astype(x.dtype)


def _dwconv(x, w):
    return lax.conv_general_dilated(
        x, w[:, None, :].astype(x.dtype), window_strides=(1,),
        padding=[(CONV_W // 2, CONV_W // 2)],
        dimension_numbers=('NWC', 'WIO', 'NWC'),
        feature_group_count=x.shape[-1])


def _project(h, w_in, conv_w):
    B, T, _ = h.shape
    p = h @ w_in
    idx = [int(i) for i in np.cumsum(IN_SIZES)[:-1]]
    na_q, na_k, na_v, dn_qkv, dn_b, dn_a, dn_z, gate_na, gate_dn = jnp.split(p, idx, axis=-1)
    dn_qkv = jax.nn.silu(_dwconv(dn_qkv, conv_w))
    dq, dk, dv = jnp.split(dn_qkv, [DN_QK_WIDTH, 2 * DN_QK_WIDTH], axis=-1)
    na_q = na_q.reshape(B, T, NA_HEADS, HEAD_DIM)
    na_k = na_k.reshape(B, T, NA_HEADS, HEAD_DIM)
    na_v = na_v.reshape(B, T, NA_HEADS, HEAD_DIM)
    dq = _l2n(dq.reshape(B, T, DN_HEADS, DN_DK))
    dk = _l2n(dk.reshape(B, T, DN_HEADS, DN_DK))
    dv = dv.reshape(B, T, DN_HEADS, DN_DV)
    return na_q, na_k, na_v, dq, dk, dv, dn_b, dn_a, dn_z, gate_na, gate_dn


def _na_context(q, k, v):
    s = jnp.einsum('bqhd,bkhd->bhqk', q, k).astype(jnp.float32) * (HEAD_DIM ** -0.5)
    p = jax.nn.softmax(s, axis=-1).astype(v.dtype)
    return jnp.einsum('bhqk,bkhd->bqhd', p, v)


def _na_latent(q, k, v, ck, cv, rpb):
    B, T, H, Dh = q.shape
    rows = T // GRID_W
    kr = min(WIN_R, rows)
    r = np.arange(rows)
    rs = np.clip(r - kr // 2, 0, rows - kr)
    krow = rs[:, None] + np.arange(kr)
    col = np.arange(GRID_W)
    cs = np.clip(col - WIN_C // 2, 0, GRID_W - WIN_C)
    kcol = np.broadcast_to(col, (kr, GRID_W)).reshape(-1)
    valid = (kcol[None, :] >= cs[:, None]) & (kcol[None, :] < cs[:, None] + WIN_C)
    dr_idx = (np.repeat(krow, GRID_W, axis=1) - r[:, None]) + (WIN_R - 1)
    dc_idx = np.clip(kcol[None, :] - col[:, None] + (WIN_C - 1), 0, 2 * WIN_C - 2)
    bias = rpb[:, dr_idx[:, None, :], dc_idx[None, :, :]].astype(jnp.float32)
    K = kr * GRID_W
    qg = q.reshape(B, rows, GRID_W, H, Dh)
    kg = k.reshape(B, rows, GRID_W, H, Dh)[:, krow].reshape(B, rows, K, H, Dh)
    vg = v.reshape(B, rows, GRID_W, H, Dh)[:, krow].reshape(B, rows, K, H, Dh)
    scale = HEAD_DIM ** -0.5
    s_loc = jnp.einsum('brqhd,brkhd->bhrqk', qg, kg).astype(jnp.float32) * scale + bias[None]
    s_loc = jnp.where(valid[None, None, None], s_loc, NEG_INF)
    s_ctx = jnp.einsum('brqhd,bhkd->bhrqk', qg, ck).astype(jnp.float32) * scale
    p = jax.nn.softmax(jnp.concatenate([s_loc, s_ctx], axis=-1), axis=-1).astype(v.dtype)
    o = jnp.einsum('bhrqk,brkhd->brqhd', p[..., :K], vg) + jnp.einsum('bhrqk,bhkd->brqhd', p[..., K:], cv)
    return o.reshape(B, T, H, Dh)


def _gated_delta_chunked(q, k, v, g, beta, s0):
    B, T, H, DK = q.shape
    DV = v.shape[-1]
    n = T // CHUNK
    f32 = jnp.float32

    def blk(a):
        a = a.astype(f32).reshape((B, n, CHUNK, H) + a.shape[3:])
        return jnp.moveaxis(a, (1, 3), (0, 2))

    qb = blk(q) * (DK ** -0.5)
    kb, vb, gb, bb = blk(k), blk(v), blk(g), blk(beta)
    gc = jnp.cumsum(gb, axis=-1)
    tril = jnp.tril(jnp.ones((CHUNK, CHUNK), bool))
    strict = jnp.tril(jnp.ones((CHUNK, CHUNK), bool), -1)
    diff = gc[..., :, None] - gc[..., None, :]
    decay = jnp.where(tril, jnp.exp(jnp.where(tril, diff, 0.0)), 0.0)
    kbeta = kb * bb[..., None]
    a_mat = jnp.where(strict, jnp.einsum('nbhid,nbhjd->nbhij', kbeta, kb) * decay, 0.0) + jnp.eye(CHUNK, dtype=f32)
    rhs = jnp.concatenate([vb * bb[..., None], kbeta * jnp.exp(gc)[..., None]], axis=-1)
    sol = lax.linalg.triangular_solve(a_mat, rhs, left_side=True, lower=True, unit_diagonal=True)
    u, w = sol[..., :DV], sol[..., DV:]
    qk = jnp.einsum('nbhid,nbhjd->nbhij', qb, kb) * decay

    def step(S, xs):
        qc, kc, uc, wc, gcc, qkc = xs
        v_new = uc - jnp.einsum('bhck,bhkv->bhcv', wc, S)
        o = (jnp.einsum('bhck,bhkv->bhcv', qc * jnp.exp(gcc)[..., None], S)
             + jnp.einsum('bhij,bhjv->bhiv', qkc, v_new))
        glast = gcc[..., -1:]
        S = S * jnp.exp(glast)[..., None] + jnp.einsum('bhck,bhcv->bhkv', kc * jnp.exp(glast - gcc)[..., None], v_new)
        return S, o

    s_fin, o = lax.scan(step, s0.astype(f32), (qb, kb, u, w, gc, qk))
    o = jnp.moveaxis(o, (0, 2), (1, 3)).reshape(B, T, H, DV)
    return o.astype(v.dtype), s_fin


def _delta_dir(q, k, v, b_logit, a_logit, a_log, dt_bias, s0, reverse):
    beta = jax.nn.sigmoid(b_logit.astype(jnp.float32))
    g = -jnp.exp(a_log.astype(jnp.float32)) * jax.nn.softplus(a_logit.astype(jnp.float32) + dt_bias.astype(jnp.float32))
    if reverse:
        q, k, v, beta, g = (jnp.flip(t, axis=1) for t in (q, k, v, beta, g))
    o, s = _gated_delta_chunked(q, k, v, g, beta, s0)
    if reverse:
        o = jnp.flip(o, axis=1)
    return o, s


def _merge(o_na, o_dn, z, gate_na, gate_dn, dn_norm, w_ao, w_do, w_out):
    B, T = o_na.shape[:2]
    o_dn = _rms(o_dn, dn_norm) * jax.nn.silu(z).reshape(B, T, DN_HEADS, DN_DV)
    br_na = o_na.reshape(B, T, NA_WIDTH) @ w_ao
    br_dn = o_dn.reshape(B, T, DN_V_WIDTH) @ w_do
    m = jax.nn.sigmoid(gate_na) * br_na + jax.nn.sigmoid(gate_dn) * br_dn
    return m @ w_out


def _mixer_context(h, w_in, conv_w, a_log, dt_bias, dn_norm, w_ao, w_do, w_out):
    q, k, v, dq, dk, dv, b, a, z, ga, gd = _project(h, w_in, conv_w)
    o_na = _na_context(q, k, v)
    s0 = jnp.zeros((h.shape[0], DN_HEADS, DN_DK, DN_DV), jnp.float32)
    o_f, s_f = _delta_dir(dq, dk, dv, b[..., :DN_HEADS], a[..., :DN_HEADS], a_log[0], dt_bias[0], s0, False)
    o_b, s_b = _delta_dir(dq, dk, dv, b[..., DN_HEADS:], a[..., DN_HEADS:], a_log[1], dt_bias[1], s0, True)
    y = _merge(o_na, o_f + o_b, z, ga, gd, dn_norm, w_ao, w_do, w_out)
    return y, jnp.transpose(k, (0, 2, 1, 3)), jnp.transpose(v, (0, 2, 1, 3)), jnp.stack([s_f, s_b], axis=1)


def _mixer_latent(h, ck, cv, st, w_in, conv_w, a_log, dt_bias, dn_norm, rpb, w_ao, w_do, w_out):
    q, k, v, dq, dk, dv, b, a, z, ga, gd = _project(h, w_in, conv_w)
    o_na = _na_latent(_axial_rope(q), _axial_rope(k), v, ck, cv, rpb)
    s = st.astype(jnp.float32)
    o_f, _ = _delta_dir(dq, dk, dv, b[..., :DN_HEADS], a[..., :DN_HEADS], a_log[0], dt_bias[0], s[:, 0], False)
    o_b, _ = _delta_dir(dq, dk, dv, b[..., DN_HEADS:], a[..., DN_HEADS:], a_log[1], dt_bias[1], s[:, 1], True)
    return _merge(o_na, o_f + o_b, z, ga, gd, dn_norm, w_ao, w_do, w_out)


def _ffn_sub(x, shift, scale, gate, w_pre, w_post, w1, w2):
    h = _rms(x, w_pre) * (1 + scale) + shift
    f = jnp.square(jax.nn.relu(h @ w1)) @ w2
    return x + gate * _rms(f, w_post)


def setup_inputs(seed: int = 0) -> dict:
    key = jax.random.key(seed)
    ks = jax.random.split(key, 24)
    f32 = jnp.float32

    def nrm(k, shape, s):
        return jax.random.normal(k, shape, f32) * s

    dt = jnp.exp(jax.random.uniform(ks[16], (DEPTH, 2, DN_HEADS), f32, math.log(1e-3), math.log(1e-1)))
    return {
        'x_prompt': nrm(ks[0], (BATCH, SEQ, D_MODEL), 1.0),
        'x_sample': nrm(ks[1], (DEC_BATCH, DEC_SEQ, D_MODEL), 1.0),
        'c': nrm(ks[2], (DEC_BATCH, D_MODEL), 1.0),
        'cache_na_k': nrm(ks[3], (DEC_BATCH, DEPTH, NA_HEADS, PAST_LEN, HEAD_DIM), 1.0),
        'cache_na_v': nrm(ks[4], (DEC_BATCH, DEPTH, NA_HEADS, PAST_LEN, HEAD_DIM), 1.0),
        'state_delta': nrm(ks[5], (DEC_BATCH, DEPTH, 2, DN_HEADS, DN_DK, DN_DV), DN_DK ** -0.5),
        'c_ctx': nrm(ks[6], (D_MODEL,), 1.0),
        'w_ada': nrm(ks[7], (DEPTH, D_MODEL, N_MOD * D_MODEL), 0.5 * D_MODEL ** -0.5),
        'b_ada': nrm(ks[8], (DEPTH, N_MOD * D_MODEL), 0.02),
        'norm_pre1': 1.0 + nrm(ks[9], (DEPTH, D_MODEL), 0.05),
        'norm_post1': 1.0 + nrm(ks[10], (DEPTH, D_MODEL), 0.05),
        'norm_pre2': 1.0 + nrm(ks[11], (DEPTH, D_MODEL), 0.05),
        'norm_post2': 1.0 + nrm(ks[12], (DEPTH, D_MODEL), 0.05),
        'w_in': nrm(ks[13], (DEPTH, D_MODEL, IN_COLS), D_MODEL ** -0.5),
        'conv_w': nrm(ks[14], (DEPTH, CONV_W, DN_CONV_CH), CONV_W ** -0.5),
        'a_log': jnp.log(jax.random.uniform(ks[15], (DEPTH, 2, DN_HEADS), f32, 1.0, 16.0)),
        'dt_bias': dt + jnp.log(-jnp.expm1(-dt)),
        'dn_norm': 1.0 + nrm(ks[17], (DEPTH, DN_DV), 0.05),
        'na_rpb': nrm(ks[18], (DEPTH, NA_HEADS, 2 * WIN_R - 1, 2 * WIN_C - 1), 0.02),
        'w_ao': nrm(ks[19], (DEPTH, NA_WIDTH, D_MODEL), NA_WIDTH ** -0.5),
        'w_do': nrm(ks[20], (DEPTH, DN_V_WIDTH, D_MODEL), DN_V_WIDTH ** -0.5),
        'w_out': nrm(ks[21], (DEPTH, D_MODEL, D_MODEL), D_MODEL ** -0.5),
        'w_ff1': nrm(ks[22], (DEPTH, D_MODEL, D_FF), D_MODEL ** -0.5),
        'w_ff2': nrm(ks[23], (DEPTH, D_FF, D_MODEL), D_FF ** -0.5),
    }


def reference(x_prompt, x_sample, c, cache_na_k, cache_na_v, state_delta, c_ctx,
              w_ada, b_ada, norm_pre1, norm_post1, norm_pre2, norm_post2,
              w_in, conv_w, a_log, dt_bias, dn_norm, na_rpb,
              w_ao, w_do, w_out, w_ff1, w_ff2):
    xp = x_prompt
    xs = x_sample
    new_k, new_v, new_s = [], [], []
    for l in range(DEPTH):
        sh1, sc1, g1, sh2, sc2, g2 = _adaln(c_ctx, w_ada[l], b_ada[l])
        h = _rms(xp, norm_pre1[l]) * (1 + sc1) + sh1
        y, kc, vc, st = _mixer_context(h, w_in[l], conv_w[l], a_log[l], dt_bias[l], dn_norm[l],
                                       w_ao[l], w_do[l], w_out[l])
        xp = xp + g1 * _rms(y, norm_post1[l])
        xp = _ffn_sub(xp, sh2, sc2, g2, norm_pre2[l], norm_post2[l], w_ff1[l], w_ff2[l])
        new_k.append(kc)
        new_v.append(vc)
        new_s.append(st.astype(x_prompt.dtype))
        sh1, sc1, g1, sh2, sc2, g2 = _adaln(c, w_ada[l], b_ada[l])
        h = _rms(xs, norm_pre1[l]) * (1 + sc1) + sh1
        y = _mixer_latent(h, cache_na_k[:, l], cache_na_v[:, l], state_delta[:, l], w_in[l], conv_w[l],
                          a_log[l], dt_bias[l], dn_norm[l], na_rpb[l], w_ao[l], w_do[l], w_out[l])
        xs = xs + g1 * _rms(y, norm_post1[l])
        xs = _ffn_sub(xs, sh2, sc2, g2, norm_pre2[l], norm_post2[l], w_ff1[l], w_ff2[l])
    new_cache_na_k = jnp.stack(new_k, axis=1)
    new_cache_na_v = jnp.stack(new_v, axis=1)
    new_state_delta = jnp.stack(new_s, axis=1)
    return (xp, xs, new_cache_na_k, new_cache_na_v, new_state_delta)
```

```cpp
#include <hip/hip_runtime.h>
#include <cstdio>
#include <cstdint>

constexpr int DM = 1024, M_CTX = 8192, M_LAT = 4096, MT = 12288, NIN = 5664, NINP = 5888, FF = 4096;
constexpr int C_Q = 0, C_K = 512, C_V = 1024, C_DN = 1536, C_B = 3072, C_A = 3088, C_Z = 3104, C_GA = 3616, C_GD = 4640;

namespace pg8 {
#define PG8_LAS __attribute__((address_space(3)))
typedef unsigned short bf16_t;
typedef short bf16x8 __attribute__((ext_vector_type(8)));
typedef float f32x4 __attribute__((ext_vector_type(4)));
typedef unsigned u32x4 __attribute__((ext_vector_type(4)));
typedef unsigned u32x2 __attribute__((ext_vector_type(2)));
constexpr int BM = 256, BK = 64, HALF = 128, HTB = HALF * BK * 2  , STAGE_BYTES = 8 * HTB, NXCD = 8, WGM = 8;

__host__ __device__ __forceinline__ int lds_byte(int r, int c) { const int st = (r >> 4) * 2 + (c >> 5), rr = r & 15, cc = c & 31, ob = rr * 64 + cc * 2; return st * 1024 + (ob ^ (((ob >> 9) & 1) << 5)); }
__host__ __device__ __forceinline__ void stage_rc(int b, int& R, int& C) { const int st = b / 1024, sb = b % 1024, swz = sb ^ (((sb >> 9) & 1) << 5); R = (st >> 1) * 16 + swz / 64; C = (st & 1) * 32 + (swz % 64) / 2; }
__host__ __device__ __forceinline__ int perm32(int rho) { const int n = rho >> 4, i = rho & 15; return 8 * (i >> 2) + 4 * n + (i & 3); }

struct Unit { int pm, pn; };
struct Gemm { const bf16_t* A; const bf16_t* Bt; int M, N, K; };

struct StaticOrder {
    int nM, nN, nwg, G, c;
    __host__ __device__ void init(int M, int N, int G_, int c_) { nM = M / BM; nN = N / BM; nwg = nM * nN; G = G_; c = c_; }
    __host__ __device__ bool next(int i, Unit& u) const {
        const long L = (long)i * G + c; if (L >= nwg) return false;
        int wgid = (int)L; { const int q = nwg / NXCD, r = nwg % NXCD, xcd = wgid % NXCD, off = wgid / NXCD; wgid = (xcd < r ? xcd * (q + 1) : r * (q + 1) + (xcd - r) * q) + off; }
        const int nig = WGM * nN, gid = wgid / nig, fm = gid * WGM, gsz = (nM - fm) < WGM ? (nM - fm) : WGM;
        u.pm = fm + ((wgid % nig) % gsz); u.pn = (wgid % nig) / gsz; return true;
    }
    __device__ __forceinline__ void a_ready(const Unit&) const {}
    __device__ __forceinline__ void done(const Unit&) const {}
};

__device__ __forceinline__ unsigned cvt_pk_bf16(float lo, float hi) { unsigned r; asm volatile("v_cvt_pk_bf16_f32 %0, %1, %2" : "=v"(r) : "v"(lo), "v"(hi)); return r; }
__device__ __forceinline__ float bf_lo(unsigned w) { return __uint_as_float(w << 16); }
__device__ __forceinline__ float bf_hi(unsigned w) { return __uint_as_float(w & 0xffff0000u); }
__device__ __forceinline__ float sigmoidf_(float x) { return 1.0f / (1.0f + __expf(-x)); }
__device__ __forceinline__ u32x4 pack8(const f32x4& v0, const f32x4& v1) { u32x4 w; w.x = cvt_pk_bf16(v0[0], v0[1]); w.y = cvt_pk_bf16(v0[2], v0[3]); w.z = cvt_pk_bf16(v1[0], v1[1]); w.w = cvt_pk_bf16(v1[2], v1[3]); return w; }


struct EpiInProj {
    static constexpr bool PERM = true, AFTER_DRAIN = false;
    bf16_t* P; float* ko; float* vo; float* BA; bf16_t* VT; const float* rope;
    __device__ __forceinline__ void operator()(const f32x4 (&acc)[2][2][4][2], const Unit& u, int wr, int wc, int fr, int fq) const {
        const int pn = u.pn, pm = u.pm;
        const bool lat = pm >= 32;
        const bool do_rope = lat && pn < 4;
        const bool do_kv = (!lat) && pn >= 2 && pn < 6;
        const bool do_vt = pn == 4 || pn == 5;
        const bool do_ba = pn == 12 && wc == 0;
        const int lane_hi = fq >> 1;
#pragma unroll
        for (int ai = 0; ai < 2; ++ai)
#pragma unroll
            for (int m = 0; m < 4; ++m) {
                const int row = pm * BM + ai * HALF + wr * 64 + m * 16 + fr;
#pragma unroll
                for (int bj = 0; bj < 2; ++bj) {
                    f32x4 v0 = acc[ai][bj][m][0], v1 = acc[ai][bj][m][1];
                    const int col = pn * BM + bj * HALF + wc * 32 + 8 * fq;
                    if (do_rope) {
                        const int t = (row - M_CTX) & 1023;
                        const int pos = (wc & 1) ? (t & 63) : (t >> 6);
                        const float* cp = rope + pos * 16 + 8 * (fq & 1);
                        const f32x4 c0 = *(const f32x4*)cp, c1 = *(const f32x4*)(cp + 4), s0 = *(const f32x4*)(cp + 1024), s1 = *(const f32x4*)(cp + 1028);
                        f32x4 p0, p1;
#pragma unroll
                        for (int i = 0; i < 4; ++i) { p0[i] = __shfl_xor(v0[i], 32); p1[i] = __shfl_xor(v1[i], 32); }
                        if (lane_hi) { v0 = p0 * s0 + v0 * c0; v1 = p1 * s1 + v1 * c1; }
                        else         { v0 = v0 * c0 - p0 * s0; v1 = v1 * c1 - p1 * s1; }
                    }
                    *(u32x4*)(P + (size_t)row * NINP + col) = pack8(v0, v1);
                    if (do_kv) {
                        const int hh = ((pn & 1) * 4) + bj * 2 + (wc >> 1);
                        const int d = (wc & 1) * 32 + 8 * fq;
                        float* dst = (pn < 4 ? ko : vo) + ((size_t)(pm * 8 + hh) * 256 + (row & 255)) * 64 + d;
                        *(f32x4*)dst = v0; *(f32x4*)(dst + 4) = v1;
                    }
                    if (do_vt) {
                        const int hh = ((pn & 1) * 4) + bj * 2 + (wc >> 1);
                        const int d = (wc & 1) * 32 + 8 * fq;
                        size_t base; int t, T;
                        if (!lat) { t = row & 255; T = 256; base = (size_t)(pm * 8 + hh) * 64 * 256; }
                        else { const int rl = row - M_CTX; t = rl & 1023; T = 1024; base = (size_t)M_CTX * 512 + (size_t)((rl >> 10) * 8 + hh) * 64 * 1024; }
                        const int pos = (t & ~12) | ((t & 4) << 1) | ((t & 8) >> 1);
                        bf16_t* dst = VT + base + (size_t)d * T + pos;
                        const u32x4 w = pack8(v0, v1);
                        dst[0] = (bf16_t)(w.x & 0xffff); dst[(size_t)T] = (bf16_t)(w.x >> 16); dst[(size_t)2 * T] = (bf16_t)(w.y & 0xffff); dst[(size_t)3 * T] = (bf16_t)(w.y >> 16);
                        dst[(size_t)4 * T] = (bf16_t)(w.z & 0xffff); dst[(size_t)5 * T] = (bf16_t)(w.z >> 16); dst[(size_t)6 * T] = (bf16_t)(w.w & 0xffff); dst[(size_t)7 * T] = (bf16_t)(w.w >> 16);
                    }
                    if (do_ba && bj == 0) { float* dst = BA + (size_t)row * 32 + 8 * fq; *(f32x4*)dst = v0; *(f32x4*)(dst + 4) = v1; }
                }
            }
    }
};

struct EpiGate1 {
    static constexpr bool PERM = true, AFTER_DRAIN = false;
    const bf16_t* P; bf16_t* M1;
    __device__ __forceinline__ void operator()(const f32x4 (&acc)[2][2][4][2], const Unit& u, int wr, int wc, int fr, int fq) const {
#pragma unroll
        for (int ai = 0; ai < 2; ++ai)
#pragma unroll
            for (int m = 0; m < 4; ++m) {
                const int row = u.pm * BM + ai * HALF + wr * 64 + m * 16 + fr;
#pragma unroll
                for (int bj = 0; bj < 2; ++bj) {
                    const int col = u.pn * BM + bj * HALF + wc * 32 + 8 * fq;
                    const u32x4 g = *(const u32x4*)(P + (size_t)row * NINP + C_GA + col);
                    f32x4 v0 = acc[ai][bj][m][0], v1 = acc[ai][bj][m][1];
                    v0[0] *= sigmoidf_(bf_lo(g.x)); v0[1] *= sigmoidf_(bf_hi(g.x)); v0[2] *= sigmoidf_(bf_lo(g.y)); v0[3] *= sigmoidf_(bf_hi(g.y));
                    v1[0] *= sigmoidf_(bf_lo(g.z)); v1[1] *= sigmoidf_(bf_hi(g.z)); v1[2] *= sigmoidf_(bf_lo(g.w)); v1[3] *= sigmoidf_(bf_hi(g.w));
                    *(u32x4*)(M1 + (size_t)row * DM + col) = pack8(v0, v1);
                }
            }
    }
};
struct EpiGate2 {
    static constexpr bool PERM = true, AFTER_DRAIN = false;
    const bf16_t* P; const bf16_t* M1; bf16_t* O;
    __device__ __forceinline__ void operator()(const f32x4 (&acc)[2][2][4][2], const Unit& u, int wr, int wc, int fr, int fq) const {
#pragma unroll
        for (int ai = 0; ai < 2; ++ai)
#pragma unroll
            for (int m = 0; m < 4; ++m) {
                const int row = u.pm * BM + ai * HALF + wr * 64 + m * 16 + fr;
#pragma unroll
                for (int bj = 0; bj < 2; ++bj) {
                    const int col = u.pn * BM + bj * HALF + wc * 32 + 8 * fq;
                    const u32x4 g = *(const u32x4*)(P + (size_t)row * NINP + C_GD + col);
                    const u32x4 q = *(const u32x4*)(M1 + (size_t)row * DM + col);
                    f32x4 v0 = acc[ai][bj][m][0], v1 = acc[ai][bj][m][1];
                    v0[0] = bf_lo(q.x) + v0[0] * sigmoidf_(bf_lo(g.x)); v0[1] = bf_hi(q.x) + v0[1] * sigmoidf_(bf_hi(g.x)); v0[2] = bf_lo(q.y) + v0[2] * sigmoidf_(bf_lo(g.y)); v0[3] = bf_hi(q.y) + v0[3] * sigmoidf_(bf_hi(g.y));
                    v1[0] = bf_lo(q.z) + v1[0] * sigmoidf_(bf_lo(g.z)); v1[1] = bf_hi(q.z) + v1[1] * sigmoidf_(bf_hi(g.z)); v1[2] = bf_lo(q.w) + v1[2] * sigmoidf_(bf_lo(g.w)); v1[3] = bf_hi(q.w) + v1[3] * sigmoidf_(bf_hi(g.w));
                    *(u32x4*)(O + (size_t)row * DM + col) = pack8(v0, v1);
                }
            }
    }
};
struct EpiRss {
    static constexpr bool PERM = true, AFTER_DRAIN = false;
    bf16_t* O; float* RSS;
    __device__ __forceinline__ void operator()(const f32x4 (&acc)[2][2][4][2], const Unit& u, int wr, int wc, int fr, int fq) const {
#pragma unroll
        for (int ai = 0; ai < 2; ++ai)
#pragma unroll
            for (int m = 0; m < 4; ++m) {
                const int row = u.pm * BM + ai * HALF + wr * 64 + m * 16 + fr;
                float s = 0.f;
#pragma unroll
                for (int bj = 0; bj < 2; ++bj) {
                    const int col = u.pn * BM + bj * HALF + wc * 32 + 8 * fq;
                    const f32x4 v0 = acc[ai][bj][m][0], v1 = acc[ai][bj][m][1];
                    s += (v0[0] * v0[0] + v0[1] * v0[1]) + (v0[2] * v0[2] + v0[3] * v0[3]) + (v1[0] * v1[0] + v1[1] * v1[1]) + (v1[2] * v1[2] + v1[3] * v1[3]);
                    *(u32x4*)(O + (size_t)row * DM + col) = pack8(v0, v1);
                }
                s += __shfl_xor(s, 16); s += __shfl_xor(s, 32);
                if (fq == 0) RSS[(size_t)row * 16 + u.pn * 4 + wc] = s;
            }
    }
};
struct EpiRelu2 {
    static constexpr bool PERM = true, AFTER_DRAIN = false;
    bf16_t* O;
    __device__ __forceinline__ void operator()(const f32x4 (&acc)[2][2][4][2], const Unit& u, int wr, int wc, int fr, int fq) const {
#pragma unroll
        for (int ai = 0; ai < 2; ++ai)
#pragma unroll
            for (int m = 0; m < 4; ++m) {
                const int row = u.pm * BM + ai * HALF + wr * 64 + m * 16 + fr;
#pragma unroll
                for (int bj = 0; bj < 2; ++bj) {
                    const int col = u.pn * BM + bj * HALF + wc * 32 + 8 * fq;
                    f32x4 v0 = acc[ai][bj][m][0], v1 = acc[ai][bj][m][1];
#pragma unroll
                    for (int i = 0; i < 4; ++i) { const float a = fmaxf(v0[i], 0.f), b = fmaxf(v1[i], 0.f); v0[i] = a * a; v1[i] = b * b; }
                    *(u32x4*)(O + (size_t)row * FF + col) = pack8(v0, v1);
                }
            }
    }
};

template <class Epi, class Sched, bool ALIGN_EPI = false, bool SP2 = false>
__device__ __forceinline__ void gemm_phase(PG8_LAS unsigned char* lds, const Gemm g, const Sched& S, const Epi& E) {
    const int tid = threadIdx.x, wid = __builtin_amdgcn_readfirstlane(tid >> 6), lane = tid & 63, wr = wid >> 2, wc = wid & 3, fr = lane & 15, fq = lane >> 4;
    const int K = g.K, nt = K / BK;
    unsigned voffA[2], voffB[2];
#pragma unroll
    for (int i = 0; i < 2; ++i) { int R, C; stage_rc(tid * 16 + i * 8192, R, C); const int Rb = Epi::PERM ? ((R & ~31) + perm32(R & 31)) : R;
        voffA[i] = (unsigned)(R * K + C) * 2u; voffB[i] = (unsigned)(Rb * K + C) * 2u; }
    const size_t kstep = (size_t)(BK * 2);
    const size_t hstep = (size_t)HALF * K * 2;
    const size_t tstep = 2 * hstep;
    const unsigned ldsw = (unsigned)wid * 1024u;
    const int aoff = lds_byte(wr * 64 + fr, fq * 8), boff = lds_byte(wc * 32 + fr, fq * 8);
#define PG8_SA(b, h) (((b) * 2 + (h)) * HTB)
#define PG8_SB(b, h) ((4 + (b) * 2 + (h)) * HTB)
#define PG8_STAGE(bufoff, gbase, voff) do { _Pragma("unroll") for (int _i = 0; _i < 2; ++_i) \
        __builtin_amdgcn_global_load_lds((const unsigned*)((const char*)(gbase) + (voff)[_i]), (PG8_LAS unsigned*)(lds + (bufoff) + ldsw + _i * 8192), 16, 0, 0); } while (0)
#define PG8_LDA(dst, b, h) do { _Pragma("unroll") for (int m = 0; m < 4; ++m) _Pragma("unroll") for (int k = 0; k < 2; ++k) dst[m][k] = *(const PG8_LAS bf16x8*)(lds + PG8_SA(b, h) + aoff + m * 2048 + k * 1024); } while (0)
#define PG8_LDB(dst, b, h) do { _Pragma("unroll") for (int n = 0; n < 2; ++n) _Pragma("unroll") for (int k = 0; k < 2; ++k) dst[n][k] = *(const PG8_LAS bf16x8*)(lds + PG8_SB(b, h) + boff + n * 2048 + k * 1024); } while (0)
#define PG8_MMA(ai, bj, At, Bt) do { __builtin_amdgcn_s_setprio(1); _Pragma("unroll") for (int m = 0; m < 4; ++m) _Pragma("unroll") for (int n = 0; n < 2; ++n) _Pragma("unroll") for (int k = 0; k < 2; ++k) \
        acc[ai][bj][m][n] = __builtin_amdgcn_mfma_f32_16x16x32_bf16(Bt[n][k], At[m][k], acc[ai][bj][m][n], 0, 0, 0); __builtin_amdgcn_s_setprio(0); } while (0)
#define PG8_WAIT_V(n) asm volatile("s_waitcnt vmcnt(" #n ")" ::: "memory")
#define PG8_WAIT_L(n) asm volatile("s_waitcnt lgkmcnt(" #n ")" ::: "memory")
#define PG8_BAR __builtin_amdgcn_s_barrier()
#define PG8_SCHED __builtin_amdgcn_sched_barrier(0)
    Unit cur, nxt; int ui = 0;
    if (!S.next(0, cur)) return;
    f32x4 acc[2][2][4][2];
#pragma unroll
    for (int a = 0; a < 2; ++a)
#pragma unroll
        for (int b = 0; b < 2; ++b)
#pragma unroll
            for (int m = 0; m < 4; ++m)
#pragma unroll
                for (int n = 0; n < 2; ++n) acc[a][b][m][n] = (f32x4){0.f, 0.f, 0.f, 0.f};
    bf16x8 At[4][2], B0[2][2], B1[2][2];
    const char* cA = (const char*)g.A + (size_t)cur.pm * tstep; const char* cB = (const char*)g.Bt + (size_t)cur.pn * tstep;
    S.a_ready(cur);
    if constexpr (SP2) {
        PG8_STAGE(PG8_SB(0, 0), cB, voffB); PG8_STAGE(PG8_SB(0, 1), cB + hstep, voffB); PG8_STAGE(PG8_SA(0, 0), cA, voffA); PG8_STAGE(PG8_SA(0, 1), cA + hstep, voffA);
        if (wr == 1) PG8_BAR;
        PG8_WAIT_V(2); PG8_BAR;
        PG8_STAGE(PG8_SB(1, 0), cB + kstep, voffB); PG8_STAGE(PG8_SA(1, 0), cA + kstep, voffA); PG8_STAGE(PG8_SB(1, 1), cB + hstep + kstep, voffB);
        PG8_WAIT_V(6); PG8_BAR;
    } else {
        PG8_STAGE(PG8_SB(0, 0), cB, voffB); PG8_STAGE(PG8_SA(0, 0), cA, voffA); PG8_STAGE(PG8_SB(0, 1), cB + hstep, voffB); PG8_STAGE(PG8_SA(0, 1), cA + hstep, voffA);
        if (wr == 1) PG8_BAR;
        PG8_WAIT_V(4); PG8_BAR;
        PG8_STAGE(PG8_SB(1, 0), cB + kstep, voffB); PG8_STAGE(PG8_SA(1, 0), cA + kstep, voffA); PG8_STAGE(PG8_SB(1, 1), cB + hstep + kstep, voffB);
        PG8_WAIT_V(6); PG8_BAR;
    }
    for (;;) {
        const bool has_next = S.next(ui + 1, nxt);
        const char* nA = has_next ? (const char*)g.A + (size_t)nxt.pm * tstep : cA; const char* nB = has_next ? (const char*)g.Bt + (size_t)nxt.pn * tstep : cB;
        for (int t = 0; t < nt; t += 2) {
            const bool last = (t == nt - 2);
            const char* a1 = cA + (size_t)(t + 1) * kstep;
            const char* a2 = last ? nA : cA + (size_t)(t + 2) * kstep; const char* b2 = last ? nB : cB + (size_t)(t + 2) * kstep;
            const char* a3 = a2 + kstep; const char* b3 = b2 + kstep;
            if (last && has_next) S.a_ready(nxt);
            if constexpr (SP2) {
            PG8_LDB(B0, 0, 0); PG8_LDB(B1, 0, 1); PG8_SCHED; PG8_LDA(At, 0, 0); PG8_STAGE(PG8_SA(1, 1), a1 + hstep, voffA);
            PG8_WAIT_V(8); PG8_WAIT_L(0); PG8_BAR; PG8_MMA(0, 0, At, B0); PG8_MMA(0, 1, At, B1); PG8_BAR; PG8_SCHED;
            PG8_LDA(At, 0, 1); PG8_STAGE(PG8_SB(0, 0), b2, voffB); PG8_STAGE(PG8_SB(0, 1), b2 + hstep, voffB); PG8_STAGE(PG8_SA(0, 0), a2, voffA);
            PG8_WAIT_V(8); PG8_WAIT_L(0); PG8_BAR; PG8_MMA(1, 0, At, B0); PG8_MMA(1, 1, At, B1); PG8_BAR; PG8_SCHED;
            PG8_LDB(B0, 1, 0); PG8_LDB(B1, 1, 1); PG8_SCHED; PG8_LDA(At, 1, 0); PG8_STAGE(PG8_SA(0, 1), a2 + hstep, voffA);
            PG8_WAIT_V(8); PG8_WAIT_L(0); PG8_BAR; PG8_MMA(0, 0, At, B0); PG8_MMA(0, 1, At, B1); PG8_BAR; PG8_SCHED;
            PG8_LDA(At, 1, 1); PG8_STAGE(PG8_SB(1, 0), b3, voffB); PG8_STAGE(PG8_SB(1, 1), b3 + hstep, voffB); PG8_STAGE(PG8_SA(1, 0), a3, voffA);
            PG8_WAIT_V(8); PG8_WAIT_L(0); PG8_BAR; PG8_MMA(1, 0, At, B0); PG8_MMA(1, 1, At, B1); PG8_BAR; PG8_SCHED;
            } else {
            PG8_LDB(B0, 0, 0); PG8_SCHED; PG8_LDA(At, 0, 0); PG8_STAGE(PG8_SA(1, 1), a1 + hstep, voffA);
            PG8_WAIT_L(8); PG8_BAR; PG8_WAIT_L(0); PG8_MMA(0, 0, At, B0); PG8_BAR; PG8_SCHED;
            PG8_LDB(B1, 0, 1); PG8_STAGE(PG8_SB(0, 0), b2, voffB);
            PG8_BAR; PG8_WAIT_L(0); PG8_MMA(0, 1, At, B1); PG8_BAR;
            PG8_LDA(At, 0, 1); PG8_STAGE(PG8_SA(0, 0), a2, voffA);
            PG8_BAR; PG8_WAIT_L(0); PG8_MMA(1, 0, At, B0); PG8_BAR; PG8_SCHED;
            PG8_STAGE(PG8_SB(0, 1), b2 + hstep, voffB);
            PG8_WAIT_V(6); PG8_BAR; PG8_MMA(1, 1, At, B1); PG8_BAR;
            PG8_LDB(B0, 1, 0); PG8_SCHED; PG8_LDA(At, 1, 0); PG8_STAGE(PG8_SA(0, 1), a2 + hstep, voffA);
            PG8_WAIT_L(8); PG8_BAR; PG8_WAIT_L(0); PG8_MMA(0, 0, At, B0); PG8_BAR; PG8_SCHED;
            PG8_LDB(B1, 1, 1); PG8_STAGE(PG8_SB(1, 0), b3, voffB);
            PG8_BAR; PG8_WAIT_L(0); PG8_MMA(0, 1, At, B1); PG8_BAR;
            PG8_LDA(At, 1, 1); PG8_STAGE(PG8_SA(1, 0), a3, voffA);
            PG8_BAR; PG8_WAIT_L(0); PG8_MMA(1, 0, At, B0); PG8_BAR; PG8_SCHED;
            PG8_STAGE(PG8_SB(1, 1), b3 + hstep, voffB);
            PG8_WAIT_V(6); PG8_BAR; PG8_MMA(1, 1, At, B1); PG8_BAR;
            }
        }
        if constexpr (ALIGN_EPI) { if (wr == 0) PG8_BAR; }
        if constexpr (!Epi::AFTER_DRAIN) { E(acc, cur, wr, wc, fr, fq); S.done(cur); }
        if (!has_next) break;
#pragma unroll
        for (int a = 0; a < 2; ++a)
#pragma unroll
            for (int b = 0; b < 2; ++b)
#pragma unroll
                for (int m = 0; m < 4; ++m)
#pragma unroll
                    for (int n = 0; n < 2; ++n) acc[a][b][m][n] = (f32x4){0.f, 0.f, 0.f, 0.f};
        cur = nxt; cA = nA; cB = nB; ++ui;
        if constexpr (ALIGN_EPI) { if (wr == 1) PG8_BAR; }
    }
    PG8_WAIT_V(0);
    if constexpr (!ALIGN_EPI) { if (wr == 0) PG8_BAR; }
    PG8_BAR;
    if constexpr (Epi::AFTER_DRAIN) { E.fused(acc, cur, wr, wc, fr, fq, lds, wid, lane); S.done(cur); }
#undef PG8_SA
#undef PG8_SB
#undef PG8_STAGE
#undef PG8_LDA
#undef PG8_LDB
#undef PG8_MMA
#undef PG8_WAIT_V
#undef PG8_WAIT_L
#undef PG8_BAR
#undef PG8_SCHED
}
}

constexpr int NWAVES = 8;
constexpr size_t MiB = 1u << 20;
constexpr size_t WS_CTL = 0, CTL_ZERO_BYTES = 64 * 1024;
constexpr size_t WS_MOD = 1 * MiB;
constexpr size_t WS_ROPE = 1 * MiB + 256 * 1024;
constexpr size_t WS_BA = 2 * MiB;
constexpr size_t WS_RSS1 = 4 * MiB, WS_RSS2 = 5 * MiB;
constexpr size_t WS_WIN = 6 * MiB, WS_WAO = 18 * MiB, WS_WDO = 19 * MiB, WS_WOUT = 20 * MiB, WS_W1 = 22 * MiB, WS_W2 = 30 * MiB;
constexpr size_t WS_XN = 38 * MiB;
constexpr size_t WS_ONA = 62 * MiB, WS_ODN = 74 * MiB;
constexpr size_t WS_P = 86 * MiB;
constexpr size_t WS_M1 = 224 * MiB;
constexpr size_t WS_CK = 248 * MiB, WS_CVT = 249 * MiB;
constexpr size_t WS_END = 256 * MiB;
constexpr size_t OUT_YP = 0, OUT_YS = (size_t)M_CTX * DM, OUT_K = (size_t)MT * DM, OUT_V = OUT_K + (size_t)32 * 8 * 256 * 64, OUT_S = OUT_V + (size_t)32 * 8 * 256 * 64;

constexpr int CW_BAR = 1024;
constexpr int RING_BYTES = 131072, LDSCTL_OFF = RING_BYTES, MISC_OFF = LDSCTL_OFF + 320, LDS_BYTES = 147456;

#define GAS __attribute__((address_space(1)))
#define LAS __attribute__((address_space(3)))
typedef unsigned short bf16;
typedef unsigned v4u __attribute__((ext_vector_type(4)));
typedef unsigned v2u __attribute__((ext_vector_type(2)));
typedef float f32x4 __attribute__((ext_vector_type(4)));
typedef float f32x16 __attribute__((ext_vector_type(16)));
typedef short bf16x8 __attribute__((ext_vector_type(8)));
#define LDS_WAIT() asm volatile("s_waitcnt lgkmcnt(0)" ::: "memory")
#define VM_WAIT() asm volatile("s_waitcnt vmcnt(0)" ::: "memory")
#define MFMA32(a, b, c) __builtin_amdgcn_mfma_f32_32x32x16_bf16((a), (b), (c), 0, 0, 0)
__device__ __forceinline__ unsigned f2bf(float f) { unsigned u = __builtin_bit_cast(unsigned, f); return (u + 0x7fffu + ((u >> 16) & 1u)) >> 16; }
typedef float f32x2_t __attribute__((ext_vector_type(2))); typedef __bf16 bf16x2_t __attribute__((ext_vector_type(2)));
__device__ __forceinline__ unsigned pk2(float lo, float hi) { f32x2_t v = {lo, hi}; bf16x2_t b = __builtin_convertvector(v, bf16x2_t); return __builtin_bit_cast(unsigned, b); }
__device__ __forceinline__ float bflo(unsigned w) { return __uint_as_float(w << 16); }
__device__ __forceinline__ float bfhi(unsigned w) { return __uint_as_float(w & 0xffff0000u); }
__device__ __forceinline__ float silu_(float x) { return x / (1.0f + __expf(-x)); }
__device__ __forceinline__ float sigm_(float x) { return 1.0f / (1.0f + __expf(-x)); }
__device__ __forceinline__ int crow(int reg, int h) { return (reg & 3) + 8 * (reg >> 2) + 4 * h; }
__device__ __forceinline__ float wave_sum(float v) {
#pragma unroll
    for (int o = 1; o < 64; o <<= 1) v += __shfl_xor(v, o);
    return v;
}

#define XB_TMO      128
#define XB_XCNT(j)  (256  + 64 * (j))
#define XB_XSUB(j)  (1280 + 64 * (j))
#define XB_XGEN(j)  (2304 + 64 * (j))
#define XB_TOP      3328
#define XB_TOPGEN   3392
#define XCD_BAR_WORDS 3456
#define XB_SPIN_CAP (1u << 22)

__device__ __forceinline__ unsigned xb_ld(unsigned* p)              { return __hip_atomic_load(p, __ATOMIC_RELAXED, __HIP_MEMORY_SCOPE_AGENT); }
__device__ __forceinline__ unsigned xb_add(unsigned* p, unsigned v) { return __hip_atomic_fetch_add(p, v, __ATOMIC_RELAXED, __HIP_MEMORY_SCOPE_AGENT); }
__device__ __forceinline__ unsigned xb_xcc_id() { return (unsigned)__builtin_amdgcn_s_getreg((3 << 11) | 20) & 0xFu; }
#define XB_SPIN(cond, bar) do { unsigned _sp = 0; while (cond) { __builtin_amdgcn_s_sleep(1); \
    if ((++_sp & 255u) == 0u) { if (xb_ld(&(bar)[XB_TMO])) break; if (_sp > XB_SPIN_CAP) { atomicAdd(&(bar)[XB_TMO], 1u); break; } } } } while (0)

struct XcdBarrier { unsigned* bar; unsigned x; volatile LAS unsigned* st; };

__device__ __forceinline__ XcdBarrier xcd_barrier_post(unsigned* bar, volatile LAS unsigned* st) {
    XcdBarrier b; b.bar = bar; b.x = xb_xcc_id(); b.st = st;
    if (threadIdx.x == 0) (void)xb_add(&bar[XB_XCNT(b.x)], 1u);
    return b;
}
__device__ __forceinline__ void xcd_barrier_complete(unsigned* bar, unsigned x, unsigned& nloc, unsigned& nx) {
    const unsigned G = gridDim.x * gridDim.y * gridDim.z;
    unsigned sum, cnt, mine, sp = 0u;
    for (;;) {
        sum = 0u; cnt = 0u; mine = 0u;
#pragma unroll
        for (unsigned j = 0; j < 16; ++j) { const unsigned c = xb_ld(&bar[XB_XCNT(j)]); sum += c; cnt += (c > 0u) ? 1u : 0u; mine = (j == x) ? c : mine; }
        if (sum == G) break;
        __builtin_amdgcn_s_sleep(1);
        if ((++sp & 255u) == 0u) { if (xb_ld(&bar[XB_TMO])) break; if (sp > XB_SPIN_CAP) { atomicAdd(&bar[XB_TMO], 1u); break; } }
    }
    nloc = mine > 0u ? mine : 1u; nx = cnt > 0u ? cnt : 1u;
}
__device__ __forceinline__ void xcd_barrier(const XcdBarrier& b) {
    asm volatile("s_waitcnt vmcnt(0)" ::: "memory");
    __syncthreads();
    if (threadIdx.x == 0) {
        unsigned* bar = b.bar;
        __builtin_amdgcn_s_waitcnt(0);
        unsigned nloc = b.st[0], nx = b.st[1];
        if (nloc == 0u) { xcd_barrier_complete(bar, b.x, nloc, nx); b.st[0] = nloc; b.st[1] = nx; }
        const unsigned old = xb_add(&bar[XB_XSUB(b.x)], 1u);
        const unsigned gen = old / nloc;
        if (old + 1u == (gen + 1u) * nloc) {
            __builtin_amdgcn_fence(__ATOMIC_RELEASE, "agent");
            asm volatile("s_waitcnt vmcnt(0)" ::: "memory");
            const unsigned og = xb_add(&bar[XB_TOP], 1u);
            const unsigned tg = og / nx;
            if (og + 1u == (tg + 1u) * nx) xb_add(&bar[XB_TOPGEN], 1u);
            else XB_SPIN(xb_ld(&bar[XB_TOPGEN]) == tg, bar);
            __builtin_amdgcn_fence(__ATOMIC_ACQUIRE, "agent");
            xb_add(&bar[XB_XGEN(b.x)], 1u);
            asm volatile("s_waitcnt vmcnt(0)" ::: "memory");
        } else {
            XB_SPIN(xb_ld(&bar[XB_XGEN(b.x)]) == gen, bar);
            __builtin_amdgcn_fence(__ATOMIC_ACQUIRE, "agent");
            asm volatile("s_waitcnt vmcnt(0)" ::: "memory");
        }
    }
    __syncthreads();
}

struct Args { const float* in[24]; float* out; unsigned char* ws; int ph_lo, ph_hi; };
enum { I_XP = 0, I_XS, I_C, I_CK, I_CV, I_ST, I_CCTX, I_WADA, I_BADA, I_PRE1, I_POST1, I_PRE2, I_POST2, I_WIN, I_CONVW, I_ALOG, I_DTB, I_DNN, I_RPB, I_WAO, I_WDO, I_WOUT, I_WFF1, I_WFF2 };

__device__ __forceinline__ void p0_transpose_item(const float* W, int K, int N, bf16* WT, LAS float* scr, int item, int lane) {
    const int nblk = N / 32, kb = item / nblk, nb = item % nblk, k0 = 64 * kb, n0 = 32 * nb;
#pragma unroll 8
    for (int i = 0; i < 32; ++i) { const int kk = 2 * i + (lane >> 5); scr[kk * 33 + (lane & 31)] = W[(size_t)(k0 + kk) * N + n0 + (lane & 31)]; }
    LDS_WAIT();
    const int c = lane & 7;
#pragma unroll
    for (int j = 0; j < 4; ++j) { const int n = (lane >> 3) + 8 * j; const LAS float* s = scr + (8 * c) * 33 + n;
        v4u o; o.x = pk2(s[0 * 33], s[1 * 33]); o.y = pk2(s[2 * 33], s[3 * 33]); o.z = pk2(s[4 * 33], s[5 * 33]); o.w = pk2(s[6 * 33], s[7 * 33]);
        *(v4u*)(WT + (size_t)(n0 + n) * K + k0 + 8 * c) = o; }
    LDS_WAIT();
}

__device__ __forceinline__ void phase_prologue(const Args& a, LAS unsigned char* lds, int vcu, int G) {
    const int tid = threadIdx.x, lane = tid & 63, wave = __builtin_amdgcn_readfirstlane(tid >> 6);
    unsigned char* ws = a.ws;
    if (vcu < 192) {
        LAS float* sl = (LAS float*)lds;
        LAS float* red = (LAS float*)(lds + 20480);
        for (int i = tid; i < 5 * 1024; i += 512) { const float v = i < 1024 ? a.in[I_CCTX][i] : a.in[I_C][i - 1024]; sl[i] = silu_(v); }
        __syncthreads();
        const int col = 32 * vcu + (lane & 31), rg = wave * 2 + (lane >> 5);
        const float* w = a.in[I_WADA] + (size_t)(rg * 64) * 6144 + col;
        float acc[5] = {0.f, 0.f, 0.f, 0.f, 0.f};
#pragma unroll 8
        for (int i = 0; i < 64; ++i) { const float wv = w[(size_t)i * 6144]; const int k = rg * 64 + i;
#pragma unroll
            for (int v = 0; v < 5; ++v) acc[v] += sl[v * 1024 + k] * wv; }
#pragma unroll
        for (int v = 0; v < 5; ++v) red[(rg * 5 + v) * 32 + (lane & 31)] = acc[v];
        __syncthreads();
        if (tid < 160) { const int v = tid >> 5, cl = tid & 31; float s = a.in[I_BADA][32 * vcu + cl];
            for (int r = 0; r < 16; ++r) s += red[(r * 5 + v) * 32 + cl];
            ((float*)(ws + WS_MOD))[v * 6144 + 32 * vcu + cl] = s; }
        __syncthreads();
    } else if (vcu == 192) {
        float* rope = (float*)(ws + WS_ROPE);
        for (int i = tid; i < 1024; i += 512) { const int pos = i >> 4, f = i & 15; const float inv = powf(10000.0f, -(float)f / 16.0f); const float ang = (float)pos * inv; rope[i] = cosf(ang); rope[1024 + i] = sinf(ang); }
    } else if (vcu < 225) {
        const int bh = vcu - 193;
        const float* ck = a.in[I_CK] + (size_t)bh * 256 * 64; const float* cv = a.in[I_CV] + (size_t)bh * 256 * 64;
        bf16* CK = (bf16*)(ws + WS_CK) + (size_t)bh * 256 * 64; bf16* CVT = (bf16*)(ws + WS_CVT) + (size_t)bh * 64 * 256;
        for (int i = tid; i < 256 * 8; i += 512) { const int key = i >> 3, c8 = i & 7;
            const f32x4 k0 = *(const f32x4*)(ck + key * 64 + c8 * 8), k1 = *(const f32x4*)(ck + key * 64 + c8 * 8 + 4);
            v4u o; o.x = pk2(k0[0], k0[1]); o.y = pk2(k0[2], k0[3]); o.z = pk2(k1[0], k1[1]); o.w = pk2(k1[2], k1[3]);
            *(v4u*)(CK + key * 64 + c8 * 8) = o;
            const f32x4 v0 = *(const f32x4*)(cv + key * 64 + c8 * 8), v1 = *(const f32x4*)(cv + key * 64 + c8 * 8 + 4);
            const int pos = (key & ~12) | ((key & 4) << 1) | ((key & 8) >> 1);
#pragma unroll
            for (int j = 0; j < 4; ++j) { CVT[(c8 * 8 + j) * 256 + pos] = (bf16)f2bf(v0[j]); CVT[(c8 * 8 + 4 + j) * 256 + pos] = (bf16)f2bf(v1[j]); }
        }
    }
    LAS float* scr = (LAS float*)(lds + 32768 + wave * 8704);
    const int gw = vcu * NWAVES + wave, NGW = G * NWAVES;
    constexpr int I_IN = 16 * 177, I_AO = 8 * 32, I_DO = 8 * 32, I_OUT = 16 * 32, I_1 = 16 * 128, I_2 = 64 * 32;
    constexpr int NITEMS = I_IN + I_AO + I_DO + I_OUT + I_1 + I_2;
    for (int it = gw; it < NITEMS; it += NGW) {
        int r = it;
        if (r < I_IN) { p0_transpose_item(a.in[I_WIN], 1024, NIN, (bf16*)(ws + WS_WIN), scr, r, lane); continue; } r -= I_IN;
        if (r < I_AO) { p0_transpose_item(a.in[I_WAO], 512, 1024, (bf16*)(ws + WS_WAO), scr, r, lane); continue; } r -= I_AO;
        if (r < I_DO) { p0_transpose_item(a.in[I_WDO], 512, 1024, (bf16*)(ws + WS_WDO), scr, r, lane); continue; } r -= I_DO;
        if (r < I_OUT) { p0_transpose_item(a.in[I_WOUT], 1024, 1024, (bf16*)(ws + WS_WOUT), scr, r, lane); continue; } r -= I_OUT;
        if (r < I_1) { p0_transpose_item(a.in[I_WFF1], 1024, FF, (bf16*)(ws + WS_W1), scr, r, lane); continue; } r -= I_1;
        p0_transpose_item(a.in[I_WFF2], FF, 1024, (bf16*)(ws + WS_W2), scr, r, lane);
    }
    { v4u* z = (v4u*)((bf16*)(ws + WS_WIN) + (size_t)NIN * 1024); const int n16 = (NINP - NIN) * 1024 * 2 / 16;
      for (int i = gw * 64 + lane; i < n16; i += NGW * 64) z[i] = (v4u){0u, 0u, 0u, 0u}; }
}

__device__ __forceinline__ const float* x_row(const Args& a, int m) { return m < M_CTX ? a.in[I_XP] + (size_t)m * DM : a.in[I_XS] + (size_t)(m - M_CTX) * DM; }
__device__ __forceinline__ int mod_idx(int m) { return m < M_CTX ? 0 : 1 + ((m - M_CTX) >> 10); }

__device__ __forceinline__ void phase_xn(const Args& a, int vcu, int G) {
    const int tid = threadIdx.x, lane = tid & 63, wave = tid >> 6;
    const int gw = vcu * NWAVES + wave, NGW = G * NWAVES;
    const float* MOD = (const float*)(a.ws + WS_MOD); bf16* XN = (bf16*)(a.ws + WS_XN);
    for (int m = gw; m < MT; m += NGW) {
        const f32x4* xr = (const f32x4*)x_row(a, m) + lane;
        const float* md = MOD + mod_idx(m) * 6144;
        f32x4 v[4]; float s = 0.f;
#pragma unroll
        for (int j = 0; j < 4; ++j) { v[j] = xr[64 * j]; s += (v[j].x * v[j].x + v[j].y * v[j].y) + (v[j].z * v[j].z + v[j].w * v[j].w); }
        const float rstd = rsqrtf(wave_sum(s) * (1.f / DM) + 1e-6f);
        v2u* o8 = (v2u*)(XN + (size_t)m * DM) + lane;
#pragma unroll
        for (int j = 0; j < 4; ++j) { const int c = (lane + 64 * j) * 4;
            const f32x4 w = *(const f32x4*)(a.in[I_PRE1] + c), sh = *(const f32x4*)(md + c), sc = *(const f32x4*)(md + 1024 + c);
            const f32x4 h = v[j] * rstd * w * (sc + 1.0f) + sh;
            v2u o; o.x = pk2(h.x, h.y); o.y = pk2(h.z, h.w); o8[64 * j] = o; }
    }
}

__device__ __forceinline__ bf16x8 pack_regs(const f32x16& p, int s) {
    v4u w; w.x = pk2(p[8 * s], p[8 * s + 1]); w.y = pk2(p[8 * s + 2], p[8 * s + 3]); w.z = pk2(p[8 * s + 4], p[8 * s + 5]); w.w = pk2(p[8 * s + 6], p[8 * s + 7]);
    return __builtin_bit_cast(bf16x8, w);
}
__device__ __forceinline__ void store_o(bf16* dst, const f32x16& o0, const f32x16& o1, float inv, int hh) {
#pragma unroll
    for (int g = 0; g < 4; ++g) {
        v2u w0, w1; w0.x = pk2(o0[4 * g] * inv, o0[4 * g + 1] * inv); w0.y = pk2(o0[4 * g + 2] * inv, o0[4 * g + 3] * inv);
        w1.x = pk2(o1[4 * g] * inv, o1[4 * g + 1] * inv); w1.y = pk2(o1[4 * g + 2] * inv, o1[4 * g + 3] * inv);
        *(v2u*)(dst + 8 * g + 4 * hh) = w0; *(v2u*)(dst + 32 + 8 * g + 4 * hh) = w1;
    }
}
constexpr float LOG2E = 1.4426950408889634f;

__device__ __forceinline__ void na_ctx_task(const Args& a, int task, int lane) {
    const int qb = task & 7, h = (task >> 3) & 7, b = task >> 6;
    const int r = lane & 31, hh = lane >> 5;
    const bf16* P = (const bf16*)(a.ws + WS_P); const bf16* VT = (const bf16*)a.out + (size_t)3 * MT * 512;
    bf16* ONA = (bf16*)(a.ws + WS_ONA);
    const bf16* Pq = P + (size_t)(b * 256 + qb * 32 + r) * NINP + C_Q + h * 64 + 8 * hh;
    bf16x8 qf[4];
#pragma unroll
    for (int s = 0; s < 4; ++s) qf[s] = *(const bf16x8*)(Pq + 16 * s);
    f32x16 st[8];
#pragma unroll
    for (int kt = 0; kt < 8; ++kt) {
        const bf16* Pk = P + (size_t)(b * 256 + kt * 32 + r) * NINP + C_K + h * 64 + 8 * hh;
        f32x16 acc = {};
#pragma unroll
        for (int s = 0; s < 4; ++s) { const bf16x8 kf = *(const bf16x8*)(Pk + 16 * s); acc = MFMA32(kf, qf[s], acc); }
        st[kt] = acc;
    }
    float mx = -3.0e38f;
#pragma unroll
    for (int kt = 0; kt < 8; ++kt)
#pragma unroll
        for (int i = 0; i < 16; ++i) mx = fmaxf(mx, st[kt][i]);
    mx = fmaxf(mx, __shfl_xor(mx, 32));
    const float sc = 0.125f * LOG2E; float sum = 0.f;
#pragma unroll
    for (int kt = 0; kt < 8; ++kt)
#pragma unroll
        for (int i = 0; i < 16; ++i) { const float p = exp2f((st[kt][i] - mx) * sc); st[kt][i] = p; sum += p; }
    sum += __shfl_xor(sum, 32);
    const bf16* VTb = VT + ((size_t)(b * 8 + h) * 64 + r) * 256 + 8 * hh;
    f32x16 o0 = {}, o1 = {};
#pragma unroll
    for (int kt = 0; kt < 8; ++kt)
#pragma unroll
        for (int s2 = 0; s2 < 2; ++s2) {
            const bf16x8 pb = pack_regs(st[kt], s2);
            const bf16x8 a0 = *(const bf16x8*)(VTb + 32 * kt + 16 * s2), a1 = *(const bf16x8*)(VTb + 32 * 256 + 32 * kt + 16 * s2);
            o0 = MFMA32(a0, pb, o0); o1 = MFMA32(a1, pb, o1);
        }
    store_o(ONA + (size_t)(b * 256 + qb * 32 + r) * 512 + h * 64, o0, o1, 1.0f / sum, hh);
}

__device__ __forceinline__ void na_lat_task(const Args& a, int task, int lane) {
    const int half = task & 1, gr = (task >> 1) & 15, h = (task >> 5) & 7, b = task >> 8;
    const int r = lane & 31, hh = lane >> 5;
    const bf16* P = (const bf16*)(a.ws + WS_P); const bf16* VT = (const bf16*)a.out + (size_t)3 * MT * 512 + (size_t)M_CTX * 512;
    const bf16* CK = (const bf16*)(a.ws + WS_CK) + (size_t)(b * 8 + h) * 256 * 64; const bf16* CVT = (const bf16*)(a.ws + WS_CVT) + (size_t)(b * 8 + h) * 64 * 256;
    const float* rpb = a.in[I_RPB] + h * 15 * 31;
    bf16* ONA = (bf16*)(a.ws + WS_ONA);
    const int cq = 32 * half + r, rowq = M_CTX + b * 1024 + gr * 64 + cq;
    const bf16* Pq = P + (size_t)rowq * NINP + C_Q + h * 64 + 8 * hh;
    bf16x8 qf[4];
#pragma unroll
    for (int s = 0; s < 4; ++s) qf[s] = *(const bf16x8*)(Pq + 16 * s);
    float m = -3.0e38f, l = 0.f; f32x16 o0 = {}, o1 = {};
    const float sc = 0.125f * LOG2E;
#define NA_STEP(S, VA0, VA1) do { \
        float tm = S[0]; _Pragma("unroll") for (int i = 1; i < 16; ++i) tm = fmaxf(tm, S[i]); \
        tm = fmaxf(tm, __shfl_xor(tm, 32)); const float mn = fmaxf(m, tm); const float al = exp2f(m - mn); m = mn; \
        float ps = 0.f; _Pragma("unroll") for (int i = 0; i < 16; ++i) { S[i] = exp2f(S[i] - mn); ps += S[i]; } \
        l = l * al + ps; o0 = o0 * al; o1 = o1 * al; \
        _Pragma("unroll") for (int s2 = 0; s2 < 2; ++s2) { const bf16x8 pb = pack_regs(S, s2); \
            o0 = MFMA32(*(const bf16x8*)((VA0) + 16 * s2), pb, o0); o1 = MFMA32(*(const bf16x8*)((VA1) + 16 * s2), pb, o1); } } while (0)
    for (int kt = 0; kt < 8; ++kt) {
        const bf16* Pk = CK + (size_t)(kt * 32 + r) * 64 + 8 * hh;
        f32x16 s = {};
#pragma unroll
        for (int ks = 0; ks < 4; ++ks) s = MFMA32(*(const bf16x8*)(Pk + 16 * ks), qf[ks], s);
#pragma unroll
        for (int i = 0; i < 16; ++i) s[i] *= sc;
        const bf16* va = CVT + (size_t)r * 256 + 32 * kt + 8 * hh;
        NA_STEP(s, va, va + 32 * 256);
    }
    const int rs = min(max(gr - 4, 0), 8), cs = min(max(cq - 8, 0), 48);
    const bf16* VTb = VT + ((size_t)(b * 8 + h) * 64 + r) * 1024 + 8 * hh;
    for (int kk = 0; kk < 8; ++kk) {
        const int kr = rs + kk;
        const float* rp = rpb + (kr - gr + 7) * 31 + 15 - cq;
        for (int ct = 0; ct < 2; ++ct) {
            const int tk = kr * 64 + ct * 32;
            const bf16* Pk = P + (size_t)(M_CTX + b * 1024 + tk + r) * NINP + C_K + h * 64 + 8 * hh;
            f32x16 s = {};
#pragma unroll
            for (int ks = 0; ks < 4; ++ks) s = MFMA32(*(const bf16x8*)(Pk + 16 * ks), qf[ks], s);
#pragma unroll
            for (int i = 0; i < 16; ++i) { const int kc = ct * 32 + crow(i, hh); const bool ok = (kc >= cs) && (kc < cs + 16);
                const float bias = ok ? rp[kc] : 0.f; s[i] = ok ? (s[i] * 0.125f + bias) * LOG2E : -1.0e30f; }
            const bf16* va = VTb + tk;
            NA_STEP(s, va, va + 32 * 1024);
        }
    }
#undef NA_STEP
    l += __shfl_xor(l, 32);
    store_o(ONA + (size_t)rowq * 512 + h * 64, o0, o1, 1.0f / l, hh);
}

__device__ __forceinline__ void conv_task(const Args& a, int task, int lane) {
    const int part = task % 3, chunk = task / 3, r0 = chunk * 16;
    const bf16* P = (const bf16*)(a.ws + WS_P); bf16* DST = (bf16*)a.out + (size_t)part * MT * 512;
    const int seq0 = r0 < M_CTX ? (r0 & ~255) : M_CTX + ((r0 - M_CTX) & ~1023), seq1 = r0 < M_CTX ? seq0 + 256 : seq0 + 1024;
    const float* cw = a.in[I_CONVW] + part * 512 + 8 * lane;
    float w[5][8];
#pragma unroll
    for (int t = 0; t < 5; ++t) { const f32x4 w0 = *(const f32x4*)(cw + t * 1536), w1 = *(const f32x4*)(cw + t * 1536 + 4);
#pragma unroll
        for (int i = 0; i < 4; ++i) { w[t][i] = w0[i]; w[t][4 + i] = w1[i]; } }
    const bf16* src = P + C_DN + part * 512 + 8 * lane;
    float x[5][8];
#define CONV_LOAD(dst, row) do { if ((row) >= seq0 && (row) < seq1) { const v4u q = *(const v4u*)(src + (size_t)(row) * NINP); \
        dst[0] = bflo(q.x); dst[1] = bfhi(q.x); dst[2] = bflo(q.y); dst[3] = bfhi(q.y); dst[4] = bflo(q.z); dst[5] = bfhi(q.z); dst[6] = bflo(q.w); dst[7] = bfhi(q.w); } \
        else { _Pragma("unroll") for (int i_ = 0; i_ < 8; ++i_) dst[i_] = 0.f; } } while (0)
    CONV_LOAD(x[0], r0 - 2); CONV_LOAD(x[1], r0 - 1); CONV_LOAD(x[2], r0); CONV_LOAD(x[3], r0 + 1);
    for (int rr = 0; rr < 16; ++rr) {
        const int row = r0 + rr;
        CONV_LOAD(x[4], row + 2);
        float o[8]; float ss = 0.f;
#pragma unroll
        for (int i = 0; i < 8; ++i) { float v = w[0][i] * x[0][i] + w[1][i] * x[1][i] + w[2][i] * x[2][i] + w[3][i] * x[3][i] + w[4][i] * x[4][i]; v = silu_(v); o[i] = v; ss += v * v; }
        if (part < 2) { ss += __shfl_xor(ss, 1); ss += __shfl_xor(ss, 2); ss += __shfl_xor(ss, 4); const float rn = rsqrtf(ss + 1e-6f);
#pragma unroll
            for (int i = 0; i < 8; ++i) o[i] *= rn; }
        v4u q; q.x = pk2(o[0], o[1]); q.y = pk2(o[2], o[3]); q.z = pk2(o[4], o[5]); q.w = pk2(o[6], o[7]);
        *(v4u*)(DST + (size_t)row * 512 + 8 * lane) = q;
#pragma unroll
        for (int t = 0; t < 4; ++t)
#pragma unroll
            for (int i = 0; i < 8; ++i) x[t][i] = x[t + 1][i];
    }
#undef CONV_LOAD
}

__device__ __forceinline__ void phase_mix_a(const Args& a, int vcu, int G) {
    const int tid = threadIdx.x, lane = tid & 63, wave = __builtin_amdgcn_readfirstlane(tid >> 6);
    const int gw = wave * G + vcu, NGW = G * NWAVES;
    constexpr int N_LAT = 1024, N_CTX = 2048, N_CONV = 768 * 3;
    for (int t = gw; t < N_LAT + N_CTX + N_CONV; t += NGW) {
        if (t < N_LAT) na_lat_task(a, t, lane);
        else if (t < N_LAT + N_CTX) na_ctx_task(a, t - N_LAT, lane);
        else conv_task(a, t - N_LAT - N_CTX, lane);
    }
}

__device__ __forceinline__ void dn_chain(const Args& a, int chain, LAS unsigned char* wl, int lane) {
    int b, h, dir, T, rowbase; const bool lat = chain < 64;
    if (lat) { b = chain >> 4; h = (chain >> 1) & 7; dir = chain & 1; T = 1024; rowbase = M_CTX + b * 1024; }
    else { const int c = chain - 64; b = c >> 4; h = (c >> 1) & 7; dir = c & 1; T = 256; rowbase = b * 256; }
    const bf16* DQ = (const bf16*)a.out; const bf16* DK = DQ + (size_t)MT * 512; const bf16* DV = DK + (size_t)MT * 512;
    const float* BA = (const float*)(a.ws + WS_BA);
    float* OUTO = dir ? (float*)(a.ws + WS_M1) : (float*)(a.ws + WS_XN);
    const float Aexp = -__expf(a.in[I_ALOG][dir * 8 + h]), dtb = a.in[I_DTB][dir * 8 + h];
    LAS float* qs = (LAS float*)wl; LAS float* ks = qs + 16 * 64; LAS float* vs = ks + 16 * 64; LAS float* scs = vs + 16 * 64;
    float S[64];
    if (lat) { const float* s0 = a.in[I_ST] + ((size_t)((b * 2 + dir) * 8 + h) * 64) * 64 + lane;
#pragma unroll
        for (int i = 0; i < 64; ++i) S[i] = s0[i * 64]; }
    else {
#pragma unroll
        for (int i = 0; i < 64; ++i) S[i] = 0.f; }
    for (int s0 = 0; s0 < T; s0 += 16) {
        LDS_WAIT();
#pragma unroll
        for (int i = 0; i < 2; ++i) { const int id = lane + 64 * i, tok = id >> 3, c8 = id & 7; const int t = dir ? T - 1 - (s0 + tok) : s0 + tok;
            const size_t off = (size_t)(rowbase + t) * 512 + h * 64 + c8 * 8;
            const v4u q = *(const v4u*)(DQ + off), k = *(const v4u*)(DK + off), v = *(const v4u*)(DV + off);
            *(LAS f32x4*)(qs + tok * 64 + c8 * 8) = (f32x4){bflo(q.x), bfhi(q.x), bflo(q.y), bfhi(q.y)}; *(LAS f32x4*)(qs + tok * 64 + c8 * 8 + 4) = (f32x4){bflo(q.z), bfhi(q.z), bflo(q.w), bfhi(q.w)};
            *(LAS f32x4*)(ks + tok * 64 + c8 * 8) = (f32x4){bflo(k.x), bfhi(k.x), bflo(k.y), bfhi(k.y)}; *(LAS f32x4*)(ks + tok * 64 + c8 * 8 + 4) = (f32x4){bflo(k.z), bfhi(k.z), bflo(k.w), bfhi(k.w)};
            *(LAS f32x4*)(vs + tok * 64 + c8 * 8) = (f32x4){bflo(v.x), bfhi(v.x), bflo(v.y), bfhi(v.y)}; *(LAS f32x4*)(vs + tok * 64 + c8 * 8 + 4) = (f32x4){bflo(v.z), bfhi(v.z), bflo(v.w), bfhi(v.w)};
        }
        LDS_WAIT();
        if (lane < 16) { const int tok = lane; const int t = dir ? T - 1 - (s0 + tok) : s0 + tok; const float* ba = BA + (size_t)(rowbase + t) * 32;
            const float beta = sigm_(ba[dir * 8 + h]); const float xx = ba[16 + dir * 8 + h] + dtb; const float sp = xx > 20.f ? xx : log1pf(__expf(xx));
            const float av = __expf(Aexp * sp); float qk = 0.f;
            for (int i = 0; i < 64; ++i) qk += qs[tok * 64 + i] * ks[tok * 64 + i];
            scs[tok * 4 + 0] = beta; scs[tok * 4 + 1] = av; scs[tok * 4 + 2] = qk; }
        LDS_WAIT();
        for (int tok = 0; tok < 16; ++tok) {
            const int t = dir ? T - 1 - (s0 + tok) : s0 + tok;
            float kv[64]; float r = 0.f, p = 0.f;
#pragma unroll
            for (int i4 = 0; i4 < 16; ++i4) { const f32x4 k4 = *(const LAS f32x4*)(ks + tok * 64 + 4 * i4), q4 = *(const LAS f32x4*)(qs + tok * 64 + 4 * i4);
#pragma unroll
                for (int j = 0; j < 4; ++j) { kv[4 * i4 + j] = k4[j]; r += k4[j] * S[4 * i4 + j]; p += q4[j] * S[4 * i4 + j]; } }
            const float beta = scs[tok * 4 + 0], av = scs[tok * 4 + 1], qk = scs[tok * 4 + 2];
            const float c = beta * (vs[tok * 64 + lane] - av * r);
#pragma unroll
            for (int i = 0; i < 64; ++i) S[i] = av * S[i] + c * kv[i];
            OUTO[(size_t)(rowbase + t) * 512 + h * 64 + lane] = 0.125f * (av * p + c * qk);
        }
    }
    if (!lat) { float* so = a.out + OUT_S + ((size_t)((b * 2 + dir) * 8 + h) * 64) * 64 + lane;
#pragma unroll
        for (int i = 0; i < 64; ++i) so[i * 64] = S[i]; }
}
__device__ __forceinline__ void phase_dn_seq(const Args& a, LAS unsigned char* lds, int vcu, int G) {
    const int tid = threadIdx.x, lane = tid & 63, wave = __builtin_amdgcn_readfirstlane(tid >> 6);
    for (int c = wave * G + vcu; c < 576; c += G * NWAVES) dn_chain(a, c, lds + wave * 16384, lane);
}

__device__ __forceinline__ void phase_combine(const Args& a, int vcu, int G) {
    const int tid = threadIdx.x, lane = tid & 63, wave = tid >> 6;
    const int gw = vcu * NWAVES + wave, NGW = G * NWAVES;
    const float* OF = (const float*)(a.ws + WS_XN); const float* OB = (const float*)(a.ws + WS_M1);
    const bf16* P = (const bf16*)(a.ws + WS_P); bf16* ODN = (bf16*)(a.ws + WS_ODN);
    const f32x4 n0 = *(const f32x4*)(a.in[I_DNN] + ((8 * lane) & 63)), n1 = *(const f32x4*)(a.in[I_DNN] + ((8 * lane) & 63) + 4);
    for (int m = gw; m < MT; m += NGW) {
        const size_t off = (size_t)m * 512 + 8 * lane;
        f32x4 o0 = *(const f32x4*)(OF + off) + *(const f32x4*)(OB + off), o1 = *(const f32x4*)(OF + off + 4) + *(const f32x4*)(OB + off + 4);
        float ss = (o0.x * o0.x + o0.y * o0.y) + (o0.z * o0.z + o0.w * o0.w) + (o1.x * o1.x + o1.y * o1.y) + (o1.z * o1.z + o1.w * o1.w);
        ss += __shfl_xor(ss, 1); ss += __shfl_xor(ss, 2); ss += __shfl_xor(ss, 4);
        const float rstd = rsqrtf(ss * (1.f / 64.f) + 1e-6f);
        const v4u z = *(const v4u*)(P + (size_t)m * NINP + C_Z + 8 * lane);
        o0 = o0 * rstd * n0; o1 = o1 * rstd * n1;
        v4u q; q.x = pk2(o0.x * silu_(bflo(z.x)), o0.y * silu_(bfhi(z.x))); q.y = pk2(o0.z * silu_(bflo(z.y)), o0.w * silu_(bfhi(z.y)));
        q.z = pk2(o1.x * silu_(bflo(z.z)), o1.y * silu_(bfhi(z.z))); q.w = pk2(o1.z * silu_(bflo(z.w)), o1.w * silu_(bfhi(z.w)));
        *(v4u*)(ODN + off) = q;
    }
}

__device__ __forceinline__ void phase_row1(const Args& a, int vcu, int G) {
    const int tid = threadIdx.x, lane = tid & 63, wave = tid >> 6;
    const int gw = vcu * NWAVES + wave, NGW = G * NWAVES;
    const float* MOD = (const float*)(a.ws + WS_MOD); const bf16* Y = (const bf16*)(a.ws + WS_ONA); const float* RSS = (const float*)(a.ws + WS_RSS1);
    bf16* XN = (bf16*)(a.ws + WS_XN);
    for (int m = gw; m < MT; m += NGW) {
        const f32x4* xr = (const f32x4*)x_row(a, m) + lane; const float* md = MOD + mod_idx(m) * 6144;
        float rs = 0.f;
        { const f32x4* rp = (const f32x4*)(RSS + (size_t)m * 16); const f32x4 r0 = rp[0], r1 = rp[1], r2 = rp[2], r3 = rp[3];
          rs = ((r0.x + r0.y) + (r0.z + r0.w)) + ((r1.x + r1.y) + (r1.z + r1.w)) + ((r2.x + r2.y) + (r2.z + r2.w)) + ((r3.x + r3.y) + (r3.z + r3.w)); }
        const float rstd1 = rsqrtf(rs * (1.f / DM) + 1e-6f);
        f32x4 x1[4]; float s = 0.f;
        const v2u* yr = (const v2u*)(Y + (size_t)m * DM) + lane;
        f32x4* orow = (f32x4*)(a.out + (size_t)m * DM) + lane;
#pragma unroll
        for (int j = 0; j < 4; ++j) { const int c = (lane + 64 * j) * 4; const v2u yy = yr[64 * j];
            const f32x4 yv = {bflo(yy.x), bfhi(yy.x), bflo(yy.y), bfhi(yy.y)};
            const f32x4 g1 = *(const f32x4*)(md + 2048 + c), pw = *(const f32x4*)(a.in[I_POST1] + c);
            x1[j] = xr[64 * j] + g1 * (yv * rstd1 * pw); orow[64 * j] = x1[j];
            s += (x1[j].x * x1[j].x + x1[j].y * x1[j].y) + (x1[j].z * x1[j].z + x1[j].w * x1[j].w); }
        const float rstd2 = rsqrtf(wave_sum(s) * (1.f / DM) + 1e-6f);
        v2u* o8 = (v2u*)(XN + (size_t)m * DM) + lane;
#pragma unroll
        for (int j = 0; j < 4; ++j) { const int c = (lane + 64 * j) * 4;
            const f32x4 w = *(const f32x4*)(a.in[I_PRE2] + c), sh = *(const f32x4*)(md + 3072 + c), sc = *(const f32x4*)(md + 4096 + c);
            const f32x4 h = x1[j] * rstd2 * w * (sc + 1.0f) + sh;
            v2u o; o.x = pk2(h.x, h.y); o.y = pk2(h.z, h.w); o8[64 * j] = o; }
    }
}
__device__ __forceinline__ void phase_row2(const Args& a, int vcu, int G) {
    const int tid = threadIdx.x, lane = tid & 63, wave = tid >> 6;
    const int gw = vcu * NWAVES + wave, NGW = G * NWAVES;
    const float* MOD = (const float*)(a.ws + WS_MOD); const bf16* Fm = (const bf16*)(a.ws + WS_ONA); const float* RSS = (const float*)(a.ws + WS_RSS2);
    for (int m = gw; m < MT; m += NGW) {
        const float* md = MOD + mod_idx(m) * 6144;
        float rs = 0.f;
        { const f32x4* rp = (const f32x4*)(RSS + (size_t)m * 16); const f32x4 r0 = rp[0], r1 = rp[1], r2 = rp[2], r3 = rp[3];
          rs = ((r0.x + r0.y) + (r0.z + r0.w)) + ((r1.x + r1.y) + (r1.z + r1.w)) + ((r2.x + r2.y) + (r2.z + r2.w)) + ((r3.x + r3.y) + (r3.z + r3.w)); }
        const float rstd = rsqrtf(rs * (1.f / DM) + 1e-6f);
        const v2u* fr = (const v2u*)(Fm + (size_t)m * DM) + lane;
        f32x4* orow = (f32x4*)(a.out + (size_t)m * DM) + lane;
#pragma unroll
        for (int j = 0; j < 4; ++j) { const int c = (lane + 64 * j) * 4; const v2u ff = fr[64 * j];
            const f32x4 fv = {bflo(ff.x), bfhi(ff.x), bflo(ff.y), bfhi(ff.y)};
            const f32x4 g2 = *(const f32x4*)(md + 5120 + c), pw = *(const f32x4*)(a.in[I_POST2] + c);
            orow[64 * j] = orow[64 * j] + g2 * (fv * rstd * pw); }
    }
}

constexpr int N_PHASES = 12;
__global__ void __launch_bounds__(NWAVES * 64, 2) fwd_kernel(Args args) {
    extern __shared__ __attribute__((aligned(16))) unsigned char lds_raw[];
    LAS unsigned char* lds = (LAS unsigned char*)lds_raw;
    const int tid = threadIdx.x;
    const int G = gridDim.x; const int bx = blockIdx.x; const int vcu = (G % 8 == 0) ? (bx % 8) * (G / 8) + bx / 8 : bx;
    volatile LAS unsigned* MISC = (volatile LAS unsigned*)(lds + MISC_OFF);
    for (int u = tid; u < (LDS_BYTES - LDSCTL_OFF) / 4; u += NWAVES * 64) ((LAS unsigned*)(lds + LDSCTL_OFF))[u] = 0u;
    __syncthreads();
    const int lo = args.ph_lo, hi = args.ph_hi;
    const bool one = (hi - lo) > 1;
    unsigned* ctl = (unsigned*)(args.ws + WS_CTL);
    XcdBarrier bar; bar.bar = ctl + CW_BAR; bar.x = 0; bar.st = nullptr;
    if (one) bar = xcd_barrier_post(ctl + CW_BAR, MISC + 8);
#define IN(k) (lo <= (k) && (k) < hi)
#define SEAM(k) do { if (IN(k) && IN((k) + 1)) xcd_barrier(bar); } while (0)
    unsigned char* ws = args.ws;
    typedef pg8::bf16_t pb;

    if (IN(0)) { phase_prologue(args, lds, vcu, G); SEAM(0); }
    if (IN(1)) { phase_xn(args, vcu, G); SEAM(1); }
    if (IN(2)) {
        pg8::Gemm g{(const pb*)(ws + WS_XN), (const pb*)(ws + WS_WIN), MT, NINP, 1024}; pg8::StaticOrder S; S.init(MT, NINP, G, bx);
        pg8::EpiInProj E{(pb*)(ws + WS_P), args.out + OUT_K, args.out + OUT_V, (float*)(ws + WS_BA), (pb*)args.out + (size_t)3 * MT * 512, (const float*)(ws + WS_ROPE)};
        pg8::gemm_phase<pg8::EpiInProj, pg8::StaticOrder, true, true>(lds, g, S, E);
        SEAM(2);
    }
    if (IN(3)) { phase_mix_a(args, vcu, G); SEAM(3); }
    if (IN(4)) { phase_dn_seq(args, lds, vcu, G); SEAM(4); }
    if (IN(5)) { phase_combine(args, vcu, G); SEAM(5); }
    if (IN(6)) {
        pg8::StaticOrder S; S.init(MT, 1024, G, bx);
        { pg8::Gemm g{(const pb*)(ws + WS_ONA), (const pb*)(ws + WS_WAO), MT, 1024, 512};
          pg8::EpiGate1 E{(const pb*)(ws + WS_P), (pb*)(ws + WS_M1)};
          pg8::gemm_phase<pg8::EpiGate1, pg8::StaticOrder, true, true>(lds, g, S, E); }
        { pg8::Gemm g{(const pb*)(ws + WS_ODN), (const pb*)(ws + WS_WDO), MT, 1024, 512};
          pg8::EpiGate2 E{(const pb*)(ws + WS_P), (const pb*)(ws + WS_M1), (pb*)(ws + WS_XN)};
          pg8::gemm_phase<pg8::EpiGate2, pg8::StaticOrder, true, true>(lds, g, S, E); }
        SEAM(6);
    }
    if (IN(7)) {
        pg8::Gemm g{(const pb*)(ws + WS_XN), (const pb*)(ws + WS_WOUT), MT, 1024, 1024}; pg8::StaticOrder S; S.init(MT, 1024, G, bx);
        pg8::EpiRss E{(pb*)(ws + WS_ONA), (float*)(ws + WS_RSS1)};
        pg8::gemm_phase<pg8::EpiRss, pg8::StaticOrder, true, true>(lds, g, S, E);
        SEAM(7);
    }
    if (IN(8)) { phase_row1(args, vcu, G); SEAM(8); }
    if (IN(9)) {
        pg8::Gemm g{(const pb*)(ws + WS_XN), (const pb*)(ws + WS_W1), MT, FF, 1024}; pg8::StaticOrder S; S.init(MT, FF, G, bx);
        pg8::EpiRelu2 E{(pb*)(ws + WS_P)};
        pg8::gemm_phase<pg8::EpiRelu2, pg8::StaticOrder, true, true>(lds, g, S, E);
        SEAM(9);
    }
    if (IN(10)) {
        pg8::Gemm g{(const pb*)(ws + WS_P), (const pb*)(ws + WS_W2), MT, 1024, FF}; pg8::StaticOrder S; S.init(MT, 1024, G, bx);
        pg8::EpiRss E{(pb*)(ws + WS_ONA), (float*)(ws + WS_RSS2)};
        pg8::gemm_phase<pg8::EpiRss, pg8::StaticOrder, true, true>(lds, g, S, E);
        SEAM(10);
    }
    if (IN(11)) { phase_row2(args, vcu, G); }
#undef IN
#undef SEAM
}

#ifndef MK_ONE_LAUNCH
#define MK_ONE_LAUNCH 0
#endif
extern "C" void kernel_launch(void* const* d_in, const int* in_sizes, int n_in, void* d_out, int out_size, void* d_ws, size_t ws_size, hipStream_t stream) {
    static int grid = 0;
    if (grid == 0) {
        if (n_in != 24 || ws_size < WS_END) { fprintf(stderr, "kernel_launch: unexpected n_in %d / ws %zu\n", n_in, ws_size); grid = -1; return; }
        int dev = 0, cus = 0;
        if (hipGetDevice(&dev) != hipSuccess || hipDeviceGetAttribute(&cus, hipDeviceAttributeMultiprocessorCount, dev) != hipSuccess) { grid = -1; return; }
        if (hipFuncSetAttribute((const void*)fwd_kernel, hipFuncAttributeMaxDynamicSharedMemorySize, LDS_BYTES) != hipSuccess) { fprintf(stderr, "kernel_launch: hipFuncSetAttribute failed\n"); grid = -1; return; }
        int per_cu = 0;
        if (hipOccupancyMaxActiveBlocksPerMultiprocessor(&per_cu, (const void*)fwd_kernel, NWAVES * 64, LDS_BYTES) != hipSuccess || per_cu < 1) fprintf(stderr, "kernel_launch: occupancy query says %d\n", per_cu);
        (void)hipGetLastError();
        grid = cus;
    }
    if (grid < 0) return;
    (void)hipMemsetAsync((char*)d_ws + WS_CTL, 0, CTL_ZERO_BYTES, stream);
    Args a{};
    for (int i = 0; i < 24; ++i) a.in[i] = (const float*)d_in[i];
    a.out = (float*)d_out; a.ws = (unsigned char*)d_ws;
#if MK_ONE_LAUNCH
    a.ph_lo = 0; a.ph_hi = N_PHASES;
    hipLaunchKernelGGL(fwd_kernel, dim3(grid), dim3(NWAVES * 64), LDS_BYTES, stream, a);
#else
    for (int p = 0; p < N_PHASES; ++p) { a.ph_lo = p; a.ph_hi = p + 1; hipLaunchKernelGGL(fwd_kernel, dim3(grid), dim3(NWAVES * 64), LDS_BYTES, stream, a); }
#endif
}
```

```cpp
#include <hip/hip_runtime.h>
#include <cstdio>
#include <cstdint>

constexpr int DM = 1024, M_CTX = 8192, M_LAT = 4096, MT = 12288, NIN = 5664, NINP = 5888, FF = 4096;
constexpr int C_Q = 0, C_K = 512, C_V = 1024, C_DN = 1536, C_B = 3072, C_A = 3088, C_Z = 3104, C_GA = 3616, C_GD = 4640;

namespace pg8 {
#define PG8_LAS __attribute__((address_space(3)))
typedef unsigned short bf16_t;
typedef short bf16x8 __attribute__((ext_vector_type(8)));
typedef float f32x4 __attribute__((ext_vector_type(4)));
typedef unsigned u32x4 __attribute__((ext_vector_type(4)));
typedef unsigned u32x2 __attribute__((ext_vector_type(2)));
constexpr int BM = 256, BK = 64, HALF = 128, HTB = HALF * BK * 2  , STAGE_BYTES = 8 * HTB, NXCD = 8, WGM = 8;

__host__ __device__ __forceinline__ int lds_byte(int r, int c) { const int st = (r >> 4) * 2 + (c >> 5), rr = r & 15, cc = c & 31, ob = rr * 64 + cc * 2; return st * 1024 + (ob ^ (((ob >> 9) & 1) << 5)); }
__host__ __device__ __forceinline__ void stage_rc(int b, int& R, int& C) { const int st = b / 1024, sb = b % 1024, swz = sb ^ (((sb >> 9) & 1) << 5); R = (st >> 1) * 16 + swz / 64; C = (st & 1) * 32 + (swz % 64) / 2; }
__host__ __device__ __forceinline__ int perm32(int rho) { const int n = rho >> 4, i = rho & 15; return 8 * (i >> 2) + 4 * n + (i & 3); }

struct Unit { int pm, pn; };
struct Gemm { const bf16_t* A; const bf16_t* Bt; int M, N, K; };

struct StaticOrder {
    int nM, nN, nwg, G, c;
    __host__ __device__ void init(int M, int N, int G_, int c_) { nM = M / BM; nN = N / BM; nwg = nM * nN; G = G_; c = c_; }
    __host__ __device__ bool next(int i, Unit& u) const {
        const long L = (long)i * G + c; if (L >= nwg) return false;
        int wgid = (int)L; { const int q = nwg / NXCD, r = nwg % NXCD, xcd = wgid % NXCD, off = wgid / NXCD; wgid = (xcd < r ? xcd * (q + 1) : r * (q + 1) + (xcd - r) * q) + off; }
        const int nig = WGM * nN, gid = wgid / nig, fm = gid * WGM, gsz = (nM - fm) < WGM ? (nM - fm) : WGM;
        u.pm = fm + ((wgid % nig) % gsz); u.pn = (wgid % nig) / gsz; return true;
    }
    __device__ __forceinline__ void a_ready(const Unit&) const {}
    __device__ __forceinline__ void done(const Unit&) const {}
};

__device__ __forceinline__ unsigned cvt_pk_bf16(float lo, float hi) { unsigned r; asm volatile("v_cvt_pk_bf16_f32 %0, %1, %2" : "=v"(r) : "v"(lo), "v"(hi)); return r; }
__device__ __forceinline__ float bf_lo(unsigned w) { return __uint_as_float(w << 16); }
__device__ __forceinline__ float bf_hi(unsigned w) { return __uint_as_float(w & 0xffff0000u); }
__device__ __forceinline__ float sigmoidf_(float x) { return 1.0f / (1.0f + __expf(-x)); }
__device__ __forceinline__ u32x4 pack8(const f32x4& v0, const f32x4& v1) { u32x4 w; w.x = cvt_pk_bf16(v0[0], v0[1]); w.y = cvt_pk_bf16(v0[2], v0[3]); w.z = cvt_pk_bf16(v1[0], v1[1]); w.w = cvt_pk_bf16(v1[2], v1[3]); return w; }


struct EpiInProj {
    static constexpr bool PERM = true, AFTER_DRAIN = false;
    bf16_t* P; float* ko; float* vo; float* BA; bf16_t* VT; const float* rope;
    __device__ __forceinline__ void operator()(const f32x4 (&acc)[2][2][4][2], const Unit& u, int wr, int wc, int fr, int fq) const {
        const int pn = u.pn, pm = u.pm;
        const bool lat = pm >= 32;
        const bool do_rope = lat && pn < 4;
        const bool do_kv = (!lat) && pn >= 2 && pn < 6;
        const bool do_vt = pn == 4 || pn == 5;
        const bool do_ba = pn == 12 && wc == 0;
        const int lane_hi = fq >> 1;
#pragma unroll
        for (int ai = 0; ai < 2; ++ai)
#pragma unroll
            for (int m = 0; m < 4; ++m) {
                const int row = pm * BM + ai * HALF + wr * 64 + m * 16 + fr;
#pragma unroll
                for (int bj = 0; bj < 2; ++bj) {
                    f32x4 v0 = acc[ai][bj][m][0], v1 = acc[ai][bj][m][1];
                    const int col = pn * BM + bj * HALF + wc * 32 + 8 * fq;
                    if (do_rope) {
                        const int t = (row - M_CTX) & 1023;
                        const int pos = (wc & 1) ? (t & 63) : (t >> 6);
                        const float* cp = rope + pos * 16 + 8 * (fq & 1);
                        const f32x4 c0 = *(const f32x4*)cp, c1 = *(const f32x4*)(cp + 4), s0 = *(const f32x4*)(cp + 1024), s1 = *(const f32x4*)(cp + 1028);
                        f32x4 p0, p1;
#pragma unroll
                        for (int i = 0; i < 4; ++i) { p0[i] = __shfl_xor(v0[i], 32); p1[i] = __shfl_xor(v1[i], 32); }
                        if (lane_hi) { v0 = p0 * s0 + v0 * c0; v1 = p1 * s1 + v1 * c1; }
                        else         { v0 = v0 * c0 - p0 * s0; v1 = v1 * c1 - p1 * s1; }
                    }
                    *(u32x4*)(P + (size_t)row * NINP + col) = pack8(v0, v1);
                    if (do_kv) {
                        const int hh = ((pn & 1) * 4) + bj * 2 + (wc >> 1);
                        const int d = (wc & 1) * 32 + 8 * fq;
                        float* dst = (pn < 4 ? ko : vo) + ((size_t)(pm * 8 + hh) * 256 + (row & 255)) * 64 + d;
                        *(f32x4*)dst = v0; *(f32x4*)(dst + 4) = v1;
                    }
                    if (do_vt) {
                        const int hh = ((pn & 1) * 4) + bj * 2 + (wc >> 1);
                        const int d = (wc & 1) * 32 + 8 * fq;
                        size_t base; int t, T;
                        if (!lat) { t = row & 255; T = 256; base = (size_t)(pm * 8 + hh) * 64 * 256; }
                        else { const int rl = row - M_CTX; t = rl & 1023; T = 1024; base = (size_t)M_CTX * 512 + (size_t)((rl >> 10) * 8 + hh) * 64 * 1024; }
                        const int pos = (t & ~12) | ((t & 4) << 1) | ((t & 8) >> 1);
                        bf16_t* dst = VT + base + (size_t)d * T + pos;
                        const u32x4 w = pack8(v0, v1);
                        dst[0] = (bf16_t)(w.x & 0xffff); dst[(size_t)T] = (bf16_t)(w.x >> 16); dst[(size_t)2 * T] = (bf16_t)(w.y & 0xffff); dst[(size_t)3 * T] = (bf16_t)(w.y >> 16);
                        dst[(size_t)4 * T] = (bf16_t)(w.z & 0xffff); dst[(size_t)5 * T] = (bf16_t)(w.z >> 16); dst[(size_t)6 * T] = (bf16_t)(w.w & 0xffff); dst[(size_t)7 * T] = (bf16_t)(w.w >> 16);
                    }
                    if (do_ba && bj == 0) { float* dst = BA + (size_t)row * 32 + 8 * fq; *(f32x4*)dst = v0; *(f32x4*)(dst + 4) = v1; }
                }
            }
    }
};

struct EpiGate1 {
    static constexpr bool PERM = true, AFTER_DRAIN = false;
    const bf16_t* P; bf16_t* M1;
    __device__ __forceinline__ void operator()(const f32x4 (&acc)[2][2][4][2], const Unit& u, int wr, int wc, int fr, int fq) const {
#pragma unroll
        for (int ai = 0; ai < 2; ++ai)
#pragma unroll
            for (int m = 0; m < 4; ++m) {
                const int row = u.pm * BM + ai * HALF + wr * 64 + m * 16 + fr;
#pragma unroll
                for (int bj = 0; bj < 2; ++bj) {
                    const int col = u.pn * BM + bj * HALF + wc * 32 + 8 * fq;
                    const u32x4 g = *(const u32x4*)(P + (size_t)row * NINP + C_GA + col);
                    f32x4 v0 = acc[ai][bj][m][0], v1 = acc[ai][bj][m][1];
                    v0[0] *= sigmoidf_(bf_lo(g.x)); v0[1] *= sigmoidf_(bf_hi(g.x)); v0[2] *= sigmoidf_(bf_lo(g.y)); v0[3] *= sigmoidf_(bf_hi(g.y));
                    v1[0] *= sigmoidf_(bf_lo(g.z)); v1[1] *= sigmoidf_(bf_hi(g.z)); v1[2] *= sigmoidf_(bf_lo(g.w)); v1[3] *= sigmoidf_(bf_hi(g.w));
                    *(u32x4*)(M1 + (size_t)row * DM + col) = pack8(v0, v1);
                }
            }
    }
};
struct EpiGate2 {
    static constexpr bool PERM = true, AFTER_DRAIN = false;
    const bf16_t* P; const bf16_t* M1; bf16_t* O;
    __device__ __forceinline__ void operator()(const f32x4 (&acc)[2][2][4][2], const Unit& u, int wr, int wc, int fr, int fq) const {
#pragma unroll
        for (int ai = 0; ai < 2; ++ai)
#pragma unroll
            for (int m = 0; m < 4; ++m) {
                const int row = u.pm * BM + ai * HALF + wr * 64 + m * 16 + fr;
#pragma unroll
                for (int bj = 0; bj < 2; ++bj) {
                    const int col = u.pn * BM + bj * HALF + wc * 32 + 8 * fq;
                    const u32x4 g = *(const u32x4*)(P + (size_t)row * NINP + C_GD + col);
                    const u32x4 q = *(const u32x4*)(M1 + (size_t)row * DM + col);
                    f32x4 v0 = acc[ai][bj][m][0], v1 = acc[ai][bj][m][1];
                    v0[0] = bf_lo(q.x) + v0[0] * sigmoidf_(bf_lo(g.x)); v0[1] = bf_hi(q.x) + v0[1] * sigmoidf_(bf_hi(g.x)); v0[2] = bf_lo(q.y) + v0[2] * sigmoidf_(bf_lo(g.y)); v0[3] = bf_hi(q.y) + v0[3] * sigmoidf_(bf_hi(g.y));
                    v1[0] = bf_lo(q.z) + v1[0] * sigmoidf_(bf_lo(g.z)); v1[1] = bf_hi(q.z) + v1[1] * sigmoidf_(bf_hi(g.z)); v1[2] = bf_lo(q.w) + v1[2] * sigmoidf_(bf_lo(g.w)); v1[3] = bf_hi(q.w) + v1[3] * sigmoidf_(bf_hi(g.w));
                    *(u32x4*)(O + (size_t)row * DM + col) = pack8(v0, v1);
                }
            }
    }
};
struct EpiRss {
    static constexpr bool PERM = true, AFTER_DRAIN = false;
    bf16_t* O; float* RSS;
    __device__ __forceinline__ void operator()(const f32x4 (&acc)[2][2][4][2], const Unit& u, int wr, int wc, int fr, int fq) const {
#pragma unroll
        for (int ai = 0; ai < 2; ++ai)
#pragma unroll
            for (int m = 0; m < 4; ++m) {
                const int row = u.pm * BM + ai * HALF + wr * 64 + m * 16 + fr;
                float s = 0.f;
#pragma unroll
                for (int bj = 0; bj < 2; ++bj) {
                    const int col = u.pn * BM + bj * HALF + wc * 32 + 8 * fq;
                    const f32x4 v0 = acc[ai][bj][m][0], v1 = acc[ai][bj][m][1];
                    s += (v0[0] * v0[0] + v0[1] * v0[1]) + (v0[2] * v0[2] + v0[3] * v0[3]) + (v1[0] * v1[0] + v1[1] * v1[1]) + (v1[2] * v1[2] + v1[3] * v1[3]);
                    *(u32x4*)(O + (size_t)row * DM + col) = pack8(v0, v1);
                }
                s += __shfl_xor(s, 16); s += __shfl_xor(s, 32);
                if (fq == 0) RSS[(size_t)row * 16 + u.pn * 4 + wc] = s;
            }
    }
};
struct EpiRelu2 {
    static constexpr bool PERM = true, AFTER_DRAIN = false;
    bf16_t* O;
    __device__ __forceinline__ void operator()(const f32x4 (&acc)[2][2][4][2], const Unit& u, int wr, int wc, int fr, int fq) const {
#pragma unroll
        for (int ai = 0; ai < 2; ++ai)
#pragma unroll
            for (int m = 0; m < 4; ++m) {
                const int row = u.pm * BM + ai * HALF + wr * 64 + m * 16 + fr;
#pragma unroll
                for (int bj = 0; bj < 2; ++bj) {
                    const int col = u.pn * BM + bj * HALF + wc * 32 + 8 * fq;
                    f32x4 v0 = acc[ai][bj][m][0], v1 = acc[ai][bj][m][1];
#pragma unroll
                    for (int i = 0; i < 4; ++i) { const float a = fmaxf(v0[i], 0.f), b = fmaxf(v1[i], 0.f); v0[i] = a * a; v1[i] = b * b; }
                    *(u32x4*)(O + (size_t)row * FF + col) = pack8(v0, v1);
                }
            }
    }
};

template <class Epi, class Sched, bool ALIGN_EPI = false, bool SP2 = false>
__device__ __forceinline__ void gemm_phase(PG8_LAS unsigned char* lds, const Gemm g, const Sched& S, const Epi& E) {
    const int tid = threadIdx.x, wid = __builtin_amdgcn_readfirstlane(tid >> 6), lane = tid & 63, wr = wid >> 2, wc = wid & 3, fr = lane & 15, fq = lane >> 4;
    const int K = g.K, nt = K / BK;
    unsigned voffA[2], voffB[2];
#pragma unroll
    for (int i = 0; i < 2; ++i) { int R, C; stage_rc(tid * 16 + i * 8192, R, C); const int Rb = Epi::PERM ? ((R & ~31) + perm32(R & 31)) : R;
        voffA[i] = (unsigned)(R * K + C) * 2u; voffB[i] = (unsigned)(Rb * K + C) * 2u; }
    const size_t kstep = (size_t)(BK * 2);
    const size_t hstep = (size_t)HALF * K * 2;
    const size_t tstep = 2 * hstep;
    const unsigned ldsw = (unsigned)wid * 1024u;
    const int aoff = lds_byte(wr * 64 + fr, fq * 8), boff = lds_byte(wc * 32 + fr, fq * 8);
#define PG8_SA(b, h) (((b) * 2 + (h)) * HTB)
#define PG8_SB(b, h) ((4 + (b) * 2 + (h)) * HTB)
#define PG8_STAGE(bufoff, gbase, voff) do { _Pragma("unroll") for (int _i = 0; _i < 2; ++_i) \
        __builtin_amdgcn_global_load_lds((const unsigned*)((const char*)(gbase) + (voff)[_i]), (PG8_LAS unsigned*)(lds + (bufoff) + ldsw + _i * 8192), 16, 0, 0); } while (0)
#define PG8_LDA(dst, b, h) do { _Pragma("unroll") for (int m = 0; m < 4; ++m) _Pragma("unroll") for (int k = 0; k < 2; ++k) dst[m][k] = *(const PG8_LAS bf16x8*)(lds + PG8_SA(b, h) + aoff + m * 2048 + k * 1024); } while (0)
#define PG8_LDB(dst, b, h) do { _Pragma("unroll") for (int n = 0; n < 2; ++n) _Pragma("unroll") for (int k = 0; k < 2; ++k) dst[n][k] = *(const PG8_LAS bf16x8*)(lds + PG8_SB(b, h) + boff + n * 2048 + k * 1024); } while (0)
#define PG8_MMA(ai, bj, At, Bt) do { __builtin_amdgcn_s_setprio(1); _Pragma("unroll") for (int m = 0; m < 4; ++m) _Pragma("unroll") for (int n = 0; n < 2; ++n) _Pragma("unroll") for (int k = 0; k < 2; ++k) \
        acc[ai][bj][m][n] = __builtin_amdgcn_mfma_f32_16x16x32_bf16(Bt[n][k], At[m][k], acc[ai][bj][m][n], 0, 0, 0); __builtin_amdgcn_s_setprio(0); } while (0)
#define PG8_WAIT_V(n) asm volatile("s_waitcnt vmcnt(" #n ")" ::: "memory")
#define PG8_WAIT_L(n) asm volatile("s_waitcnt lgkmcnt(" #n ")" ::: "memory")
#define PG8_BAR __builtin_amdgcn_s_barrier()
#define PG8_SCHED __builtin_amdgcn_sched_barrier(0)
    Unit cur, nxt; int ui = 0;
    if (!S.next(0, cur)) return;
    f32x4 acc[2][2][4][2];
#pragma unroll
    for (int a = 0; a < 2; ++a)
#pragma unroll
        for (int b = 0; b < 2; ++b)
#pragma unroll
            for (int m = 0; m < 4; ++m)
#pragma unroll
                for (int n = 0; n < 2; ++n) acc[a][b][m][n] = (f32x4){0.f, 0.f, 0.f, 0.f};
    bf16x8 At[4][2], B0[2][2], B1[2][2];
    const char* cA = (const char*)g.A + (size_t)cur.pm * tstep; const char* cB = (const char*)g.Bt + (size_t)cur.pn * tstep;
    S.a_ready(cur);
    if constexpr (SP2) {
        PG8_STAGE(PG8_SB(0, 0), cB, voffB); PG8_STAGE(PG8_SB(0, 1), cB + hstep, voffB); PG8_STAGE(PG8_SA(0, 0), cA, voffA); PG8_STAGE(PG8_SA(0, 1), cA + hstep, voffA);
        if (wr == 1) PG8_BAR;
        PG8_WAIT_V(2); PG8_BAR;
        PG8_STAGE(PG8_SB(1, 0), cB + kstep, voffB); PG8_STAGE(PG8_SA(1, 0), cA + kstep, voffA); PG8_STAGE(PG8_SB(1, 1), cB + hstep + kstep, voffB);
        PG8_WAIT_V(6); PG8_BAR;
    } else {
        PG8_STAGE(PG8_SB(0, 0), cB, voffB); PG8_STAGE(PG8_SA(0, 0), cA, voffA); PG8_STAGE(PG8_SB(0, 1), cB + hstep, voffB); PG8_STAGE(PG8_SA(0, 1), cA + hstep, voffA);
        if (wr == 1) PG8_BAR;
        PG8_WAIT_V(4); PG8_BAR;
        PG8_STAGE(PG8_SB(1, 0), cB + kstep, voffB); PG8_STAGE(PG8_SA(1, 0), cA + kstep, voffA); PG8_STAGE(PG8_SB(1, 1), cB + hstep + kstep, voffB);
        PG8_WAIT_V(6); PG8_BAR;
    }
    for (;;) {
        const bool has_next = S.next(ui + 1, nxt);
        const char* nA = has_next ? (const char*)g.A + (size_t)nxt.pm * tstep : cA; const char* nB = has_next ? (const char*)g.Bt + (size_t)nxt.pn * tstep : cB;
        for (int t = 0; t < nt; t += 2) {
            const bool last = (t == nt - 2);
            const char* a1 = cA + (size_t)(t + 1) * kstep;
            const char* a2 = last ? nA : cA + (size_t)(t + 2) * kstep; const char* b2 = last ? nB : cB + (size_t)(t + 2) * kstep;
            const char* a3 = a2 + kstep; const char* b3 = b2 + kstep;
            if (last && has_next) S.a_ready(nxt);
            if constexpr (SP2) {
            PG8_LDB(B0, 0, 0); PG8_LDB(B1, 0, 1); PG8_SCHED; PG8_LDA(At, 0, 0); PG8_STAGE(PG8_SA(1, 1), a1 + hstep, voffA);
            PG8_WAIT_V(8); PG8_WAIT_L(0); PG8_BAR; PG8_MMA(0, 0, At, B0); PG8_MMA(0, 1, At, B1); PG8_BAR; PG8_SCHED;
            PG8_LDA(At, 0, 1); PG8_STAGE(PG8_SB(0, 0), b2, voffB); PG8_STAGE(PG8_SB(0, 1), b2 + hstep, voffB); PG8_STAGE(PG8_SA(0, 0), a2, voffA);
            PG8_WAIT_V(8); PG8_WAIT_L(0); PG8_BAR; PG8_MMA(1, 0, At, B0); PG8_MMA(1, 1, At, B1); PG8_BAR; PG8_SCHED;
            PG8_LDB(B0, 1, 0); PG8_LDB(B1, 1, 1); PG8_SCHED; PG8_LDA(At, 1, 0); PG8_STAGE(PG8_SA(0, 1), a2 + hstep, voffA);
            PG8_WAIT_V(8); PG8_WAIT_L(0); PG8_BAR; PG8_MMA(0, 0, At, B0); PG8_MMA(0, 1, At, B1); PG8_BAR; PG8_SCHED;
            PG8_LDA(At, 1, 1); PG8_STAGE(PG8_SB(1, 0), b3, voffB); PG8_STAGE(PG8_SB(1, 1), b3 + hstep, voffB); PG8_STAGE(PG8_SA(1, 0), a3, voffA);
            PG8_WAIT_V(8); PG8_WAIT_L(0); PG8_BAR; PG8_MMA(1, 0, At, B0); PG8_MMA(1, 1, At, B1); PG8_BAR; PG8_SCHED;
            } else {
            PG8_LDB(B0, 0, 0); PG8_SCHED; PG8_LDA(At, 0, 0); PG8_STAGE(PG8_SA(1, 1), a1 + hstep, voffA);
            PG8_WAIT_L(8); PG8_BAR; PG8_WAIT_L(0); PG8_MMA(0, 0, At, B0); PG8_BAR; PG8_SCHED;
            PG8_LDB(B1, 0, 1); PG8_STAGE(PG8_SB(0, 0), b2, voffB);
            PG8_BAR; PG8_WAIT_L(0); PG8_MMA(0, 1, At, B1); PG8_BAR;
            PG8_LDA(At, 0, 1); PG8_STAGE(PG8_SA(0, 0), a2, voffA);
            PG8_BAR; PG8_WAIT_L(0); PG8_MMA(1, 0, At, B0); PG8_BAR; PG8_SCHED;
            PG8_STAGE(PG8_SB(0, 1), b2 + hstep, voffB);
            PG8_WAIT_V(6); PG8_BAR; PG8_MMA(1, 1, At, B1); PG8_BAR;
            PG8_LDB(B0, 1, 0); PG8_SCHED; PG8_LDA(At, 1, 0); PG8_STAGE(PG8_SA(0, 1), a2 + hstep, voffA);
            PG8_WAIT_L(8); PG8_BAR; PG8_WAIT_L(0); PG8_MMA(0, 0, At, B0); PG8_BAR; PG8_SCHED;
            PG8_LDB(B1, 1, 1); PG8_STAGE(PG8_SB(1, 0), b3, voffB);
            PG8_BAR; PG8_WAIT_L(0); PG8_MMA(0, 1, At, B1); PG8_BAR;
            PG8_LDA(At, 1, 1); PG8_STAGE(PG8_SA(1, 0), a3, voffA);
            PG8_BAR; PG8_WAIT_L(0); PG8_MMA(1, 0, At, B0); PG8_BAR; PG8_SCHED;
            PG8_STAGE(PG8_SB(1, 1), b3 + hstep, voffB);
            PG8_WAIT_V(6); PG8_BAR; PG8_MMA(1, 1, At, B1); PG8_BAR;
            }
        }
        if constexpr (ALIGN_EPI) { if (wr == 0) PG8_BAR; }
        if constexpr (!Epi::AFTER_DRAIN) { E(acc, cur, wr, wc, fr, fq); S.done(cur); }
        if (!has_next) break;
#pragma unroll
        for (int a = 0; a < 2; ++a)
#pragma unroll
            for (int b = 0; b < 2; ++b)
#pragma unroll
                for (int m = 0; m < 4; ++m)
#pragma unroll
                    for (int n = 0; n < 2; ++n) acc[a][b][m][n] = (f32x4){0.f, 0.f, 0.f, 0.f};
        cur = nxt; cA = nA; cB = nB; ++ui;
        if constexpr (ALIGN_EPI) { if (wr == 1) PG8_BAR; }
    }
    PG8_WAIT_V(0);
    if constexpr (!ALIGN_EPI) { if (wr == 0) PG8_BAR; }
    PG8_BAR;
    if constexpr (Epi::AFTER_DRAIN) { E.fused(acc, cur, wr, wc, fr, fq, lds, wid, lane); S.done(cur); }
#undef PG8_SA
#undef PG8_SB
#undef PG8_STAGE
#undef PG8_LDA
#undef PG8_LDB
#undef PG8_MMA
#undef PG8_WAIT_V
#undef PG8_WAIT_L
#undef PG8_BAR
#undef PG8_SCHED
}
}

constexpr int NWAVES = 8;
constexpr size_t MiB = 1u << 20;
constexpr size_t WS_CTL = 0, CTL_ZERO_BYTES = 64 * 1024;
constexpr size_t WS_MOD = 1 * MiB;
constexpr size_t WS_ROPE = 1 * MiB + 256 * 1024;
constexpr size_t WS_BA = 2 * MiB;
constexpr size_t WS_RSS1 = 4 * MiB, WS_RSS2 = 5 * MiB;
constexpr size_t WS_WIN = 6 * MiB, WS_WAO = 18 * MiB, WS_WDO = 19 * MiB, WS_WOUT = 20 * MiB, WS_W1 = 22 * MiB, WS_W2 = 30 * MiB;
constexpr size_t WS_XN = 38 * MiB;
constexpr size_t WS_ONA = 62 * MiB, WS_ODN = 74 * MiB;
constexpr size_t WS_P = 86 * MiB;
constexpr size_t WS_M1 = 224 * MiB;
constexpr size_t WS_CK = 248 * MiB, WS_CVT = 249 * MiB;
constexpr size_t WS_END = 256 * MiB;
constexpr size_t OUT_YP = 0, OUT_YS = (size_t)M_CTX * DM, OUT_K = (size_t)MT * DM, OUT_V = OUT_K + (size_t)32 * 8 * 256 * 64, OUT_S = OUT_V + (size_t)32 * 8 * 256 * 64;

constexpr int CW_BAR = 1024;
constexpr int RING_BYTES = 131072, LDSCTL_OFF = RING_BYTES, MISC_OFF = LDSCTL_OFF + 320, LDS_BYTES = 147456;

#define GAS __attribute__((address_space(1)))
#define LAS __attribute__((address_space(3)))
typedef unsigned short bf16;
typedef unsigned v4u __attribute__((ext_vector_type(4)));
typedef unsigned v2u __attribute__((ext_vector_type(2)));
typedef float f32x4 __attribute__((ext_vector_type(4)));
typedef float f32x16 __attribute__((ext_vector_type(16)));
typedef short bf16x8 __attribute__((ext_vector_type(8)));
#define LDS_WAIT() asm volatile("s_waitcnt lgkmcnt(0)" ::: "memory")
#define VM_WAIT() asm volatile("s_waitcnt vmcnt(0)" ::: "memory")
#define MFMA32(a, b, c) __builtin_amdgcn_mfma_f32_32x32x16_bf16((a), (b), (c), 0, 0, 0)
__device__ __forceinline__ unsigned f2bf(float f) { unsigned u = __builtin_bit_cast(unsigned, f); return (u + 0x7fffu + ((u >> 16) & 1u)) >> 16; }
typedef float f32x2_t __attribute__((ext_vector_type(2))); typedef __bf16 bf16x2_t __attribute__((ext_vector_type(2)));
__device__ __forceinline__ unsigned pk2(float lo, float hi) { f32x2_t v = {lo, hi}; bf16x2_t b = __builtin_convertvector(v, bf16x2_t); return __builtin_bit_cast(unsigned, b); }
__device__ __forceinline__ float bflo(unsigned w) { return __uint_as_float(w << 16); }
__device__ __forceinline__ float bfhi(unsigned w) { return __uint_as_float(w & 0xffff0000u); }
__device__ __forceinline__ float silu_(float x) { return x / (1.0f + __expf(-x)); }
__device__ __forceinline__ float sigm_(float x) { return 1.0f / (1.0f + __expf(-x)); }
__device__ __forceinline__ int crow(int reg, int h) { return (reg & 3) + 8 * (reg >> 2) + 4 * h; }
__device__ __forceinline__ float wave_sum(float v) {
#pragma unroll
    for (int o = 1; o < 64; o <<= 1) v += __shfl_xor(v, o);
    return v;
}

#define XB_TMO      128
#define XB_XCNT(j)  (256  + 64 * (j))
#define XB_XSUB(j)  (1280 + 64 * (j))
#define XB_XGEN(j)  (2304 + 64 * (j))
#define XB_TOP      3328
#define XB_TOPGEN   3392
#define XCD_BAR_WORDS 3456
#define XB_SPIN_CAP (1u << 22)

__device__ __forceinline__ unsigned xb_ld(unsigned* p)              { return __hip_atomic_load(p, __ATOMIC_RELAXED, __HIP_MEMORY_SCOPE_AGENT); }
__device__ __forceinline__ unsigned xb_add(unsigned* p, unsigned v) { return __hip_atomic_fetch_add(p, v, __ATOMIC_RELAXED, __HIP_MEMORY_SCOPE_AGENT); }
__device__ __forceinline__ unsigned xb_xcc_id() { return (unsigned)__builtin_amdgcn_s_getreg((3 << 11) | 20) & 0xFu; }
#define XB_SPIN(cond, bar) do { unsigned _sp = 0; while (cond) { __builtin_amdgcn_s_sleep(1); \
    if ((++_sp & 255u) == 0u) { if (xb_ld(&(bar)[XB_TMO])) break; if (_sp > XB_SPIN_CAP) { atomicAdd(&(bar)[XB_TMO], 1u); break; } } } } while (0)

struct XcdBarrier { unsigned* bar; unsigned x; volatile LAS unsigned* st; };

__device__ __forceinline__ XcdBarrier xcd_barrier_post(unsigned* bar, volatile LAS unsigned* st) {
    XcdBarrier b; b.bar = bar; b.x = xb_xcc_id(); b.st = st;
    if (threadIdx.x == 0) (void)xb_add(&bar[XB_XCNT(b.x)], 1u);
    return b;
}
__device__ __forceinline__ void xcd_barrier_complete(unsigned* bar, unsigned x, unsigned& nloc, unsigned& nx) {
    const unsigned G = gridDim.x * gridDim.y * gridDim.z;
    unsigned sum, cnt, mine, sp = 0u;
    for (;;) {
        sum = 0u; cnt = 0u; mine = 0u;
#pragma unroll
        for (unsigned j = 0; j < 16; ++j) { const unsigned c = xb_ld(&bar[XB_XCNT(j)]); sum += c; cnt += (c > 0u) ? 1u : 0u; mine = (j == x) ? c : mine; }
        if (sum == G) break;
        __builtin_amdgcn_s_sleep(1);
        if ((++sp & 255u) == 0u) { if (xb_ld(&bar[XB_TMO])) break; if (sp > XB_SPIN_CAP) { atomicAdd(&bar[XB_TMO], 1u); break; } }
    }
    nloc = mine > 0u ? mine : 1u; nx = cnt > 0u ? cnt : 1u;
}
__device__ __forceinline__ void xcd_barrier(const XcdBarrier& b) {
    asm volatile("s_waitcnt vmcnt(0)" ::: "memory");
    __syncthreads();
    if (threadIdx.x == 0) {
        unsigned* bar = b.bar;
        __builtin_amdgcn_s_waitcnt(0);
        unsigned nloc = b.st[0], nx = b.st[1];
        if (nloc == 0u) { xcd_barrier_complete(bar, b.x, nloc, nx); b.st[0] = nloc; b.st[1] = nx; }
        const unsigned old = xb_add(&bar[XB_XSUB(b.x)], 1u);
        const unsigned gen = old / nloc;
        if (old + 1u == (gen + 1u) * nloc) {
            __builtin_amdgcn_fence(__ATOMIC_RELEASE, "agent");
            asm volatile("s_waitcnt vmcnt(0)" ::: "memory");
            const unsigned og = xb_add(&bar[XB_TOP], 1u);
            const unsigned tg = og / nx;
            if (og + 1u == (tg + 1u) * nx) xb_add(&bar[XB_TOPGEN], 1u);
            else XB_SPIN(xb_ld(&bar[XB_TOPGEN]) == tg, bar);
            __builtin_amdgcn_fence(__ATOMIC_ACQUIRE, "agent");
            xb_add(&bar[XB_XGEN(b.x)], 1u);
            asm volatile("s_waitcnt vmcnt(0)" ::: "memory");
        } else {
            XB_SPIN(xb_ld(&bar[XB_XGEN(b.x)]) == gen, bar);
            __builtin_amdgcn_fence(__ATOMIC_ACQUIRE, "agent");
            asm volatile("s_waitcnt vmcnt(0)" ::: "memory");
        }
    }
    __syncthreads();
}

struct Args { const float* in[24]; float* out; unsigned char* ws; int ph_lo, ph_hi; };
enum { I_XP = 0, I_XS, I_C, I_CK, I_CV, I_ST, I_CCTX, I_WADA, I_BADA, I_PRE1, I_POST1, I_PRE2, I_POST2, I_WIN, I_CONVW, I_ALOG, I_DTB, I_DNN, I_RPB, I_WAO, I_WDO, I_WOUT, I_WFF1, I_WFF2 };

__device__ __forceinline__ void p0_transpose_item(const float* W, int K, int N, bf16* WT, LAS float* scr, int item, int lane) {
    const int nblk = N / 32, kb = item / nblk, nb = item % nblk, k0 = 64 * kb, n0 = 32 * nb;
#pragma unroll 8
    for (int i = 0; i < 32; ++i) { const int kk = 2 * i + (lane >> 5); scr[kk * 33 + (lane & 31)] = W[(size_t)(k0 + kk) * N + n0 + (lane & 31)]; }
    LDS_WAIT();
    const int c = lane & 7;
#pragma unroll
    for (int j = 0; j < 4; ++j) { const int n = (lane >> 3) + 8 * j; const LAS float* s = scr + (8 * c) * 33 + n;
        v4u o; o.x = pk2(s[0 * 33], s[1 * 33]); o.y = pk2(s[2 * 33], s[3 * 33]); o.z = pk2(s[4 * 33], s[5 * 33]); o.w = pk2(s[6 * 33], s[7 * 33]);
        *(v4u*)(WT + (size_t)(n0 + n) * K + k0 + 8 * c) = o; }
    LDS_WAIT();
}

__device__ __forceinline__ void phase_prologue(const Args& a, LAS unsigned char* lds, int vcu, int G) {
    const int tid = threadIdx.x, lane = tid & 63, wave = __builtin_amdgcn_readfirstlane(tid >> 6);
    unsigned char* ws = a.ws;
    if (vcu < 192) {
        LAS float* sl = (LAS float*)lds;
        LAS float* red = (LAS float*)(lds + 20480);
        for (int i = tid; i < 5 * 1024; i += 512) { const float v = i < 1024 ? a.in[I_CCTX][i] : a.in[I_C][i - 1024]; sl[i] = silu_(v); }
        __syncthreads();
        const int col = 32 * vcu + (lane & 31), rg = wave * 2 + (lane >> 5);
        const float* w = a.in[I_WADA] + (size_t)(rg * 64) * 6144 + col;
        float acc[5] = {0.f, 0.f, 0.f, 0.f, 0.f};
#pragma unroll 8
        for (int i = 0; i < 64; ++i) { const float wv = w[(size_t)i * 6144]; const int k = rg * 64 + i;
#pragma unroll
            for (int v = 0; v < 5; ++v) acc[v] += sl[v * 1024 + k] * wv; }
#pragma unroll
        for (int v = 0; v < 5; ++v) red[(rg * 5 + v) * 32 + (lane & 31)] = acc[v];
        __syncthreads();
        if (tid < 160) { const int v = tid >> 5, cl = tid & 31; float s = a.in[I_BADA][32 * vcu + cl];
            for (int r = 0; r < 16; ++r) s += red[(r * 5 + v) * 32 + cl];
            ((float*)(ws + WS_MOD))[v * 6144 + 32 * vcu + cl] = s; }
        __syncthreads();
    } else if (vcu == 192) {
        float* rope = (float*)(ws + WS_ROPE);
        for (int i = tid; i < 1024; i += 512) { const int pos = i >> 4, f = i & 15; const float inv = powf(10000.0f, -(float)f / 16.0f); const float ang = (float)pos * inv; rope[i] = cosf(ang); rope[1024 + i] = sinf(ang); }
    } else if (vcu < 225) {
        const int bh = vcu - 193;
        const float* ck = a.in[I_CK] + (size_t)bh * 256 * 64; const float* cv = a.in[I_CV] + (size_t)bh * 256 * 64;
        bf16* CK = (bf16*)(ws + WS_CK) + (size_t)bh * 256 * 64; bf16* CVT = (bf16*)(ws + WS_CVT) + (size_t)bh * 64 * 256;
        for (int i = tid; i < 256 * 8; i += 512) { const int key = i >> 3, c8 = i & 7;
            const f32x4 k0 = *(const f32x4*)(ck + key * 64 + c8 * 8), k1 = *(const f32x4*)(ck + key * 64 + c8 * 8 + 4);
            v4u o; o.x = pk2(k0[0], k0[1]); o.y = pk2(k0[2], k0[3]); o.z = pk2(k1[0], k1[1]); o.w = pk2(k1[2], k1[3]);
            *(v4u*)(CK + key * 64 + c8 * 8) = o;
            const f32x4 v0 = *(const f32x4*)(cv + key * 64 + c8 * 8), v1 = *(const f32x4*)(cv + key * 64 + c8 * 8 + 4);
            const int pos = (key & ~12) | ((key & 4) << 1) | ((key & 8) >> 1);
#pragma unroll
            for (int j = 0; j < 4; ++j) { CVT[(c8 * 8 + j) * 256 + pos] = (bf16)f2bf(v0[j]); CVT[(c8 * 8 + 4 + j) * 256 + pos] = (bf16)f2bf(v1[j]); }
        }
    }
    LAS float* scr = (LAS float*)(lds + 32768 + wave * 8704);
    const int gw = vcu * NWAVES + wave, NGW = G * NWAVES;
    constexpr int I_IN = 16 * 177, I_AO = 8 * 32, I_DO = 8 * 32, I_OUT = 16 * 32, I_1 = 16 * 128, I_2 = 64 * 32;
    constexpr int NITEMS = I_IN + I_AO + I_DO + I_OUT + I_1 + I_2;
    for (int it = gw; it < NITEMS; it += NGW) {
        int r = it;
        if (r < I_IN) { p0_transpose_item(a.in[I_WIN], 1024, NIN, (bf16*)(ws + WS_WIN), scr, r, lane); continue; } r -= I_IN;
        if (r < I_AO) { p0_transpose_item(a.in[I_WAO], 512, 1024, (bf16*)(ws + WS_WAO), scr, r, lane); continue; } r -= I_AO;
        if (r < I_DO) { p0_transpose_item(a.in[I_WDO], 512, 1024, (bf16*)(ws + WS_WDO), scr, r, lane); continue; } r -= I_DO;
        if (r < I_OUT) { p0_transpose_item(a.in[I_WOUT], 1024, 1024, (bf16*)(ws + WS_WOUT), scr, r, lane); continue; } r -= I_OUT;
        if (r < I_1) { p0_transpose_item(a.in[I_WFF1], 1024, FF, (bf16*)(ws + WS_W1), scr, r, lane); continue; } r -= I_1;
        p0_transpose_item(a.in[I_WFF2], FF, 1024, (bf16*)(ws + WS_W2), scr, r, lane);
    }
    { v4u* z = (v4u*)((bf16*)(ws + WS_WIN) + (size_t)NIN * 1024); const int n16 = (NINP - NIN) * 1024 * 2 / 16;
      for (int i = gw * 64 + lane; i < n16; i += NGW * 64) z[i] = (v4u){0u, 0u, 0u, 0u}; }
}

__device__ __forceinline__ const float* x_row(const Args& a, int m) { return m < M_CTX ? a.in[I_XP] + (size_t)m * DM : a.in[I_XS] + (size_t)(m - M_CTX) * DM; }
__device__ __forceinline__ int mod_idx(int m) { return m < M_CTX ? 0 : 1 + ((m - M_CTX) >> 10); }

__device__ __forceinline__ void phase_xn(const Args& a, int vcu, int G) {
    const int tid = threadIdx.x, lane = tid & 63, wave = tid >> 6;
    const int gw = vcu * NWAVES + wave, NGW = G * NWAVES;
    const float* MOD = (const float*)(a.ws + WS_MOD); bf16* XN = (bf16*)(a.ws + WS_XN);
    for (int m = gw; m < MT; m += NGW) {
        const f32x4* xr = (const f32x4*)x_row(a, m) + lane;
        const float* md = MOD + mod_idx(m) * 6144;
        f32x4 v[4]; float s = 0.f;
#pragma unroll
        for (int j = 0; j < 4; ++j) { v[j] = xr[64 * j]; s += (v[j].x * v[j].x + v[j].y * v[j].y) + (v[j].z * v[j].z + v[j].w * v[j].w); }
        const float rstd = rsqrtf(wave_sum(s) * (1.f / DM) + 1e-6f);
        v2u* o8 = (v2u*)(XN + (size_t)m * DM) + lane;
#pragma unroll
        for (int j = 0; j < 4; ++j) { const int c = (lane + 64 * j) * 4;
            const f32x4 w = *(const f32x4*)(a.in[I_PRE1] + c), sh = *(const f32x4*)(md + c), sc = *(const f32x4*)(md + 1024 + c);
            const f32x4 h = v[j] * rstd * w * (sc + 1.0f) + sh;
            v2u o; o.x = pk2(h.x, h.y); o.y = pk2(h.z, h.w); o8[64 * j] = o; }
    }
}

__device__ __forceinline__ bf16x8 pack_regs(const f32x16& p, int s) {
    v4u w; w.x = pk2(p[8 * s], p[8 * s + 1]); w.y = pk2(p[8 * s + 2], p[8 * s + 3]); w.z = pk2(p[8 * s + 4], p[8 * s + 5]); w.w = pk2(p[8 * s + 6], p[8 * s + 7]);
    return __builtin_bit_cast(bf16x8, w);
}
__device__ __forceinline__ void store_o(bf16* dst, const f32x16& o0, const f32x16& o1, float inv, int hh) {
#pragma unroll
    for (int g = 0; g < 4; ++g) {
        v2u w0, w1; w0.x = pk2(o0[4 * g] * inv, o0[4 * g + 1] * inv); w0.y = pk2(o0[4 * g + 2] * inv, o0[4 * g + 3] * inv);
        w1.x = pk2(o1[4 * g] * inv, o1[4 * g + 1] * inv); w1.y = pk2(o1[4 * g + 2] * inv, o1[4 * g + 3] * inv);
        *(v2u*)(dst + 8 * g + 4 * hh) = w0; *(v2u*)(dst + 32 + 8 * g + 4 * hh) = w1;
    }
}
constexpr float LOG2E = 1.4426950408889634f;

__device__ __forceinline__ void na_ctx_task(const Args& a, int task, int lane) {
    const int qb = task & 7, h = (task >> 3) & 7, b = task >> 6;
    const int r = lane & 31, hh = lane >> 5;
    const bf16* P = (const bf16*)(a.ws + WS_P); const bf16* VT = (const bf16*)a.out + (size_t)3 * MT * 512;
    bf16* ONA = (bf16*)(a.ws + WS_ONA);
    const bf16* Pq = P + (size_t)(b * 256 + qb * 32 + r) * NINP + C_Q + h * 64 + 8 * hh;
    bf16x8 qf[4];
#pragma unroll
    for (int s = 0; s < 4; ++s) qf[s] = *(const bf16x8*)(Pq + 16 * s);
    f32x16 st[8];
#pragma unroll
    for (int kt = 0; kt < 8; ++kt) {
        const bf16* Pk = P + (size_t)(b * 256 + kt * 32 + r) * NINP + C_K + h * 64 + 8 * hh;
        f32x16 acc = {};
#pragma unroll
        for (int s = 0; s < 4; ++s) { const bf16x8 kf = *(const bf16x8*)(Pk + 16 * s); acc = MFMA32(kf, qf[s], acc); }
        st[kt] = acc;
    }
    float mx = -3.0e38f;
#pragma unroll
    for (int kt = 0; kt < 8; ++kt)
#pragma unroll
        for (int i = 0; i < 16; ++i) mx = fmaxf(mx, st[kt][i]);
    mx = fmaxf(mx, __shfl_xor(mx, 32));
    const float sc = 0.125f * LOG2E; float sum = 0.f;
#pragma unroll
    for (int kt = 0; kt < 8; ++kt)
#pragma unroll
        for (int i = 0; i < 16; ++i) { const float p = exp2f((st[kt][i] - mx) * sc); st[kt][i] = p; sum += p; }
    sum += __shfl_xor(sum, 32);
    const bf16* VTb = VT + ((size_t)(b * 8 + h) * 64 + r) * 256 + 8 * hh;
    f32x16 o0 = {}, o1 = {};
#pragma unroll
    for (int kt = 0; kt < 8; ++kt)
#pragma unroll
        for (int s2 = 0; s2 < 2; ++s2) {
            const bf16x8 pb = pack_regs(st[kt], s2);
            const bf16x8 a0 = *(const bf16x8*)(VTb + 32 * kt + 16 * s2), a1 = *(const bf16x8*)(VTb + 32 * 256 + 32 * kt + 16 * s2);
            o0 = MFMA32(a0, pb, o0); o1 = MFMA32(a1, pb, o1);
        }
    store_o(ONA + (size_t)(b * 256 + qb * 32 + r) * 512 + h * 64, o0, o1, 1.0f / sum, hh);
}

__device__ __forceinline__ void na_lat_task(const Args& a, int task, int lane) {
    const int half = task & 1, gr = (task >> 1) & 15, h = (task >> 5) & 7, b = task >> 8;
    const int r = lane & 31, hh = lane >> 5;
    const bf16* P = (const bf16*)(a.ws + WS_P); const bf16* VT = (const bf16*)a.out + (size_t)3 * MT * 512 + (size_t)M_CTX * 512;
    const bf16* CK = (const bf16*)(a.ws + WS_CK) + (size_t)(b * 8 + h) * 256 * 64; const bf16* CVT = (const bf16*)(a.ws + WS_CVT) + (size_t)(b * 8 + h) * 64 * 256;
    const float* rpb = a.in[I_RPB] + h * 15 * 31;
    bf16* ONA = (bf16*)(a.ws + WS_ONA);
    const int cq = 32 * half + r, rowq = M_CTX + b * 1024 + gr * 64 + cq;
    const bf16* Pq = P + (size_t)rowq * NINP + C_Q + h * 64 + 8 * hh;
    bf16x8 qf[4];
#pragma unroll
    for (int s = 0; s < 4; ++s) qf[s] = *(const bf16x8*)(Pq + 16 * s);
    float m = -3.0e38f, l = 0.f; f32x16 o0 = {}, o1 = {};
    const float sc = 0.125f * LOG2E;
#define NA_STEP(S, VA0, VA1) do { \
        float tm = S[0]; _Pragma("unroll") for (int i = 1; i < 16; ++i) tm = fmaxf(tm, S[i]); \
        tm = fmaxf(tm, __shfl_xor(tm, 32)); const float mn = fmaxf(m, tm); const float al = exp2f(m - mn); m = mn; \
        float ps = 0.f; _Pragma("unroll") for (int i = 0; i < 16; ++i) { S[i] = exp2f(S[i] - mn); ps += S[i]; } \
        l = l * al + ps; o0 = o0 * al; o1 = o1 * al; \
        _Pragma("unroll") for (int s2 = 0; s2 < 2; ++s2) { const bf16x8 pb = pack_regs(S, s2); \
            o0 = MFMA32(*(const bf16x8*)((VA0) + 16 * s2), pb, o0); o1 = MFMA32(*(const bf16x8*)((VA1) + 16 * s2), pb, o1); } } while (0)
    for (int kt = 0; kt < 8; ++kt) {
        const bf16* Pk = CK + (size_t)(kt * 32 + r) * 64 + 8 * hh;
        f32x16 s = {};
#pragma unroll
        for (int ks = 0; ks < 4; ++ks) s = MFMA32(*(const bf16x8*)(Pk + 16 * ks), qf[ks], s);
#pragma unroll
        for (int i = 0; i < 16; ++i) s[i] *= sc;
        const bf16* va = CVT + (size_t)r * 256 + 32 * kt + 8 * hh;
        NA_STEP(s, va, va + 32 * 256);
    }
    const int rs = min(max(gr - 4, 0), 8), cs = min(max(cq - 8, 0), 48);
    const bf16* VTb = VT + ((size_t)(b * 8 + h) * 64 + r) * 1024 + 8 * hh;
    for (int kk = 0; kk < 8; ++kk) {
        const int kr = rs + kk;
        const float* rp = rpb + (kr - gr + 7) * 31 + 15 - cq;
        for (int ct = 0; ct < 2; ++ct) {
            const int tk = kr * 64 + ct * 32;
            const bf16* Pk = P + (size_t)(M_CTX + b * 1024 + tk + r) * NINP + C_K + h * 64 + 8 * hh;
            f32x16 s = {};
#pragma unroll
            for (int ks = 0; ks < 4; ++ks) s = MFMA32(*(const bf16x8*)(Pk + 16 * ks), qf[ks], s);
#pragma unroll
            for (int i = 0; i < 16; ++i) { const int kc = ct * 32 + crow(i, hh); const bool ok = (kc >= cs) && (kc < cs + 16);
                const float bias = ok ? rp[kc] : 0.f; s[i] = ok ? (s[i] * 0.125f + bias) * LOG2E : -1.0e30f; }
            const bf16* va = VTb + tk;
            NA_STEP(s, va, va + 32 * 1024);
        }
    }
#undef NA_STEP
    l += __shfl_xor(l, 32);
    store_o(ONA + (size_t)rowq * 512 + h * 64, o0, o1, 1.0f / l, hh);
}

__device__ __forceinline__ void conv_task(const Args& a, int task, int lane) {
    const int part = task % 3, chunk = task / 3, r0 = chunk * 16;
    const bf16* P = (const bf16*)(a.ws + WS_P); bf16* DST = (bf16*)a.out + (size_t)part * MT * 512;
    const int seq0 = r0 < M_CTX ? (r0 & ~255) : M_CTX + ((r0 - M_CTX) & ~1023), seq1 = r0 < M_CTX ? seq0 + 256 : seq0 + 1024;
    const float* cw = a.in[I_CONVW] + part * 512 + 8 * lane;
    float w[5][8];
#pragma unroll
    for (int t = 0; t < 5; ++t) { const f32x4 w0 = *(const f32x4*)(cw + t * 1536), w1 = *(const f32x4*)(cw + t * 1536 + 4);
#pragma unroll
        for (int i = 0; i < 4; ++i) { w[t][i] = w0[i]; w[t][4 + i] = w1[i]; } }
    const bf16* src = P + C_DN + part * 512 + 8 * lane;
    float x[5][8];
#define CONV_LOAD(dst, row) do { if ((row) >= seq0 && (row) < seq1) { const v4u q = *(const v4u*)(src + (size_t)(row) * NINP); \
        dst[0] = bflo(q.x); dst[1] = bfhi(q.x); dst[2] = bflo(q.y); dst[3] = bfhi(q.y); dst[4] = bflo(q.z); dst[5] = bfhi(q.z); dst[6] = bflo(q.w); dst[7] = bfhi(q.w); } \
        else { _Pragma("unroll") for (int i_ = 0; i_ < 8; ++i_) dst[i_] = 0.f; } } while (0)
    CONV_LOAD(x[0], r0 - 2); CONV_LOAD(x[1], r0 - 1); CONV_LOAD(x[2], r0); CONV_LOAD(x[3], r0 + 1);
    for (int rr = 0; rr < 16; ++rr) {
        const int row = r0 + rr;
        CONV_LOAD(x[4], row + 2);
        float o[8]; float ss = 0.f;
#pragma unroll
        for (int i = 0; i < 8; ++i) { float v = w[0][i] * x[0][i] + w[1][i] * x[1][i] + w[2][i] * x[2][i] + w[3][i] * x[3][i] + w[4][i] * x[4][i]; v = silu_(v); o[i] = v; ss += v * v; }
        if (part < 2) { ss += __shfl_xor(ss, 1); ss += __shfl_xor(ss, 2); ss += __shfl_xor(ss, 4); const float rn = rsqrtf(ss + 1e-6f);
#pragma unroll
            for (int i = 0; i < 8; ++i) o[i] *= rn; }
        v4u q; q.x = pk2(o[0], o[1]); q.y = pk2(o[2], o[3]); q.z = pk2(o[4], o[5]); q.w = pk2(o[6], o[7]);
        *(v4u*)(DST + (size_t)row * 512 + 8 * lane) = q;
#pragma unroll
        for (int t = 0; t < 4; ++t)
#pragma unroll
            for (int i = 0; i < 8; ++i) x[t][i] = x[t + 1][i];
    }
#undef CONV_LOAD
}

__device__ __forceinline__ void phase_mix_a(const Args& a, int vcu, int G) {
    const int tid = threadIdx.x, lane = tid & 63, wave = __builtin_amdgcn_readfirstlane(tid >> 6);
    const int gw = wave * G + vcu, NGW = G * NWAVES;
    constexpr int N_LAT = 1024, N_CTX = 2048, N_CONV = 768 * 3;
    for (int t = gw; t < N_LAT + N_CTX + N_CONV; t += NGW) {
        if (t < N_LAT) na_lat_task(a, t, lane);
        else if (t < N_LAT + N_CTX) na_ctx_task(a, t - N_LAT, lane);
        else conv_task(a, t - N_LAT - N_CTX, lane);
    }
}

__device__ __forceinline__ void dn_chain(const Args& a, int chain, LAS unsigned char* wl, int lane) {
    int b, h, dir, T, rowbase; const bool lat = chain < 64;
    if (lat) { b = chain >> 4; h = (chain >> 1) & 7; dir = chain & 1; T = 1024; rowbase = M_CTX + b * 1024; }
    else { const int c = chain - 64; b = c >> 4; h = (c >> 1) & 7; dir = c & 1; T = 256; rowbase = b * 256; }
    const bf16* DQ = (const bf16*)a.out; const bf16* DK = DQ + (size_t)MT * 512; const bf16* DV = DK + (size_t)MT * 512;
    const float* BA = (const float*)(a.ws + WS_BA);
    float* OUTO = dir ? (float*)(a.ws + WS_M1) : (float*)(a.ws + WS_XN);
    const float Aexp = -__expf(a.in[I_ALOG][dir * 8 + h]), dtb = a.in[I_DTB][dir * 8 + h];
    LAS float* qs = (LAS float*)wl; LAS float* ks = qs + 16 * 64; LAS float* vs = ks + 16 * 64; LAS float* scs = vs + 16 * 64;
    float S[64];
    if (lat) { const float* s0 = a.in[I_ST] + ((size_t)((b * 2 + dir) * 8 + h) * 64) * 64 + lane;
#pragma unroll
        for (int i = 0; i < 64; ++i) S[i] = s0[i * 64]; }
    else {
#pragma unroll
        for (int i = 0; i < 64; ++i) S[i] = 0.f; }
    for (int s0 = 0; s0 < T; s0 += 16) {
        LDS_WAIT();
#pragma unroll
        for (int i = 0; i < 2; ++i) { const int id = lane + 64 * i, tok = id >> 3, c8 = id & 7; const int t = dir ? T - 1 - (s0 + tok) : s0 + tok;
            const size_t off = (size_t)(rowbase + t) * 512 + h * 64 + c8 * 8;
            const v4u q = *(const v4u*)(DQ + off), k = *(const v4u*)(DK + off), v = *(const v4u*)(DV + off);
            *(LAS f32x4*)(qs + tok * 64 + c8 * 8) = (f32x4){bflo(q.x), bfhi(q.x), bflo(q.y), bfhi(q.y)}; *(LAS f32x4*)(qs + tok * 64 + c8 * 8 + 4) = (f32x4){bflo(q.z), bfhi(q.z), bflo(q.w), bfhi(q.w)};
            *(LAS f32x4*)(ks + tok * 64 + c8 * 8) = (f32x4){bflo(k.x), bfhi(k.x), bflo(k.y), bfhi(k.y)}; *(LAS f32x4*)(ks + tok * 64 + c8 * 8 + 4) = (f32x4){bflo(k.z), bfhi(k.z), bflo(k.w), bfhi(k.w)};
            *(LAS f32x4*)(vs + tok * 64 + c8 * 8) = (f32x4){bflo(v.x), bfhi(v.x), bflo(v.y), bfhi(v.y)}; *(LAS f32x4*)(vs + tok * 64 + c8 * 8 + 4) = (f32x4){bflo(v.z), bfhi(v.z), bflo(v.w), bfhi(v.w)};
        }
        LDS_WAIT();
        if (lane < 16) { const int tok = lane; const int t = dir ? T - 1 - (s0 + tok) : s0 + tok; const float* ba = BA + (size_t)(rowbase + t) * 32;
            const float beta = sigm_(ba[dir * 8 + h]); const float xx = ba[16 + dir * 8 + h] + dtb; const float sp = xx > 20.f ? xx : log1pf(__expf(xx));
            const float av = __expf(Aexp * sp); float qk = 0.f;
            for (int i = 0; i < 64; ++i) qk += qs[tok * 64 + i] * ks[tok * 64 + i];
            scs[tok * 4 + 0] = beta; scs[tok * 4 + 1] = av; scs[tok * 4 + 2] = qk; }
        LDS_WAIT();
        for (int tok = 0; tok < 16; ++tok) {
            const int t = dir ? T - 1 - (s0 + tok) : s0 + tok;
            float kv[64]; float r = 0.f, p = 0.f;
#pragma unroll
            for (int i4 = 0; i4 < 16; ++i4) { const f32x4 k4 = *(const LAS f32x4*)(ks + tok * 64 + 4 * i4), q4 = *(const LAS f32x4*)(qs + tok * 64 + 4 * i4);
#pragma unroll
                for (int j = 0; j < 4; ++j) { kv[4 * i4 + j] = k4[j]; r += k4[j] * S[4 * i4 + j]; p += q4[j] * S[4 * i4 + j]; } }
            const float beta = scs[tok * 4 + 0], av = scs[tok * 4 + 1], qk = scs[tok * 4 + 2];
            const float c = beta * (vs[tok * 64 + lane] - av * r);
#pragma unroll
            for (int i = 0; i < 64; ++i) S[i] = av * S[i] + c * kv[i];
            OUTO[(size_t)(rowbase + t) * 512 + h * 64 + lane] = 0.125f * (av * p + c * qk);
        }
    }
    if (!lat) { float* so = a.out + OUT_S + ((size_t)((b * 2 + dir) * 8 + h) * 64) * 64 + lane;
#pragma unroll
        for (int i = 0; i < 64; ++i) so[i * 64] = S[i]; }
}
__device__ __forceinline__ void phase_dn_seq(const Args& a, LAS unsigned char* lds, int vcu, int G) {
    const int tid = threadIdx.x, lane = tid & 63, wave = __builtin_amdgcn_readfirstlane(tid >> 6);
    for (int c = wave * G + vcu; c < 576; c += G * NWAVES) dn_chain(a, c, lds + wave * 16384, lane);
}

__device__ __forceinline__ void phase_combine(const Args& a, int vcu, int G) {
    const int tid = threadIdx.x, lane = tid & 63, wave = tid >> 6;
    const int gw = vcu * NWAVES + wave, NGW = G * NWAVES;
    const float* OF = (const float*)(a.ws + WS_XN); const float* OB = (const float*)(a.ws + WS_M1);
    const bf16* P = (const bf16*)(a.ws + WS_P); bf16* ODN = (bf16*)(a.ws + WS_ODN);
    const f32x4 n0 = *(const f32x4*)(a.in[I_DNN] + ((8 * lane) & 63)), n1 = *(const f32x4*)(a.in[I_DNN] + ((8 * lane) & 63) + 4);
    for (int m = gw; m < MT; m += NGW) {
        const size_t off = (size_t)m * 512 + 8 * lane;
        f32x4 o0 = *(const f32x4*)(OF + off) + *(const f32x4*)(OB + off), o1 = *(const f32x4*)(OF + off + 4) + *(const f32x4*)(OB + off + 4);
        float ss = (o0.x * o0.x + o0.y * o0.y) + (o0.z * o0.z + o0.w * o0.w) + (o1.x * o1.x + o1.y * o1.y) + (o1.z * o1.z + o1.w * o1.w);
        ss += __shfl_xor(ss, 1); ss += __shfl_xor(ss, 2); ss += __shfl_xor(ss, 4);
        const float rstd = rsqrtf(ss * (1.f / 64.f) + 1e-6f);
        const v4u z = *(const v4u*)(P + (size_t)m * NINP + C_Z + 8 * lane);
        o0 = o0 * rstd * n0; o1 = o1 * rstd * n1;
        v4u q; q.x = pk2(o0.x * silu_(bflo(z.x)), o0.y * silu_(bfhi(z.x))); q.y = pk2(o0.z * silu_(bflo(z.y)), o0.w * silu_(bfhi(z.y)));
        q.z = pk2(o1.x * silu_(bflo(z.z)), o1.y * silu_(bfhi(z.z))); q.w = pk2(o1.z * silu_(bflo(z.w)), o1.w * silu_(bfhi(z.w)));
        *(v4u*)(ODN + off) = q;
    }
}

__device__ __forceinline__ void phase_row1(const Args& a, int vcu, int G) {
    const int tid = threadIdx.x, lane = tid & 63, wave = tid >> 6;
    const int gw = vcu * NWAVES + wave, NGW = G * NWAVES;
    const float* MOD = (const float*)(a.ws + WS_MOD); const bf16* Y = (const bf16*)(a.ws + WS_ONA); const float* RSS = (const float*)(a.ws + WS_RSS1);
    bf16* XN = (bf16*)(a.ws + WS_XN);
    for (int m = gw; m < MT; m += NGW) {
        const f32x4* xr = (const f32x4*)x_row(a, m) + lane; const float* md = MOD + mod_idx(m) * 6144;
        float rs = 0.f;
        { const f32x4* rp = (const f32x4*)(RSS + (size_t)m * 16); const f32x4 r0 = rp[0], r1 = rp[1], r2 = rp[2], r3 = rp[3];
          rs = ((r0.x + r0.y) + (r0.z + r0.w)) + ((r1.x + r1.y) + (r1.z + r1.w)) + ((r2.x + r2.y) + (r2.z + r2.w)) + ((r3.x + r3.y) + (r3.z + r3.w)); }
        const float rstd1 = rsqrtf(rs * (1.f / DM) + 1e-6f);
        f32x4 x1[4]; float s = 0.f;
        const v2u* yr = (const v2u*)(Y + (size_t)m * DM) + lane;
        f32x4* orow = (f32x4*)(a.out + (size_t)m * DM) + lane;
#pragma unroll
        for (int j = 0; j < 4; ++j) { const int c = (lane + 64 * j) * 4; const v2u yy = yr[64 * j];
            const f32x4 yv = {bflo(yy.x), bfhi(yy.x), bflo(yy.y), bfhi(yy.y)};
            const f32x4 g1 = *(const f32x4*)(md + 2048 + c), pw = *(const f32x4*)(a.in[I_POST1] + c);
            x1[j] = xr[64 * j] + g1 * (yv * rstd1 * pw); orow[64 * j] = x1[j];
            s += (x1[j].x * x1[j].x + x1[j].y * x1[j].y) + (x1[j].z * x1[j].z + x1[j].w * x1[j].w); }
        const float rstd2 = rsqrtf(wave_sum(s) * (1.f / DM) + 1e-6f);
        v2u* o8 = (v2u*)(XN + (size_t)m * DM) + lane;
#pragma unroll
        for (int j = 0; j < 4; ++j) { const int c = (lane + 64 * j) * 4;
            const f32x4 w = *(const f32x4*)(a.in[I_PRE2] + c), sh = *(const f32x4*)(md + 3072 + c), sc = *(const f32x4*)(md + 4096 + c);
            const f32x4 h = x1[j] * rstd2 * w * (sc + 1.0f) + sh;
            v2u o; o.x = pk2(h.x, h.y); o.y = pk2(h.z, h.w); o8[64 * j] = o; }
    }
}
__device__ __forceinline__ void phase_row2(const Args& a, int vcu, int G) {
    const int tid = threadIdx.x, lane = tid & 63, wave = tid >> 6;
    const int gw = vcu * NWAVES + wave, NGW = G * NWAVES;
    const float* MOD = (const float*)(a.ws + WS_MOD); const bf16* Fm = (const bf16*)(a.ws + WS_ONA); const float* RSS = (const float*)(a.ws + WS_RSS2);
    for (int m = gw; m < MT; m += NGW) {
        const float* md = MOD + mod_idx(m) * 6144;
        float rs = 0.f;
        { const f32x4* rp = (const f32x4*)(RSS + (size_t)m * 16); const f32x4 r0 = rp[0], r1 = rp[1], r2 = rp[2], r3 = rp[3];
          rs = ((r0.x + r0.y) + (r0.z + r0.w)) + ((r1.x + r1.y) + (r1.z + r1.w)) + ((r2.x + r2.y) + (r2.z + r2.w)) + ((r3.x + r3.y) + (r3.z + r3.w)); }
        const float rstd = rsqrtf(rs * (1.f / DM) + 1e-6f);
        const v2u* fr = (const v2u*)(Fm + (size_t)m * DM) + lane;
        f32x4* orow = (f32x4*)(a.out + (size_t)m * DM) + lane;
#pragma unroll
        for (int j = 0; j < 4; ++j) { const int c = (lane + 64 * j) * 4; const v2u ff = fr[64 * j];
            const f32x4 fv = {bflo(ff.x), bfhi(ff.x), bflo(ff.y), bfhi(ff.y)};
            const f32x4 g2 = *(const f32x4*)(md + 5120 + c), pw = *(const f32x4*)(a.in[I_POST2] + c);
            orow[64 * j] = orow[64 * j] + g2 * (fv * rstd * pw); }
    }
}

constexpr int N_PHASES = 12;
__global__ void __launch_bounds__(NWAVES * 64, 2) fwd_kernel(Args args) {
    extern __shared__ __attribute__((aligned(16))) unsigned char lds_raw[];
    LAS unsigned char* lds = (LAS unsigned char*)lds_raw;
    const int tid = threadIdx.x;
    const int G = gridDim.x; const int bx = blockIdx.x; const int vcu = (G % 8 == 0) ? (bx % 8) * (G / 8) + bx / 8 : bx;
    volatile LAS unsigned* MISC = (volatile LAS unsigned*)(lds + MISC_OFF);
    for (int u = tid; u < (LDS_BYTES - LDSCTL_OFF) / 4; u += NWAVES * 64) ((LAS unsigned*)(lds + LDSCTL_OFF))[u] = 0u;
    __syncthreads();
    const int lo = args.ph_lo, hi = args.ph_hi;
    const bool one = (hi - lo) > 1;
    unsigned* ctl = (unsigned*)(args.ws + WS_CTL);
    XcdBarrier bar; bar.bar = ctl + CW_BAR; bar.x = 0; bar.st = nullptr;
    if (one) bar = xcd_barrier_post(ctl + CW_BAR, MISC + 8);
#define IN(k) (lo <= (k) && (k) < hi)
#define SEAM(k) do { if (IN(k) && IN((k) + 1)) xcd_barrier(bar); } while (0)
    unsigned char* ws = args.ws;
    typedef pg8::bf16_t pb;

    if (IN(0)) { phase_prologue(args, lds, vcu, G); SEAM(0); }
    if (IN(1)) { phase_xn(args, vcu, G); SEAM(1); }
    if (IN(2)) {
        pg8::Gemm g{(const pb*)(ws + WS_XN), (const pb*)(ws + WS_WIN), MT, NINP, 1024}; pg8::StaticOrder S; S.init(MT, NINP, G, bx);
        pg8::EpiInProj E{(pb*)(ws + WS_P), args.out + OUT_K, args.out + OUT_V, (float*)(ws + WS_BA), (pb*)args.out + (size_t)3 * MT * 512, (const float*)(ws + WS_ROPE)};
        pg8::gemm_phase<pg8::EpiInProj, pg8::StaticOrder, true, true>(lds, g, S, E);
        SEAM(2);
    }
    if (IN(3)) { phase_mix_a(args, vcu, G); SEAM(3); }
    if (IN(4)) { phase_dn_seq(args, lds, vcu, G); SEAM(4); }
    if (IN(5)) { phase_combine(args, vcu, G); SEAM(5); }
    if (IN(6)) {
        pg8::StaticOrder S; S.init(MT, 1024, G, bx);
        { pg8::Gemm g{(const pb*)(ws + WS_ONA), (const pb*)(ws + WS_WAO), MT, 1024, 512};
          pg8::EpiGate1 E{(const pb*)(ws + WS_P), (pb*)(ws + WS_M1)};
          pg8::gemm_phase<pg8::EpiGate1, pg8::StaticOrder, true, true>(lds, g, S, E); }
        { pg8::Gemm g{(const pb*)(ws + WS_ODN), (const pb*)(ws + WS_WDO), MT, 1024, 512};
          pg8::EpiGate2 E{(const pb*)(ws + WS_P), (const pb*)(ws + WS_M1), (pb*)(ws + WS_XN)};
          pg8::gemm_phase<pg8::EpiGate2, pg8::StaticOrder, true, true>(lds, g, S, E); }
        SEAM(6);
    }
    if (IN(7)) {
        pg8::Gemm g{(const pb*)(ws + WS_XN), (const pb*)(ws + WS_WOUT), MT, 1024, 1024}; pg8::StaticOrder S; S.init(MT, 1024, G, bx);
        pg8::EpiRss E{(pb*)(ws + WS_ONA), (float*)(ws + WS_RSS1)};
        pg8::gemm_phase<pg8::EpiRss, pg8::StaticOrder, true, true>(lds, g, S, E);
        SEAM(7);
    }
    if (IN(8)) { phase_row1(args, vcu, G); SEAM(8); }
    if (IN(9)) {
        pg8::Gemm g{(const pb*)(ws + WS_XN), (const pb*)(ws + WS_W1), MT, FF, 1024}; pg8::StaticOrder S; S.init(MT, FF, G, bx);
        pg8::EpiRelu2 E{(pb*)(ws + WS_P)};
        pg8::gemm_phase<pg8::EpiRelu2, pg8::StaticOrder, true, true>(lds, g, S, E);
        SEAM(9);
    }
    if (IN(10)) {
        pg8::Gemm g{(const pb*)(ws + WS_P), (const pb*)(ws + WS_W2), MT, 1024, FF}; pg8::StaticOrder S; S.init(MT, 1024, G, bx);
        pg8::EpiRss E{(pb*)(ws + WS_ONA), (float*)(ws + WS_RSS2)};
        pg8::gemm_phase<pg8::EpiRss, pg8::StaticOrder, true, true>(lds, g, S, E);
        SEAM(10);
    }
    if (IN(11)) { phase_row2(args, vcu, G); }
#undef IN
#undef SEAM
}

#ifndef MK_ONE_LAUNCH
#define MK_ONE_LAUNCH 1
#endif
extern "C" void kernel_launch(void* const* d_in, const int* in_sizes, int n_in, void* d_out, int out_size, void* d_ws, size_t ws_size, hipStream_t stream) {
    static int grid = 0;
    if (grid == 0) {
        if (n_in != 24 || ws_size < WS_END) { fprintf(stderr, "kernel_launch: unexpected n_in %d / ws %zu\n", n_in, ws_size); grid = -1; return; }
        int dev = 0, cus = 0;
        if (hipGetDevice(&dev) != hipSuccess || hipDeviceGetAttribute(&cus, hipDeviceAttributeMultiprocessorCount, dev) != hipSuccess) { grid = -1; return; }
        if (hipFuncSetAttribute((const void*)fwd_kernel, hipFuncAttributeMaxDynamicSharedMemorySize, LDS_BYTES) != hipSuccess) { fprintf(stderr, "kernel_launch: hipFuncSetAttribute failed\n"); grid = -1; return; }
        int per_cu = 0;
        if (hipOccupancyMaxActiveBlocksPerMultiprocessor(&per_cu, (const void*)fwd_kernel, NWAVES * 64, LDS_BYTES) != hipSuccess || per_cu < 1) fprintf(stderr, "kernel_launch: occupancy query says %d\n", per_cu);
        (void)hipGetLastError();
        grid = cus;
    }
    if (grid < 0) return;
    (void)hipMemsetAsync((char*)d_ws + WS_CTL, 0, CTL_ZERO_BYTES, stream);
    Args a{};
    for (int i = 0; i < 24; ++i) a.in[i] = (const float*)d_in[i];
    a.out = (float*)d_out; a.ws = (unsigned char*)d_ws;
#if MK_ONE_LAUNCH
    a.ph_lo = 0; a.ph_hi = N_PHASES;
    hipLaunchKernelGGL(fwd_kernel, dim3(grid), dim3(NWAVES * 64), LDS_BYTES, stream, a);
#else
    for (int p = 0; p < N_PHASES; ++p) { a.ph_lo = p; a.ph_hi = p + 1; hipLaunchKernelGGL(fwd_kernel, dim3(grid), dim3(NWAVES * 64), LDS_BYTES, stream, a); }
#endif
}
```

```cpp
#include <hip/hip_runtime.h>
#include <cstdio>
#include <cstdint>

constexpr int DM = 1024, M_CTX = 8192, M_LAT = 4096, MT = 12288, NIN = 5664, NINP = 5888, FF = 4096;
constexpr int LDA_ = 3072, LDB_ = 2816;
constexpr int C_Q = 0, C_K = 512, C_V = 1024, C_DN = 1536, CB_Z = 32, CB_GA = 544, CB_GD = 1568;

namespace pg8 {
#define PG8_LAS __attribute__((address_space(3)))
typedef unsigned short bf16_t;
typedef short bf16x8 __attribute__((ext_vector_type(8)));
typedef float f32x4 __attribute__((ext_vector_type(4)));
typedef unsigned u32x4 __attribute__((ext_vector_type(4)));
typedef unsigned u32x2 __attribute__((ext_vector_type(2)));
constexpr int BM = 256, BK = 64, HALF = 128, HTB = HALF * BK * 2  , STAGE_BYTES = 8 * HTB, NXCD = 8, WGM = 8;

__host__ __device__ __forceinline__ int lds_byte(int r, int c) { const int st = (r >> 4) * 2 + (c >> 5), rr = r & 15, cc = c & 31, ob = rr * 64 + cc * 2; return st * 1024 + (ob ^ (((ob >> 9) & 1) << 5)); }
__host__ __device__ __forceinline__ void stage_rc(int b, int& R, int& C) { const int st = b / 1024, sb = b % 1024, swz = sb ^ (((sb >> 9) & 1) << 5); R = (st >> 1) * 16 + swz / 64; C = (st & 1) * 32 + (swz % 64) / 2; }
__host__ __device__ __forceinline__ int perm32(int rho) { const int n = rho >> 4, i = rho & 15; return 8 * (i >> 2) + 4 * n + (i & 3); }

struct Unit { int pm, pn; };
struct Gemm { const bf16_t* A; const bf16_t* Bt; int M, N, K; };

struct StaticOrder {
    int nM, nN, nwg, G, c;
    __host__ __device__ void init(int M, int N, int G_, int c_) { nM = M / BM; nN = N / BM; nwg = nM * nN; G = G_; c = c_; }
    __host__ __device__ bool next(int i, Unit& u) const {
        const long L = (long)i * G + c; if (L >= nwg) return false;
        int wgid = (int)L; { const int q = nwg / NXCD, r = nwg % NXCD, xcd = wgid % NXCD, off = wgid / NXCD; wgid = (xcd < r ? xcd * (q + 1) : r * (q + 1) + (xcd - r) * q) + off; }
        const int nig = WGM * nN, gid = wgid / nig, fm = gid * WGM, gsz = (nM - fm) < WGM ? (nM - fm) : WGM;
        u.pm = fm + ((wgid % nig) % gsz); u.pn = (wgid % nig) / gsz; return true;
    }
    __device__ __forceinline__ void a_ready(const Unit&) const {}
    __device__ __forceinline__ void done(const Unit&) const {}
};

__device__ __forceinline__ unsigned cvt_pk_bf16(float lo, float hi) { unsigned r; asm volatile("v_cvt_pk_bf16_f32 %0, %1, %2" : "=v"(r) : "v"(lo), "v"(hi)); return r; }
__device__ __forceinline__ float bf_lo(unsigned w) { return __uint_as_float(w << 16); }
__device__ __forceinline__ float bf_hi(unsigned w) { return __uint_as_float(w & 0xffff0000u); }
__device__ __forceinline__ float sigmoidf_(float x) { return 1.0f / (1.0f + __expf(-x)); }
__device__ __forceinline__ u32x4 pack8(const f32x4& v0, const f32x4& v1) { u32x4 w; w.x = cvt_pk_bf16(v0[0], v0[1]); w.y = cvt_pk_bf16(v0[2], v0[3]); w.z = cvt_pk_bf16(v1[0], v1[1]); w.w = cvt_pk_bf16(v1[2], v1[3]); return w; }


struct EpiInProj {
    static constexpr bool PERM = true, AFTER_DRAIN = false;
    bf16_t* PA; bf16_t* PB; float* ko; float* vo; float* BA; bf16_t* VT; const float* rope;
    __device__ __forceinline__ void operator()(const f32x4 (&acc)[2][2][4][2], const Unit& u, int wr, int wc, int fr, int fq) const {
        const int pn = u.pn, pm = u.pm;
        const bool lat = pm >= 32;
        const bool do_rope = lat && pn < 4;
        const bool do_kv = (!lat) && pn >= 2 && pn < 6;
        const bool do_vt = pn == 4 || pn == 5;
        const bool do_ba = pn == 12 && wc == 0;
        const int lane_hi = fq >> 1;
#pragma unroll
        for (int ai = 0; ai < 2; ++ai)
#pragma unroll
            for (int m = 0; m < 4; ++m) {
                const int row = pm * BM + ai * HALF + wr * 64 + m * 16 + fr;
#pragma unroll
                for (int bj = 0; bj < 2; ++bj) {
                    f32x4 v0 = acc[ai][bj][m][0], v1 = acc[ai][bj][m][1];
                    const int col = pn * BM + bj * HALF + wc * 32 + 8 * fq;
                    if (do_rope) {
                        const int t = (row - M_CTX) & 1023;
                        const int pos = (wc & 1) ? (t & 63) : (t >> 6);
                        const float* cp = rope + pos * 16 + 8 * (fq & 1);
                        const f32x4 c0 = *(const f32x4*)cp, c1 = *(const f32x4*)(cp + 4), s0 = *(const f32x4*)(cp + 1024), s1 = *(const f32x4*)(cp + 1028);
                        f32x4 p0, p1;
#pragma unroll
                        for (int i = 0; i < 4; ++i) { p0[i] = __shfl_xor(v0[i], 32); p1[i] = __shfl_xor(v1[i], 32); }
                        if (lane_hi) { v0 = p0 * s0 + v0 * c0; v1 = p1 * s1 + v1 * c1; }
                        else         { v0 = v0 * c0 - p0 * s0; v1 = v1 * c1 - p1 * s1; }
                    }
                    if (pn < 12) *(u32x4*)(PA + (size_t)row * LDA_ + col) = pack8(v0, v1); else *(u32x4*)(PB + (size_t)row * LDB_ + (col - 3072)) = pack8(v0, v1);
                    if (do_kv) {
                        const int hh = ((pn & 1) * 4) + bj * 2 + (wc >> 1);
                        const int d = (wc & 1) * 32 + 8 * fq;
                        float* dst = (pn < 4 ? ko : vo) + ((size_t)(pm * 8 + hh) * 256 + (row & 255)) * 64 + d;
                        *(f32x4*)dst = v0; *(f32x4*)(dst + 4) = v1;
                    }
                    if (do_vt) {
                        const int hh = ((pn & 1) * 4) + bj * 2 + (wc >> 1);
                        const int d = (wc & 1) * 32 + 8 * fq;
                        size_t base; int t, T;
                        if (!lat) { t = row & 255; T = 256; base = (size_t)(pm * 8 + hh) * 64 * 256; }
                        else { const int rl = row - M_CTX; t = rl & 1023; T = 1024; base = (size_t)M_CTX * 512 + (size_t)((rl >> 10) * 8 + hh) * 64 * 1024; }
                        const int pos = (t & ~12) | ((t & 4) << 1) | ((t & 8) >> 1);
                        bf16_t* dst = VT + base + (size_t)d * T + pos;
                        const u32x4 w = pack8(v0, v1);
                        dst[0] = (bf16_t)(w.x & 0xffff); dst[(size_t)T] = (bf16_t)(w.x >> 16); dst[(size_t)2 * T] = (bf16_t)(w.y & 0xffff); dst[(size_t)3 * T] = (bf16_t)(w.y >> 16);
                        dst[(size_t)4 * T] = (bf16_t)(w.z & 0xffff); dst[(size_t)5 * T] = (bf16_t)(w.z >> 16); dst[(size_t)6 * T] = (bf16_t)(w.w & 0xffff); dst[(size_t)7 * T] = (bf16_t)(w.w >> 16);
                    }
                    if (do_ba && bj == 0) { float* dst = BA + (size_t)row * 32 + 8 * fq; *(f32x4*)dst = v0; *(f32x4*)(dst + 4) = v1; }
                }
            }
    }
};

struct EpiGate1 {
    static constexpr bool PERM = true, AFTER_DRAIN = false;
    const bf16_t* P; bf16_t* M1;
    __device__ __forceinline__ void operator()(const f32x4 (&acc)[2][2][4][2], const Unit& u, int wr, int wc, int fr, int fq) const {
#pragma unroll
        for (int ai = 0; ai < 2; ++ai)
#pragma unroll
            for (int m = 0; m < 4; ++m) {
                const int row = u.pm * BM + ai * HALF + wr * 64 + m * 16 + fr;
#pragma unroll
                for (int bj = 0; bj < 2; ++bj) {
                    const int col = u.pn * BM + bj * HALF + wc * 32 + 8 * fq;
                    const u32x4 g = *(const u32x4*)(P + (size_t)row * LDB_ + CB_GA + col);
                    f32x4 v0 = acc[ai][bj][m][0], v1 = acc[ai][bj][m][1];
                    v0[0] *= sigmoidf_(bf_lo(g.x)); v0[1] *= sigmoidf_(bf_hi(g.x)); v0[2] *= sigmoidf_(bf_lo(g.y)); v0[3] *= sigmoidf_(bf_hi(g.y));
                    v1[0] *= sigmoidf_(bf_lo(g.z)); v1[1] *= sigmoidf_(bf_hi(g.z)); v1[2] *= sigmoidf_(bf_lo(g.w)); v1[3] *= sigmoidf_(bf_hi(g.w));
                    *(u32x4*)(M1 + (size_t)row * DM + col) = pack8(v0, v1);
                }
            }
    }
};
struct EpiGate2 {
    static constexpr bool PERM = true, AFTER_DRAIN = false;
    const bf16_t* P; const bf16_t* M1; bf16_t* O;
    __device__ __forceinline__ void operator()(const f32x4 (&acc)[2][2][4][2], const Unit& u, int wr, int wc, int fr, int fq) const {
#pragma unroll
        for (int ai = 0; ai < 2; ++ai)
#pragma unroll
            for (int m = 0; m < 4; ++m) {
                const int row = u.pm * BM + ai * HALF + wr * 64 + m * 16 + fr;
#pragma unroll
                for (int bj = 0; bj < 2; ++bj) {
                    const int col = u.pn * BM + bj * HALF + wc * 32 + 8 * fq;
                    const u32x4 g = *(const u32x4*)(P + (size_t)row * LDB_ + CB_GD + col);
                    const u32x4 q = *(const u32x4*)(M1 + (size_t)row * DM + col);
                    f32x4 v0 = acc[ai][bj][m][0], v1 = acc[ai][bj][m][1];
                    v0[0] = bf_lo(q.x) + v0[0] * sigmoidf_(bf_lo(g.x)); v0[1] = bf_hi(q.x) + v0[1] * sigmoidf_(bf_hi(g.x)); v0[2] = bf_lo(q.y) + v0[2] * sigmoidf_(bf_lo(g.y)); v0[3] = bf_hi(q.y) + v0[3] * sigmoidf_(bf_hi(g.y));
                    v1[0] = bf_lo(q.z) + v1[0] * sigmoidf_(bf_lo(g.z)); v1[1] = bf_hi(q.z) + v1[1] * sigmoidf_(bf_hi(g.z)); v1[2] = bf_lo(q.w) + v1[2] * sigmoidf_(bf_lo(g.w)); v1[3] = bf_hi(q.w) + v1[3] * sigmoidf_(bf_hi(g.w));
                    *(u32x4*)(O + (size_t)row * DM + col) = pack8(v0, v1);
                }
            }
    }
};
struct EpiRss {
    static constexpr bool PERM = true, AFTER_DRAIN = false;
    bf16_t* O; float* RSS;
    __device__ __forceinline__ void operator()(const f32x4 (&acc)[2][2][4][2], const Unit& u, int wr, int wc, int fr, int fq) const {
#pragma unroll
        for (int ai = 0; ai < 2; ++ai)
#pragma unroll
            for (int m = 0; m < 4; ++m) {
                const int row = u.pm * BM + ai * HALF + wr * 64 + m * 16 + fr;
                float s = 0.f;
#pragma unroll
                for (int bj = 0; bj < 2; ++bj) {
                    const int col = u.pn * BM + bj * HALF + wc * 32 + 8 * fq;
                    const f32x4 v0 = acc[ai][bj][m][0], v1 = acc[ai][bj][m][1];
                    s += (v0[0] * v0[0] + v0[1] * v0[1]) + (v0[2] * v0[2] + v0[3] * v0[3]) + (v1[0] * v1[0] + v1[1] * v1[1]) + (v1[2] * v1[2] + v1[3] * v1[3]);
                    *(u32x4*)(O + (size_t)row * DM + col) = pack8(v0, v1);
                }
                s += __shfl_xor(s, 16); s += __shfl_xor(s, 32);
                if (fq == 0) RSS[((size_t)u.pn * MT + row) * 4 + wc] = s;
            }
    }
};
struct EpiRelu2 {
    static constexpr bool PERM = true, AFTER_DRAIN = false;
    bf16_t* O;
    __device__ __forceinline__ void operator()(const f32x4 (&acc)[2][2][4][2], const Unit& u, int wr, int wc, int fr, int fq) const {
#pragma unroll
        for (int ai = 0; ai < 2; ++ai)
#pragma unroll
            for (int m = 0; m < 4; ++m) {
                const int row = u.pm * BM + ai * HALF + wr * 64 + m * 16 + fr;
#pragma unroll
                for (int bj = 0; bj < 2; ++bj) {
                    const int col = u.pn * BM + bj * HALF + wc * 32 + 8 * fq;
                    f32x4 v0 = acc[ai][bj][m][0], v1 = acc[ai][bj][m][1];
#pragma unroll
                    for (int i = 0; i < 4; ++i) { const float a = fmaxf(v0[i], 0.f), b = fmaxf(v1[i], 0.f); v0[i] = a * a; v1[i] = b * b; }
                    *(u32x4*)(O + (size_t)row * FF + col) = pack8(v0, v1);
                }
            }
    }
};

template <class Epi, class Sched, bool ALIGN_EPI = false, bool SP2 = false>
__device__ __forceinline__ void gemm_phase(PG8_LAS unsigned char* lds, const Gemm g, const Sched& S, const Epi& E) {
    const int tid = threadIdx.x, wid = __builtin_amdgcn_readfirstlane(tid >> 6), lane = tid & 63, wr = wid >> 2, wc = wid & 3, fr = lane & 15, fq = lane >> 4;
    const int K = g.K, nt = K / BK;
    unsigned voffA[2], voffB[2];
#pragma unroll
    for (int i = 0; i < 2; ++i) { int R, C; stage_rc(tid * 16 + i * 8192, R, C); const int Rb = Epi::PERM ? ((R & ~31) + perm32(R & 31)) : R;
        voffA[i] = (unsigned)(R * K + C) * 2u; voffB[i] = (unsigned)(Rb * K + C) * 2u; }
    const size_t kstep = (size_t)(BK * 2);
    const size_t hstep = (size_t)HALF * K * 2;
    const size_t tstep = 2 * hstep;
    const unsigned ldsw = (unsigned)wid * 1024u;
    const int aoff = lds_byte(wr * 64 + fr, fq * 8), boff = lds_byte(wc * 32 + fr, fq * 8);
#define PG8_SA(b, h) (((b) * 2 + (h)) * HTB)
#define PG8_SB(b, h) ((4 + (b) * 2 + (h)) * HTB)
#define PG8_STAGE(bufoff, gbase, voff) do { _Pragma("unroll") for (int _i = 0; _i < 2; ++_i) \
        __builtin_amdgcn_global_load_lds((const unsigned*)((const char*)(gbase) + (voff)[_i]), (PG8_LAS unsigned*)(lds + (bufoff) + ldsw + _i * 8192), 16, 0, 0); } while (0)
#define PG8_LDA(dst, b, h) do { _Pragma("unroll") for (int m = 0; m < 4; ++m) _Pragma("unroll") for (int k = 0; k < 2; ++k) dst[m][k] = *(const PG8_LAS bf16x8*)(lds + PG8_SA(b, h) + aoff + m * 2048 + k * 1024); } while (0)
#define PG8_LDB(dst, b, h) do { _Pragma("unroll") for (int n = 0; n < 2; ++n) _Pragma("unroll") for (int k = 0; k < 2; ++k) dst[n][k] = *(const PG8_LAS bf16x8*)(lds + PG8_SB(b, h) + boff + n * 2048 + k * 1024); } while (0)
#define PG8_MMA(ai, bj, At, Bt) do { __builtin_amdgcn_s_setprio(1); _Pragma("unroll") for (int m = 0; m < 4; ++m) _Pragma("unroll") for (int n = 0; n < 2; ++n) _Pragma("unroll") for (int k = 0; k < 2; ++k) \
        acc[ai][bj][m][n] = __builtin_amdgcn_mfma_f32_16x16x32_bf16(Bt[n][k], At[m][k], acc[ai][bj][m][n], 0, 0, 0); __builtin_amdgcn_s_setprio(0); } while (0)
#define PG8_WAIT_V(n) asm volatile("s_waitcnt vmcnt(" #n ")" ::: "memory")
#define PG8_WAIT_L(n) asm volatile("s_waitcnt lgkmcnt(" #n ")" ::: "memory")
#define PG8_BAR __builtin_amdgcn_s_barrier()
#define PG8_SCHED __builtin_amdgcn_sched_barrier(0)
    Unit cur, nxt; int ui = 0;
    if (!S.next(0, cur)) return;
    f32x4 acc[2][2][4][2];
#pragma unroll
    for (int a = 0; a < 2; ++a)
#pragma unroll
        for (int b = 0; b < 2; ++b)
#pragma unroll
            for (int m = 0; m < 4; ++m)
#pragma unroll
                for (int n = 0; n < 2; ++n) acc[a][b][m][n] = (f32x4){0.f, 0.f, 0.f, 0.f};
    bf16x8 At[4][2], B0[2][2], B1[2][2];
    const char* cA = (const char*)g.A + (size_t)cur.pm * tstep; const char* cB = (const char*)g.Bt + (size_t)cur.pn * tstep;
    S.a_ready(cur);
    if constexpr (SP2) {
        PG8_STAGE(PG8_SB(0, 0), cB, voffB); PG8_STAGE(PG8_SB(0, 1), cB + hstep, voffB); PG8_STAGE(PG8_SA(0, 0), cA, voffA); PG8_STAGE(PG8_SA(0, 1), cA + hstep, voffA);
        if (wr == 1) PG8_BAR;
        PG8_WAIT_V(2); PG8_BAR;
        PG8_STAGE(PG8_SB(1, 0), cB + kstep, voffB); PG8_STAGE(PG8_SA(1, 0), cA + kstep, voffA); PG8_STAGE(PG8_SB(1, 1), cB + hstep + kstep, voffB);
        PG8_WAIT_V(6); PG8_BAR;
    } else {
        PG8_STAGE(PG8_SB(0, 0), cB, voffB); PG8_STAGE(PG8_SA(0, 0), cA, voffA); PG8_STAGE(PG8_SB(0, 1), cB + hstep, voffB); PG8_STAGE(PG8_SA(0, 1), cA + hstep, voffA);
        if (wr == 1) PG8_BAR;
        PG8_WAIT_V(4); PG8_BAR;
        PG8_STAGE(PG8_SB(1, 0), cB + kstep, voffB); PG8_STAGE(PG8_SA(1, 0), cA + kstep, voffA); PG8_STAGE(PG8_SB(1, 1), cB + hstep + kstep, voffB);
        PG8_WAIT_V(6); PG8_BAR;
    }
    for (;;) {
        const bool has_next = S.next(ui + 1, nxt);
        const char* nA = has_next ? (const char*)g.A + (size_t)nxt.pm * tstep : cA; const char* nB = has_next ? (const char*)g.Bt + (size_t)nxt.pn * tstep : cB;
        for (int t = 0; t < nt; t += 2) {
            const bool last = (t == nt - 2);
            const char* a1 = cA + (size_t)(t + 1) * kstep;
            const char* a2 = last ? nA : cA + (size_t)(t + 2) * kstep; const char* b2 = last ? nB : cB + (size_t)(t + 2) * kstep;
            const char* a3 = a2 + kstep; const char* b3 = b2 + kstep;
            if (last && has_next) S.a_ready(nxt);
            if constexpr (SP2) {
            PG8_LDB(B0, 0, 0); PG8_LDB(B1, 0, 1); PG8_SCHED; PG8_LDA(At, 0, 0); PG8_STAGE(PG8_SA(1, 1), a1 + hstep, voffA);
            PG8_WAIT_V(8); PG8_WAIT_L(0); PG8_BAR; PG8_MMA(0, 0, At, B0); PG8_MMA(0, 1, At, B1); PG8_BAR; PG8_SCHED;
            PG8_LDA(At, 0, 1); PG8_STAGE(PG8_SB(0, 0), b2, voffB); PG8_STAGE(PG8_SB(0, 1), b2 + hstep, voffB); PG8_STAGE(PG8_SA(0, 0), a2, voffA);
            PG8_WAIT_V(8); PG8_WAIT_L(0); PG8_BAR; PG8_MMA(1, 0, At, B0); PG8_MMA(1, 1, At, B1); PG8_BAR; PG8_SCHED;
            PG8_LDB(B0, 1, 0); PG8_LDB(B1, 1, 1); PG8_SCHED; PG8_LDA(At, 1, 0); PG8_STAGE(PG8_SA(0, 1), a2 + hstep, voffA);
            PG8_WAIT_V(8); PG8_WAIT_L(0); PG8_BAR; PG8_MMA(0, 0, At, B0); PG8_MMA(0, 1, At, B1); PG8_BAR; PG8_SCHED;
            PG8_LDA(At, 1, 1); PG8_STAGE(PG8_SB(1, 0), b3, voffB); PG8_STAGE(PG8_SB(1, 1), b3 + hstep, voffB); PG8_STAGE(PG8_SA(1, 0), a3, voffA);
            PG8_WAIT_V(8); PG8_WAIT_L(0); PG8_BAR; PG8_MMA(1, 0, At, B0); PG8_MMA(1, 1, At, B1); PG8_BAR; PG8_SCHED;
            } else {
            PG8_LDB(B0, 0, 0); PG8_SCHED; PG8_LDA(At, 0, 0); PG8_STAGE(PG8_SA(1, 1), a1 + hstep, voffA);
            PG8_WAIT_L(8); PG8_BAR; PG8_WAIT_L(0); PG8_MMA(0, 0, At, B0); PG8_BAR; PG8_SCHED;
            PG8_LDB(B1, 0, 1); PG8_STAGE(PG8_SB(0, 0), b2, voffB);
            PG8_BAR; PG8_WAIT_L(0); PG8_MMA(0, 1, At, B1); PG8_BAR;
            PG8_LDA(At, 0, 1); PG8_STAGE(PG8_SA(0, 0), a2, voffA);
            PG8_BAR; PG8_WAIT_L(0); PG8_MMA(1, 0, At, B0); PG8_BAR; PG8_SCHED;
            PG8_STAGE(PG8_SB(0, 1), b2 + hstep, voffB);
            PG8_WAIT_V(6); PG8_BAR; PG8_MMA(1, 1, At, B1); PG8_BAR;
            PG8_LDB(B0, 1, 0); PG8_SCHED; PG8_LDA(At, 1, 0); PG8_STAGE(PG8_SA(0, 1), a2 + hstep, voffA);
            PG8_WAIT_L(8); PG8_BAR; PG8_WAIT_L(0); PG8_MMA(0, 0, At, B0); PG8_BAR; PG8_SCHED;
            PG8_LDB(B1, 1, 1); PG8_STAGE(PG8_SB(1, 0), b3, voffB);
            PG8_BAR; PG8_WAIT_L(0); PG8_MMA(0, 1, At, B1); PG8_BAR;
            PG8_LDA(At, 1, 1); PG8_STAGE(PG8_SA(1, 0), a3, voffA);
            PG8_BAR; PG8_WAIT_L(0); PG8_MMA(1, 0, At, B0); PG8_BAR; PG8_SCHED;
            PG8_STAGE(PG8_SB(1, 1), b3 + hstep, voffB);
            PG8_WAIT_V(6); PG8_BAR; PG8_MMA(1, 1, At, B1); PG8_BAR;
            }
        }
        if constexpr (ALIGN_EPI) { if (wr == 0) PG8_BAR; }
        if constexpr (!Epi::AFTER_DRAIN) { E(acc, cur, wr, wc, fr, fq); S.done(cur); }
        if (!has_next) break;
#pragma unroll
        for (int a = 0; a < 2; ++a)
#pragma unroll
            for (int b = 0; b < 2; ++b)
#pragma unroll
                for (int m = 0; m < 4; ++m)
#pragma unroll
                    for (int n = 0; n < 2; ++n) acc[a][b][m][n] = (f32x4){0.f, 0.f, 0.f, 0.f};
        cur = nxt; cA = nA; cB = nB; ++ui;
        if constexpr (ALIGN_EPI) { if (wr == 1) PG8_BAR; }
    }
    PG8_WAIT_V(0);
    if constexpr (!ALIGN_EPI) { if (wr == 0) PG8_BAR; }
    PG8_BAR;
    if constexpr (Epi::AFTER_DRAIN) { E.fused(acc, cur, wr, wc, fr, fq, lds, wid, lane); S.done(cur); }
#undef PG8_SA
#undef PG8_SB
#undef PG8_STAGE
#undef PG8_LDA
#undef PG8_LDB
#undef PG8_MMA
#undef PG8_WAIT_V
#undef PG8_WAIT_L
#undef PG8_BAR
#undef PG8_SCHED
}
}

constexpr int NWAVES = 8;
constexpr size_t MiB = 1u << 20;
constexpr size_t WS_CTL = 0, CTL_ZERO_BYTES = 64 * 1024;
constexpr size_t WS_MOD = 1 * MiB;
constexpr size_t WS_ROPE = 1 * MiB + 256 * 1024;
constexpr size_t WS_BA = 2 * MiB;
constexpr size_t WS_RSS1 = 4 * MiB, WS_RSS2 = 5 * MiB;
constexpr size_t WS_WIN = 6 * MiB, WS_WAO = 18 * MiB, WS_WDO = 19 * MiB, WS_WOUT = 20 * MiB, WS_W1 = 22 * MiB, WS_W2 = 30 * MiB;
constexpr size_t WS_XN = 38 * MiB;
constexpr size_t WS_ONA = 62 * MiB, WS_ODN = 74 * MiB;
constexpr size_t WS_PA = 86 * MiB;
constexpr size_t WS_PB = 158 * MiB;
constexpr size_t WS_SC = 250 * MiB;
constexpr size_t WS_M1 = 224 * MiB;
constexpr size_t WS_CK = 248 * MiB, WS_CVT = 249 * MiB;
constexpr size_t WS_END = 256 * MiB;
constexpr size_t OUT_YP = 0, OUT_YS = (size_t)M_CTX * DM, OUT_K = (size_t)MT * DM, OUT_V = OUT_K + (size_t)32 * 8 * 256 * 64, OUT_S = OUT_V + (size_t)32 * 8 * 256 * 64;

constexpr int CW_BAR = 1024;
constexpr int RING_BYTES = 131072, LDS_BYTES = 147456, LDSCTL_OFF = LDS_BYTES - 1024, MISC_OFF = LDSCTL_OFF + 320;

#define GAS __attribute__((address_space(1)))
#define LAS __attribute__((address_space(3)))
typedef unsigned short bf16;
typedef unsigned v4u __attribute__((ext_vector_type(4)));
typedef unsigned v2u __attribute__((ext_vector_type(2)));
typedef float f32x4 __attribute__((ext_vector_type(4)));
typedef float f32x16 __attribute__((ext_vector_type(16)));
typedef short bf16x8 __attribute__((ext_vector_type(8)));
#define LDS_WAIT() asm volatile("s_waitcnt lgkmcnt(0)" ::: "memory")
#define VM_WAIT() asm volatile("s_waitcnt vmcnt(0)" ::: "memory")
#define MFMA32(a, b, c) __builtin_amdgcn_mfma_f32_32x32x16_bf16((a), (b), (c), 0, 0, 0)
__device__ __forceinline__ unsigned f2bf(float f) { unsigned u = __builtin_bit_cast(unsigned, f); return (u + 0x7fffu + ((u >> 16) & 1u)) >> 16; }
typedef float f32x2_t __attribute__((ext_vector_type(2))); typedef __bf16 bf16x2_t __attribute__((ext_vector_type(2)));
__device__ __forceinline__ unsigned pk2(float lo, float hi) { f32x2_t v = {lo, hi}; bf16x2_t b = __builtin_convertvector(v, bf16x2_t); return __builtin_bit_cast(unsigned, b); }
__device__ __forceinline__ float bflo(unsigned w) { return __uint_as_float(w << 16); }
__device__ __forceinline__ float bfhi(unsigned w) { return __uint_as_float(w & 0xffff0000u); }
__device__ __forceinline__ float silu_(float x) { return x / (1.0f + __expf(-x)); }
__device__ __forceinline__ float sigm_(float x) { return 1.0f / (1.0f + __expf(-x)); }
__device__ __host__ __forceinline__ constexpr int swap23(int x) { return (x & ~12) | ((x & 4) << 1) | ((x & 8) >> 1); }
__device__ __forceinline__ int crow(int reg, int h) { return (reg & 3) + 8 * (reg >> 2) + 4 * h; }
__device__ __forceinline__ float wave_sum(float v) {
#pragma unroll
    for (int o = 1; o < 64; o <<= 1) v += __shfl_xor(v, o);
    return v;
}

#define XB_TMO      128
#define XB_XCNT(j)  (256  + 64 * (j))
#define XB_XSUB(j)  (1280 + 64 * (j))
#define XB_XGEN(j)  (2304 + 64 * (j))
#define XB_TOP      3328
#define XB_TOPGEN   3392
#define XCD_BAR_WORDS 3456
#define XB_SPIN_CAP (1u << 22)

__device__ __forceinline__ unsigned xb_ld(unsigned* p)              { return __hip_atomic_load(p, __ATOMIC_RELAXED, __HIP_MEMORY_SCOPE_AGENT); }
__device__ __forceinline__ unsigned xb_add(unsigned* p, unsigned v) { return __hip_atomic_fetch_add(p, v, __ATOMIC_RELAXED, __HIP_MEMORY_SCOPE_AGENT); }
__device__ __forceinline__ unsigned xb_xcc_id() { return (unsigned)__builtin_amdgcn_s_getreg((3 << 11) | 20) & 0xFu; }
#define XB_SPIN(cond, bar) do { unsigned _sp = 0; while (cond) { __builtin_amdgcn_s_sleep(1); \
    if ((++_sp & 255u) == 0u) { if (xb_ld(&(bar)[XB_TMO])) break; if (_sp > XB_SPIN_CAP) { atomicAdd(&(bar)[XB_TMO], 1u); break; } } } } while (0)

struct XcdBarrier { unsigned* bar; unsigned x; volatile LAS unsigned* st; };

__device__ __forceinline__ XcdBarrier xcd_barrier_post(unsigned* bar, volatile LAS unsigned* st) {
    XcdBarrier b; b.bar = bar; b.x = xb_xcc_id(); b.st = st;
    if (threadIdx.x == 0) (void)xb_add(&bar[XB_XCNT(b.x)], 1u);
    return b;
}
__device__ __forceinline__ void xcd_barrier_complete(unsigned* bar, unsigned x, unsigned& nloc, unsigned& nx) {
    const unsigned G = gridDim.x * gridDim.y * gridDim.z;
    unsigned sum, cnt, mine, sp = 0u;
    for (;;) {
        sum = 0u; cnt = 0u; mine = 0u;
#pragma unroll
        for (unsigned j = 0; j < 16; ++j) { const unsigned c = xb_ld(&bar[XB_XCNT(j)]); sum += c; cnt += (c > 0u) ? 1u : 0u; mine = (j == x) ? c : mine; }
        if (sum == G) break;
        __builtin_amdgcn_s_sleep(1);
        if ((++sp & 255u) == 0u) { if (xb_ld(&bar[XB_TMO])) break; if (sp > XB_SPIN_CAP) { atomicAdd(&bar[XB_TMO], 1u); break; } }
    }
    nloc = mine > 0u ? mine : 1u; nx = cnt > 0u ? cnt : 1u;
}
__device__ __forceinline__ void xcd_barrier(const XcdBarrier& b) {
    asm volatile("s_waitcnt vmcnt(0)" ::: "memory");
    __syncthreads();
    if (threadIdx.x == 0) {
        unsigned* bar = b.bar;
        __builtin_amdgcn_s_waitcnt(0);
        unsigned nloc = b.st[0], nx = b.st[1];
        if (nloc == 0u) { xcd_barrier_complete(bar, b.x, nloc, nx); b.st[0] = nloc; b.st[1] = nx; }
        const unsigned old = xb_add(&bar[XB_XSUB(b.x)], 1u);
        const unsigned gen = old / nloc;
        if (old + 1u == (gen + 1u) * nloc) {
            __builtin_amdgcn_fence(__ATOMIC_RELEASE, "agent");
            asm volatile("s_waitcnt vmcnt(0)" ::: "memory");
            const unsigned og = xb_add(&bar[XB_TOP], 1u);
            const unsigned tg = og / nx;
            if (og + 1u == (tg + 1u) * nx) xb_add(&bar[XB_TOPGEN], 1u);
            else XB_SPIN(xb_ld(&bar[XB_TOPGEN]) == tg, bar);
            __builtin_amdgcn_fence(__ATOMIC_ACQUIRE, "agent");
            xb_add(&bar[XB_XGEN(b.x)], 1u);
            asm volatile("s_waitcnt vmcnt(0)" ::: "memory");
        } else {
            XB_SPIN(xb_ld(&bar[XB_XGEN(b.x)]) == gen, bar);
            __builtin_amdgcn_fence(__ATOMIC_ACQUIRE, "agent");
            asm volatile("s_waitcnt vmcnt(0)" ::: "memory");
        }
    }
    __syncthreads();
}

struct Args { const float* in[24]; float* out; unsigned char* ws; int ph_lo, ph_hi; };
enum { I_XP = 0, I_XS, I_C, I_CK, I_CV, I_ST, I_CCTX, I_WADA, I_BADA, I_PRE1, I_POST1, I_PRE2, I_POST2, I_WIN, I_CONVW, I_ALOG, I_DTB, I_DNN, I_RPB, I_WAO, I_WDO, I_WOUT, I_WFF1, I_WFF2 };

__device__ __forceinline__ void p0_transpose_item(const float* W, int K, int N, bf16* WT, LAS float* scr, int item, int lane) {
    const int nblk = N / 32, kb = item / nblk, nb = item % nblk, k0 = 64 * kb, n0 = 32 * nb;
#pragma unroll 8
    for (int i = 0; i < 32; ++i) { const int kk = 2 * i + (lane >> 5); scr[kk * 33 + (lane & 31)] = W[(size_t)(k0 + kk) * N + n0 + (lane & 31)]; }
    LDS_WAIT();
    const int c = lane & 7;
#pragma unroll
    for (int j = 0; j < 4; ++j) { const int n = (lane >> 3) + 8 * j; const LAS float* s = scr + (8 * c) * 33 + n;
        v4u o; o.x = pk2(s[0 * 33], s[1 * 33]); o.y = pk2(s[2 * 33], s[3 * 33]); o.z = pk2(s[4 * 33], s[5 * 33]); o.w = pk2(s[6 * 33], s[7 * 33]);
        *(v4u*)(WT + (size_t)(n0 + n) * K + k0 + 8 * c) = o; }
    LDS_WAIT();
}

__device__ __forceinline__ void phase_prologue(const Args& a, LAS unsigned char* lds, int vcu, int G) {
    const int tid = threadIdx.x, lane = tid & 63, wave = __builtin_amdgcn_readfirstlane(tid >> 6);
    unsigned char* ws = a.ws;
    if (vcu < 192) {
        LAS float* sl = (LAS float*)lds;
        LAS float* red = (LAS float*)(lds + 20480);
        for (int i = tid; i < 5 * 1024; i += 512) { const float v = i < 1024 ? a.in[I_CCTX][i] : a.in[I_C][i - 1024]; sl[i] = silu_(v); }
        __syncthreads();
        const int col = 32 * vcu + (lane & 31), rg = wave * 2 + (lane >> 5);
        const float* w = a.in[I_WADA] + (size_t)(rg * 64) * 6144 + col;
        float acc[5] = {0.f, 0.f, 0.f, 0.f, 0.f};
#pragma unroll 8
        for (int i = 0; i < 64; ++i) { const float wv = w[(size_t)i * 6144]; const int k = rg * 64 + i;
#pragma unroll
            for (int v = 0; v < 5; ++v) acc[v] += sl[v * 1024 + k] * wv; }
#pragma unroll
        for (int v = 0; v < 5; ++v) red[(rg * 5 + v) * 32 + (lane & 31)] = acc[v];
        __syncthreads();
        if (tid < 160) { const int v = tid >> 5, cl = tid & 31; float s = a.in[I_BADA][32 * vcu + cl];
            for (int r = 0; r < 16; ++r) s += red[(r * 5 + v) * 32 + cl];
            ((float*)(ws + WS_MOD))[v * 6144 + 32 * vcu + cl] = s; }
        __syncthreads();
    } else if (vcu == 192) {
        float* rope = (float*)(ws + WS_ROPE);
        for (int i = tid; i < 1024; i += 512) { const int pos = i >> 4, f = i & 15; const float inv = powf(10000.0f, -(float)f / 16.0f); const float ang = (float)pos * inv; rope[i] = cosf(ang); rope[1024 + i] = sinf(ang); }
    } else if (vcu < 225) {
        const int bh = vcu - 193;
        const float* ck = a.in[I_CK] + (size_t)bh * 256 * 64; const float* cv = a.in[I_CV] + (size_t)bh * 256 * 64;
        bf16* CK = (bf16*)(ws + WS_CK) + (size_t)bh * 256 * 64; bf16* CVT = (bf16*)(ws + WS_CVT) + (size_t)bh * 64 * 256;
        for (int i = tid; i < 256 * 8; i += 512) { const int key = i >> 3, c8 = i & 7;
            const f32x4 k0 = *(const f32x4*)(ck + key * 64 + c8 * 8), k1 = *(const f32x4*)(ck + key * 64 + c8 * 8 + 4);
            v4u o; o.x = pk2(k0[0], k0[1]); o.y = pk2(k0[2], k0[3]); o.z = pk2(k1[0], k1[1]); o.w = pk2(k1[2], k1[3]);
            *(v4u*)(CK + key * 64 + c8 * 8) = o;
            const f32x4 v0 = *(const f32x4*)(cv + key * 64 + c8 * 8), v1 = *(const f32x4*)(cv + key * 64 + c8 * 8 + 4);
            const int pos = (key & ~12) | ((key & 4) << 1) | ((key & 8) >> 1);
#pragma unroll
            for (int j = 0; j < 4; ++j) { CVT[(c8 * 8 + j) * 256 + pos] = (bf16)f2bf(v0[j]); CVT[(c8 * 8 + 4 + j) * 256 + pos] = (bf16)f2bf(v1[j]); }
        }
    }
    LAS float* scr = (LAS float*)(lds + 32768 + wave * 8704);
    const int gw = vcu * NWAVES + wave, NGW = G * NWAVES;
    constexpr int I_IN = 16 * 177, I_AO = 8 * 32, I_DO = 8 * 32, I_OUT = 16 * 32, I_1 = 16 * 128, I_2 = 64 * 32;
    constexpr int NITEMS = I_IN + I_AO + I_DO + I_OUT + I_1 + I_2;
    for (int it = gw; it < NITEMS; it += NGW) {
        int r = it;
        if (r < I_IN) { p0_transpose_item(a.in[I_WIN], 1024, NIN, (bf16*)(ws + WS_WIN), scr, r, lane); continue; } r -= I_IN;
        if (r < I_AO) { p0_transpose_item(a.in[I_WAO], 512, 1024, (bf16*)(ws + WS_WAO), scr, r, lane); continue; } r -= I_AO;
        if (r < I_DO) { p0_transpose_item(a.in[I_WDO], 512, 1024, (bf16*)(ws + WS_WDO), scr, r, lane); continue; } r -= I_DO;
        if (r < I_OUT) { p0_transpose_item(a.in[I_WOUT], 1024, 1024, (bf16*)(ws + WS_WOUT), scr, r, lane); continue; } r -= I_OUT;
        if (r < I_1) { p0_transpose_item(a.in[I_WFF1], 1024, FF, (bf16*)(ws + WS_W1), scr, r, lane); continue; } r -= I_1;
        p0_transpose_item(a.in[I_WFF2], FF, 1024, (bf16*)(ws + WS_W2), scr, r, lane);
    }
    { v4u* z = (v4u*)((bf16*)(ws + WS_WIN) + (size_t)NIN * 1024); const int n16 = (NINP - NIN) * 1024 * 2 / 16;
      for (int i = gw * 64 + lane; i < n16; i += NGW * 64) z[i] = (v4u){0u, 0u, 0u, 0u}; }
}

__device__ __forceinline__ const float* x_row(const Args& a, int m) { return m < M_CTX ? a.in[I_XP] + (size_t)m * DM : a.in[I_XS] + (size_t)(m - M_CTX) * DM; }
__device__ __forceinline__ int mod_idx(int m) { return m < M_CTX ? 0 : 1 + ((m - M_CTX) >> 10); }

__device__ __forceinline__ void phase_xn(const Args& a, int vcu, int G) {
    const int tid = threadIdx.x, lane = tid & 63, wave = tid >> 6;
    const int gw = vcu * NWAVES + wave, NGW = G * NWAVES;
    const float* MOD = (const float*)(a.ws + WS_MOD); bf16* XN = (bf16*)(a.ws + WS_XN);
    for (int m = gw; m < MT; m += NGW) {
        const f32x4* xr = (const f32x4*)x_row(a, m) + lane;
        const float* md = MOD + mod_idx(m) * 6144;
        f32x4 v[4]; float s = 0.f;
#pragma unroll
        for (int j = 0; j < 4; ++j) { v[j] = xr[64 * j]; s += (v[j].x * v[j].x + v[j].y * v[j].y) + (v[j].z * v[j].z + v[j].w * v[j].w); }
        const float rstd = rsqrtf(wave_sum(s) * (1.f / DM) + 1e-6f);
        v2u* o8 = (v2u*)(XN + (size_t)m * DM) + lane;
#pragma unroll
        for (int j = 0; j < 4; ++j) { const int c = (lane + 64 * j) * 4;
            const f32x4 w = *(const f32x4*)(a.in[I_PRE1] + c), sh = *(const f32x4*)(md + c), sc = *(const f32x4*)(md + 1024 + c);
            const f32x4 h = v[j] * rstd * w * (sc + 1.0f) + sh;
            v2u o; o.x = pk2(h.x, h.y); o.y = pk2(h.z, h.w); o8[64 * j] = o; }
    }
}

__device__ __forceinline__ bf16x8 pack_regs(const f32x16& p, int s) {
    v4u w; w.x = pk2(p[8 * s], p[8 * s + 1]); w.y = pk2(p[8 * s + 2], p[8 * s + 3]); w.z = pk2(p[8 * s + 4], p[8 * s + 5]); w.w = pk2(p[8 * s + 6], p[8 * s + 7]);
    return __builtin_bit_cast(bf16x8, w);
}
__device__ __forceinline__ void store_o(bf16* dst, const f32x16& o0, const f32x16& o1, float inv, int hh) {
#pragma unroll
    for (int g = 0; g < 4; ++g) {
        v2u w0, w1; w0.x = pk2(o0[4 * g] * inv, o0[4 * g + 1] * inv); w0.y = pk2(o0[4 * g + 2] * inv, o0[4 * g + 3] * inv);
        w1.x = pk2(o1[4 * g] * inv, o1[4 * g + 1] * inv); w1.y = pk2(o1[4 * g + 2] * inv, o1[4 * g + 3] * inv);
        *(v2u*)(dst + 8 * g + 4 * hh) = w0; *(v2u*)(dst + 32 + 8 * g + 4 * hh) = w1;
    }
}
constexpr float LOG2E = 1.4426950408889634f;

__device__ __forceinline__ void na_ctx_task(const Args& a, int task, int lane) {
    const int qb = task & 7, h = (task >> 3) & 7, b = task >> 6;
    const int r = lane & 31, hh = lane >> 5;
    const bf16* P = (const bf16*)(a.ws + WS_PA); const bf16* VT = (const bf16*)a.out + (size_t)3 * MT * 512;
    bf16* ONA = (bf16*)(a.ws + WS_ONA);
    const bf16* Pq = P + (size_t)(b * 256 + qb * 32 + r) * LDA_ + C_Q + h * 64 + 8 * hh;
    bf16x8 qf[4];
#pragma unroll
    for (int s = 0; s < 4; ++s) qf[s] = *(const bf16x8*)(Pq + 16 * s);
    f32x16 st[8];
#pragma unroll
    for (int kt = 0; kt < 8; ++kt) {
        const bf16* Pk = P + (size_t)(b * 256 + kt * 32 + r) * LDA_ + C_K + h * 64 + 8 * hh;
        f32x16 acc = {};
#pragma unroll
        for (int s = 0; s < 4; ++s) { const bf16x8 kf = *(const bf16x8*)(Pk + 16 * s); acc = MFMA32(kf, qf[s], acc); }
        st[kt] = acc;
    }
    float mx = -3.0e38f;
#pragma unroll
    for (int kt = 0; kt < 8; ++kt)
#pragma unroll
        for (int i = 0; i < 16; ++i) mx = fmaxf(mx, st[kt][i]);
    mx = fmaxf(mx, __shfl_xor(mx, 32));
    const float sc = 0.125f * LOG2E; float sum = 0.f;
#pragma unroll
    for (int kt = 0; kt < 8; ++kt)
#pragma unroll
        for (int i = 0; i < 16; ++i) { const float p = exp2f((st[kt][i] - mx) * sc); st[kt][i] = p; sum += p; }
    sum += __shfl_xor(sum, 32);
    const bf16* VTb = VT + ((size_t)(b * 8 + h) * 64 + r) * 256 + 8 * hh;
    f32x16 o0 = {}, o1 = {};
#pragma unroll
    for (int kt = 0; kt < 8; ++kt)
#pragma unroll
        for (int s2 = 0; s2 < 2; ++s2) {
            const bf16x8 pb = pack_regs(st[kt], s2);
            const bf16x8 a0 = *(const bf16x8*)(VTb + 32 * kt + 16 * s2), a1 = *(const bf16x8*)(VTb + 32 * 256 + 32 * kt + 16 * s2);
            o0 = MFMA32(a0, pb, o0); o1 = MFMA32(a1, pb, o1);
        }
    store_o(ONA + (size_t)(b * 256 + qb * 32 + r) * 512 + h * 64, o0, o1, 1.0f / sum, hh);
}

__device__ __forceinline__ void na_lat_task(const Args& a, int task, int lane) {
    const int half = task & 1, gr = (task >> 1) & 15, h = (task >> 5) & 7, b = task >> 8;
    const int r = lane & 31, hh = lane >> 5;
    const bf16* P = (const bf16*)(a.ws + WS_PA); const bf16* VT = (const bf16*)a.out + (size_t)3 * MT * 512 + (size_t)M_CTX * 512;
    const bf16* CK = (const bf16*)(a.ws + WS_CK) + (size_t)(b * 8 + h) * 256 * 64; const bf16* CVT = (const bf16*)(a.ws + WS_CVT) + (size_t)(b * 8 + h) * 64 * 256;
    const float* rpb = a.in[I_RPB] + h * 15 * 31;
    bf16* ONA = (bf16*)(a.ws + WS_ONA);
    const int cq = 32 * half + r, rowq = M_CTX + b * 1024 + gr * 64 + cq;
    const bf16* Pq = P + (size_t)rowq * LDA_ + C_Q + h * 64 + 8 * hh;
    bf16x8 qf[4];
#pragma unroll
    for (int s = 0; s < 4; ++s) qf[s] = *(const bf16x8*)(Pq + 16 * s);
    float m = -3.0e38f, l = 0.f; f32x16 o0 = {}, o1 = {};
    const float sc = 0.125f * LOG2E;
#define NA_STEP(S, VA0, VA1) do { \
        float tm = S[0]; _Pragma("unroll") for (int i = 1; i < 16; ++i) tm = fmaxf(tm, S[i]); \
        tm = fmaxf(tm, __shfl_xor(tm, 32)); const float mn = fmaxf(m, tm); const float al = exp2f(m - mn); m = mn; \
        float ps = 0.f; _Pragma("unroll") for (int i = 0; i < 16; ++i) { S[i] = exp2f(S[i] - mn); ps += S[i]; } \
        l = l * al + ps; o0 = o0 * al; o1 = o1 * al; \
        _Pragma("unroll") for (int s2 = 0; s2 < 2; ++s2) { const bf16x8 pb = pack_regs(S, s2); \
            o0 = MFMA32(*(const bf16x8*)((VA0) + 16 * s2), pb, o0); o1 = MFMA32(*(const bf16x8*)((VA1) + 16 * s2), pb, o1); } } while (0)
    for (int kt = 0; kt < 8; ++kt) {
        const bf16* Pk = CK + (size_t)(kt * 32 + r) * 64 + 8 * hh;
        f32x16 s = {};
#pragma unroll
        for (int ks = 0; ks < 4; ++ks) s = MFMA32(*(const bf16x8*)(Pk + 16 * ks), qf[ks], s);
#pragma unroll
        for (int i = 0; i < 16; ++i) s[i] *= sc;
        const bf16* va = CVT + (size_t)r * 256 + 32 * kt + 8 * hh;
        NA_STEP(s, va, va + 32 * 256);
    }
    const int rs = min(max(gr - 4, 0), 8), cs = min(max(cq - 8, 0), 48);
    const bf16* VTb = VT + ((size_t)(b * 8 + h) * 64 + r) * 1024 + 8 * hh;
    for (int kk = 0; kk < 8; ++kk) {
        const int kr = rs + kk;
        const float* rp = rpb + (kr - gr + 7) * 31 + 15 - cq;
        for (int ct = 0; ct < 2; ++ct) {
            const int tk = kr * 64 + ct * 32;
            const bf16* Pk = P + (size_t)(M_CTX + b * 1024 + tk + r) * LDA_ + C_K + h * 64 + 8 * hh;
            f32x16 s = {};
#pragma unroll
            for (int ks = 0; ks < 4; ++ks) s = MFMA32(*(const bf16x8*)(Pk + 16 * ks), qf[ks], s);
#pragma unroll
            for (int i = 0; i < 16; ++i) { const int kc = ct * 32 + crow(i, hh); const bool ok = (kc >= cs) && (kc < cs + 16);
                const float bias = ok ? rp[kc] : 0.f; s[i] = ok ? (s[i] * 0.125f + bias) * LOG2E : -1.0e30f; }
            const bf16* va = VTb + tk;
            NA_STEP(s, va, va + 32 * 1024);
        }
    }
#undef NA_STEP
    l += __shfl_xor(l, 32);
    store_o(ONA + (size_t)rowq * 512 + h * 64, o0, o1, 1.0f / l, hh);
}

__device__ __forceinline__ void conv_task(const Args& a, int task, int lane) {
    const int part = task % 3, chunk = task / 3, r0 = chunk * 64;
    const bf16* P = (const bf16*)(a.ws + WS_PA); bf16* DST = (bf16*)a.out + (size_t)part * MT * 512;
    const int seq0 = r0 < M_CTX ? (r0 & ~255) : M_CTX + ((r0 - M_CTX) & ~1023), seq1 = r0 < M_CTX ? seq0 + 256 : seq0 + 1024;
    const float* cw = a.in[I_CONVW] + part * 512 + 8 * lane;
    float w[5][8];
#pragma unroll
    for (int t = 0; t < 5; ++t) { const f32x4 w0 = *(const f32x4*)(cw + t * 1536), w1 = *(const f32x4*)(cw + t * 1536 + 4);
#pragma unroll
        for (int i = 0; i < 4; ++i) { w[t][i] = w0[i]; w[t][4 + i] = w1[i]; } }
    const bf16* src = P + C_DN + part * 512 + 8 * lane;
    float x[5][8];
#define CONV_LOAD(dst, row) do { if ((row) >= seq0 && (row) < seq1) { const v4u q = *(const v4u*)(src + (size_t)(row) * LDA_); \
        dst[0] = bflo(q.x); dst[1] = bfhi(q.x); dst[2] = bflo(q.y); dst[3] = bfhi(q.y); dst[4] = bflo(q.z); dst[5] = bfhi(q.z); dst[6] = bflo(q.w); dst[7] = bfhi(q.w); } \
        else { _Pragma("unroll") for (int i_ = 0; i_ < 8; ++i_) dst[i_] = 0.f; } } while (0)
    CONV_LOAD(x[0], r0 - 2); CONV_LOAD(x[1], r0 - 1); CONV_LOAD(x[2], r0); CONV_LOAD(x[3], r0 + 1);
    for (int rr = 0; rr < 64; ++rr) {
        const int row = r0 + rr;
        CONV_LOAD(x[4], row + 2);
        float o[8]; float ss = 0.f;
#pragma unroll
        for (int i = 0; i < 8; ++i) { float v = w[0][i] * x[0][i] + w[1][i] * x[1][i] + w[2][i] * x[2][i] + w[3][i] * x[3][i] + w[4][i] * x[4][i]; v = silu_(v); o[i] = v; ss += v * v; }
        if (part < 2) { ss += __shfl_xor(ss, 1); ss += __shfl_xor(ss, 2); ss += __shfl_xor(ss, 4); const float rn = rsqrtf(ss + 1e-6f);
#pragma unroll
            for (int i = 0; i < 8; ++i) o[i] *= rn; }
        v4u q; q.x = pk2(o[0], o[1]); q.y = pk2(o[2], o[3]); q.z = pk2(o[4], o[5]); q.w = pk2(o[6], o[7]);
        const unsigned hv[8] = {q.x & 0xffffu, q.x >> 16, q.y & 0xffffu, q.y >> 16, q.z & 0xffffu, q.z >> 16, q.w & 0xffffu, q.w >> 16};
        const int hd = lane >> 3, j0 = (8 * lane) & 63;
        int sb_, tt, T_, ch0;
        if (row < M_CTX) { const int b_ = row >> 8; tt = row & 255; T_ = 256; ch0 = 64 + ((b_ * 8 + hd) << 1); sb_ = b_ * 8 + hd; }
        else { const int rl = row - M_CTX; const int b_ = rl >> 10; tt = rl & 1023; T_ = 1024; ch0 = (b_ * 8 + hd) << 1; sb_ = b_ * 8 + hd; }
        if (part < 2) { bf16* dp = DST + (size_t)row * 512 + 16 * (lane >> 1) + 4 * (lane & 1);
            *(v2u*)dp = (v2u){q.x, q.y}; *(v2u*)(dp + 8) = (v2u){q.z, q.w}; }
#ifndef NO_KTVC
        if (part == 1) {
            bf16* ktf = (bf16*)(a.ws + WS_XN) + (row < M_CTX ? (size_t)sb_ * 64 * 256 : (size_t)M_CTX * 512 + (size_t)sb_ * 64 * 1024) + (size_t)j0 * T_;
            bf16* ktb = ktf + (size_t)MT * 512;
            const int pf = swap23(tt), pb = swap23(T_ - 1 - tt);
#pragma unroll
            for (int e = 0; e < 8; ++e) { ktf[(size_t)e * T_ + pf] = (bf16)hv[e]; ktb[(size_t)e * T_ + pb] = (bf16)hv[e]; }
        }
        if (part == 2) {
            const int jw = j0 >> 5, r0 = j0 & 31;
#pragma unroll
            for (int dd = 0; dd < 2; ++dd) {
                const int u = dd ? T_ - 1 - tt : tt, c = u & 63;
                const int task = (row < M_CTX ? 512 + sb_ * 4 : sb_ * 16) + (u >> 6);
                const int cb = c >> 5, hh = (c >> 2) & 1, g = ((c >> 3) & 3) * 4 + (c & 3);
                bf16* vcp = (dd ? (bf16*)(a.ws + WS_ODN) : (bf16*)a.out + (size_t)2 * MT * 512) + ((size_t)((task * 2 + jw) * 2 + cb) * 64 + hh * 32 + r0) * 16 + g;
#pragma unroll
                for (int e = 0; e < 8; ++e) vcp[e * 16] = (bf16)hv[e];
            }
        }
#endif
#pragma unroll
        for (int t = 0; t < 4; ++t)
#pragma unroll
            for (int i = 0; i < 8; ++i) x[t][i] = x[t + 1][i];
    }
#undef CONV_LOAD
}

__device__ __forceinline__ void phase_mix_a(const Args& a, int vcu, int G) {
    const int tid = threadIdx.x, lane = tid & 63, wave = __builtin_amdgcn_readfirstlane(tid >> 6);
    const int gw = wave * G + vcu, NGW = G * NWAVES;
    constexpr int N_LAT = 1024, N_CTX = 2048, N_CONV = 192 * 3;
    for (int t = gw; t < N_LAT + N_CTX + N_CONV; t += NGW) {
        if (t < N_LAT) na_lat_task(a, t, lane);
        else if (t < N_LAT + N_CTX) na_ctx_task(a, t - N_LAT, lane);
        else conv_task(a, t - N_LAT - N_CTX, lane);
    }
}

struct DnChain { int b, h, dir, T, rowbase, task0; bool lat; };
__device__ __forceinline__ DnChain dn_decode(int chain) {
    DnChain d; d.lat = chain < 64;
    if (d.lat) { d.b = chain >> 4; d.h = (chain >> 1) & 7; d.dir = chain & 1; d.T = 1024; d.rowbase = M_CTX + d.b * 1024; d.task0 = chain * 16; }
    else { const int c = chain - 64; d.b = c >> 4; d.h = (c >> 1) & 7; d.dir = c & 1; d.T = 256; d.rowbase = d.b * 256; d.task0 = 1024 + c * 4; }
    return d;
}

__device__ __forceinline__ void dn_pre_task(const Args& a, int task, LAS float* LT, LAS float* tab, int lane) {
    int chain, n;
    if (task < 1024) { chain = task >> 4; n = task & 15; } else { const int t2 = task - 1024; chain = 64 + (t2 >> 2); n = t2 & 3; }
    const DnChain d = dn_decode(chain);
    const int h = d.h, dir = d.dir;
    const bf16* DQ = (const bf16*)a.out; const bf16* DK = DQ + (size_t)MT * 512;
    const float* BA = (const float*)(a.ws + WS_BA);
    bf16* rec = (bf16*)(a.ws + WS_PA) + (size_t)task * 8192; bf16* Tm = rec; bf16* QKm = rec + 4096;
    float* SC = (float*)(a.ws + WS_SC) + (size_t)task * 320;
    const int R0 = d.rowbase + (dir ? d.T - 1 - 64 * n : 64 * n), RS = dir ? -1 : 1;
    const int r = lane & 31, hh = lane >> 5;
    {
        const float* ba = BA + (size_t)(R0 + lane * RS) * 32;
        const float beta = sigm_(ba[dir * 8 + h]);
        const float xx = ba[16 + dir * 8 + h] + a.in[I_DTB][dir * 8 + h];
        const float sp = xx > 20.f ? xx : log1pf(__expf(xx));
        float gc = -__expf(a.in[I_ALOG][dir * 8 + h]) * sp;
#pragma unroll
        for (int o = 1; o < 64; o <<= 1) { const float t = __shfl_up(gc, o); if (lane >= o) gc += t; }
        const float gl = __shfl(gc, 63);
        const float eg = __expf(gc);
        SC[lane] = beta; SC[64 + lane] = beta * eg; SC[128 + lane] = 0.125f * eg; SC[192 + lane] = __expf(gl - gc); SC[256 + lane] = __expf(gl);
        LDS_WAIT();
        tab[lane] = gc; tab[64 + lane] = beta;
        LDS_WAIT();
    }
    bf16x8 kf[2][4], qf[2][4];
#pragma unroll
    for (int cb = 0; cb < 2; ++cb) { const size_t ro = (size_t)(R0 + (32 * cb + r) * RS) * 512 + h * 64 + 8 * hh;
#pragma unroll
        for (int s = 0; s < 4; ++s) { kf[cb][s] = *(const bf16x8*)(DK + ro + 16 * s); qf[cb][s] = *(const bf16x8*)(DQ + ro + 16 * s); } }
    const float gcol0 = tab[r], gcol1 = tab[32 + r];
#pragma unroll
    for (int tile = 0; tile < 3; ++tile) {
        const int cb = tile == 0 ? 0 : 1, cbp = tile == 2 ? 1 : 0;
        f32x16 acc = {};
#pragma unroll
        for (int s = 0; s < 4; ++s) acc = MFMA32(kf[cb][s], kf[cbp][s], acc);
        const float gcol = cbp ? gcol1 : gcol0; const int cp = 32 * cbp + r;
#pragma unroll
        for (int g = 0; g < 4; ++g) {
            const f32x4 gr = *(const LAS f32x4*)(tab + 32 * cb + 8 * g + 4 * hh), br = *(const LAS f32x4*)(tab + 64 + 32 * cb + 8 * g + 4 * hh);
            f32x4 v;
#pragma unroll
            for (int j = 0; j < 4; ++j) { const int c = 32 * cb + 8 * g + 4 * hh + j; v[j] = (cp < c) ? br[j] * acc[4 * g + j] * __expf(gr[j] - gcol) : 0.f; }
            *(LAS f32x4*)(LT + cp * 68 + 32 * cb + 8 * g + 4 * hh) = v;
        }
    }
#ifndef DN_NO_QK
#pragma unroll
    for (int tile = 0; tile < 3; ++tile) {
        const int cb = tile == 0 ? 0 : 1, cbp = tile == 2 ? 1 : 0;
        f32x16 acc = {};
#pragma unroll
        for (int s = 0; s < 4; ++s) acc = MFMA32(kf[cbp][s], qf[cb][s], acc);
        const float gcc = cb ? gcol1 : gcol0; const int c = 32 * cb + r;
#pragma unroll
        for (int g = 0; g < 4; ++g) {
            const f32x4 gr = *(const LAS f32x4*)(tab + 32 * cbp + 8 * g + 4 * hh);
#pragma unroll
            for (int j = 0; j < 4; ++j) { const int cp = 32 * cbp + 8 * g + 4 * hh + j; acc[4 * g + j] = (cp <= c) ? 0.125f * acc[4 * g + j] * __expf(gcc - gr[j]) : 0.f; }
        }
#pragma unroll
        for (int s = 0; s < 2; ++s) *(bf16x8*)(QKm + c * 64 + 32 * cbp + 16 * s + 8 * hh) = pack_regs(acc, s);
    }
    if (hh == 0) { *(v4u*)(QKm + r * 64 + 32) = (v4u){0u, 0u, 0u, 0u}; *(v4u*)(QKm + r * 64 + 40) = (v4u){0u, 0u, 0u, 0u}; *(v4u*)(QKm + r * 64 + 48) = (v4u){0u, 0u, 0u, 0u}; *(v4u*)(QKm + r * 64 + 56) = (v4u){0u, 0u, 0u, 0u}; }
#endif
    LDS_WAIT();
#ifndef DN_NO_T
    {
        float t[64]; float zero_ = 0.f; asm volatile("" : "+v"(zero_));
#pragma unroll
        for (int i = 0; i < 64; ++i) t[i] = zero_;
#pragma unroll
        for (int nn = 63; nn >= 0; --nn) {
            float a0 = (lane == nn) ? 1.f : 0.f, a1 = 0.f;
            const LAS float* lrow = LT + nn * 68;
            if (nn < 63) asm volatile("" : "+v"(lrow) : "v"(t[nn < 63 ? nn + 1 : 63]));
#pragma unroll
            for (int m4 = (nn + 1) / 4; m4 < 16; ++m4) { const f32x4 lr = *(const LAS f32x4*)(lrow + 4 * m4);
                a0 -= lr[0] * t[4 * m4]; a1 -= lr[1] * t[4 * m4 + 1]; a0 -= lr[2] * t[4 * m4 + 2]; a1 -= lr[3] * t[4 * m4 + 3]; }
            t[nn] = a0 + a1;
        }
        bf16* dst = Tm + lane * 64;
#pragma unroll
        for (int q = 0; q < 8; ++q) { v4u w;
            w.x = pk2(t[swap23(8 * q + 0)], t[swap23(8 * q + 1)]); w.y = pk2(t[swap23(8 * q + 2)], t[swap23(8 * q + 3)]);
            w.z = pk2(t[swap23(8 * q + 4)], t[swap23(8 * q + 5)]); w.w = pk2(t[swap23(8 * q + 6)], t[swap23(8 * q + 7)]);
            *(v4u*)(dst + 8 * q) = w; }
    }
#endif
    LDS_WAIT();
}
__device__ __forceinline__ void phase_dn_pre(const Args& a, LAS unsigned char* lds, int vcu, int G) {
    const int tid = threadIdx.x, lane = tid & 63, wave = __builtin_amdgcn_readfirstlane(tid >> 6);
    LAS float* LT = (LAS float*)(lds + wave * 17408); LAS float* tab = (LAS float*)(lds + 139264 + wave * 512);
    for (int t = wave * G + vcu; t < 3072; t += G * NWAVES) { int l2 = lane; asm volatile("" : "+v"(l2)); dn_pre_task(a, t, LT, tab, l2); }
}

__device__ __forceinline__ void dn_scan_task(const Args& a, int wt, int lane) {
    const int chain = wt >> 1, jw = wt & 1;
    const DnChain d = dn_decode(chain);
    const int h = d.h, dir = d.dir, NC = d.T >> 6, T = d.T;
    const int r = lane & 31, hh = lane >> 5, jcol = 32 * jw + r;
    const bf16* DQ = (const bf16*)a.out; const bf16* DK = DQ + (size_t)MT * 512;
    const bf16* VC = dir ? (const bf16*)(a.ws + WS_ODN) : DQ + (size_t)2 * MT * 512;
    const bf16* KTs = (const bf16*)(a.ws + WS_XN) + (dir ? (size_t)MT * 512 : 0) + (d.lat ? (size_t)M_CTX * 512 + (size_t)(d.b * 8 + h) * 64 * 1024 : (size_t)(d.b * 8 + h) * 64 * 256);
    bf16* OUTO = (bf16*)(a.ws + WS_M1) + (dir ? (size_t)MT * 512 : 0);
    const int RS = dir ? -1 : 1;
    f32x16 S[2];
    if (d.lat) { const float* s0 = a.in[I_ST] + ((size_t)((d.b * 2 + dir) * 8 + h) * 64) * 64 + jcol;
#pragma unroll
        for (int ib = 0; ib < 2; ++ib)
#pragma unroll
            for (int g = 0; g < 16; ++g) S[ib][g] = s0[(32 * ib + crow(g, hh)) * 64]; }
    else { S[0] = (f32x16){}; S[1] = (f32x16){}; }
    for (int n = 0; n < NC; ++n) {
        const int task = d.task0 + n;
        const int R0 = d.rowbase + (dir ? T - 1 - 64 * n : 64 * n);
        const bf16* rec = (const bf16*)(a.ws + WS_PA) + (size_t)task * 8192; const bf16* Tm = rec + r * 64 + 8 * hh; const bf16* QKm = Tm + 4096;
        const float* SC = (const float*)(a.ws + WS_SC) + (size_t)task * 320 + 4 * hh;
        const int taskd = (d.lat ? (d.b * 8 + h) * 16 : 512 + (d.b * 8 + h) * 4) + n;
        const bf16* vc = VC + ((size_t)(taskd * 2 + jw) * 2 * 64 + lane) * 16;
        const bf16* kt = KTs + (size_t)r * T + 64 * n + 8 * hh;
        bf16* oo = OUTO + (size_t)(taskd * 2 + jw) * 2 * 16 * 64 + lane;
        bf16x8 sb[2][2];
#pragma unroll
        for (int ib = 0; ib < 2; ++ib)
#pragma unroll
            for (int s = 0; s < 2; ++s) sb[ib][s] = pack_regs(S[ib], s);
        f32x16 X[2], o[2];
#pragma unroll
        for (int cb = 0; cb < 2; ++cb) {
            const size_t ro = (size_t)(R0 + (32 * cb + r) * RS) * 512 + h * 64 + 8 * hh;
            f32x16 ax = {}, ao = {};
#pragma unroll
            for (int ib = 0; ib < 2; ++ib)
#pragma unroll
                for (int s = 0; s < 2; ++s) { ax = MFMA32(*(const bf16x8*)(DK + ro + 32 * ib + 16 * s), sb[ib][s], ax); ao = MFMA32(*(const bf16x8*)(DQ + ro + 32 * ib + 16 * s), sb[ib][s], ao); }
            X[cb] = ax; o[cb] = ao;
        }
#pragma unroll
        for (int cb = 0; cb < 2; ++cb) {
            const v4u va = *(const v4u*)(vc + cb * 1024), vb_ = *(const v4u*)(vc + cb * 1024 + 8);
            const float vv[16] = {bflo(va.x), bfhi(va.x), bflo(va.y), bfhi(va.y), bflo(va.z), bfhi(va.z), bflo(va.w), bfhi(va.w),
                                  bflo(vb_.x), bfhi(vb_.x), bflo(vb_.y), bfhi(vb_.y), bflo(vb_.z), bfhi(vb_.z), bflo(vb_.w), bfhi(vb_.w)};
#pragma unroll
            for (int g = 0; g < 4; ++g) {
                const f32x4 s0 = *(const f32x4*)(SC + 32 * cb + 8 * g), s1 = *(const f32x4*)(SC + 64 + 32 * cb + 8 * g), s2 = *(const f32x4*)(SC + 128 + 32 * cb + 8 * g);
#pragma unroll
                for (int j = 0; j < 4; ++j) { X[cb][4 * g + j] = s0[j] * vv[4 * g + j] - s1[j] * X[cb][4 * g + j]; o[cb][4 * g + j] *= s2[j]; }
            }
        }
        f32x16 vn[2];
        {
            bf16x8 xb[2][2];
#pragma unroll
            for (int cb = 0; cb < 2; ++cb)
#pragma unroll
                for (int s = 0; s < 2; ++s) xb[cb][s] = pack_regs(X[cb], s);
#pragma unroll
            for (int cb = 0; cb < 2; ++cb) { f32x16 acc = {};
#pragma unroll
                for (int cbp = 0; cbp <= cb; ++cbp)
#pragma unroll
                    for (int s = 0; s < 2; ++s) acc = MFMA32(*(const bf16x8*)(Tm + cb * 2048 + 32 * cbp + 16 * s), xb[cbp][s], acc);
                vn[cb] = acc; }
        }
        {
            bf16x8 vb[2][2];
#pragma unroll
            for (int cb = 0; cb < 2; ++cb)
#pragma unroll
                for (int s = 0; s < 2; ++s) vb[cb][s] = pack_regs(vn[cb], s);
#pragma unroll
            for (int cb = 0; cb < 2; ++cb) { f32x16 acc = o[cb];
#pragma unroll
                for (int cbp = 0; cbp <= cb; ++cbp)
#pragma unroll
                    for (int s = 0; s < 2; ++s) acc = MFMA32(*(const bf16x8*)(QKm + cb * 2048 + 32 * cbp + 16 * s), vb[cbp][s], acc);
#pragma unroll
                for (int g = 0; g < 16; ++g) oo[(cb * 16 + g) * 64] = (bf16)f2bf(acc[g]); }
        }
        {
            const float egl = SC[256];
#pragma unroll
            for (int cb = 0; cb < 2; ++cb)
#pragma unroll
                for (int g = 0; g < 4; ++g) { const f32x4 s3 = *(const f32x4*)(SC + 192 + 32 * cb + 8 * g);
#pragma unroll
                    for (int j = 0; j < 4; ++j) vn[cb][4 * g + j] *= s3[j]; }
            bf16x8 vb[2][2];
#pragma unroll
            for (int cb = 0; cb < 2; ++cb)
#pragma unroll
                for (int s = 0; s < 2; ++s) vb[cb][s] = pack_regs(vn[cb], s);
#pragma unroll
            for (int ib = 0; ib < 2; ++ib) { f32x16 acc = S[ib] * egl;
#pragma unroll
                for (int cb = 0; cb < 2; ++cb)
#pragma unroll
                    for (int s = 0; s < 2; ++s) acc = MFMA32(*(const bf16x8*)(kt + (size_t)(32 * ib) * T + 32 * cb + 16 * s), vb[cb][s], acc);
                S[ib] = acc; }
        }
    }
    if (!d.lat) { float* so = a.out + OUT_S + ((size_t)((d.b * 2 + dir) * 8 + h) * 64) * 64 + jcol;
#pragma unroll
        for (int ib = 0; ib < 2; ++ib)
#pragma unroll
            for (int g = 0; g < 16; ++g) so[(32 * ib + crow(g, hh)) * 64] = S[ib][g]; }
}
__device__ __forceinline__ void phase_dn_scan(const Args& a, int vcu, int G) {
    const int tid = threadIdx.x, lane = tid & 63, wave = __builtin_amdgcn_readfirstlane(tid >> 6);
    for (int t = wave * G + vcu; t < 1152; t += G * NWAVES) dn_scan_task(a, t, lane);
}

__device__ __forceinline__ void phase_combine(const Args& a, int vcu, int G) {
    const int tid = threadIdx.x, lane = tid & 63, wave = tid >> 6;
    const int gw = vcu * NWAVES + wave, NGW = G * NWAVES;
    const bf16* OF = (const bf16*)(a.ws + WS_M1); const bf16* OB = OF + (size_t)MT * 512;
    const bf16* P = (const bf16*)(a.ws + WS_PB); bf16* ODN = (bf16*)(a.ws + WS_ODN);
    const f32x4 n0 = *(const f32x4*)(a.in[I_DNN] + ((8 * lane) & 63)), n1 = *(const f32x4*)(a.in[I_DNN] + ((8 * lane) & 63) + 4);
    const int hd = lane >> 3, j0 = (8 * lane) & 63, jw = j0 >> 5, r0 = j0 & 31;
    for (int m = gw; m < MT; m += NGW) {
        int tt, T_, ch0;
        if (m < M_CTX) { const int b_ = m >> 8; tt = m & 255; T_ = 256; ch0 = 64 + ((b_ * 8 + hd) << 1); }
        else { const int rl = m - M_CTX; const int b_ = rl >> 10; tt = rl & 1023; T_ = 1024; ch0 = (b_ * 8 + hd) << 1; }
        v4u w[2];
#pragma unroll
        for (int dd = 0; dd < 2; ++dd) {
            const int u = dd ? T_ - 1 - tt : tt, c = u & 63;
            const int task = (m < M_CTX ? 512 + (ch0 >> 1) * 4 - 128 : (ch0 >> 1) * 16) + (u >> 6);
            const int cb = c >> 5, hh = (c >> 2) & 1, g = ((c >> 3) & 3) * 4 + (c & 3);
            w[dd] = *(const v4u*)((dd ? OB : OF) + ((size_t)((task * 2 + jw) * 2 + cb) * 16 + g) * 64 + hh * 32 + r0);
        }
        f32x4 o0 = {bflo(w[0].x) + bflo(w[1].x), bfhi(w[0].x) + bfhi(w[1].x), bflo(w[0].y) + bflo(w[1].y), bfhi(w[0].y) + bfhi(w[1].y)};
        f32x4 o1 = {bflo(w[0].z) + bflo(w[1].z), bfhi(w[0].z) + bfhi(w[1].z), bflo(w[0].w) + bflo(w[1].w), bfhi(w[0].w) + bfhi(w[1].w)};
        float ss = (o0.x * o0.x + o0.y * o0.y) + (o0.z * o0.z + o0.w * o0.w) + (o1.x * o1.x + o1.y * o1.y) + (o1.z * o1.z + o1.w * o1.w);
        ss += __shfl_xor(ss, 1); ss += __shfl_xor(ss, 2); ss += __shfl_xor(ss, 4);
        const float rstd = rsqrtf(ss * (1.f / 64.f) + 1e-6f);
        const v4u z = *(const v4u*)(P + (size_t)m * LDB_ + CB_Z + 8 * lane);
        o0 = o0 * rstd * n0; o1 = o1 * rstd * n1;
        v4u q; q.x = pk2(o0.x * silu_(bflo(z.x)), o0.y * silu_(bfhi(z.x))); q.y = pk2(o0.z * silu_(bflo(z.y)), o0.w * silu_(bfhi(z.y)));
        q.z = pk2(o1.x * silu_(bflo(z.z)), o1.y * silu_(bfhi(z.z))); q.w = pk2(o1.z * silu_(bflo(z.w)), o1.w * silu_(bfhi(z.w)));
        *(v4u*)(ODN + (size_t)m * 512 + 8 * lane) = q;
    }
}

__device__ __forceinline__ void phase_row1(const Args& a, int vcu, int G) {
    const int tid = threadIdx.x, lane = tid & 63, wave = tid >> 6;
    const int gw = vcu * NWAVES + wave, NGW = G * NWAVES;
    const float* MOD = (const float*)(a.ws + WS_MOD); const bf16* Y = (const bf16*)(a.ws + WS_ONA); const float* RSS = (const float*)(a.ws + WS_RSS1);
    bf16* XN = (bf16*)(a.ws + WS_XN);
    for (int m = gw; m < MT; m += NGW) {
        const f32x4* xr = (const f32x4*)x_row(a, m) + lane; const float* md = MOD + mod_idx(m) * 6144;
        float rs = 0.f;
        { const float rv = lane < 16 ? RSS[((size_t)(lane >> 2) * MT + m) * 4 + (lane & 3)] : 0.f;
          rs = rv; rs += __shfl_xor(rs, 1); rs += __shfl_xor(rs, 2); rs += __shfl_xor(rs, 4); rs += __shfl_xor(rs, 8); rs = __shfl(rs, 0); }
        const float rstd1 = rsqrtf(rs * (1.f / DM) + 1e-6f);
        f32x4 x1[4]; float s = 0.f;
        const v2u* yr = (const v2u*)(Y + (size_t)m * DM) + lane;
        f32x4* orow = (f32x4*)(a.out + (size_t)m * DM) + lane;
#pragma unroll
        for (int j = 0; j < 4; ++j) { const int c = (lane + 64 * j) * 4; const v2u yy = yr[64 * j];
            const f32x4 yv = {bflo(yy.x), bfhi(yy.x), bflo(yy.y), bfhi(yy.y)};
            const f32x4 g1 = *(const f32x4*)(md + 2048 + c), pw = *(const f32x4*)(a.in[I_POST1] + c);
            x1[j] = xr[64 * j] + g1 * (yv * rstd1 * pw); orow[64 * j] = x1[j];
            s += (x1[j].x * x1[j].x + x1[j].y * x1[j].y) + (x1[j].z * x1[j].z + x1[j].w * x1[j].w); }
        const float rstd2 = rsqrtf(wave_sum(s) * (1.f / DM) + 1e-6f);
        v2u* o8 = (v2u*)(XN + (size_t)m * DM) + lane;
#pragma unroll
        for (int j = 0; j < 4; ++j) { const int c = (lane + 64 * j) * 4;
            const f32x4 w = *(const f32x4*)(a.in[I_PRE2] + c), sh = *(const f32x4*)(md + 3072 + c), sc = *(const f32x4*)(md + 4096 + c);
            const f32x4 h = x1[j] * rstd2 * w * (sc + 1.0f) + sh;
            v2u o; o.x = pk2(h.x, h.y); o.y = pk2(h.z, h.w); o8[64 * j] = o; }
    }
}
__device__ __forceinline__ void phase_row2(const Args& a, int vcu, int G) {
    const int tid = threadIdx.x, lane = tid & 63, wave = tid >> 6;
    const int gw = vcu * NWAVES + wave, NGW = G * NWAVES;
    const float* MOD = (const float*)(a.ws + WS_MOD); const bf16* Fm = (const bf16*)(a.ws + WS_ONA); const float* RSS = (const float*)(a.ws + WS_RSS2);
    for (int m = gw; m < MT; m += NGW) {
        const float* md = MOD + mod_idx(m) * 6144;
        float rs = 0.f;
        { const float rv = lane < 16 ? RSS[((size_t)(lane >> 2) * MT + m) * 4 + (lane & 3)] : 0.f;
          rs = rv; rs += __shfl_xor(rs, 1); rs += __shfl_xor(rs, 2); rs += __shfl_xor(rs, 4); rs += __shfl_xor(rs, 8); rs = __shfl(rs, 0); }
        const float rstd = rsqrtf(rs * (1.f / DM) + 1e-6f);
        const v2u* fr = (const v2u*)(Fm + (size_t)m * DM) + lane;
        f32x4* orow = (f32x4*)(a.out + (size_t)m * DM) + lane;
#pragma unroll
        for (int j = 0; j < 4; ++j) { const int c = (lane + 64 * j) * 4; const v2u ff = fr[64 * j];
            const f32x4 fv = {bflo(ff.x), bfhi(ff.x), bflo(ff.y), bfhi(ff.y)};
            const f32x4 g2 = *(const f32x4*)(md + 5120 + c), pw = *(const f32x4*)(a.in[I_POST2] + c);
            orow[64 * j] = orow[64 * j] + g2 * (fv * rstd * pw); }
    }
}

constexpr int N_PHASES = 13;
__global__ void __launch_bounds__(NWAVES * 64, 2) fwd_kernel(Args args) {
    extern __shared__ __attribute__((aligned(16))) unsigned char lds_raw[];
    LAS unsigned char* lds = (LAS unsigned char*)lds_raw;
    const int tid = threadIdx.x;
    const int G = gridDim.x; const int bx = blockIdx.x; const int vcu = (G % 8 == 0) ? (bx % 8) * (G / 8) + bx / 8 : bx;
    volatile LAS unsigned* MISC = (volatile LAS unsigned*)(lds + MISC_OFF);
    for (int u = tid; u < (LDS_BYTES - LDSCTL_OFF) / 4; u += NWAVES * 64) ((LAS unsigned*)(lds + LDSCTL_OFF))[u] = 0u;
    __syncthreads();
    const int lo = args.ph_lo, hi = args.ph_hi;
    const bool one = (hi - lo) > 1;
    unsigned* ctl = (unsigned*)(args.ws + WS_CTL);
    XcdBarrier bar; bar.bar = ctl + CW_BAR; bar.x = 0; bar.st = nullptr;
    if (one) bar = xcd_barrier_post(ctl + CW_BAR, MISC + 8);
#ifndef ONLY_PHASE
#define ONLY_PHASE -1
#endif
#ifndef SKIP_MASK
#define SKIP_MASK 0
#endif
#define IN(k) ((ONLY_PHASE < 0 || ONLY_PHASE == (k)) && !((SKIP_MASK >> (k)) & 1) && lo <= (k) && (k) < hi)
#define SEAM(k) do { if (one) xcd_barrier(bar); } while (0)
    unsigned char* ws = args.ws;
    typedef pg8::bf16_t pb;

    if (IN(0)) { phase_prologue(args, lds, vcu, G); SEAM(0); }
    if (IN(1)) { phase_xn(args, vcu, G); SEAM(1); }
    if (IN(2)) {
        pg8::Gemm g{(const pb*)(ws + WS_XN), (const pb*)(ws + WS_WIN), MT, NINP, 1024}; pg8::StaticOrder S; S.init(MT, NINP, G, bx);
        pg8::EpiInProj E{(pb*)(ws + WS_PA), (pb*)(ws + WS_PB), args.out + OUT_K, args.out + OUT_V, (float*)(ws + WS_BA), (pb*)args.out + (size_t)3 * MT * 512, (const float*)(ws + WS_ROPE)};
        pg8::gemm_phase<pg8::EpiInProj, pg8::StaticOrder, true, true>(lds, g, S, E);
        SEAM(2);
    }
    if (IN(3)) { phase_mix_a(args, vcu, G); SEAM(3); }
#ifdef DN_STUB
    { const int gt = vcu * 512 + tid; v4u* z = (v4u*)(ws + WS_ODN); for (int i = gt; i < (int)(12 * MiB / 16); i += G * 512) z[i] = (v4u){0u, 0u, 0u, 0u};
      v4u* z2 = (v4u*)(args.out + OUT_S); for (int i = gt; i < 2097152 / 4; i += G * 512) z2[i] = (v4u){0u, 0u, 0u, 0u}; SEAM(3); }
#endif
    if (IN(4)) { phase_dn_pre(args, lds, vcu, G); SEAM(4); }
    if (IN(5)) { phase_dn_scan(args, vcu, G); SEAM(5); }
    if (IN(6)) { phase_combine(args, vcu, G); SEAM(6); }
#ifdef REP36
    if (IN(3)) { phase_mix_a(args, vcu, G); SEAM(3); }
    if (IN(4)) { phase_dn_pre(args, lds, vcu, G); SEAM(4); }
    if (IN(5)) { phase_dn_scan(args, vcu, G); SEAM(5); }
    if (IN(6)) { phase_combine(args, vcu, G); SEAM(6); }
#endif
    if (IN(7)) {
        pg8::StaticOrder S; S.init(MT, 1024, G, bx);
        { pg8::Gemm g{(const pb*)(ws + WS_ONA), (const pb*)(ws + WS_WAO), MT, 1024, 512};
          pg8::EpiGate1 E{(const pb*)(ws + WS_PB), (pb*)(ws + WS_M1)};
          pg8::gemm_phase<pg8::EpiGate1, pg8::StaticOrder, true, true>(lds, g, S, E); }
        { pg8::Gemm g{(const pb*)(ws + WS_ODN), (const pb*)(ws + WS_WDO), MT, 1024, 512};
          pg8::EpiGate2 E{(const pb*)(ws + WS_PB), (const pb*)(ws + WS_M1), (pb*)(ws + WS_XN)};
          pg8::gemm_phase<pg8::EpiGate2, pg8::StaticOrder, true, true>(lds, g, S, E); }
        SEAM(7);
    }
    if (IN(8)) {
        pg8::Gemm g{(const pb*)(ws + WS_XN), (const pb*)(ws + WS_WOUT), MT, 1024, 1024}; pg8::StaticOrder S; S.init(MT, 1024, G, bx);
        pg8::EpiRss E{(pb*)(ws + WS_ONA), (float*)(ws + WS_RSS1)};
        pg8::gemm_phase<pg8::EpiRss, pg8::StaticOrder, true, true>(lds, g, S, E);
        SEAM(8);
    }
    if (IN(9)) { phase_row1(args, vcu, G); SEAM(9); }
    if (IN(10)) {
        pg8::Gemm g{(const pb*)(ws + WS_XN), (const pb*)(ws + WS_W1), MT, FF, 1024}; pg8::StaticOrder S; S.init(MT, FF, G, bx);
        pg8::EpiRelu2 E{(pb*)(ws + WS_PA)};
        pg8::gemm_phase<pg8::EpiRelu2, pg8::StaticOrder, true, true>(lds, g, S, E);
        SEAM(10);
    }
    if (IN(11)) {
        pg8::Gemm g{(const pb*)(ws + WS_PA), (const pb*)(ws + WS_W2), MT, 1024, FF}; pg8::StaticOrder S; S.init(MT, 1024, G, bx);
        pg8::EpiRss E{(pb*)(ws + WS_ONA), (float*)(ws + WS_RSS2)};
        pg8::gemm_phase<pg8::EpiRss, pg8::StaticOrder, true, true>(lds, g, S, E);
        SEAM(11);
    }
    if (IN(12)) { phase_row2(args, vcu, G); }
#undef IN
#undef SEAM
}

#ifndef MK_ONE_LAUNCH
#define MK_ONE_LAUNCH 1
#endif
extern "C" void kernel_launch(void* const* d_in, const int* in_sizes, int n_in, void* d_out, int out_size, void* d_ws, size_t ws_size, hipStream_t stream) {
    static int grid = 0;
    if (grid == 0) {
        if (n_in != 24 || ws_size < WS_END) { fprintf(stderr, "kernel_launch: unexpected n_in %d / ws %zu\n", n_in, ws_size); grid = -1; return; }
        int dev = 0, cus = 0;
        if (hipGetDevice(&dev) != hipSuccess || hipDeviceGetAttribute(&cus, hipDeviceAttributeMultiprocessorCount, dev) != hipSuccess) { grid = -1; return; }
        if (hipFuncSetAttribute((const void*)fwd_kernel, hipFuncAttributeMaxDynamicSharedMemorySize, LDS_BYTES) != hipSuccess) { fprintf(stderr, "kernel_launch: hipFuncSetAttribute failed\n"); grid = -1; return; }
        int per_cu = 0;
        if (hipOccupancyMaxActiveBlocksPerMultiprocessor(&per_cu, (const void*)fwd_kernel, NWAVES * 64, LDS_BYTES) != hipSuccess || per_cu < 1) fprintf(stderr, "kernel_launch: occupancy query says %d\n", per_cu);
        (void)hipGetLastError();
        grid = cus;
    }
    if (grid < 0) return;
    (void)hipMemsetAsync((char*)d_ws + WS_CTL, 0, CTL_ZERO_BYTES, stream);
    Args a{};
    for (int i = 0; i < 24; ++i) a.in[i] = (const float*)d_in[i];
    a.out = (float*)d_out; a.ws = (unsigned char*)d_ws;
#if MK_ONE_LAUNCH
    a.ph_lo = 0; a.ph_hi = N_PHASES;
    hipLaunchKernelGGL(fwd_kernel, dim3(grid), dim3(NWAVES * 64), LDS_BYTES, stream, a);
#else
    for (int p = 0; p < N_PHASES; ++p) { a.ph_lo = p; a.ph_hi = p + 1; hipLaunchKernelGGL(fwd_kernel, dim3(grid), dim3(NWAVES * 64), LDS_BYTES, stream, a); }
#endif
}
```

```cpp
#include <hip/hip_runtime.h>
#include <cstdio>
#include <cstdint>

constexpr int DM = 1024, M_CTX = 8192, M_LAT = 4096, MT = 12288, NIN = 5664, NINP = 5888, FF = 4096;
constexpr int LDA_ = 3072, LDB_ = 2816;
constexpr int C_Q = 0, C_K = 512, C_V = 1024, C_DN = 1536, CB_Z = 32, CB_GA = 544, CB_GD = 1568;

namespace pg8 {
#define PG8_LAS __attribute__((address_space(3)))
typedef unsigned short bf16_t;
typedef short bf16x8 __attribute__((ext_vector_type(8)));
typedef float f32x4 __attribute__((ext_vector_type(4)));
typedef unsigned u32x4 __attribute__((ext_vector_type(4)));
typedef unsigned u32x2 __attribute__((ext_vector_type(2)));
constexpr int BM = 256, BK = 64, HALF = 128, HTB = HALF * BK * 2  , STAGE_BYTES = 8 * HTB, NXCD = 8, WGM = 8;

__host__ __device__ __forceinline__ int lds_byte(int r, int c) { const int st = (r >> 4) * 2 + (c >> 5), rr = r & 15, cc = c & 31, ob = rr * 64 + cc * 2; return st * 1024 + (ob ^ (((ob >> 9) & 1) << 5)); }
__host__ __device__ __forceinline__ void stage_rc(int b, int& R, int& C) { const int st = b / 1024, sb = b % 1024, swz = sb ^ (((sb >> 9) & 1) << 5); R = (st >> 1) * 16 + swz / 64; C = (st & 1) * 32 + (swz % 64) / 2; }
__host__ __device__ __forceinline__ int perm32(int rho) { const int n = rho >> 4, i = rho & 15; return 8 * (i >> 2) + 4 * n + (i & 3); }

struct Unit { int pm, pn; };
struct Gemm { const bf16_t* A; const bf16_t* Bt; int M, N, K; };

struct StaticOrder {
    int nM, nN, nwg, G, c;
    __host__ __device__ void init(int M, int N, int G_, int c_) { nM = M / BM; nN = N / BM; nwg = nM * nN; G = G_; c = c_; }
    __host__ __device__ bool next(int i, Unit& u) const {
        const long L = (long)i * G + c; if (L >= nwg) return false;
        int wgid = (int)L; { const int q = nwg / NXCD, r = nwg % NXCD, xcd = wgid % NXCD, off = wgid / NXCD; wgid = (xcd < r ? xcd * (q + 1) : r * (q + 1) + (xcd - r) * q) + off; }
        const int nig = WGM * nN, gid = wgid / nig, fm = gid * WGM, gsz = (nM - fm) < WGM ? (nM - fm) : WGM;
        u.pm = fm + ((wgid % nig) % gsz); u.pn = (wgid % nig) / gsz; return true;
    }
    __device__ __forceinline__ void a_ready(const Unit&) const {}
    __device__ __forceinline__ void done(const Unit&) const {}
};

__device__ __forceinline__ unsigned cvt_pk_bf16(float lo, float hi) { unsigned r; asm volatile("v_cvt_pk_bf16_f32 %0, %1, %2" : "=v"(r) : "v"(lo), "v"(hi)); return r; }
__device__ __forceinline__ float bf_lo(unsigned w) { return __uint_as_float(w << 16); }
__device__ __forceinline__ float bf_hi(unsigned w) { return __uint_as_float(w & 0xffff0000u); }
__device__ __forceinline__ float sigmoidf_(float x) { return 1.0f / (1.0f + __expf(-x)); }
__device__ __forceinline__ u32x4 pack8(const f32x4& v0, const f32x4& v1) { u32x4 w; w.x = cvt_pk_bf16(v0[0], v0[1]); w.y = cvt_pk_bf16(v0[2], v0[3]); w.z = cvt_pk_bf16(v1[0], v1[1]); w.w = cvt_pk_bf16(v1[2], v1[3]); return w; }


struct EpiInProj {
    static constexpr bool PERM = true, AFTER_DRAIN = false;
    bf16_t* PA; bf16_t* PB; float* ko; float* vo; float* BA; bf16_t* VT; const float* rope;
    __device__ __forceinline__ void operator()(const f32x4 (&acc)[2][2][4][2], const Unit& u, int wr, int wc, int fr, int fq) const {
        const int pn = u.pn, pm = u.pm;
        const bool lat = pm >= 32;
        const bool do_rope = lat && pn < 4;
        const bool do_kv = (!lat) && pn >= 2 && pn < 6;
        const bool do_vt = pn == 4 || pn == 5;
        const bool do_ba = pn == 12 && wc == 0;
        const int lane_hi = fq >> 1;
#pragma unroll
        for (int ai = 0; ai < 2; ++ai)
#pragma unroll
            for (int m = 0; m < 4; ++m) {
                const int row = pm * BM + ai * HALF + wr * 64 + m * 16 + fr;
#pragma unroll
                for (int bj = 0; bj < 2; ++bj) {
                    f32x4 v0 = acc[ai][bj][m][0], v1 = acc[ai][bj][m][1];
                    const int col = pn * BM + bj * HALF + wc * 32 + 8 * fq;
                    if (do_rope) {
                        const int t = (row - M_CTX) & 1023;
                        const int pos = (wc & 1) ? (t & 63) : (t >> 6);
                        const float* cp = rope + pos * 16 + 8 * (fq & 1);
                        const f32x4 c0 = *(const f32x4*)cp, c1 = *(const f32x4*)(cp + 4), s0 = *(const f32x4*)(cp + 1024), s1 = *(const f32x4*)(cp + 1028);
                        f32x4 p0, p1;
#pragma unroll
                        for (int i = 0; i < 4; ++i) { p0[i] = __shfl_xor(v0[i], 32); p1[i] = __shfl_xor(v1[i], 32); }
                        if (lane_hi) { v0 = p0 * s0 + v0 * c0; v1 = p1 * s1 + v1 * c1; }
                        else         { v0 = v0 * c0 - p0 * s0; v1 = v1 * c1 - p1 * s1; }
                    }
                    if (pn < 12) *(u32x4*)(PA + (size_t)row * LDA_ + col) = pack8(v0, v1); else *(u32x4*)(PB + (size_t)row * LDB_ + (col - 3072)) = pack8(v0, v1);
                    if (do_kv) {
                        const int hh = ((pn & 1) * 4) + bj * 2 + (wc >> 1);
                        const int d = (wc & 1) * 32 + 8 * fq;
                        float* dst = (pn < 4 ? ko : vo) + ((size_t)(pm * 8 + hh) * 256 + (row & 255)) * 64 + d;
                        *(f32x4*)dst = v0; *(f32x4*)(dst + 4) = v1;
                    }
                    if (do_vt) {
                        const int hh = ((pn & 1) * 4) + bj * 2 + (wc >> 1);
                        const int d = (wc & 1) * 32 + 8 * fq;
                        size_t base; int t, T;
                        if (!lat) { t = row & 255; T = 256; base = (size_t)(pm * 8 + hh) * 64 * 256; }
                        else { const int rl = row - M_CTX; t = rl & 1023; T = 1024; base = (size_t)M_CTX * 512 + (size_t)((rl >> 10) * 8 + hh) * 64 * 1024; }
                        const int pos = (t & ~12) | ((t & 4) << 1) | ((t & 8) >> 1);
                        bf16_t* dst = VT + base + (size_t)d * T + pos;
                        const u32x4 w = pack8(v0, v1);
                        dst[0] = (bf16_t)(w.x & 0xffff); dst[(size_t)T] = (bf16_t)(w.x >> 16); dst[(size_t)2 * T] = (bf16_t)(w.y & 0xffff); dst[(size_t)3 * T] = (bf16_t)(w.y >> 16);
                        dst[(size_t)4 * T] = (bf16_t)(w.z & 0xffff); dst[(size_t)5 * T] = (bf16_t)(w.z >> 16); dst[(size_t)6 * T] = (bf16_t)(w.w & 0xffff); dst[(size_t)7 * T] = (bf16_t)(w.w >> 16);
                    }
                    if (do_ba && bj == 0) { float* dst = BA + (size_t)row * 32 + 8 * fq; *(f32x4*)dst = v0; *(f32x4*)(dst + 4) = v1; }
                }
            }
    }
};

struct EpiGate1 {
    static constexpr bool PERM = true, AFTER_DRAIN = false;
    const bf16_t* P; bf16_t* M1;
    __device__ __forceinline__ void operator()(const f32x4 (&acc)[2][2][4][2], const Unit& u, int wr, int wc, int fr, int fq) const {
#pragma unroll
        for (int ai = 0; ai < 2; ++ai)
#pragma unroll
            for (int m = 0; m < 4; ++m) {
                const int row = u.pm * BM + ai * HALF + wr * 64 + m * 16 + fr;
#pragma unroll
                for (int bj = 0; bj < 2; ++bj) {
                    const int col = u.pn * BM + bj * HALF + wc * 32 + 8 * fq;
                    const u32x4 g = *(const u32x4*)(P + (size_t)row * LDB_ + CB_GA + col);
                    f32x4 v0 = acc[ai][bj][m][0], v1 = acc[ai][bj][m][1];
                    v0[0] *= sigmoidf_(bf_lo(g.x)); v0[1] *= sigmoidf_(bf_hi(g.x)); v0[2] *= sigmoidf_(bf_lo(g.y)); v0[3] *= sigmoidf_(bf_hi(g.y));
                    v1[0] *= sigmoidf_(bf_lo(g.z)); v1[1] *= sigmoidf_(bf_hi(g.z)); v1[2] *= sigmoidf_(bf_lo(g.w)); v1[3] *= sigmoidf_(bf_hi(g.w));
                    *(u32x4*)(M1 + (size_t)row * DM + col) = pack8(v0, v1);
                }
            }
    }
};
struct EpiGate2 {
    static constexpr bool PERM = true, AFTER_DRAIN = false;
    const bf16_t* P; const bf16_t* M1; bf16_t* O;
    __device__ __forceinline__ void operator()(const f32x4 (&acc)[2][2][4][2], const Unit& u, int wr, int wc, int fr, int fq) const {
#pragma unroll
        for (int ai = 0; ai < 2; ++ai)
#pragma unroll
            for (int m = 0; m < 4; ++m) {
                const int row = u.pm * BM + ai * HALF + wr * 64 + m * 16 + fr;
#pragma unroll
                for (int bj = 0; bj < 2; ++bj) {
                    const int col = u.pn * BM + bj * HALF + wc * 32 + 8 * fq;
                    const u32x4 g = *(const u32x4*)(P + (size_t)row * LDB_ + CB_GD + col);
                    const u32x4 q = *(const u32x4*)(M1 + (size_t)row * DM + col);
                    f32x4 v0 = acc[ai][bj][m][0], v1 = acc[ai][bj][m][1];
                    v0[0] = bf_lo(q.x) + v0[0] * sigmoidf_(bf_lo(g.x)); v0[1] = bf_hi(q.x) + v0[1] * sigmoidf_(bf_hi(g.x)); v0[2] = bf_lo(q.y) + v0[2] * sigmoidf_(bf_lo(g.y)); v0[3] = bf_hi(q.y) + v0[3] * sigmoidf_(bf_hi(g.y));
                    v1[0] = bf_lo(q.z) + v1[0] * sigmoidf_(bf_lo(g.z)); v1[1] = bf_hi(q.z) + v1[1] * sigmoidf_(bf_hi(g.z)); v1[2] = bf_lo(q.w) + v1[2] * sigmoidf_(bf_lo(g.w)); v1[3] = bf_hi(q.w) + v1[3] * sigmoidf_(bf_hi(g.w));
                    *(u32x4*)(O + (size_t)row * DM + col) = pack8(v0, v1);
                }
            }
    }
};
struct EpiRss {
    static constexpr bool PERM = true, AFTER_DRAIN = false;
    bf16_t* O; float* RSS;
    __device__ __forceinline__ void operator()(const f32x4 (&acc)[2][2][4][2], const Unit& u, int wr, int wc, int fr, int fq) const {
#pragma unroll
        for (int ai = 0; ai < 2; ++ai)
#pragma unroll
            for (int m = 0; m < 4; ++m) {
                const int row = u.pm * BM + ai * HALF + wr * 64 + m * 16 + fr;
                float s = 0.f;
#pragma unroll
                for (int bj = 0; bj < 2; ++bj) {
                    const int col = u.pn * BM + bj * HALF + wc * 32 + 8 * fq;
                    const f32x4 v0 = acc[ai][bj][m][0], v1 = acc[ai][bj][m][1];
                    s += (v0[0] * v0[0] + v0[1] * v0[1]) + (v0[2] * v0[2] + v0[3] * v0[3]) + (v1[0] * v1[0] + v1[1] * v1[1]) + (v1[2] * v1[2] + v1[3] * v1[3]);
                    *(u32x4*)(O + (size_t)row * DM + col) = pack8(v0, v1);
                }
                s += __shfl_xor(s, 16); s += __shfl_xor(s, 32);
                if (fq == 0) RSS[((size_t)u.pn * MT + row) * 4 + wc] = s;
            }
    }
};
struct EpiRelu2 {
    static constexpr bool PERM = true, AFTER_DRAIN = false;
    bf16_t* O;
    __device__ __forceinline__ void operator()(const f32x4 (&acc)[2][2][4][2], const Unit& u, int wr, int wc, int fr, int fq) const {
#pragma unroll
        for (int ai = 0; ai < 2; ++ai)
#pragma unroll
            for (int m = 0; m < 4; ++m) {
                const int row = u.pm * BM + ai * HALF + wr * 64 + m * 16 + fr;
#pragma unroll
                for (int bj = 0; bj < 2; ++bj) {
                    const int col = u.pn * BM + bj * HALF + wc * 32 + 8 * fq;
                    f32x4 v0 = acc[ai][bj][m][0], v1 = acc[ai][bj][m][1];
#pragma unroll
                    for (int i = 0; i < 4; ++i) { const float a = fmaxf(v0[i], 0.f), b = fmaxf(v1[i], 0.f); v0[i] = a * a; v1[i] = b * b; }
                    *(u32x4*)(O + (size_t)row * FF + col) = pack8(v0, v1);
                }
            }
    }
};

template <class Epi, class Sched, bool ALIGN_EPI = false, bool SP2 = false>
__device__ __forceinline__ void gemm_phase(PG8_LAS unsigned char* lds, const Gemm g, const Sched& S, const Epi& E) {
    const int tid = threadIdx.x, wid = __builtin_amdgcn_readfirstlane(tid >> 6), lane = tid & 63, wr = wid >> 2, wc = wid & 3, fr = lane & 15, fq = lane >> 4;
    const int K = g.K, nt = K / BK;
    unsigned voffA[2], voffB[2];
#pragma unroll
    for (int i = 0; i < 2; ++i) { int R, C; stage_rc(tid * 16 + i * 8192, R, C); const int Rb = Epi::PERM ? ((R & ~31) + perm32(R & 31)) : R;
        voffA[i] = (unsigned)(R * K + C) * 2u; voffB[i] = (unsigned)(Rb * K + C) * 2u; }
    const size_t kstep = (size_t)(BK * 2);
    const size_t hstep = (size_t)HALF * K * 2;
    const size_t tstep = 2 * hstep;
    const unsigned ldsw = (unsigned)wid * 1024u;
    const int aoff = lds_byte(wr * 64 + fr, fq * 8), boff = lds_byte(wc * 32 + fr, fq * 8);
#define PG8_SA(b, h) (((b) * 2 + (h)) * HTB)
#define PG8_SB(b, h) ((4 + (b) * 2 + (h)) * HTB)
#define PG8_STAGE(bufoff, gbase, voff) do { _Pragma("unroll") for (int _i = 0; _i < 2; ++_i) \
        __builtin_amdgcn_global_load_lds((const unsigned*)((const char*)(gbase) + (voff)[_i]), (PG8_LAS unsigned*)(lds + (bufoff) + ldsw + _i * 8192), 16, 0, 0); } while (0)
#define PG8_LDA(dst, b, h) do { _Pragma("unroll") for (int m = 0; m < 4; ++m) _Pragma("unroll") for (int k = 0; k < 2; ++k) dst[m][k] = *(const PG8_LAS bf16x8*)(lds + PG8_SA(b, h) + aoff + m * 2048 + k * 1024); } while (0)
#define PG8_LDB(dst, b, h) do { _Pragma("unroll") for (int n = 0; n < 2; ++n) _Pragma("unroll") for (int k = 0; k < 2; ++k) dst[n][k] = *(const PG8_LAS bf16x8*)(lds + PG8_SB(b, h) + boff + n * 2048 + k * 1024); } while (0)
#define PG8_MMA(ai, bj, At, Bt) do { __builtin_amdgcn_s_setprio(1); _Pragma("unroll") for (int m = 0; m < 4; ++m) _Pragma("unroll") for (int n = 0; n < 2; ++n) _Pragma("unroll") for (int k = 0; k < 2; ++k) \
        acc[ai][bj][m][n] = __builtin_amdgcn_mfma_f32_16x16x32_bf16(Bt[n][k], At[m][k], acc[ai][bj][m][n], 0, 0, 0); __builtin_amdgcn_s_setprio(0); } while (0)
#define PG8_WAIT_V(n) asm volatile("s_waitcnt vmcnt(" #n ")" ::: "memory")
#define PG8_WAIT_L(n) asm volatile("s_waitcnt lgkmcnt(" #n ")" ::: "memory")
#define PG8_BAR __builtin_amdgcn_s_barrier()
#define PG8_SCHED __builtin_amdgcn_sched_barrier(0)
    Unit cur, nxt; int ui = 0;
    if (!S.next(0, cur)) return;
    f32x4 acc[2][2][4][2];
#pragma unroll
    for (int a = 0; a < 2; ++a)
#pragma unroll
        for (int b = 0; b < 2; ++b)
#pragma unroll
            for (int m = 0; m < 4; ++m)
#pragma unroll
                for (int n = 0; n < 2; ++n) acc[a][b][m][n] = (f32x4){0.f, 0.f, 0.f, 0.f};
    bf16x8 At[4][2], B0[2][2], B1[2][2];
    const char* cA = (const char*)g.A + (size_t)cur.pm * tstep; const char* cB = (const char*)g.Bt + (size_t)cur.pn * tstep;
    S.a_ready(cur);
    if constexpr (SP2) {
        PG8_STAGE(PG8_SB(0, 0), cB, voffB); PG8_STAGE(PG8_SB(0, 1), cB + hstep, voffB); PG8_STAGE(PG8_SA(0, 0), cA, voffA); PG8_STAGE(PG8_SA(0, 1), cA + hstep, voffA);
        if (wr == 1) PG8_BAR;
        PG8_WAIT_V(2); PG8_BAR;
        PG8_STAGE(PG8_SB(1, 0), cB + kstep, voffB); PG8_STAGE(PG8_SA(1, 0), cA + kstep, voffA); PG8_STAGE(PG8_SB(1, 1), cB + hstep + kstep, voffB);
        PG8_WAIT_V(6); PG8_BAR;
    } else {
        PG8_STAGE(PG8_SB(0, 0), cB, voffB); PG8_STAGE(PG8_SA(0, 0), cA, voffA); PG8_STAGE(PG8_SB(0, 1), cB + hstep, voffB); PG8_STAGE(PG8_SA(0, 1), cA + hstep, voffA);
        if (wr == 1) PG8_BAR;
        PG8_WAIT_V(4); PG8_BAR;
        PG8_STAGE(PG8_SB(1, 0), cB + kstep, voffB); PG8_STAGE(PG8_SA(1, 0), cA + kstep, voffA); PG8_STAGE(PG8_SB(1, 1), cB + hstep + kstep, voffB);
        PG8_WAIT_V(6); PG8_BAR;
    }
    for (;;) {
        const bool has_next = S.next(ui + 1, nxt);
        const char* nA = has_next ? (const char*)g.A + (size_t)nxt.pm * tstep : cA; const char* nB = has_next ? (const char*)g.Bt + (size_t)nxt.pn * tstep : cB;
        for (int t = 0; t < nt; t += 2) {
            const bool last = (t == nt - 2);
            const char* a1 = cA + (size_t)(t + 1) * kstep;
            const char* a2 = last ? nA : cA + (size_t)(t + 2) * kstep; const char* b2 = last ? nB : cB + (size_t)(t + 2) * kstep;
            const char* a3 = a2 + kstep; const char* b3 = b2 + kstep;
            if (last && has_next) S.a_ready(nxt);
            if constexpr (SP2) {
            PG8_LDB(B0, 0, 0); PG8_LDB(B1, 0, 1); PG8_SCHED; PG8_LDA(At, 0, 0); PG8_STAGE(PG8_SA(1, 1), a1 + hstep, voffA);
            PG8_WAIT_V(8); PG8_WAIT_L(0); PG8_BAR; PG8_MMA(0, 0, At, B0); PG8_MMA(0, 1, At, B1); PG8_BAR; PG8_SCHED;
            PG8_LDA(At, 0, 1); PG8_STAGE(PG8_SB(0, 0), b2, voffB); PG8_STAGE(PG8_SB(0, 1), b2 + hstep, voffB); PG8_STAGE(PG8_SA(0, 0), a2, voffA);
            PG8_WAIT_V(8); PG8_WAIT_L(0); PG8_BAR; PG8_MMA(1, 0, At, B0); PG8_MMA(1, 1, At, B1); PG8_BAR; PG8_SCHED;
            PG8_LDB(B0, 1, 0); PG8_LDB(B1, 1, 1); PG8_SCHED; PG8_LDA(At, 1, 0); PG8_STAGE(PG8_SA(0, 1), a2 + hstep, voffA);
            PG8_WAIT_V(8); PG8_WAIT_L(0); PG8_BAR; PG8_MMA(0, 0, At, B0); PG8_MMA(0, 1, At, B1); PG8_BAR; PG8_SCHED;
            PG8_LDA(At, 1, 1); PG8_STAGE(PG8_SB(1, 0), b3, voffB); PG8_STAGE(PG8_SB(1, 1), b3 + hstep, voffB); PG8_STAGE(PG8_SA(1, 0), a3, voffA);
            PG8_WAIT_V(8); PG8_WAIT_L(0); PG8_BAR; PG8_MMA(1, 0, At, B0); PG8_MMA(1, 1, At, B1); PG8_BAR; PG8_SCHED;
            } else {
            PG8_LDB(B0, 0, 0); PG8_SCHED; PG8_LDA(At, 0, 0); PG8_STAGE(PG8_SA(1, 1), a1 + hstep, voffA);
            PG8_WAIT_L(8); PG8_BAR; PG8_WAIT_L(0); PG8_MMA(0, 0, At, B0); PG8_BAR; PG8_SCHED;
            PG8_LDB(B1, 0, 1); PG8_STAGE(PG8_SB(0, 0), b2, voffB);
            PG8_BAR; PG8_WAIT_L(0); PG8_MMA(0, 1, At, B1); PG8_BAR;
            PG8_LDA(At, 0, 1); PG8_STAGE(PG8_SA(0, 0), a2, voffA);
            PG8_BAR; PG8_WAIT_L(0); PG8_MMA(1, 0, At, B0); PG8_BAR; PG8_SCHED;
            PG8_STAGE(PG8_SB(0, 1), b2 + hstep, voffB);
            PG8_WAIT_V(6); PG8_BAR; PG8_MMA(1, 1, At, B1); PG8_BAR;
            PG8_LDB(B0, 1, 0); PG8_SCHED; PG8_LDA(At, 1, 0); PG8_STAGE(PG8_SA(0, 1), a2 + hstep, voffA);
            PG8_WAIT_L(8); PG8_BAR; PG8_WAIT_L(0); PG8_MMA(0, 0, At, B0); PG8_BAR; PG8_SCHED;
            PG8_LDB(B1, 1, 1); PG8_STAGE(PG8_SB(1, 0), b3, voffB);
            PG8_BAR; PG8_WAIT_L(0); PG8_MMA(0, 1, At, B1); PG8_BAR;
            PG8_LDA(At, 1, 1); PG8_STAGE(PG8_SA(1, 0), a3, voffA);
            PG8_BAR; PG8_WAIT_L(0); PG8_MMA(1, 0, At, B0); PG8_BAR; PG8_SCHED;
            PG8_STAGE(PG8_SB(1, 1), b3 + hstep, voffB);
            PG8_WAIT_V(6); PG8_BAR; PG8_MMA(1, 1, At, B1); PG8_BAR;
            }
        }
        if constexpr (ALIGN_EPI) { if (wr == 0) PG8_BAR; }
        if constexpr (!Epi::AFTER_DRAIN) { E(acc, cur, wr, wc, fr, fq); S.done(cur); }
        if (!has_next) break;
#pragma unroll
        for (int a = 0; a < 2; ++a)
#pragma unroll
            for (int b = 0; b < 2; ++b)
#pragma unroll
                for (int m = 0; m < 4; ++m)
#pragma unroll
                    for (int n = 0; n < 2; ++n) acc[a][b][m][n] = (f32x4){0.f, 0.f, 0.f, 0.f};
        cur = nxt; cA = nA; cB = nB; ++ui;
        if constexpr (ALIGN_EPI) { if (wr == 1) PG8_BAR; }
    }
    PG8_WAIT_V(0);
    if constexpr (!ALIGN_EPI) { if (wr == 0) PG8_BAR; }
    PG8_BAR;
    if constexpr (Epi::AFTER_DRAIN) { E.fused(acc, cur, wr, wc, fr, fq, lds, wid, lane); S.done(cur); }
#undef PG8_SA
#undef PG8_SB
#undef PG8_STAGE
#undef PG8_LDA
#undef PG8_LDB
#undef PG8_MMA
#undef PG8_WAIT_V
#undef PG8_WAIT_L
#undef PG8_BAR
#undef PG8_SCHED
}
}

constexpr int NWAVES = 8;
constexpr size_t MiB = 1u << 20;
constexpr size_t WS_CTL = 0, CTL_ZERO_BYTES = 64 * 1024;
constexpr size_t WS_MOD = 1 * MiB;
constexpr size_t WS_ROPE = 1 * MiB + 256 * 1024;
constexpr size_t WS_BA = 2 * MiB;
constexpr size_t WS_RSS1 = 4 * MiB, WS_RSS2 = 5 * MiB;
constexpr size_t WS_WIN = 6 * MiB, WS_WAO = 18 * MiB, WS_WDO = 19 * MiB, WS_WOUT = 20 * MiB, WS_W1 = 22 * MiB, WS_W2 = 30 * MiB;
constexpr size_t WS_XN = 38 * MiB;
constexpr size_t WS_ONA = 62 * MiB, WS_ODN = 74 * MiB;
constexpr size_t WS_PA = 86 * MiB;
constexpr size_t WS_PB = 158 * MiB;
constexpr size_t WS_SC = 250 * MiB;
constexpr size_t WS_M1 = 224 * MiB;
constexpr size_t WS_CK = 248 * MiB, WS_CVT = 249 * MiB;
constexpr size_t WS_END = 256 * MiB;
constexpr size_t OUT_YP = 0, OUT_YS = (size_t)M_CTX * DM, OUT_K = (size_t)MT * DM, OUT_V = OUT_K + (size_t)32 * 8 * 256 * 64, OUT_S = OUT_V + (size_t)32 * 8 * 256 * 64;

constexpr int CW_BAR = 1024;
constexpr int RING_BYTES = 131072, LDS_BYTES = 147456, LDSCTL_OFF = LDS_BYTES - 1024, MISC_OFF = LDSCTL_OFF + 320;

#define GAS __attribute__((address_space(1)))
#define LAS __attribute__((address_space(3)))
typedef unsigned short bf16;
typedef unsigned v4u __attribute__((ext_vector_type(4)));
typedef unsigned v2u __attribute__((ext_vector_type(2)));
typedef float f32x4 __attribute__((ext_vector_type(4)));
typedef float f32x16 __attribute__((ext_vector_type(16)));
typedef short bf16x8 __attribute__((ext_vector_type(8)));
#define LDS_WAIT() asm volatile("s_waitcnt lgkmcnt(0)" ::: "memory")
#define VM_WAIT() asm volatile("s_waitcnt vmcnt(0)" ::: "memory")
#define MFMA32(a, b, c) __builtin_amdgcn_mfma_f32_32x32x16_bf16((a), (b), (c), 0, 0, 0)
__device__ __forceinline__ unsigned f2bf(float f) { unsigned u = __builtin_bit_cast(unsigned, f); return (u + 0x7fffu + ((u >> 16) & 1u)) >> 16; }
typedef float f32x2_t __attribute__((ext_vector_type(2))); typedef __bf16 bf16x2_t __attribute__((ext_vector_type(2)));
__device__ __forceinline__ unsigned pk2(float lo, float hi) { f32x2_t v = {lo, hi}; bf16x2_t b = __builtin_convertvector(v, bf16x2_t); return __builtin_bit_cast(unsigned, b); }
__device__ __forceinline__ float bflo(unsigned w) { return __uint_as_float(w << 16); }
__device__ __forceinline__ float bfhi(unsigned w) { return __uint_as_float(w & 0xffff0000u); }
__device__ __forceinline__ float silu_(float x) { return x / (1.0f + __expf(-x)); }
__device__ __forceinline__ float sigm_(float x) { return 1.0f / (1.0f + __expf(-x)); }
__device__ __host__ __forceinline__ constexpr int swap23(int x) { return (x & ~12) | ((x & 4) << 1) | ((x & 8) >> 1); }
__device__ __forceinline__ int crow(int reg, int h) { return (reg & 3) + 8 * (reg >> 2) + 4 * h; }
__device__ __forceinline__ float wave_sum(float v) {
#pragma unroll
    for (int o = 1; o < 64; o <<= 1) v += __shfl_xor(v, o);
    return v;
}

#define XB_TMO      128
#define XB_XCNT(j)  (256  + 64 * (j))
#define XB_XSUB(j)  (1280 + 64 * (j))
#define XB_XGEN(j)  (2304 + 64 * (j))
#define XB_TOP      3328
#define XB_TOPGEN   3392
#define XCD_BAR_WORDS 3456
#define XB_SPIN_CAP (1u << 22)

__device__ __forceinline__ unsigned xb_ld(unsigned* p)              { return __hip_atomic_load(p, __ATOMIC_RELAXED, __HIP_MEMORY_SCOPE_AGENT); }
__device__ __forceinline__ unsigned xb_add(unsigned* p, unsigned v) { return __hip_atomic_fetch_add(p, v, __ATOMIC_RELAXED, __HIP_MEMORY_SCOPE_AGENT); }
__device__ __forceinline__ unsigned xb_xcc_id() { return (unsigned)__builtin_amdgcn_s_getreg((3 << 11) | 20) & 0xFu; }
#define XB_SPIN(cond, bar) do { unsigned _sp = 0; while (cond) { __builtin_amdgcn_s_sleep(1); \
    if ((++_sp & 255u) == 0u) { if (xb_ld(&(bar)[XB_TMO])) break; if (_sp > XB_SPIN_CAP) { atomicAdd(&(bar)[XB_TMO], 1u); break; } } } } while (0)

struct XcdBarrier { unsigned* bar; unsigned x; volatile LAS unsigned* st; };

__device__ __forceinline__ XcdBarrier xcd_barrier_post(unsigned* bar, volatile LAS unsigned* st) {
    XcdBarrier b; b.bar = bar; b.x = xb_xcc_id(); b.st = st;
    if (threadIdx.x == 0) (void)xb_add(&bar[XB_XCNT(b.x)], 1u);
    return b;
}
__device__ __forceinline__ void xcd_barrier_complete(unsigned* bar, unsigned x, unsigned& nloc, unsigned& nx) {
    const unsigned G = gridDim.x * gridDim.y * gridDim.z;
    unsigned sum, cnt, mine, sp = 0u;
    for (;;) {
        sum = 0u; cnt = 0u; mine = 0u;
#pragma unroll
        for (unsigned j = 0; j < 16; ++j) { const unsigned c = xb_ld(&bar[XB_XCNT(j)]); sum += c; cnt += (c > 0u) ? 1u : 0u; mine = (j == x) ? c : mine; }
        if (sum == G) break;
        __builtin_amdgcn_s_sleep(1);
        if ((++sp & 255u) == 0u) { if (xb_ld(&bar[XB_TMO])) break; if (sp > XB_SPIN_CAP) { atomicAdd(&bar[XB_TMO], 1u); break; } }
    }
    nloc = mine > 0u ? mine : 1u; nx = cnt > 0u ? cnt : 1u;
}
__device__ __forceinline__ void xcd_barrier(const XcdBarrier& b) {
    asm volatile("s_waitcnt vmcnt(0)" ::: "memory");
    __syncthreads();
    if (threadIdx.x == 0) {
        unsigned* bar = b.bar;
        __builtin_amdgcn_s_waitcnt(0);
        unsigned nloc = b.st[0], nx = b.st[1];
        if (nloc == 0u) { xcd_barrier_complete(bar, b.x, nloc, nx); b.st[0] = nloc; b.st[1] = nx; }
        const unsigned old = xb_add(&bar[XB_XSUB(b.x)], 1u);
        const unsigned gen = old / nloc;
        if (old + 1u == (gen + 1u) * nloc) {
            __builtin_amdgcn_fence(__ATOMIC_RELEASE, "agent");
            asm volatile("s_waitcnt vmcnt(0)" ::: "memory");
            const unsigned og = xb_add(&bar[XB_TOP], 1u);
            const unsigned tg = og / nx;
            if (og + 1u == (tg + 1u) * nx) xb_add(&bar[XB_TOPGEN], 1u);
            else XB_SPIN(xb_ld(&bar[XB_TOPGEN]) == tg, bar);
            __builtin_amdgcn_fence(__ATOMIC_ACQUIRE, "agent");
            xb_add(&bar[XB_XGEN(b.x)], 1u);
            asm volatile("s_waitcnt vmcnt(0)" ::: "memory");
        } else {
            XB_SPIN(xb_ld(&bar[XB_XGEN(b.x)]) == gen, bar);
            __builtin_amdgcn_fence(__ATOMIC_ACQUIRE, "agent");
            asm volatile("s_waitcnt vmcnt(0)" ::: "memory");
        }
    }
    __syncthreads();
}

struct Args { const float* in[24]; float* out; unsigned char* ws; int ph_lo, ph_hi; };
enum { I_XP = 0, I_XS, I_C, I_CK, I_CV, I_ST, I_CCTX, I_WADA, I_BADA, I_PRE1, I_POST1, I_PRE2, I_POST2, I_WIN, I_CONVW, I_ALOG, I_DTB, I_DNN, I_RPB, I_WAO, I_WDO, I_WOUT, I_WFF1, I_WFF2 };

__device__ __forceinline__ void p0_transpose_item(const float* W, int K, int N, bf16* WT, LAS float* scr, int item, int lane) {
    const int nblk = N / 32, kb = item / nblk, nb = item % nblk, k0 = 64 * kb, n0 = 32 * nb;
#pragma unroll 8
    for (int i = 0; i < 32; ++i) { const int kk = 2 * i + (lane >> 5); scr[kk * 33 + (lane & 31)] = W[(size_t)(k0 + kk) * N + n0 + (lane & 31)]; }
    LDS_WAIT();
    const int c = lane & 7;
#pragma unroll
    for (int j = 0; j < 4; ++j) { const int n = (lane >> 3) + 8 * j; const LAS float* s = scr + (8 * c) * 33 + n;
        v4u o; o.x = pk2(s[0 * 33], s[1 * 33]); o.y = pk2(s[2 * 33], s[3 * 33]); o.z = pk2(s[4 * 33], s[5 * 33]); o.w = pk2(s[6 * 33], s[7 * 33]);
        *(v4u*)(WT + (size_t)(n0 + n) * K + k0 + 8 * c) = o; }
    LDS_WAIT();
}

__device__ __forceinline__ void phase_prologue(const Args& a, LAS unsigned char* lds, int vcu, int G) {
    const int tid = threadIdx.x, lane = tid & 63, wave = __builtin_amdgcn_readfirstlane(tid >> 6);
    unsigned char* ws = a.ws;
    if (vcu < 192) {
        LAS float* sl = (LAS float*)lds;
        LAS float* red = (LAS float*)(lds + 20480);
        for (int i = tid; i < 5 * 1024; i += 512) { const float v = i < 1024 ? a.in[I_CCTX][i] : a.in[I_C][i - 1024]; sl[i] = silu_(v); }
        __syncthreads();
        const int col = 32 * vcu + (lane & 31), rg = wave * 2 + (lane >> 5);
        const float* w = a.in[I_WADA] + (size_t)(rg * 64) * 6144 + col;
        float acc[5] = {0.f, 0.f, 0.f, 0.f, 0.f};
#pragma unroll 8
        for (int i = 0; i < 64; ++i) { const float wv = w[(size_t)i * 6144]; const int k = rg * 64 + i;
#pragma unroll
            for (int v = 0; v < 5; ++v) acc[v] += sl[v * 1024 + k] * wv; }
#pragma unroll
        for (int v = 0; v < 5; ++v) red[(rg * 5 + v) * 32 + (lane & 31)] = acc[v];
        __syncthreads();
        if (tid < 160) { const int v = tid >> 5, cl = tid & 31; float s = a.in[I_BADA][32 * vcu + cl];
            for (int r = 0; r < 16; ++r) s += red[(r * 5 + v) * 32 + cl];
            ((float*)(ws + WS_MOD))[v * 6144 + 32 * vcu + cl] = s; }
        __syncthreads();
    } else if (vcu == 192) {
        float* rope = (float*)(ws + WS_ROPE);
        for (int i = tid; i < 1024; i += 512) { const int pos = i >> 4, f = i & 15; const float inv = powf(10000.0f, -(float)f / 16.0f); const float ang = (float)pos * inv; rope[i] = cosf(ang); rope[1024 + i] = sinf(ang); }
    } else if (vcu < 225) {
        const int bh = vcu - 193;
        const float* ck = a.in[I_CK] + (size_t)bh * 256 * 64; const float* cv = a.in[I_CV] + (size_t)bh * 256 * 64;
        bf16* CK = (bf16*)(ws + WS_CK) + (size_t)bh * 256 * 64; bf16* CVT = (bf16*)(ws + WS_CVT) + (size_t)bh * 64 * 256;
        for (int i = tid; i < 256 * 8; i += 512) { const int key = i >> 3, c8 = i & 7;
            const f32x4 k0 = *(const f32x4*)(ck + key * 64 + c8 * 8), k1 = *(const f32x4*)(ck + key * 64 + c8 * 8 + 4);
            v4u o; o.x = pk2(k0[0], k0[1]); o.y = pk2(k0[2], k0[3]); o.z = pk2(k1[0], k1[1]); o.w = pk2(k1[2], k1[3]);
            *(v4u*)(CK + key * 64 + c8 * 8) = o;
            const f32x4 v0 = *(const f32x4*)(cv + key * 64 + c8 * 8), v1 = *(const f32x4*)(cv + key * 64 + c8 * 8 + 4);
            const int pos = (key & ~12) | ((key & 4) << 1) | ((key & 8) >> 1);
#pragma unroll
            for (int j = 0; j < 4; ++j) { CVT[(c8 * 8 + j) * 256 + pos] = (bf16)f2bf(v0[j]); CVT[(c8 * 8 + 4 + j) * 256 + pos] = (bf16)f2bf(v1[j]); }
        }
    }
    LAS float* scr = (LAS float*)(lds + 32768 + wave * 8704);
    const int gw = vcu * NWAVES + wave, NGW = G * NWAVES;
    constexpr int I_IN = 16 * 177, I_AO = 8 * 32, I_DO = 8 * 32, I_OUT = 16 * 32, I_1 = 16 * 128, I_2 = 64 * 32;
    constexpr int NITEMS = I_IN + I_AO + I_DO + I_OUT + I_1 + I_2;
    for (int it = gw; it < NITEMS; it += NGW) {
        int r = it;
        if (r < I_IN) { p0_transpose_item(a.in[I_WIN], 1024, NIN, (bf16*)(ws + WS_WIN), scr, r, lane); continue; } r -= I_IN;
        if (r < I_AO) { p0_transpose_item(a.in[I_WAO], 512, 1024, (bf16*)(ws + WS_WAO), scr, r, lane); continue; } r -= I_AO;
        if (r < I_DO) { p0_transpose_item(a.in[I_WDO], 512, 1024, (bf16*)(ws + WS_WDO), scr, r, lane); continue; } r -= I_DO;
        if (r < I_OUT) { p0_transpose_item(a.in[I_WOUT], 1024, 1024, (bf16*)(ws + WS_WOUT), scr, r, lane); continue; } r -= I_OUT;
        if (r < I_1) { p0_transpose_item(a.in[I_WFF1], 1024, FF, (bf16*)(ws + WS_W1), scr, r, lane); continue; } r -= I_1;
        p0_transpose_item(a.in[I_WFF2], FF, 1024, (bf16*)(ws + WS_W2), scr, r, lane);
    }
    { v4u* z = (v4u*)((bf16*)(ws + WS_WIN) + (size_t)NIN * 1024); const int n16 = (NINP - NIN) * 1024 * 2 / 16;
      for (int i = gw * 64 + lane; i < n16; i += NGW * 64) z[i] = (v4u){0u, 0u, 0u, 0u}; }
}

__device__ __forceinline__ const float* x_row(const Args& a, int m) { return m < M_CTX ? a.in[I_XP] + (size_t)m * DM : a.in[I_XS] + (size_t)(m - M_CTX) * DM; }
__device__ __forceinline__ int mod_idx(int m) { return m < M_CTX ? 0 : 1 + ((m - M_CTX) >> 10); }

__device__ __forceinline__ void phase_xn(const Args& a, int vcu, int G) {
    const int tid = threadIdx.x, lane = tid & 63, wave = tid >> 6;
    const int gw = vcu * NWAVES + wave, NGW = G * NWAVES;
    const float* MOD = (const float*)(a.ws + WS_MOD); bf16* XN = (bf16*)(a.ws + WS_XN);
    for (int m = gw; m < MT; m += NGW) {
        const f32x4* xr = (const f32x4*)x_row(a, m) + lane;
        const float* md = MOD + mod_idx(m) * 6144;
        f32x4 v[4]; float s = 0.f;
#pragma unroll
        for (int j = 0; j < 4; ++j) { v[j] = xr[64 * j]; s += (v[j].x * v[j].x + v[j].y * v[j].y) + (v[j].z * v[j].z + v[j].w * v[j].w); }
        const float rstd = rsqrtf(wave_sum(s) * (1.f / DM) + 1e-6f);
        v2u* o8 = (v2u*)(XN + (size_t)m * DM) + lane;
#pragma unroll
        for (int j = 0; j < 4; ++j) { const int c = (lane + 64 * j) * 4;
            const f32x4 w = *(const f32x4*)(a.in[I_PRE1] + c), sh = *(const f32x4*)(md + c), sc = *(const f32x4*)(md + 1024 + c);
            const f32x4 h = v[j] * rstd * w * (sc + 1.0f) + sh;
            v2u o; o.x = pk2(h.x, h.y); o.y = pk2(h.z, h.w); o8[64 * j] = o; }
    }
}

__device__ __forceinline__ bf16x8 pack_regs(const f32x16& p, int s) {
    v4u w; w.x = pk2(p[8 * s], p[8 * s + 1]); w.y = pk2(p[8 * s + 2], p[8 * s + 3]); w.z = pk2(p[8 * s + 4], p[8 * s + 5]); w.w = pk2(p[8 * s + 6], p[8 * s + 7]);
    return __builtin_bit_cast(bf16x8, w);
}
__device__ __forceinline__ void store_o(bf16* dst, const f32x16& o0, const f32x16& o1, float inv, int hh) {
#pragma unroll
    for (int g = 0; g < 4; ++g) {
        v2u w0, w1; w0.x = pk2(o0[4 * g] * inv, o0[4 * g + 1] * inv); w0.y = pk2(o0[4 * g + 2] * inv, o0[4 * g + 3] * inv);
        w1.x = pk2(o1[4 * g] * inv, o1[4 * g + 1] * inv); w1.y = pk2(o1[4 * g + 2] * inv, o1[4 * g + 3] * inv);
        *(v2u*)(dst + 8 * g + 4 * hh) = w0; *(v2u*)(dst + 32 + 8 * g + 4 * hh) = w1;
    }
}
constexpr float LOG2E = 1.4426950408889634f;

struct AttnTile { const bf16* k; const bf16* v0; const bf16* v1; };
template <bool LAT>
__device__ __forceinline__ void attn_task(const Args& a, int task, int lane) {
    const int r = lane & 31, hh = lane >> 5;
    const bf16* P = (const bf16*)(a.ws + WS_PA); bf16* ONA = (bf16*)(a.ws + WS_ONA);
    int b, h, rowq, gr = 0, cq = 0;
    if (LAT) { const int half = task & 1; gr = (task >> 1) & 15; h = (task >> 5) & 7; b = task >> 8; cq = 32 * half + r; rowq = M_CTX + b * 1024 + gr * 64 + cq; }
    else { const int qb = task & 7; h = (task >> 3) & 7; b = task >> 6; rowq = b * 256 + qb * 32 + r; }
    constexpr int NT = LAT ? 24 : 8;
    const bf16* VTb = LAT ? (const bf16*)a.out + (size_t)3 * MT * 512 + (size_t)M_CTX * 512 + ((size_t)(b * 8 + h) * 64 + r) * 1024 + 8 * hh
                          : (const bf16*)a.out + (size_t)3 * MT * 512 + ((size_t)(b * 8 + h) * 64 + r) * 256 + 8 * hh;
    const bf16* CK = (const bf16*)(a.ws + WS_CK) + (size_t)(b * 8 + h) * 256 * 64 + 8 * hh; const bf16* CVT = (const bf16*)(a.ws + WS_CVT) + ((size_t)(b * 8 + h) * 64 + r) * 256 + 8 * hh;
    const float* rpb = a.in[I_RPB] + h * 15 * 31;
    const int rs = LAT ? min(max(gr - 4, 0), 8) : 0, cs = LAT ? min(max(cq - 8, 0), 48) : 0;
    const bf16* Pkl = P + (size_t)(LAT ? M_CTX + b * 1024 : b * 256) * LDA_ + C_K + h * 64 + 8 * hh;
    auto tile = [&](int t) -> AttnTile {
        AttnTile d;
        if (LAT && t < 8) { d.k = CK + (size_t)(t * 32 + r) * 64; d.v0 = CVT + 32 * t; d.v1 = d.v0 + 32 * 256; }
        else if (LAT) { const int tl = t - 8, tk = (rs + (tl >> 1)) * 64 + (tl & 1) * 32; d.k = Pkl + (size_t)(tk + r) * LDA_; d.v0 = VTb + tk; d.v1 = d.v0 + 32 * 1024; }
        else { d.k = Pkl + (size_t)(t * 32 + r) * LDA_; d.v0 = VTb + 32 * t; d.v1 = d.v0 + 32 * 256; }
        return d;
    };
    bf16x8 qf[4];
    { const bf16* Pq = P + (size_t)rowq * LDA_ + C_Q + h * 64 + 8 * hh;
#pragma unroll
      for (int s = 0; s < 4; ++s) qf[s] = *(const bf16x8*)(Pq + 16 * s); }
    float m = -3.0e38f, l = 0.f; f32x16 o0 = {}, o1 = {};
    const float sc = 0.125f * LOG2E;
    bf16x8 kA[4], vA[4], kB[4], vB[4];
#define AT_LOAD(K_, V_, t_) do { const AttnTile d_ = tile(t_); _Pragma("unroll") for (int s_ = 0; s_ < 4; ++s_) K_[s_] = *(const bf16x8*)(d_.k + 16 * s_); \
        V_[0] = *(const bf16x8*)(d_.v0); V_[1] = *(const bf16x8*)(d_.v0 + 16); V_[2] = *(const bf16x8*)(d_.v1); V_[3] = *(const bf16x8*)(d_.v1 + 16); } while (0)
#define AT_COMP(K_, V_, t_) do { f32x16 S = {}; _Pragma("unroll") for (int s_ = 0; s_ < 4; ++s_) S = MFMA32(K_[s_], qf[s_], S); \
        if (LAT && (t_) >= 8) { const int tl_ = (t_) - 8, kr_ = rs + (tl_ >> 1), ct_ = tl_ & 1; const float* rp_ = rpb + (kr_ - gr + 7) * 31 + 15 - cq; \
            _Pragma("unroll") for (int i = 0; i < 16; ++i) { const int kc = ct_ * 32 + crow(i, hh); const bool ok = (kc >= cs) && (kc < cs + 16); \
                const float bias = ok ? rp_[kc] : 0.f; S[i] = ok ? (S[i] * 0.125f + bias) * LOG2E : -1.0e30f; } } \
        else { _Pragma("unroll") for (int i = 0; i < 16; ++i) S[i] *= sc; } \
        float tm = S[0]; _Pragma("unroll") for (int i = 1; i < 16; ++i) tm = fmaxf(tm, S[i]); \
        tm = fmaxf(tm, __shfl_xor(tm, 32)); const float mn = fmaxf(m, tm); const float al = exp2f(m - mn); m = mn; \
        float ps = 0.f; _Pragma("unroll") for (int i = 0; i < 16; ++i) { S[i] = exp2f(S[i] - mn); ps += S[i]; } \
        l = l * al + ps; o0 = o0 * al; o1 = o1 * al; \
        const bf16x8 p0_ = pack_regs(S, 0), p1_ = pack_regs(S, 1); \
        o0 = MFMA32(V_[0], p0_, o0); o0 = MFMA32(V_[1], p1_, o0); o1 = MFMA32(V_[2], p0_, o1); o1 = MFMA32(V_[3], p1_, o1); } while (0)
    AT_LOAD(kA, vA, 0);
    for (int t = 0; t < NT; t += 2) {
        AT_LOAD(kB, vB, t + 1);
        AT_COMP(kA, vA, t);
        if (t + 2 < NT) AT_LOAD(kA, vA, t + 2);
        AT_COMP(kB, vB, t + 1);
    }
#undef AT_LOAD
#undef AT_COMP
    l += __shfl_xor(l, 32);
    store_o(ONA + (size_t)rowq * 512 + h * 64, o0, o1, 1.0f / l, hh);
}

__device__ __forceinline__ void conv_task(const Args& a, int task, int lane) {
    const int hd = task & 7, part = (task >> 3) % 3, chunk = task / 24, r0 = chunk * 64;
    const bf16* P = (const bf16*)(a.ws + WS_PA);
    int seq0, T_, sb_;
    if (r0 < M_CTX) { seq0 = r0 & ~255; T_ = 256; sb_ = (r0 >> 8) * 8 + hd; } else { seq0 = M_CTX + ((r0 - M_CTX) & ~1023); T_ = 1024; sb_ = ((r0 - M_CTX) >> 10) * 8 + hd; }
    const int seq1 = seq0 + T_, kc = (r0 - seq0) >> 6, NC = T_ >> 6;
    const int ch = part * 512 + hd * 64 + lane;
    float w[5];
#pragma unroll
    for (int t = 0; t < 5; ++t) w[t] = a.in[I_CONVW][t * 1536 + ch];
    const bf16* src = P + C_DN + ch;
    float x[68];
#pragma unroll
    for (int i = 0; i < 68; ++i) { const int row = r0 - 2 + i; x[i] = (row >= seq0 && row < seq1) ? bflo((unsigned)src[(size_t)row * LDA_]) : 0.f; }
    float o[64];
#pragma unroll
    for (int rr = 0; rr < 64; ++rr) { const float v = w[0] * x[rr] + w[1] * x[rr + 1] + w[2] * x[rr + 2] + w[3] * x[rr + 3] + w[4] * x[rr + 4]; o[rr] = silu_(v); }
    if (part < 2) {
#pragma unroll
        for (int rr = 0; rr < 64; ++rr) { const float ss = wave_sum(o[rr] * o[rr]); o[rr] *= rsqrtf(ss + 1e-6f); }
        bf16* dst = (bf16*)a.out + (size_t)part * MT * 512 + (size_t)r0 * 512 + hd * 64 + swap23(lane);
#pragma unroll
        for (int rr = 0; rr < 64; ++rr) dst[(size_t)rr * 512] = (bf16)f2bf(o[rr]);
    }
    if (part == 1) {
        bf16* ktf = (bf16*)(a.ws + WS_XN) + (r0 < M_CTX ? (size_t)sb_ * 64 * 256 : (size_t)M_CTX * 512 + (size_t)sb_ * 64 * 1024) + (size_t)lane * T_;
        bf16* ktb = ktf + (size_t)MT * 512 + 64 * (NC - 1 - kc); ktf += 64 * kc;
#pragma unroll
        for (int q = 0; q < 8; ++q) { v4u wf, wb;
            wf.x = pk2(o[swap23(8 * q + 0)], o[swap23(8 * q + 1)]); wf.y = pk2(o[swap23(8 * q + 2)], o[swap23(8 * q + 3)]); wf.z = pk2(o[swap23(8 * q + 4)], o[swap23(8 * q + 5)]); wf.w = pk2(o[swap23(8 * q + 6)], o[swap23(8 * q + 7)]);
            wb.x = pk2(o[63 - swap23(8 * q + 0)], o[63 - swap23(8 * q + 1)]); wb.y = pk2(o[63 - swap23(8 * q + 2)], o[63 - swap23(8 * q + 3)]); wb.z = pk2(o[63 - swap23(8 * q + 4)], o[63 - swap23(8 * q + 5)]); wb.w = pk2(o[63 - swap23(8 * q + 6)], o[63 - swap23(8 * q + 7)]);
            *(v4u*)(ktf + 8 * q) = wf; *(v4u*)(ktb + 8 * q) = wb; }
    }
    if (part == 2) {
        const int jw = lane >> 5, r = lane & 31;
        const int td0 = (r0 < M_CTX ? 512 + sb_ * 4 : sb_ * 16);
#pragma unroll
        for (int dd = 0; dd < 2; ++dd) {
            const int taskd = td0 + (dd ? NC - 1 - kc : kc);
            bf16* base = (dd ? (bf16*)(a.ws + WS_ODN) : (bf16*)a.out + (size_t)2 * MT * 512) + ((size_t)(taskd * 2 + jw) * 2 * 64 + r) * 16;
#pragma unroll
            for (int cb = 0; cb < 2; ++cb)
#pragma unroll
                for (int hh = 0; hh < 2; ++hh) { v4u w0, w1;
#define CV(g_) o[dd ? 63 - (32 * cb + crow((g_), hh)) : (32 * cb + crow((g_), hh))]
                    w0.x = pk2(CV(0), CV(1)); w0.y = pk2(CV(2), CV(3)); w0.z = pk2(CV(4), CV(5)); w0.w = pk2(CV(6), CV(7));
                    w1.x = pk2(CV(8), CV(9)); w1.y = pk2(CV(10), CV(11)); w1.z = pk2(CV(12), CV(13)); w1.w = pk2(CV(14), CV(15));
#undef CV
                    bf16* dp = base + (size_t)(cb * 64 + hh * 32) * 16; *(v4u*)dp = w0; *(v4u*)(dp + 8) = w1; }
        }
    }
}

__device__ __forceinline__ void phase_mix_a(const Args& a, int vcu, int G) {
    const int tid = threadIdx.x, wave = __builtin_amdgcn_readfirstlane(tid >> 6);
    const int gw = wave * G + vcu;
#define MIX_LANE() int lane = tid & 63; asm volatile("" : "+v"(lane))
    if (G * NWAVES == 2048) {
        if (gw < 1024) { { MIX_LANE(); attn_task<true>(a, gw, lane); } { MIX_LANE(); conv_task(a, gw, lane); } }
        else { const int w = gw - 1024;
            { MIX_LANE(); attn_task<false>(a, w, lane); } { MIX_LANE(); attn_task<false>(a, w + 1024, lane); }
            for (int c = 1024 + w; c < 4608; c += 1024) { MIX_LANE(); conv_task(a, c, lane); } }
    } else {
        for (int t = gw; t < 1024 + 2048 + 4608; t += G * NWAVES) { MIX_LANE();
            if (t < 1024) attn_task<true>(a, t, lane); else if (t < 3072) attn_task<false>(a, t - 1024, lane); else conv_task(a, t - 3072, lane); }
    }
#undef MIX_LANE
}

struct DnChain { int b, h, dir, T, rowbase, task0; bool lat; };
__device__ __forceinline__ DnChain dn_decode(int chain) {
    DnChain d; d.lat = chain < 64;
    if (d.lat) { d.b = chain >> 4; d.h = (chain >> 1) & 7; d.dir = chain & 1; d.T = 1024; d.rowbase = M_CTX + d.b * 1024; d.task0 = chain * 16; }
    else { const int c = chain - 64; d.b = c >> 4; d.h = (c >> 1) & 7; d.dir = c & 1; d.T = 256; d.rowbase = d.b * 256; d.task0 = 1024 + c * 4; }
    return d;
}

__device__ __forceinline__ void dn_pre_task(const Args& a, int task, LAS float* LT, LAS float* tab, int lane) {
    int chain, n;
    if (task < 1024) { chain = task >> 4; n = task & 15; } else { const int t2 = task - 1024; chain = 64 + (t2 >> 2); n = t2 & 3; }
    const DnChain d = dn_decode(chain);
    const int h = d.h, dir = d.dir;
    const bf16* DQ = (const bf16*)a.out; const bf16* DK = DQ + (size_t)MT * 512;
    const float* BA = (const float*)(a.ws + WS_BA);
    bf16* rec = (bf16*)(a.ws + WS_PA) + (size_t)task * 8192; bf16* Tm = rec; bf16* QKm = rec + 4096;
    float* SC = (float*)(a.ws + WS_SC) + (size_t)task * 320;
    const int R0 = d.rowbase + (dir ? d.T - 1 - 64 * n : 64 * n), RS = dir ? -1 : 1;
    const int r = lane & 31, hh = lane >> 5;
    {
        const float* ba = BA + (size_t)(R0 + lane * RS) * 32;
        const float beta = sigm_(ba[dir * 8 + h]);
        const float xx = ba[16 + dir * 8 + h] + a.in[I_DTB][dir * 8 + h];
        const float sp = xx > 20.f ? xx : log1pf(__expf(xx));
        float gc = -__expf(a.in[I_ALOG][dir * 8 + h]) * sp;
#pragma unroll
        for (int o = 1; o < 64; o <<= 1) { const float t = __shfl_up(gc, o); if (lane >= o) gc += t; }
        const float gl = __shfl(gc, 63);
        const float eg = __expf(gc);
        SC[lane] = beta; SC[64 + lane] = beta * eg; SC[128 + lane] = 0.125f * eg; SC[192 + lane] = __expf(gl - gc); SC[256 + lane] = __expf(gl);
        LDS_WAIT();
        tab[lane] = gc; tab[64 + lane] = beta;
        LDS_WAIT();
    }
    bf16x8 kf[2][4], qf[2][4];
#pragma unroll
    for (int cb = 0; cb < 2; ++cb) { const size_t ro = (size_t)(R0 + (32 * cb + r) * RS) * 512 + h * 64 + 8 * hh;
#pragma unroll
        for (int s = 0; s < 4; ++s) { kf[cb][s] = *(const bf16x8*)(DK + ro + 16 * s); qf[cb][s] = *(const bf16x8*)(DQ + ro + 16 * s); } }
    const float gcol0 = tab[r], gcol1 = tab[32 + r];
#pragma unroll
    for (int tile = 0; tile < 3; ++tile) {
        const int cb = tile == 0 ? 0 : 1, cbp = tile == 2 ? 1 : 0;
        f32x16 acc = {};
#pragma unroll
        for (int s = 0; s < 4; ++s) acc = MFMA32(kf[cb][s], kf[cbp][s], acc);
        const float gcol = cbp ? gcol1 : gcol0; const int cp = 32 * cbp + r;
#pragma unroll
        for (int g = 0; g < 4; ++g) {
            const f32x4 gr = *(const LAS f32x4*)(tab + 32 * cb + 8 * g + 4 * hh), br = *(const LAS f32x4*)(tab + 64 + 32 * cb + 8 * g + 4 * hh);
            f32x4 v;
#pragma unroll
            for (int j = 0; j < 4; ++j) { const int c = 32 * cb + 8 * g + 4 * hh + j; v[j] = (cp < c) ? br[j] * acc[4 * g + j] * __expf(gr[j] - gcol) : 0.f; }
            *(LAS f32x4*)(LT + cp * 68 + 32 * cb + 8 * g + 4 * hh) = v;
        }
    }
#ifndef DN_NO_QK
#pragma unroll
    for (int tile = 0; tile < 3; ++tile) {
        const int cb = tile == 0 ? 0 : 1, cbp = tile == 2 ? 1 : 0;
        f32x16 acc = {};
#pragma unroll
        for (int s = 0; s < 4; ++s) acc = MFMA32(kf[cbp][s], qf[cb][s], acc);
        const float gcc = cb ? gcol1 : gcol0; const int c = 32 * cb + r;
#pragma unroll
        for (int g = 0; g < 4; ++g) {
            const f32x4 gr = *(const LAS f32x4*)(tab + 32 * cbp + 8 * g + 4 * hh);
#pragma unroll
            for (int j = 0; j < 4; ++j) { const int cp = 32 * cbp + 8 * g + 4 * hh + j; acc[4 * g + j] = (cp <= c) ? 0.125f * acc[4 * g + j] * __expf(gcc - gr[j]) : 0.f; }
        }
#pragma unroll
        for (int s = 0; s < 2; ++s) *(bf16x8*)(QKm + c * 64 + 32 * cbp + 16 * s + 8 * hh) = pack_regs(acc, s);
    }
    if (hh == 0) { *(v4u*)(QKm + r * 64 + 32) = (v4u){0u, 0u, 0u, 0u}; *(v4u*)(QKm + r * 64 + 40) = (v4u){0u, 0u, 0u, 0u}; *(v4u*)(QKm + r * 64 + 48) = (v4u){0u, 0u, 0u, 0u}; *(v4u*)(QKm + r * 64 + 56) = (v4u){0u, 0u, 0u, 0u}; }
#endif
    LDS_WAIT();
#ifndef DN_NO_T
    {
        float t[64]; float zero_ = 0.f; asm volatile("" : "+v"(zero_));
#pragma unroll
        for (int i = 0; i < 64; ++i) t[i] = zero_;
#pragma unroll
        for (int nn = 63; nn >= 0; --nn) {
            float a0 = (lane == nn) ? 1.f : 0.f, a1 = 0.f;
            const LAS float* lrow = LT + nn * 68;
            if (nn < 63) asm volatile("" : "+v"(lrow) : "v"(t[nn < 63 ? nn + 1 : 63]));
#pragma unroll
            for (int m4 = (nn + 1) / 4; m4 < 16; ++m4) { const f32x4 lr = *(const LAS f32x4*)(lrow + 4 * m4);
                a0 -= lr[0] * t[4 * m4]; a1 -= lr[1] * t[4 * m4 + 1]; a0 -= lr[2] * t[4 * m4 + 2]; a1 -= lr[3] * t[4 * m4 + 3]; }
            t[nn] = a0 + a1;
        }
        bf16* dst = Tm + lane * 64;
#pragma unroll
        for (int q = 0; q < 8; ++q) { v4u w;
            w.x = pk2(t[swap23(8 * q + 0)], t[swap23(8 * q + 1)]); w.y = pk2(t[swap23(8 * q + 2)], t[swap23(8 * q + 3)]);
            w.z = pk2(t[swap23(8 * q + 4)], t[swap23(8 * q + 5)]); w.w = pk2(t[swap23(8 * q + 6)], t[swap23(8 * q + 7)]);
            *(v4u*)(dst + 8 * q) = w; }
    }
#endif
    LDS_WAIT();
}
__device__ __forceinline__ void phase_dn_pre(const Args& a, LAS unsigned char* lds, int vcu, int G) {
    const int tid = threadIdx.x, lane = tid & 63, wave = __builtin_amdgcn_readfirstlane(tid >> 6);
    LAS float* LT = (LAS float*)(lds + wave * 17408); LAS float* tab = (LAS float*)(lds + 139264 + wave * 512);
    for (int t = wave * G + vcu; t < 3072; t += G * NWAVES) { int l2 = lane; asm volatile("" : "+v"(l2)); dn_pre_task(a, t, LT, tab, l2); }
}

__device__ __forceinline__ void dn_scan_task(const Args& a, int wt, int lane) {
    const int chain = wt >> 1, jw = wt & 1;
    const DnChain d = dn_decode(chain);
    const int h = d.h, dir = d.dir, NC = d.T >> 6, T = d.T;
    const int r = lane & 31, hh = lane >> 5, jcol = 32 * jw + r;
    const bf16* DQ = (const bf16*)a.out; const bf16* DK = DQ + (size_t)MT * 512;
    const bf16* VC = dir ? (const bf16*)(a.ws + WS_ODN) : DQ + (size_t)2 * MT * 512;
    const bf16* KTs = (const bf16*)(a.ws + WS_XN) + (dir ? (size_t)MT * 512 : 0) + (d.lat ? (size_t)M_CTX * 512 + (size_t)(d.b * 8 + h) * 64 * 1024 : (size_t)(d.b * 8 + h) * 64 * 256);
    bf16* OUTO = (bf16*)(a.ws + WS_M1) + (dir ? (size_t)MT * 512 : 0);
    const int RS = dir ? -1 : 1;
    f32x16 S[2];
    if (d.lat) { const float* s0 = a.in[I_ST] + ((size_t)((d.b * 2 + dir) * 8 + h) * 64) * 64 + jcol;
#pragma unroll
        for (int ib = 0; ib < 2; ++ib)
#pragma unroll
            for (int g = 0; g < 16; ++g) S[ib][g] = s0[(32 * ib + crow(g, hh)) * 64]; }
    else { S[0] = (f32x16){}; S[1] = (f32x16){}; }
    for (int n = 0; n < NC; ++n) {
        const int task = d.task0 + n;
        const int R0 = d.rowbase + (dir ? T - 1 - 64 * n : 64 * n);
        const bf16* rec = (const bf16*)(a.ws + WS_PA) + (size_t)task * 8192; const bf16* Tm = rec + r * 64 + 8 * hh; const bf16* QKm = Tm + 4096;
        const float* SC = (const float*)(a.ws + WS_SC) + (size_t)task * 320 + 4 * hh;
        const int taskd = (d.lat ? (d.b * 8 + h) * 16 : 512 + (d.b * 8 + h) * 4) + n;
        const bf16* vc = VC + ((size_t)(taskd * 2 + jw) * 2 * 64 + lane) * 16;
        const bf16* kt = KTs + (size_t)r * T + 64 * n + 8 * hh;
        bf16* oo = OUTO + (size_t)(taskd * 2 + jw) * 2 * 16 * 64 + lane;
        bf16x8 sb[2][2];
#pragma unroll
        for (int ib = 0; ib < 2; ++ib)
#pragma unroll
            for (int s = 0; s < 2; ++s) sb[ib][s] = pack_regs(S[ib], s);
        f32x16 X[2], o[2];
#pragma unroll
        for (int cb = 0; cb < 2; ++cb) {
            const size_t ro = (size_t)(R0 + (32 * cb + r) * RS) * 512 + h * 64 + 8 * hh;
            f32x16 ax = {}, ao = {};
#pragma unroll
            for (int ib = 0; ib < 2; ++ib)
#pragma unroll
                for (int s = 0; s < 2; ++s) { ax = MFMA32(*(const bf16x8*)(DK + ro + 32 * ib + 16 * s), sb[ib][s], ax); ao = MFMA32(*(const bf16x8*)(DQ + ro + 32 * ib + 16 * s), sb[ib][s], ao); }
            X[cb] = ax; o[cb] = ao;
        }
#pragma unroll
        for (int cb = 0; cb < 2; ++cb) {
            const v4u va = *(const v4u*)(vc + cb * 1024), vb_ = *(const v4u*)(vc + cb * 1024 + 8);
            const float vv[16] = {bflo(va.x), bfhi(va.x), bflo(va.y), bfhi(va.y), bflo(va.z), bfhi(va.z), bflo(va.w), bfhi(va.w),
                                  bflo(vb_.x), bfhi(vb_.x), bflo(vb_.y), bfhi(vb_.y), bflo(vb_.z), bfhi(vb_.z), bflo(vb_.w), bfhi(vb_.w)};
#pragma unroll
            for (int g = 0; g < 4; ++g) {
                const f32x4 s0 = *(const f32x4*)(SC + 32 * cb + 8 * g), s1 = *(const f32x4*)(SC + 64 + 32 * cb + 8 * g), s2 = *(const f32x4*)(SC + 128 + 32 * cb + 8 * g);
#pragma unroll
                for (int j = 0; j < 4; ++j) { X[cb][4 * g + j] = s0[j] * vv[4 * g + j] - s1[j] * X[cb][4 * g + j]; o[cb][4 * g + j] *= s2[j]; }
            }
        }
        f32x16 vn[2];
        {
            bf16x8 xb[2][2];
#pragma unroll
            for (int cb = 0; cb < 2; ++cb)
#pragma unroll
                for (int s = 0; s < 2; ++s) xb[cb][s] = pack_regs(X[cb], s);
#pragma unroll
            for (int cb = 0; cb < 2; ++cb) { f32x16 acc = {};
#pragma unroll
                for (int cbp = 0; cbp <= cb; ++cbp)
#pragma unroll
                    for (int s = 0; s < 2; ++s) acc = MFMA32(*(const bf16x8*)(Tm + cb * 2048 + 32 * cbp + 16 * s), xb[cbp][s], acc);
                vn[cb] = acc; }
        }
        {
            bf16x8 vb[2][2];
#pragma unroll
            for (int cb = 0; cb < 2; ++cb)
#pragma unroll
                for (int s = 0; s < 2; ++s) vb[cb][s] = pack_regs(vn[cb], s);
#pragma unroll
            for (int cb = 0; cb < 2; ++cb) { f32x16 acc = o[cb];
#pragma unroll
                for (int cbp = 0; cbp <= cb; ++cbp)
#pragma unroll
                    for (int s = 0; s < 2; ++s) acc = MFMA32(*(const bf16x8*)(QKm + cb * 2048 + 32 * cbp + 16 * s), vb[cbp][s], acc);
#pragma unroll
                for (int g = 0; g < 16; ++g) oo[(cb * 16 + g) * 64] = (bf16)f2bf(acc[g]); }
        }
        {
            const float egl = SC[256];
#pragma unroll
            for (int cb = 0; cb < 2; ++cb)
#pragma unroll
                for (int g = 0; g < 4; ++g) { const f32x4 s3 = *(const f32x4*)(SC + 192 + 32 * cb + 8 * g);
#pragma unroll
                    for (int j = 0; j < 4; ++j) vn[cb][4 * g + j] *= s3[j]; }
            bf16x8 vb[2][2];
#pragma unroll
            for (int cb = 0; cb < 2; ++cb)
#pragma unroll
                for (int s = 0; s < 2; ++s) vb[cb][s] = pack_regs(vn[cb], s);
#pragma unroll
            for (int ib = 0; ib < 2; ++ib) { f32x16 acc = S[ib] * egl;
#pragma unroll
                for (int cb = 0; cb < 2; ++cb)
#pragma unroll
                    for (int s = 0; s < 2; ++s) acc = MFMA32(*(const bf16x8*)(kt + (size_t)(32 * ib) * T + 32 * cb + 16 * s), vb[cb][s], acc);
                S[ib] = acc; }
        }
    }
    if (!d.lat) { float* so = a.out + OUT_S + ((size_t)((d.b * 2 + dir) * 8 + h) * 64) * 64 + jcol;
#pragma unroll
        for (int ib = 0; ib < 2; ++ib)
#pragma unroll
            for (int g = 0; g < 16; ++g) so[(32 * ib + crow(g, hh)) * 64] = S[ib][g]; }
}
__device__ __forceinline__ void phase_dn_scan(const Args& a, int vcu, int G) {
    const int tid = threadIdx.x, lane = tid & 63, wave = __builtin_amdgcn_readfirstlane(tid >> 6);
    for (int t = wave * G + vcu; t < 1152; t += G * NWAVES) dn_scan_task(a, t, lane);
}

__device__ __forceinline__ void phase_combine(const Args& a, int vcu, int G) {
    const int tid = threadIdx.x, lane = tid & 63, wave = tid >> 6;
    const int gw = vcu * NWAVES + wave, NGW = G * NWAVES;
    const bf16* OF = (const bf16*)(a.ws + WS_M1); const bf16* OB = OF + (size_t)MT * 512;
    const bf16* P = (const bf16*)(a.ws + WS_PB); bf16* ODN = (bf16*)(a.ws + WS_ODN);
    const f32x4 n0 = *(const f32x4*)(a.in[I_DNN] + ((8 * lane) & 63)), n1 = *(const f32x4*)(a.in[I_DNN] + ((8 * lane) & 63) + 4);
    const int hd = lane >> 3, j0 = (8 * lane) & 63, jw = j0 >> 5, r0 = j0 & 31;
    for (int m = gw; m < MT; m += NGW) {
        int tt, T_, ch0;
        if (m < M_CTX) { const int b_ = m >> 8; tt = m & 255; T_ = 256; ch0 = 64 + ((b_ * 8 + hd) << 1); }
        else { const int rl = m - M_CTX; const int b_ = rl >> 10; tt = rl & 1023; T_ = 1024; ch0 = (b_ * 8 + hd) << 1; }
        v4u w[2];
#pragma unroll
        for (int dd = 0; dd < 2; ++dd) {
            const int u = dd ? T_ - 1 - tt : tt, c = u & 63;
            const int task = (m < M_CTX ? 512 + (ch0 >> 1) * 4 - 128 : (ch0 >> 1) * 16) + (u >> 6);
            const int cb = c >> 5, hh = (c >> 2) & 1, g = ((c >> 3) & 3) * 4 + (c & 3);
            w[dd] = *(const v4u*)((dd ? OB : OF) + ((size_t)((task * 2 + jw) * 2 + cb) * 16 + g) * 64 + hh * 32 + r0);
        }
        f32x4 o0 = {bflo(w[0].x) + bflo(w[1].x), bfhi(w[0].x) + bfhi(w[1].x), bflo(w[0].y) + bflo(w[1].y), bfhi(w[0].y) + bfhi(w[1].y)};
        f32x4 o1 = {bflo(w[0].z) + bflo(w[1].z), bfhi(w[0].z) + bfhi(w[1].z), bflo(w[0].w) + bflo(w[1].w), bfhi(w[0].w) + bfhi(w[1].w)};
        float ss = (o0.x * o0.x + o0.y * o0.y) + (o0.z * o0.z + o0.w * o0.w) + (o1.x * o1.x + o1.y * o1.y) + (o1.z * o1.z + o1.w * o1.w);
        ss += __shfl_xor(ss, 1); ss += __shfl_xor(ss, 2); ss += __shfl_xor(ss, 4);
        const float rstd = rsqrtf(ss * (1.f / 64.f) + 1e-6f);
        const v4u z = *(const v4u*)(P + (size_t)m * LDB_ + CB_Z + 8 * lane);
        o0 = o0 * rstd * n0; o1 = o1 * rstd * n1;
        v4u q; q.x = pk2(o0.x * silu_(bflo(z.x)), o0.y * silu_(bfhi(z.x))); q.y = pk2(o0.z * silu_(bflo(z.y)), o0.w * silu_(bfhi(z.y)));
        q.z = pk2(o1.x * silu_(bflo(z.z)), o1.y * silu_(bfhi(z.z))); q.w = pk2(o1.z * silu_(bflo(z.w)), o1.w * silu_(bfhi(z.w)));
        *(v4u*)(ODN + (size_t)m * 512 + 8 * lane) = q;
    }
}

__device__ __forceinline__ void phase_row1(const Args& a, int vcu, int G) {
    const int tid = threadIdx.x, lane = tid & 63, wave = tid >> 6;
    const int gw = vcu * NWAVES + wave, NGW = G * NWAVES;
    const float* MOD = (const float*)(a.ws + WS_MOD); const bf16* Y = (const bf16*)(a.ws + WS_ONA); const float* RSS = (const float*)(a.ws + WS_RSS1);
    bf16* XN = (bf16*)(a.ws + WS_XN);
    for (int m = gw; m < MT; m += NGW) {
        const f32x4* xr = (const f32x4*)x_row(a, m) + lane; const float* md = MOD + mod_idx(m) * 6144;
        float rs = 0.f;
        { const float rv = lane < 16 ? RSS[((size_t)(lane >> 2) * MT + m) * 4 + (lane & 3)] : 0.f;
          rs = rv; rs += __shfl_xor(rs, 1); rs += __shfl_xor(rs, 2); rs += __shfl_xor(rs, 4); rs += __shfl_xor(rs, 8); rs = __shfl(rs, 0); }
        const float rstd1 = rsqrtf(rs * (1.f / DM) + 1e-6f);
        f32x4 x1[4]; float s = 0.f;
        const v2u* yr = (const v2u*)(Y + (size_t)m * DM) + lane;
        f32x4* orow = (f32x4*)(a.out + (size_t)m * DM) + lane;
#pragma unroll
        for (int j = 0; j < 4; ++j) { const int c = (lane + 64 * j) * 4; const v2u yy = yr[64 * j];
            const f32x4 yv = {bflo(yy.x), bfhi(yy.x), bflo(yy.y), bfhi(yy.y)};
            const f32x4 g1 = *(const f32x4*)(md + 2048 + c), pw = *(const f32x4*)(a.in[I_POST1] + c);
            x1[j] = xr[64 * j] + g1 * (yv * rstd1 * pw); orow[64 * j] = x1[j];
            s += (x1[j].x * x1[j].x + x1[j].y * x1[j].y) + (x1[j].z * x1[j].z + x1[j].w * x1[j].w); }
        const float rstd2 = rsqrtf(wave_sum(s) * (1.f / DM) + 1e-6f);
        v2u* o8 = (v2u*)(XN + (size_t)m * DM) + lane;
#pragma unroll
        for (int j = 0; j < 4; ++j) { const int c = (lane + 64 * j) * 4;
            const f32x4 w = *(const f32x4*)(a.in[I_PRE2] + c), sh = *(const f32x4*)(md + 3072 + c), sc = *(const f32x4*)(md + 4096 + c);
            const f32x4 h = x1[j] * rstd2 * w * (sc + 1.0f) + sh;
            v2u o; o.x = pk2(h.x, h.y); o.y = pk2(h.z, h.w); o8[64 * j] = o; }
    }
}
__device__ __forceinline__ void phase_row2(const Args& a, int vcu, int G) {
    const int tid = threadIdx.x, lane = tid & 63, wave = tid >> 6;
    const int gw = vcu * NWAVES + wave, NGW = G * NWAVES;
    const float* MOD = (const float*)(a.ws + WS_MOD); const bf16* Fm = (const bf16*)(a.ws + WS_ONA); const float* RSS = (const float*)(a.ws + WS_RSS2);
    for (int m = gw; m < MT; m += NGW) {
        const float* md = MOD + mod_idx(m) * 6144;
        float rs = 0.f;
        { const float rv = lane < 16 ? RSS[((size_t)(lane >> 2) * MT + m) * 4 + (lane & 3)] : 0.f;
          rs = rv; rs += __shfl_xor(rs, 1); rs += __shfl_xor(rs, 2); rs += __shfl_xor(rs, 4); rs += __shfl_xor(rs, 8); rs = __shfl(rs, 0); }
        const float rstd = rsqrtf(rs * (1.f / DM) + 1e-6f);
        const v2u* fr = (const v2u*)(Fm + (size_t)m * DM) + lane;
        f32x4* orow = (f32x4*)(a.out + (size_t)m * DM) + lane;
#pragma unroll
        for (int j = 0; j < 4; ++j) { const int c = (lane + 64 * j) * 4; const v2u ff = fr[64 * j];
            const f32x4 fv = {bflo(ff.x), bfhi(ff.x), bflo(ff.y), bfhi(ff.y)};
            const f32x4 g2 = *(const f32x4*)(md + 5120 + c), pw = *(const f32x4*)(a.in[I_POST2] + c);
            orow[64 * j] = orow[64 * j] + g2 * (fv * rstd * pw); }
    }
}

constexpr int N_PHASES = 13;
__global__ void __launch_bounds__(NWAVES * 64, 2) fwd_kernel(Args args) {
    extern __shared__ __attribute__((aligned(16))) unsigned char lds_raw[];
    LAS unsigned char* lds = (LAS unsigned char*)lds_raw;
    const int tid = threadIdx.x;
    const int G = gridDim.x; const int bx = blockIdx.x; const int vcu = (G % 8 == 0) ? (bx % 8) * (G / 8) + bx / 8 : bx;
    volatile LAS unsigned* MISC = (volatile LAS unsigned*)(lds + MISC_OFF);
    for (int u = tid; u < (LDS_BYTES - LDSCTL_OFF) / 4; u += NWAVES * 64) ((LAS unsigned*)(lds + LDSCTL_OFF))[u] = 0u;
    __syncthreads();
    const int lo = args.ph_lo, hi = args.ph_hi;
    const bool one = (hi - lo) > 1;
    unsigned* ctl = (unsigned*)(args.ws + WS_CTL);
    XcdBarrier bar; bar.bar = ctl + CW_BAR; bar.x = 0; bar.st = nullptr;
    if (one) bar = xcd_barrier_post(ctl + CW_BAR, MISC + 8);
#ifndef ONLY_PHASE
#define ONLY_PHASE -1
#endif
#ifndef SKIP_MASK
#define SKIP_MASK 0
#endif
#define IN(k) ((ONLY_PHASE < 0 || ONLY_PHASE == (k)) && !((SKIP_MASK >> (k)) & 1) && lo <= (k) && (k) < hi)
#define SEAM(k) do { if (one) xcd_barrier(bar); } while (0)
    unsigned char* ws = args.ws;
    typedef pg8::bf16_t pb;

#ifndef REPEAT_MASK
#define REPEAT_MASK 0
#endif
#define REP(k) ((REPEAT_MASK >> (k)) & 1)
#define PH_INPROJ do { pg8::Gemm g{(const pb*)(ws + WS_XN), (const pb*)(ws + WS_WIN), MT, NINP, 1024}; pg8::StaticOrder S; S.init(MT, NINP, G, bx); \
        pg8::EpiInProj E{(pb*)(ws + WS_PA), (pb*)(ws + WS_PB), args.out + OUT_K, args.out + OUT_V, (float*)(ws + WS_BA), (pb*)args.out + (size_t)3 * MT * 512, (const float*)(ws + WS_ROPE)}; \
        pg8::gemm_phase<pg8::EpiInProj, pg8::StaticOrder, true, true>(lds, g, S, E); } while (0)
#define PH_MERGE do { pg8::StaticOrder S; S.init(MT, 1024, G, bx); \
        { pg8::Gemm g{(const pb*)(ws + WS_ONA), (const pb*)(ws + WS_WAO), MT, 1024, 512}; pg8::EpiGate1 E{(const pb*)(ws + WS_PB), (pb*)(ws + WS_M1)}; \
          pg8::gemm_phase<pg8::EpiGate1, pg8::StaticOrder, true, true>(lds, g, S, E); } \
        { pg8::Gemm g{(const pb*)(ws + WS_ODN), (const pb*)(ws + WS_WDO), MT, 1024, 512}; pg8::EpiGate2 E{(const pb*)(ws + WS_PB), (const pb*)(ws + WS_M1), (pb*)(ws + WS_XN)}; \
          pg8::gemm_phase<pg8::EpiGate2, pg8::StaticOrder, true, true>(lds, g, S, E); } } while (0)
#define PH_WOUT do { pg8::Gemm g{(const pb*)(ws + WS_XN), (const pb*)(ws + WS_WOUT), MT, 1024, 1024}; pg8::StaticOrder S; S.init(MT, 1024, G, bx); \
        pg8::EpiRss E{(pb*)(ws + WS_ONA), (float*)(ws + WS_RSS1)}; pg8::gemm_phase<pg8::EpiRss, pg8::StaticOrder, true, true>(lds, g, S, E); } while (0)
#define PH_FF1 do { pg8::Gemm g{(const pb*)(ws + WS_XN), (const pb*)(ws + WS_W1), MT, FF, 1024}; pg8::StaticOrder S; S.init(MT, FF, G, bx); \
        pg8::EpiRelu2 E{(pb*)(ws + WS_PA)}; pg8::gemm_phase<pg8::EpiRelu2, pg8::StaticOrder, true, true>(lds, g, S, E); } while (0)
#define PH_FF2 do { pg8::Gemm g{(const pb*)(ws + WS_PA), (const pb*)(ws + WS_W2), MT, 1024, FF}; pg8::StaticOrder S; S.init(MT, 1024, G, bx); \
        pg8::EpiRss E{(pb*)(ws + WS_ONA), (float*)(ws + WS_RSS2)}; pg8::gemm_phase<pg8::EpiRss, pg8::StaticOrder, true, true>(lds, g, S, E); } while (0)
#define RUN(k, body) do { if (IN(k)) { body; SEAM(k); if (REP(k)) { body; SEAM(k); } } } while (0)
    RUN(0, phase_prologue(args, lds, vcu, G));
    RUN(1, phase_xn(args, vcu, G));
    RUN(2, PH_INPROJ);
    RUN(3, phase_mix_a(args, vcu, G));
    RUN(4, phase_dn_pre(args, lds, vcu, G));
    RUN(5, phase_dn_scan(args, vcu, G));
    RUN(6, phase_combine(args, vcu, G));
    RUN(7, PH_MERGE);
    RUN(8, PH_WOUT);
    RUN(9, phase_row1(args, vcu, G));
    RUN(10, PH_FF1);
    RUN(11, PH_FF2);
    if (IN(12)) { phase_row2(args, vcu, G); }
#undef IN
#undef SEAM
}

#ifndef MK_ONE_LAUNCH
#define MK_ONE_LAUNCH 1
#endif
extern "C" void kernel_launch(void* const* d_in, const int* in_sizes, int n_in, void* d_out, int out_size, void* d_ws, size_t ws_size, hipStream_t stream) {
    static int grid = 0;
    if (grid == 0) {
        if (n_in != 24 || ws_size < WS_END) { fprintf(stderr, "kernel_launch: unexpected n_in %d / ws %zu\n", n_in, ws_size); grid = -1; return; }
        int dev = 0, cus = 0;
        if (hipGetDevice(&dev) != hipSuccess || hipDeviceGetAttribute(&cus, hipDeviceAttributeMultiprocessorCount, dev) != hipSuccess) { grid = -1; return; }
        if (hipFuncSetAttribute((const void*)fwd_kernel, hipFuncAttributeMaxDynamicSharedMemorySize, LDS_BYTES) != hipSuccess) { fprintf(stderr, "kernel_launch: hipFuncSetAttribute failed\n"); grid = -1; return; }
        int per_cu = 0;
        if (hipOccupancyMaxActiveBlocksPerMultiprocessor(&per_cu, (const void*)fwd_kernel, NWAVES * 64, LDS_BYTES) != hipSuccess || per_cu < 1) fprintf(stderr, "kernel_launch: occupancy query says %d\n", per_cu);
        (void)hipGetLastError();
        grid = cus;
    }
    if (grid < 0) return;
    (void)hipMemsetAsync((char*)d_ws + WS_CTL, 0, CTL_ZERO_BYTES, stream);
    Args a{};
    for (int i = 0; i < 24; ++i) a.in[i] = (const float*)d_in[i];
    a.out = (float*)d_out; a.ws = (unsigned char*)d_ws;
#if MK_ONE_LAUNCH
    a.ph_lo = 0; a.ph_hi = N_PHASES;
    hipLaunchKernelGGL(fwd_kernel, dim3(grid), dim3(NWAVES * 64), LDS_BYTES, stream, a);
#else
    for (int p = 0; p < N_PHASES; ++p) { a.ph_lo = p; a.ph_hi = p + 1; hipLaunchKernelGGL(fwd_kernel, dim3(grid), dim3(NWAVES * 64), LDS_BYTES, stream, a); }
#endif
}
```

```cpp
#include <hip/hip_runtime.h>
#include <cstdio>
#include <cstdint>

constexpr int DM = 1024, M_CTX = 8192, M_LAT = 4096, MT = 12288, NIN = 5664, NINP = 5888, FF = 4096;
constexpr int LDA_ = 3072, LDB_ = 2816;
constexpr int C_Q = 0, C_K = 512, C_V = 1024, C_DN = 1536, CB_Z = 32, CB_GA = 544, CB_GD = 1568;

namespace pg8 {
#define PG8_LAS __attribute__((address_space(3)))
typedef unsigned short bf16_t;
typedef short bf16x8 __attribute__((ext_vector_type(8)));
typedef float f32x4 __attribute__((ext_vector_type(4)));
typedef unsigned u32x4 __attribute__((ext_vector_type(4)));
typedef unsigned u32x2 __attribute__((ext_vector_type(2)));
constexpr int BM = 256, BK = 64, HALF = 128, HTB = HALF * BK * 2  , STAGE_BYTES = 8 * HTB, NXCD = 8, WGM = 8;

__host__ __device__ __forceinline__ int lds_byte(int r, int c) { const int st = (r >> 4) * 2 + (c >> 5), rr = r & 15, cc = c & 31, ob = rr * 64 + cc * 2; return st * 1024 + (ob ^ (((ob >> 9) & 1) << 5)); }
__host__ __device__ __forceinline__ void stage_rc(int b, int& R, int& C) { const int st = b / 1024, sb = b % 1024, swz = sb ^ (((sb >> 9) & 1) << 5); R = (st >> 1) * 16 + swz / 64; C = (st & 1) * 32 + (swz % 64) / 2; }
__host__ __device__ __forceinline__ int perm32(int rho) { const int n = rho >> 4, i = rho & 15; return 8 * (i >> 2) + 4 * n + (i & 3); }

struct Unit { int pm, pn; };
struct Gemm { const bf16_t* A; const bf16_t* Bt; int M, N, K; };

struct StaticOrder {
    int nM, nN, nwg, G, c;
    __host__ __device__ void init(int M, int N, int G_, int c_) { nM = M / BM; nN = N / BM; nwg = nM * nN; G = G_; c = c_; }
    __host__ __device__ bool next(int i, Unit& u) const {
        const long L = (long)i * G + c; if (L >= nwg) return false;
        int wgid = (int)L; { const int q = nwg / NXCD, r = nwg % NXCD, xcd = wgid % NXCD, off = wgid / NXCD; wgid = (xcd < r ? xcd * (q + 1) : r * (q + 1) + (xcd - r) * q) + off; }
        const int nig = WGM * nN, gid = wgid / nig, fm = gid * WGM, gsz = (nM - fm) < WGM ? (nM - fm) : WGM;
        u.pm = fm + ((wgid % nig) % gsz); u.pn = (wgid % nig) / gsz; return true;
    }
    __device__ __forceinline__ void a_ready(const Unit&) const {}
    __device__ __forceinline__ void done(const Unit&) const {}
};

__device__ __forceinline__ unsigned cvt_pk_bf16(float lo, float hi) { unsigned r; asm volatile("v_cvt_pk_bf16_f32 %0, %1, %2" : "=v"(r) : "v"(lo), "v"(hi)); return r; }
__device__ __forceinline__ float bf_lo(unsigned w) { return __uint_as_float(w << 16); }
__device__ __forceinline__ float bf_hi(unsigned w) { return __uint_as_float(w & 0xffff0000u); }
__device__ __forceinline__ float sigmoidf_(float x) { return __builtin_amdgcn_rcpf(1.0f + __expf(-x)); }
__device__ __forceinline__ u32x4 pack8(const f32x4& v0, const f32x4& v1) { u32x4 w; w.x = cvt_pk_bf16(v0[0], v0[1]); w.y = cvt_pk_bf16(v0[2], v0[3]); w.z = cvt_pk_bf16(v1[0], v1[1]); w.w = cvt_pk_bf16(v1[2], v1[3]); return w; }


struct EpiInProj {
    static constexpr bool PERM = true, AFTER_DRAIN = false;
    bf16_t* PA; bf16_t* PB; float* ko; float* vo; float* BA; bf16_t* VT; const float* rope;
    __device__ __forceinline__ void operator()(const f32x4 (&acc)[2][2][4][2], const Unit& u, int wr, int wc, int fr, int fq) const {
        const int pn = u.pn, pm = u.pm;
        const bool lat = pm >= 32;
        const bool do_rope = lat && pn < 4;
        const bool do_kv = (!lat) && pn >= 2 && pn < 6;
        const bool do_vt = pn == 4 || pn == 5;
        const bool do_ba = pn == 12 && wc == 0;
        const int lane_hi = fq >> 1;
#pragma unroll
        for (int ai = 0; ai < 2; ++ai)
#pragma unroll
            for (int m = 0; m < 4; ++m) {
                const int row = pm * BM + ai * HALF + wr * 64 + m * 16 + fr;
#pragma unroll
                for (int bj = 0; bj < 2; ++bj) {
                    f32x4 v0 = acc[ai][bj][m][0], v1 = acc[ai][bj][m][1];
                    const int col = pn * BM + bj * HALF + wc * 32 + 8 * fq;
                    if (do_rope) {
                        const int t = (row - M_CTX) & 1023;
                        const int pos = (wc & 1) ? (t & 63) : (t >> 6);
                        const float* cp = rope + pos * 16 + 8 * (fq & 1);
                        const f32x4 c0 = *(const f32x4*)cp, c1 = *(const f32x4*)(cp + 4), s0 = *(const f32x4*)(cp + 1024), s1 = *(const f32x4*)(cp + 1028);
                        f32x4 p0, p1;
#pragma unroll
                        for (int i = 0; i < 4; ++i) { p0[i] = __shfl_xor(v0[i], 32); p1[i] = __shfl_xor(v1[i], 32); }
                        if (lane_hi) { v0 = p0 * s0 + v0 * c0; v1 = p1 * s1 + v1 * c1; }
                        else         { v0 = v0 * c0 - p0 * s0; v1 = v1 * c1 - p1 * s1; }
                    }
                    if (pn < 12) *(u32x4*)(PA + (size_t)row * LDA_ + col) = pack8(v0, v1); else *(u32x4*)(PB + (size_t)row * LDB_ + (col - 3072)) = pack8(v0, v1);
                    if (do_kv) {
                        const int hh = ((pn & 1) * 4) + bj * 2 + (wc >> 1);
                        const int d = (wc & 1) * 32 + 8 * fq;
                        float* dst = (pn < 4 ? ko : vo) + ((size_t)(pm * 8 + hh) * 256 + (row & 255)) * 64 + d;
                        *(f32x4*)dst = v0; *(f32x4*)(dst + 4) = v1;
                    }
                    if (do_vt) {
                        const int hh = ((pn & 1) * 4) + bj * 2 + (wc >> 1);
                        const int d = (wc & 1) * 32 + 8 * fq;
                        size_t base; int t, T;
                        if (!lat) { t = row & 255; T = 256; base = (size_t)(pm * 8 + hh) * 64 * 256; }
                        else { const int rl = row - M_CTX; t = rl & 1023; T = 1024; base = (size_t)M_CTX * 512 + (size_t)((rl >> 10) * 8 + hh) * 64 * 1024; }
                        const int pos = (t & ~12) | ((t & 4) << 1) | ((t & 8) >> 1);
                        bf16_t* dst = VT + base + (size_t)d * T + pos;
                        const u32x4 w = pack8(v0, v1);
                        dst[0] = (bf16_t)(w.x & 0xffff); dst[(size_t)T] = (bf16_t)(w.x >> 16); dst[(size_t)2 * T] = (bf16_t)(w.y & 0xffff); dst[(size_t)3 * T] = (bf16_t)(w.y >> 16);
                        dst[(size_t)4 * T] = (bf16_t)(w.z & 0xffff); dst[(size_t)5 * T] = (bf16_t)(w.z >> 16); dst[(size_t)6 * T] = (bf16_t)(w.w & 0xffff); dst[(size_t)7 * T] = (bf16_t)(w.w >> 16);
                    }
                    if (do_ba && bj == 0) { float* dst = BA + (size_t)row * 32 + 8 * fq; *(f32x4*)dst = v0; *(f32x4*)(dst + 4) = v1; }
                }
            }
    }
};

struct EpiGate1 {
    static constexpr bool PERM = true, AFTER_DRAIN = false;
    const bf16_t* P; bf16_t* M1;
    __device__ __forceinline__ void operator()(const f32x4 (&acc)[2][2][4][2], const Unit& u, int wr, int wc, int fr, int fq) const {
#pragma unroll
        for (int ai = 0; ai < 2; ++ai)
#pragma unroll
            for (int m = 0; m < 4; ++m) {
                const int row = u.pm * BM + ai * HALF + wr * 64 + m * 16 + fr;
#pragma unroll
                for (int bj = 0; bj < 2; ++bj) {
                    const int col = u.pn * BM + bj * HALF + wc * 32 + 8 * fq;
                    const u32x4 g = *(const u32x4*)(P + (size_t)row * LDB_ + CB_GA + col);
                    f32x4 v0 = acc[ai][bj][m][0], v1 = acc[ai][bj][m][1];
                    v0[0] *= sigmoidf_(bf_lo(g.x)); v0[1] *= sigmoidf_(bf_hi(g.x)); v0[2] *= sigmoidf_(bf_lo(g.y)); v0[3] *= sigmoidf_(bf_hi(g.y));
                    v1[0] *= sigmoidf_(bf_lo(g.z)); v1[1] *= sigmoidf_(bf_hi(g.z)); v1[2] *= sigmoidf_(bf_lo(g.w)); v1[3] *= sigmoidf_(bf_hi(g.w));
                    *(u32x4*)(M1 + (size_t)row * DM + col) = pack8(v0, v1);
                }
            }
    }
};
struct EpiGate2 {
    static constexpr bool PERM = true, AFTER_DRAIN = false;
    const bf16_t* P; const bf16_t* M1; bf16_t* O;
    __device__ __forceinline__ void operator()(const f32x4 (&acc)[2][2][4][2], const Unit& u, int wr, int wc, int fr, int fq) const {
#pragma unroll
        for (int ai = 0; ai < 2; ++ai)
#pragma unroll
            for (int m = 0; m < 4; ++m) {
                const int row = u.pm * BM + ai * HALF + wr * 64 + m * 16 + fr;
#pragma unroll
                for (int bj = 0; bj < 2; ++bj) {
                    const int col = u.pn * BM + bj * HALF + wc * 32 + 8 * fq;
                    const u32x4 g = *(const u32x4*)(P + (size_t)row * LDB_ + CB_GD + col);
                    const u32x4 q = *(const u32x4*)(M1 + (size_t)row * DM + col);
                    f32x4 v0 = acc[ai][bj][m][0], v1 = acc[ai][bj][m][1];
                    v0[0] = bf_lo(q.x) + v0[0] * sigmoidf_(bf_lo(g.x)); v0[1] = bf_hi(q.x) + v0[1] * sigmoidf_(bf_hi(g.x)); v0[2] = bf_lo(q.y) + v0[2] * sigmoidf_(bf_lo(g.y)); v0[3] = bf_hi(q.y) + v0[3] * sigmoidf_(bf_hi(g.y));
                    v1[0] = bf_lo(q.z) + v1[0] * sigmoidf_(bf_lo(g.z)); v1[1] = bf_hi(q.z) + v1[1] * sigmoidf_(bf_hi(g.z)); v1[2] = bf_lo(q.w) + v1[2] * sigmoidf_(bf_lo(g.w)); v1[3] = bf_hi(q.w) + v1[3] * sigmoidf_(bf_hi(g.w));
                    *(u32x4*)(O + (size_t)row * DM + col) = pack8(v0, v1);
                }
            }
    }
};
struct EpiRss {
    static constexpr bool PERM = true, AFTER_DRAIN = false;
    bf16_t* O; float* RSS;
    __device__ __forceinline__ void operator()(const f32x4 (&acc)[2][2][4][2], const Unit& u, int wr, int wc, int fr, int fq) const {
#pragma unroll
        for (int ai = 0; ai < 2; ++ai)
#pragma unroll
            for (int m = 0; m < 4; ++m) {
                const int row = u.pm * BM + ai * HALF + wr * 64 + m * 16 + fr;
                float s = 0.f;
#pragma unroll
                for (int bj = 0; bj < 2; ++bj) {
                    const int col = u.pn * BM + bj * HALF + wc * 32 + 8 * fq;
                    const f32x4 v0 = acc[ai][bj][m][0], v1 = acc[ai][bj][m][1];
                    s += (v0[0] * v0[0] + v0[1] * v0[1]) + (v0[2] * v0[2] + v0[3] * v0[3]) + (v1[0] * v1[0] + v1[1] * v1[1]) + (v1[2] * v1[2] + v1[3] * v1[3]);
                    *(u32x4*)(O + (size_t)row * DM + col) = pack8(v0, v1);
                }
                s += __shfl_xor(s, 16); s += __shfl_xor(s, 32);
                if (fq == 0) RSS[((size_t)u.pn * MT + row) * 4 + wc] = s;
            }
    }
};
struct EpiRelu2 {
    static constexpr bool PERM = true, AFTER_DRAIN = false;
    bf16_t* O;
    __device__ __forceinline__ void operator()(const f32x4 (&acc)[2][2][4][2], const Unit& u, int wr, int wc, int fr, int fq) const {
#pragma unroll
        for (int ai = 0; ai < 2; ++ai)
#pragma unroll
            for (int m = 0; m < 4; ++m) {
                const int row = u.pm * BM + ai * HALF + wr * 64 + m * 16 + fr;
#pragma unroll
                for (int bj = 0; bj < 2; ++bj) {
                    const int col = u.pn * BM + bj * HALF + wc * 32 + 8 * fq;
                    f32x4 v0 = acc[ai][bj][m][0], v1 = acc[ai][bj][m][1];
#pragma unroll
                    for (int i = 0; i < 4; ++i) { const float a = fmaxf(v0[i], 0.f), b = fmaxf(v1[i], 0.f); v0[i] = a * a; v1[i] = b * b; }
                    *(u32x4*)(O + (size_t)row * FF + col) = pack8(v0, v1);
                }
            }
    }
};

template <class Epi, class Sched, bool ALIGN_EPI = false, bool SP2 = false>
__device__ __forceinline__ void gemm_phase(PG8_LAS unsigned char* lds, const Gemm g, const Sched& S, const Epi& E) {
    const int tid = threadIdx.x, wid = __builtin_amdgcn_readfirstlane(tid >> 6), lane = tid & 63, wr = wid >> 2, wc = wid & 3, fr = lane & 15, fq = lane >> 4;
    const int K = g.K, nt = K / BK;
    unsigned voffA[2], voffB[2];
#pragma unroll
    for (int i = 0; i < 2; ++i) { int R, C; stage_rc(tid * 16 + i * 8192, R, C); const int Rb = Epi::PERM ? ((R & ~31) + perm32(R & 31)) : R;
        voffA[i] = (unsigned)(R * K + C) * 2u; voffB[i] = (unsigned)(Rb * K + C) * 2u; }
    const size_t kstep = (size_t)(BK * 2);
    const size_t hstep = (size_t)HALF * K * 2;
    const size_t tstep = 2 * hstep;
    const unsigned ldsw = (unsigned)wid * 1024u;
    const int aoff = lds_byte(wr * 64 + fr, fq * 8), boff = lds_byte(wc * 32 + fr, fq * 8);
#define PG8_SA(b, h) (((b) * 2 + (h)) * HTB)
#define PG8_SB(b, h) ((4 + (b) * 2 + (h)) * HTB)
#define PG8_STAGE(bufoff, gbase, voff) do { _Pragma("unroll") for (int _i = 0; _i < 2; ++_i) \
        __builtin_amdgcn_global_load_lds((const unsigned*)((const char*)(gbase) + (voff)[_i]), (PG8_LAS unsigned*)(lds + (bufoff) + ldsw + _i * 8192), 16, 0, 0); } while (0)
#define PG8_LDA(dst, b, h) do { _Pragma("unroll") for (int m = 0; m < 4; ++m) _Pragma("unroll") for (int k = 0; k < 2; ++k) dst[m][k] = *(const PG8_LAS bf16x8*)(lds + PG8_SA(b, h) + aoff + m * 2048 + k * 1024); } while (0)
#define PG8_LDB(dst, b, h) do { _Pragma("unroll") for (int n = 0; n < 2; ++n) _Pragma("unroll") for (int k = 0; k < 2; ++k) dst[n][k] = *(const PG8_LAS bf16x8*)(lds + PG8_SB(b, h) + boff + n * 2048 + k * 1024); } while (0)
#define PG8_MMA(ai, bj, At, Bt) do { __builtin_amdgcn_s_setprio(1); _Pragma("unroll") for (int m = 0; m < 4; ++m) _Pragma("unroll") for (int n = 0; n < 2; ++n) _Pragma("unroll") for (int k = 0; k < 2; ++k) \
        acc[ai][bj][m][n] = __builtin_amdgcn_mfma_f32_16x16x32_bf16(Bt[n][k], At[m][k], acc[ai][bj][m][n], 0, 0, 0); __builtin_amdgcn_s_setprio(0); } while (0)
#define PG8_WAIT_V(n) asm volatile("s_waitcnt vmcnt(" #n ")" ::: "memory")
#define PG8_WAIT_L(n) asm volatile("s_waitcnt lgkmcnt(" #n ")" ::: "memory")
#define PG8_BAR __builtin_amdgcn_s_barrier()
#define PG8_SCHED __builtin_amdgcn_sched_barrier(0)
    Unit cur, nxt; int ui = 0;
    if (!S.next(0, cur)) return;
    f32x4 acc[2][2][4][2];
#pragma unroll
    for (int a = 0; a < 2; ++a)
#pragma unroll
        for (int b = 0; b < 2; ++b)
#pragma unroll
            for (int m = 0; m < 4; ++m)
#pragma unroll
                for (int n = 0; n < 2; ++n) acc[a][b][m][n] = (f32x4){0.f, 0.f, 0.f, 0.f};
    bf16x8 At[4][2], B0[2][2], B1[2][2];
    const char* cA = (const char*)g.A + (size_t)cur.pm * tstep; const char* cB = (const char*)g.Bt + (size_t)cur.pn * tstep;
    S.a_ready(cur);
    if constexpr (SP2) {
        PG8_STAGE(PG8_SB(0, 0), cB, voffB); PG8_STAGE(PG8_SB(0, 1), cB + hstep, voffB); PG8_STAGE(PG8_SA(0, 0), cA, voffA); PG8_STAGE(PG8_SA(0, 1), cA + hstep, voffA);
        if (wr == 1) PG8_BAR;
        PG8_WAIT_V(2); PG8_BAR;
        PG8_STAGE(PG8_SB(1, 0), cB + kstep, voffB); PG8_STAGE(PG8_SA(1, 0), cA + kstep, voffA); PG8_STAGE(PG8_SB(1, 1), cB + hstep + kstep, voffB);
        PG8_WAIT_V(6); PG8_BAR;
    } else {
        PG8_STAGE(PG8_SB(0, 0), cB, voffB); PG8_STAGE(PG8_SA(0, 0), cA, voffA); PG8_STAGE(PG8_SB(0, 1), cB + hstep, voffB); PG8_STAGE(PG8_SA(0, 1), cA + hstep, voffA);
        if (wr == 1) PG8_BAR;
        PG8_WAIT_V(4); PG8_BAR;
        PG8_STAGE(PG8_SB(1, 0), cB + kstep, voffB); PG8_STAGE(PG8_SA(1, 0), cA + kstep, voffA); PG8_STAGE(PG8_SB(1, 1), cB + hstep + kstep, voffB);
        PG8_WAIT_V(6); PG8_BAR;
    }
    for (;;) {
        const bool has_next = S.next(ui + 1, nxt);
        const char* nA = has_next ? (const char*)g.A + (size_t)nxt.pm * tstep : cA; const char* nB = has_next ? (const char*)g.Bt + (size_t)nxt.pn * tstep : cB;
        for (int t = 0; t < nt; t += 2) {
            const bool last = (t == nt - 2);
            const char* a1 = cA + (size_t)(t + 1) * kstep;
            const char* a2 = last ? nA : cA + (size_t)(t + 2) * kstep; const char* b2 = last ? nB : cB + (size_t)(t + 2) * kstep;
            const char* a3 = a2 + kstep; const char* b3 = b2 + kstep;
            if (last && has_next) S.a_ready(nxt);
            if constexpr (SP2) {
            PG8_LDB(B0, 0, 0); PG8_LDB(B1, 0, 1); PG8_SCHED; PG8_LDA(At, 0, 0); PG8_STAGE(PG8_SA(1, 1), a1 + hstep, voffA);
            PG8_WAIT_V(8); PG8_WAIT_L(0); PG8_BAR; PG8_MMA(0, 0, At, B0); PG8_MMA(0, 1, At, B1); PG8_BAR; PG8_SCHED;
            PG8_LDA(At, 0, 1); PG8_STAGE(PG8_SB(0, 0), b2, voffB); PG8_STAGE(PG8_SB(0, 1), b2 + hstep, voffB); PG8_STAGE(PG8_SA(0, 0), a2, voffA);
            PG8_WAIT_V(8); PG8_WAIT_L(0); PG8_BAR; PG8_MMA(1, 0, At, B0); PG8_MMA(1, 1, At, B1); PG8_BAR; PG8_SCHED;
            PG8_LDB(B0, 1, 0); PG8_LDB(B1, 1, 1); PG8_SCHED; PG8_LDA(At, 1, 0); PG8_STAGE(PG8_SA(0, 1), a2 + hstep, voffA);
            PG8_WAIT_V(8); PG8_WAIT_L(0); PG8_BAR; PG8_MMA(0, 0, At, B0); PG8_MMA(0, 1, At, B1); PG8_BAR; PG8_SCHED;
            PG8_LDA(At, 1, 1); PG8_STAGE(PG8_SB(1, 0), b3, voffB); PG8_STAGE(PG8_SB(1, 1), b3 + hstep, voffB); PG8_STAGE(PG8_SA(1, 0), a3, voffA);
            PG8_WAIT_V(8); PG8_WAIT_L(0); PG8_BAR; PG8_MMA(1, 0, At, B0); PG8_MMA(1, 1, At, B1); PG8_BAR; PG8_SCHED;
            } else {
            PG8_LDB(B0, 0, 0); PG8_SCHED; PG8_LDA(At, 0, 0); PG8_STAGE(PG8_SA(1, 1), a1 + hstep, voffA);
            PG8_WAIT_L(8); PG8_BAR; PG8_WAIT_L(0); PG8_MMA(0, 0, At, B0); PG8_BAR; PG8_SCHED;
            PG8_LDB(B1, 0, 1); PG8_STAGE(PG8_SB(0, 0), b2, voffB);
            PG8_BAR; PG8_WAIT_L(0); PG8_MMA(0, 1, At, B1); PG8_BAR;
            PG8_LDA(At, 0, 1); PG8_STAGE(PG8_SA(0, 0), a2, voffA);
            PG8_BAR; PG8_WAIT_L(0); PG8_MMA(1, 0, At, B0); PG8_BAR; PG8_SCHED;
            PG8_STAGE(PG8_SB(0, 1), b2 + hstep, voffB);
            PG8_WAIT_V(6); PG8_BAR; PG8_MMA(1, 1, At, B1); PG8_BAR;
            PG8_LDB(B0, 1, 0); PG8_SCHED; PG8_LDA(At, 1, 0); PG8_STAGE(PG8_SA(0, 1), a2 + hstep, voffA);
            PG8_WAIT_L(8); PG8_BAR; PG8_WAIT_L(0); PG8_MMA(0, 0, At, B0); PG8_BAR; PG8_SCHED;
            PG8_LDB(B1, 1, 1); PG8_STAGE(PG8_SB(1, 0), b3, voffB);
            PG8_BAR; PG8_WAIT_L(0); PG8_MMA(0, 1, At, B1); PG8_BAR;
            PG8_LDA(At, 1, 1); PG8_STAGE(PG8_SA(1, 0), a3, voffA);
            PG8_BAR; PG8_WAIT_L(0); PG8_MMA(1, 0, At, B0); PG8_BAR; PG8_SCHED;
            PG8_STAGE(PG8_SB(1, 1), b3 + hstep, voffB);
            PG8_WAIT_V(6); PG8_BAR; PG8_MMA(1, 1, At, B1); PG8_BAR;
            }
        }
        if constexpr (ALIGN_EPI) { if (wr == 0) PG8_BAR; }
        if constexpr (!Epi::AFTER_DRAIN) { E(acc, cur, wr, wc, fr, fq); S.done(cur); }
        if (!has_next) break;
#pragma unroll
        for (int a = 0; a < 2; ++a)
#pragma unroll
            for (int b = 0; b < 2; ++b)
#pragma unroll
                for (int m = 0; m < 4; ++m)
#pragma unroll
                    for (int n = 0; n < 2; ++n) acc[a][b][m][n] = (f32x4){0.f, 0.f, 0.f, 0.f};
        cur = nxt; cA = nA; cB = nB; ++ui;
        if constexpr (ALIGN_EPI) { if (wr == 1) PG8_BAR; }
    }
    PG8_WAIT_V(0);
    if constexpr (!ALIGN_EPI) { if (wr == 0) PG8_BAR; }
    PG8_BAR;
    if constexpr (Epi::AFTER_DRAIN) { E.fused(acc, cur, wr, wc, fr, fq, lds, wid, lane); S.done(cur); }
#undef PG8_SA
#undef PG8_SB
#undef PG8_STAGE
#undef PG8_LDA
#undef PG8_LDB
#undef PG8_MMA
#undef PG8_WAIT_V
#undef PG8_WAIT_L
#undef PG8_BAR
#undef PG8_SCHED
}
}

constexpr int NWAVES = 8;
constexpr size_t MiB = 1u << 20;
constexpr size_t WS_CTL = 0, CTL_ZERO_BYTES = 64 * 1024;
constexpr size_t WS_MOD = 1 * MiB;
constexpr size_t WS_ROPE = 1 * MiB + 256 * 1024;
constexpr size_t WS_BA = 2 * MiB;
constexpr size_t WS_RSS1 = 4 * MiB, WS_RSS2 = 5 * MiB;
constexpr size_t WS_WIN = 6 * MiB, WS_WAO = 18 * MiB, WS_WDO = 19 * MiB, WS_WOUT = 20 * MiB, WS_W1 = 22 * MiB, WS_W2 = 30 * MiB;
constexpr size_t WS_XN = 38 * MiB;
constexpr size_t WS_ONA = 62 * MiB, WS_ODN = 74 * MiB;
constexpr size_t WS_PA = 86 * MiB;
constexpr size_t WS_PB = 158 * MiB;
constexpr size_t WS_SC = 250 * MiB;
constexpr size_t WS_M1 = 224 * MiB;
constexpr size_t WS_CK = 248 * MiB, WS_CVT = 249 * MiB;
constexpr size_t WS_END = 256 * MiB;
constexpr size_t OUT_YP = 0, OUT_YS = (size_t)M_CTX * DM, OUT_K = (size_t)MT * DM, OUT_V = OUT_K + (size_t)32 * 8 * 256 * 64, OUT_S = OUT_V + (size_t)32 * 8 * 256 * 64;

constexpr int CW_BAR = 1024;
constexpr int RING_BYTES = 131072, LDS_BYTES = 147456, LDSCTL_OFF = LDS_BYTES - 1024, MISC_OFF = LDSCTL_OFF + 320;

#define GAS __attribute__((address_space(1)))
#define LAS __attribute__((address_space(3)))
typedef unsigned short bf16;
typedef unsigned v4u __attribute__((ext_vector_type(4)));
typedef unsigned v2u __attribute__((ext_vector_type(2)));
typedef float f32x4 __attribute__((ext_vector_type(4)));
typedef float f32x16 __attribute__((ext_vector_type(16)));
typedef short bf16x8 __attribute__((ext_vector_type(8)));
#define LDS_WAIT() asm volatile("s_waitcnt lgkmcnt(0)" ::: "memory")
#define VM_WAIT() asm volatile("s_waitcnt vmcnt(0)" ::: "memory")
#define MFMA32(a, b, c) __builtin_amdgcn_mfma_f32_32x32x16_bf16((a), (b), (c), 0, 0, 0)
__device__ __forceinline__ unsigned f2bf(float f) { unsigned u = __builtin_bit_cast(unsigned, f); return (u + 0x7fffu + ((u >> 16) & 1u)) >> 16; }
typedef float f32x2_t __attribute__((ext_vector_type(2))); typedef __bf16 bf16x2_t __attribute__((ext_vector_type(2)));
__device__ __forceinline__ unsigned pk2(float lo, float hi) { f32x2_t v = {lo, hi}; bf16x2_t b = __builtin_convertvector(v, bf16x2_t); return __builtin_bit_cast(unsigned, b); }
__device__ __forceinline__ float bflo(unsigned w) { return __uint_as_float(w << 16); }
__device__ __forceinline__ float bfhi(unsigned w) { return __uint_as_float(w & 0xffff0000u); }
__device__ __forceinline__ float silu_(float x) { return x * __builtin_amdgcn_rcpf(1.0f + __expf(-x)); }
__device__ __forceinline__ float sigm_(float x) { return __builtin_amdgcn_rcpf(1.0f + __expf(-x)); }
__device__ __host__ __forceinline__ constexpr int swap23(int x) { return (x & ~12) | ((x & 4) << 1) | ((x & 8) >> 1); }
__device__ __forceinline__ int crow(int reg, int h) { return (reg & 3) + 8 * (reg >> 2) + 4 * h; }
template <int CTRL, int ROWMASK> __device__ __forceinline__ float dpp_add(float v) {
    return v + __builtin_bit_cast(float, __builtin_amdgcn_update_dpp(0, __builtin_bit_cast(int, v), CTRL, ROWMASK, 0xF, false));
}
__device__ __forceinline__ float wave_sum_dpp(float v) {
    v = dpp_add<0xB1, 0xF>(v);
    v = dpp_add<0x4E, 0xF>(v);
    v = dpp_add<0x141, 0xF>(v);
    v = dpp_add<0x140, 0xF>(v);
    v = dpp_add<0x142, 0xA>(v);
    v = dpp_add<0x143, 0xC>(v);
    return __builtin_bit_cast(float, __builtin_amdgcn_readlane(__builtin_bit_cast(int, v), 63));
}
__device__ __forceinline__ float wave_sum(float v) {
#pragma unroll
    for (int o = 1; o < 64; o <<= 1) v += __shfl_xor(v, o);
    return v;
}

#define XB_TMO      128
#define XB_XCNT(j)  (256  + 64 * (j))
#define XB_XSUB(j)  (1280 + 64 * (j))
#define XB_XGEN(j)  (2304 + 64 * (j))
#define XB_TOP      3328
#define XB_TOPGEN   3392
#define XCD_BAR_WORDS 3456
#define XB_SPIN_CAP (1u << 22)

__device__ __forceinline__ unsigned xb_ld(unsigned* p)              { return __hip_atomic_load(p, __ATOMIC_RELAXED, __HIP_MEMORY_SCOPE_AGENT); }
__device__ __forceinline__ unsigned xb_add(unsigned* p, unsigned v) { return __hip_atomic_fetch_add(p, v, __ATOMIC_RELAXED, __HIP_MEMORY_SCOPE_AGENT); }
__device__ __forceinline__ unsigned xb_xcc_id() { return (unsigned)__builtin_amdgcn_s_getreg((3 << 11) | 20) & 0xFu; }
#define XB_SPIN(cond, bar) do { unsigned _sp = 0; while (cond) { __builtin_amdgcn_s_sleep(1); \
    if ((++_sp & 255u) == 0u) { if (xb_ld(&(bar)[XB_TMO])) break; if (_sp > XB_SPIN_CAP) { atomicAdd(&(bar)[XB_TMO], 1u); break; } } } } while (0)

struct XcdBarrier { unsigned* bar; unsigned x; volatile LAS unsigned* st; };

__device__ __forceinline__ XcdBarrier xcd_barrier_post(unsigned* bar, volatile LAS unsigned* st) {
    XcdBarrier b; b.bar = bar; b.x = xb_xcc_id(); b.st = st;
    if (threadIdx.x == 0) (void)xb_add(&bar[XB_XCNT(b.x)], 1u);
    return b;
}
__device__ __forceinline__ void xcd_barrier_complete(unsigned* bar, unsigned x, unsigned& nloc, unsigned& nx) {
    const unsigned G = gridDim.x * gridDim.y * gridDim.z;
    unsigned sum, cnt, mine, sp = 0u;
    for (;;) {
        sum = 0u; cnt = 0u; mine = 0u;
#pragma unroll
        for (unsigned j = 0; j < 16; ++j) { const unsigned c = xb_ld(&bar[XB_XCNT(j)]); sum += c; cnt += (c > 0u) ? 1u : 0u; mine = (j == x) ? c : mine; }
        if (sum == G) break;
        __builtin_amdgcn_s_sleep(1);
        if ((++sp & 255u) == 0u) { if (xb_ld(&bar[XB_TMO])) break; if (sp > XB_SPIN_CAP) { atomicAdd(&bar[XB_TMO], 1u); break; } }
    }
    nloc = mine > 0u ? mine : 1u; nx = cnt > 0u ? cnt : 1u;
}
__device__ __forceinline__ void xcd_barrier(const XcdBarrier& b) {
    asm volatile("s_waitcnt vmcnt(0)" ::: "memory");
    __syncthreads();
    if (threadIdx.x == 0) {
        unsigned* bar = b.bar;
        __builtin_amdgcn_s_waitcnt(0);
        unsigned nloc = b.st[0], nx = b.st[1];
        if (nloc == 0u) { xcd_barrier_complete(bar, b.x, nloc, nx); b.st[0] = nloc; b.st[1] = nx; }
        const unsigned old = xb_add(&bar[XB_XSUB(b.x)], 1u);
        const unsigned gen = old / nloc;
        if (old + 1u == (gen + 1u) * nloc) {
            __builtin_amdgcn_fence(__ATOMIC_RELEASE, "agent");
            asm volatile("s_waitcnt vmcnt(0)" ::: "memory");
            const unsigned og = xb_add(&bar[XB_TOP], 1u);
            const unsigned tg = og / nx;
            if (og + 1u == (tg + 1u) * nx) xb_add(&bar[XB_TOPGEN], 1u);
            else XB_SPIN(xb_ld(&bar[XB_TOPGEN]) == tg, bar);
            __builtin_amdgcn_fence(__ATOMIC_ACQUIRE, "agent");
            xb_add(&bar[XB_XGEN(b.x)], 1u);
            asm volatile("s_waitcnt vmcnt(0)" ::: "memory");
        } else {
            XB_SPIN(xb_ld(&bar[XB_XGEN(b.x)]) == gen, bar);
            __builtin_amdgcn_fence(__ATOMIC_ACQUIRE, "agent");
            asm volatile("s_waitcnt vmcnt(0)" ::: "memory");
        }
    }
    __syncthreads();
}

struct Args { const float* in[24]; float* out; unsigned char* ws; int ph_lo, ph_hi; };
enum { I_XP = 0, I_XS, I_C, I_CK, I_CV, I_ST, I_CCTX, I_WADA, I_BADA, I_PRE1, I_POST1, I_PRE2, I_POST2, I_WIN, I_CONVW, I_ALOG, I_DTB, I_DNN, I_RPB, I_WAO, I_WDO, I_WOUT, I_WFF1, I_WFF2 };

__device__ __forceinline__ void p0_transpose_item(const float* W, int K, int N, bf16* WT, LAS float* scr, int item, int lane) {
    const int nblk = N / 32, kb = item / nblk, nb = item % nblk, k0 = 64 * kb, n0 = 32 * nb;
#pragma unroll 8
    for (int i = 0; i < 32; ++i) { const int kk = 2 * i + (lane >> 5); scr[kk * 33 + (lane & 31)] = W[(size_t)(k0 + kk) * N + n0 + (lane & 31)]; }
    LDS_WAIT();
    const int c = lane & 7;
#pragma unroll
    for (int j = 0; j < 4; ++j) { const int n = (lane >> 3) + 8 * j; const LAS float* s = scr + (8 * c) * 33 + n;
        v4u o; o.x = pk2(s[0 * 33], s[1 * 33]); o.y = pk2(s[2 * 33], s[3 * 33]); o.z = pk2(s[4 * 33], s[5 * 33]); o.w = pk2(s[6 * 33], s[7 * 33]);
        *(v4u*)(WT + (size_t)(n0 + n) * K + k0 + 8 * c) = o; }
    LDS_WAIT();
}

__device__ __forceinline__ void phase_prologue(const Args& a, LAS unsigned char* lds, int vcu, int G) {
    const int tid = threadIdx.x, lane = tid & 63, wave = __builtin_amdgcn_readfirstlane(tid >> 6);
    unsigned char* ws = a.ws;
    if (vcu < 192) {
        LAS float* sl = (LAS float*)lds;
        LAS float* red = (LAS float*)(lds + 20480);
        for (int i = tid; i < 5 * 1024; i += 512) { const float v = i < 1024 ? a.in[I_CCTX][i] : a.in[I_C][i - 1024]; sl[i] = silu_(v); }
        __syncthreads();
        const int col = 32 * vcu + (lane & 31), rg = wave * 2 + (lane >> 5);
        const float* w = a.in[I_WADA] + (size_t)(rg * 64) * 6144 + col;
        float acc[5] = {0.f, 0.f, 0.f, 0.f, 0.f};
#pragma unroll 8
        for (int i = 0; i < 64; ++i) { const float wv = w[(size_t)i * 6144]; const int k = rg * 64 + i;
#pragma unroll
            for (int v = 0; v < 5; ++v) acc[v] += sl[v * 1024 + k] * wv; }
#pragma unroll
        for (int v = 0; v < 5; ++v) red[(rg * 5 + v) * 32 + (lane & 31)] = acc[v];
        __syncthreads();
        if (tid < 160) { const int v = tid >> 5, cl = tid & 31; float s = a.in[I_BADA][32 * vcu + cl];
            for (int r = 0; r < 16; ++r) s += red[(r * 5 + v) * 32 + cl];
            ((float*)(ws + WS_MOD))[v * 6144 + 32 * vcu + cl] = s; }
        __syncthreads();
    } else if (vcu == 192) {
        float* rope = (float*)(ws + WS_ROPE);
        for (int i = tid; i < 1024; i += 512) { const int pos = i >> 4, f = i & 15; const float inv = powf(10000.0f, -(float)f / 16.0f); const float ang = (float)pos * inv; rope[i] = cosf(ang); rope[1024 + i] = sinf(ang); }
    } else if (vcu < 225) {
        const int bh = vcu - 193;
        const float* ck = a.in[I_CK] + (size_t)bh * 256 * 64; const float* cv = a.in[I_CV] + (size_t)bh * 256 * 64;
        bf16* CK = (bf16*)(ws + WS_CK) + (size_t)bh * 256 * 64; bf16* CVT = (bf16*)(ws + WS_CVT) + (size_t)bh * 64 * 256;
        for (int i = tid; i < 256 * 8; i += 512) { const int key = i >> 3, c8 = i & 7;
            const f32x4 k0 = *(const f32x4*)(ck + key * 64 + c8 * 8), k1 = *(const f32x4*)(ck + key * 64 + c8 * 8 + 4);
            v4u o; o.x = pk2(k0[0], k0[1]); o.y = pk2(k0[2], k0[3]); o.z = pk2(k1[0], k1[1]); o.w = pk2(k1[2], k1[3]);
            *(v4u*)(CK + key * 64 + c8 * 8) = o;
            const f32x4 v0 = *(const f32x4*)(cv + key * 64 + c8 * 8), v1 = *(const f32x4*)(cv + key * 64 + c8 * 8 + 4);
            const int pos = (key & ~12) | ((key & 4) << 1) | ((key & 8) >> 1);
#pragma unroll
            for (int j = 0; j < 4; ++j) { CVT[(c8 * 8 + j) * 256 + pos] = (bf16)f2bf(v0[j]); CVT[(c8 * 8 + 4 + j) * 256 + pos] = (bf16)f2bf(v1[j]); }
        }
    }
    LAS float* scr = (LAS float*)(lds + 32768 + wave * 8704);
    const int gw = vcu * NWAVES + wave, NGW = G * NWAVES;
    constexpr int I_IN = 16 * 177, I_AO = 8 * 32, I_DO = 8 * 32, I_OUT = 16 * 32, I_1 = 16 * 128, I_2 = 64 * 32;
    constexpr int NITEMS = I_IN + I_AO + I_DO + I_OUT + I_1 + I_2;
    for (int it = gw; it < NITEMS; it += NGW) {
        int r = it;
        if (r < I_IN) { p0_transpose_item(a.in[I_WIN], 1024, NIN, (bf16*)(ws + WS_WIN), scr, r, lane); continue; } r -= I_IN;
        if (r < I_AO) { p0_transpose_item(a.in[I_WAO], 512, 1024, (bf16*)(ws + WS_WAO), scr, r, lane); continue; } r -= I_AO;
        if (r < I_DO) { p0_transpose_item(a.in[I_WDO], 512, 1024, (bf16*)(ws + WS_WDO), scr, r, lane); continue; } r -= I_DO;
        if (r < I_OUT) { p0_transpose_item(a.in[I_WOUT], 1024, 1024, (bf16*)(ws + WS_WOUT), scr, r, lane); continue; } r -= I_OUT;
        if (r < I_1) { p0_transpose_item(a.in[I_WFF1], 1024, FF, (bf16*)(ws + WS_W1), scr, r, lane); continue; } r -= I_1;
        p0_transpose_item(a.in[I_WFF2], FF, 1024, (bf16*)(ws + WS_W2), scr, r, lane);
    }
    { v4u* z = (v4u*)((bf16*)(ws + WS_WIN) + (size_t)NIN * 1024); const int n16 = (NINP - NIN) * 1024 * 2 / 16;
      for (int i = gw * 64 + lane; i < n16; i += NGW * 64) z[i] = (v4u){0u, 0u, 0u, 0u}; }
}

__device__ __forceinline__ const float* x_row(const Args& a, int m) { return m < M_CTX ? a.in[I_XP] + (size_t)m * DM : a.in[I_XS] + (size_t)(m - M_CTX) * DM; }
__device__ __forceinline__ int mod_idx(int m) { return m < M_CTX ? 0 : 1 + ((m - M_CTX) >> 10); }

__device__ __forceinline__ void phase_xn(const Args& a, int vcu, int G) {
    const int tid = threadIdx.x, lane = tid & 63, wave = tid >> 6;
    const int gw = vcu * NWAVES + wave, NGW = G * NWAVES;
    const float* MOD = (const float*)(a.ws + WS_MOD); bf16* XN = (bf16*)(a.ws + WS_XN);
    for (int m = gw; m < MT; m += NGW) {
        const f32x4* xr = (const f32x4*)x_row(a, m) + lane;
        const float* md = MOD + mod_idx(m) * 6144;
        f32x4 v[4]; float s = 0.f;
#pragma unroll
        for (int j = 0; j < 4; ++j) { v[j] = xr[64 * j]; s += (v[j].x * v[j].x + v[j].y * v[j].y) + (v[j].z * v[j].z + v[j].w * v[j].w); }
        const float rstd = rsqrtf(wave_sum(s) * (1.f / DM) + 1e-6f);
        v2u* o8 = (v2u*)(XN + (size_t)m * DM) + lane;
#pragma unroll
        for (int j = 0; j < 4; ++j) { const int c = (lane + 64 * j) * 4;
            const f32x4 w = *(const f32x4*)(a.in[I_PRE1] + c), sh = *(const f32x4*)(md + c), sc = *(const f32x4*)(md + 1024 + c);
            const f32x4 h = v[j] * rstd * w * (sc + 1.0f) + sh;
            v2u o; o.x = pk2(h.x, h.y); o.y = pk2(h.z, h.w); o8[64 * j] = o; }
    }
}

__device__ __forceinline__ bf16x8 pack_regs(const f32x16& p, int s) {
    v4u w; w.x = pk2(p[8 * s], p[8 * s + 1]); w.y = pk2(p[8 * s + 2], p[8 * s + 3]); w.z = pk2(p[8 * s + 4], p[8 * s + 5]); w.w = pk2(p[8 * s + 6], p[8 * s + 7]);
    return __builtin_bit_cast(bf16x8, w);
}
__device__ __forceinline__ void store_o(bf16* dst, const f32x16& o0, const f32x16& o1, float inv, int hh) {
#pragma unroll
    for (int g = 0; g < 4; ++g) {
        v2u w0, w1; w0.x = pk2(o0[4 * g] * inv, o0[4 * g + 1] * inv); w0.y = pk2(o0[4 * g + 2] * inv, o0[4 * g + 3] * inv);
        w1.x = pk2(o1[4 * g] * inv, o1[4 * g + 1] * inv); w1.y = pk2(o1[4 * g + 2] * inv, o1[4 * g + 3] * inv);
        *(v2u*)(dst + 8 * g + 4 * hh) = w0; *(v2u*)(dst + 32 + 8 * g + 4 * hh) = w1;
    }
}
constexpr float LOG2E = 1.4426950408889634f;

struct AttnTile { const bf16* k; const bf16* v0; const bf16* v1; };
template <bool LAT>
__device__ __forceinline__ void attn_task(const Args& a, int task, int lane, LAS float* wl) {
    const int r = lane & 31, hh = lane >> 5;
    const bf16* P = (const bf16*)(a.ws + WS_PA); bf16* ONA = (bf16*)(a.ws + WS_ONA);
    int b, h, rowq, gr = 0, cq = 0;
    if (LAT) { const int half = task & 1; gr = (task >> 1) & 15; h = (task >> 5) & 7; b = task >> 8; cq = 32 * half + r; rowq = M_CTX + b * 1024 + gr * 64 + cq; }
    else { const int qb = task & 7; h = (task >> 3) & 7; b = task >> 6; rowq = b * 256 + qb * 32 + r; }
    constexpr int NT = LAT ? 24 : 8;
    const bf16* VTb = LAT ? (const bf16*)a.out + (size_t)3 * MT * 512 + (size_t)M_CTX * 512 + ((size_t)(b * 8 + h) * 64 + r) * 1024 + 8 * hh
                          : (const bf16*)a.out + (size_t)3 * MT * 512 + ((size_t)(b * 8 + h) * 64 + r) * 256 + 8 * hh;
    const bf16* CK = (const bf16*)(a.ws + WS_CK) + (size_t)(b * 8 + h) * 256 * 64 + 8 * hh; const bf16* CVT = (const bf16*)(a.ws + WS_CVT) + ((size_t)(b * 8 + h) * 64 + r) * 256 + 8 * hh;
    if (LAT) { LDS_WAIT();
#pragma unroll
        for (int i = 0; i < 8; ++i) { const int idx = lane + 64 * i; if (idx < 465) wl[idx] = a.in[I_RPB][h * 465 + idx]; }
        LDS_WAIT(); }
    const LAS float* rpb = wl;
    const int rs = LAT ? min(max(gr - 4, 0), 8) : 0, cs = LAT ? min(max(cq - 8, 0), 48) : 0;
    const bf16* Pkl = P + (size_t)(LAT ? M_CTX + b * 1024 : b * 256) * LDA_ + C_K + h * 64 + 8 * hh;
    auto tile = [&](int t) -> AttnTile {
        AttnTile d;
        if (LAT && t < 8) { d.k = CK + (size_t)(t * 32 + r) * 64; d.v0 = CVT + 32 * t; d.v1 = d.v0 + 32 * 256; }
        else if (LAT) { const int tl = t - 8, tk = (rs + (tl >> 1)) * 64 + (tl & 1) * 32; d.k = Pkl + (size_t)(tk + r) * LDA_; d.v0 = VTb + tk; d.v1 = d.v0 + 32 * 1024; }
        else { d.k = Pkl + (size_t)(t * 32 + r) * LDA_; d.v0 = VTb + 32 * t; d.v1 = d.v0 + 32 * 256; }
        return d;
    };
    bf16x8 qf[4];
    { const bf16* Pq = P + (size_t)rowq * LDA_ + C_Q + h * 64 + 8 * hh;
#pragma unroll
      for (int s = 0; s < 4; ++s) qf[s] = *(const bf16x8*)(Pq + 16 * s); }
    float m = -3.0e38f, l = 0.f; f32x16 o0 = {}, o1 = {};
    const float sc = 0.125f * LOG2E;
    bf16x8 kA[4], vA[4], kB[4], vB[4];
#define AT_LOAD(K_, V_, t_) do { const AttnTile d_ = tile(t_); _Pragma("unroll") for (int s_ = 0; s_ < 4; ++s_) K_[s_] = *(const bf16x8*)(d_.k + 16 * s_); \
        V_[0] = *(const bf16x8*)(d_.v0); V_[1] = *(const bf16x8*)(d_.v0 + 16); V_[2] = *(const bf16x8*)(d_.v1); V_[3] = *(const bf16x8*)(d_.v1 + 16); } while (0)
#define AT_COMP(K_, V_, t_) do { f32x16 S = {}; _Pragma("unroll") for (int s_ = 0; s_ < 4; ++s_) S = MFMA32(K_[s_], qf[s_], S); \
        if (LAT && (t_) >= 8) { const int tl_ = (t_) - 8, kr_ = rs + (tl_ >> 1), ct_ = tl_ & 1; const LAS float* rp_ = rpb + (kr_ - gr + 7) * 31 + 15 - cq; \
            _Pragma("unroll") for (int i = 0; i < 16; ++i) { const int kc = ct_ * 32 + crow(i, hh); const bool ok = (kc >= cs) && (kc < cs + 16); \
                const float bias = rp_[ok ? kc : cq]; S[i] = ok ? (S[i] * 0.125f + bias) * LOG2E : -1.0e30f; } } \
        else { _Pragma("unroll") for (int i = 0; i < 16; ++i) S[i] *= sc; } \
        float tm = S[0]; _Pragma("unroll") for (int i = 1; i < 16; ++i) tm = fmaxf(tm, S[i]); \
        tm = fmaxf(tm, __shfl_xor(tm, 32)); const float mn = fmaxf(m, tm); const float al = __builtin_amdgcn_exp2f(m - mn); m = mn; \
        float ps = 0.f; _Pragma("unroll") for (int i = 0; i < 16; ++i) { S[i] = __builtin_amdgcn_exp2f(S[i] - mn); ps += S[i]; } \
        l = l * al + ps; o0 = o0 * al; o1 = o1 * al; \
        const bf16x8 p0_ = pack_regs(S, 0), p1_ = pack_regs(S, 1); \
        o0 = MFMA32(V_[0], p0_, o0); o0 = MFMA32(V_[1], p1_, o0); o1 = MFMA32(V_[2], p0_, o1); o1 = MFMA32(V_[3], p1_, o1); } while (0)
    AT_LOAD(kA, vA, 0);
    for (int t = 0; t < NT; t += 2) {
        AT_LOAD(kB, vB, t + 1);
        AT_COMP(kA, vA, t);
        if (t + 2 < NT) AT_LOAD(kA, vA, t + 2);
        AT_COMP(kB, vB, t + 1);
    }
#undef AT_LOAD
#undef AT_COMP
    l += __shfl_xor(l, 32);
    store_o(ONA + (size_t)rowq * 512 + h * 64, o0, o1, 1.0f / l, hh);
}

__device__ __forceinline__ void conv_task(const Args& a, int task, int lane) {
    const int hd = task & 7, part = (task >> 3) % 3, chunk = task / 24, r0 = chunk * 64;
    const bf16* P = (const bf16*)(a.ws + WS_PA);
    int seq0, T_, sb_;
    if (r0 < M_CTX) { seq0 = r0 & ~255; T_ = 256; sb_ = (r0 >> 8) * 8 + hd; } else { seq0 = M_CTX + ((r0 - M_CTX) & ~1023); T_ = 1024; sb_ = ((r0 - M_CTX) >> 10) * 8 + hd; }
    const int seq1 = seq0 + T_, kc = (r0 - seq0) >> 6, NC = T_ >> 6;
    const int ch = part * 512 + hd * 64 + lane;
    float w[5];
#pragma unroll
    for (int t = 0; t < 5; ++t) w[t] = a.in[I_CONVW][t * 1536 + ch];
    const bf16* src = P + C_DN + ch;
    float x[68];
    {
        unsigned raw[68];
#pragma unroll
        for (int i = 0; i < 68; ++i) { const int row = r0 - 2 + i; const int rc = min(max(row, seq0), seq1 - 1); raw[i] = src[(size_t)rc * LDA_]; }
        asm volatile("" ::: "memory");
#pragma unroll
        for (int i = 0; i < 68; ++i) { const int row = r0 - 2 + i; x[i] = (row >= seq0 && row < seq1) ? bflo(raw[i]) : 0.f; }
    }
    float o[64];
#pragma unroll
    for (int rr = 0; rr < 64; ++rr) { const float v = w[0] * x[rr] + w[1] * x[rr + 1] + w[2] * x[rr + 2] + w[3] * x[rr + 3] + w[4] * x[rr + 4]; o[rr] = silu_(v); }
    if (part < 2) {
#pragma unroll
        for (int rr = 0; rr < 64; ++rr) { const float ss = wave_sum_dpp(o[rr] * o[rr]); o[rr] *= __builtin_amdgcn_rsqf(ss + 1e-6f); }
        bf16* dst = (bf16*)a.out + (size_t)part * MT * 512 + (size_t)r0 * 512 + hd * 64 + swap23(lane);
#pragma unroll
        for (int rr = 0; rr < 64; ++rr) dst[(size_t)rr * 512] = (bf16)f2bf(o[rr]);
    }
    if (part == 1) {
        bf16* ktf = (bf16*)(a.ws + WS_XN) + (r0 < M_CTX ? (size_t)sb_ * 64 * 256 : (size_t)M_CTX * 512 + (size_t)sb_ * 64 * 1024) + (size_t)lane * T_;
        bf16* ktb = ktf + (size_t)MT * 512 + 64 * (NC - 1 - kc); ktf += 64 * kc;
#pragma unroll
        for (int q = 0; q < 8; ++q) { v4u wf, wb;
            wf.x = pk2(o[swap23(8 * q + 0)], o[swap23(8 * q + 1)]); wf.y = pk2(o[swap23(8 * q + 2)], o[swap23(8 * q + 3)]); wf.z = pk2(o[swap23(8 * q + 4)], o[swap23(8 * q + 5)]); wf.w = pk2(o[swap23(8 * q + 6)], o[swap23(8 * q + 7)]);
            wb.x = pk2(o[63 - swap23(8 * q + 0)], o[63 - swap23(8 * q + 1)]); wb.y = pk2(o[63 - swap23(8 * q + 2)], o[63 - swap23(8 * q + 3)]); wb.z = pk2(o[63 - swap23(8 * q + 4)], o[63 - swap23(8 * q + 5)]); wb.w = pk2(o[63 - swap23(8 * q + 6)], o[63 - swap23(8 * q + 7)]);
            *(v4u*)(ktf + 8 * q) = wf; *(v4u*)(ktb + 8 * q) = wb; }
    }
    if (part == 2) {
        const int jw = lane >> 5, r = lane & 31;
        const int td0 = (r0 < M_CTX ? 512 + sb_ * 4 : sb_ * 16);
        const float* BA = (const float*)(a.ws + WS_BA) + (size_t)r0 * 32 + hd;
        float bl[2][64];
#pragma unroll
        for (int rr = 0; rr < 64; ++rr) { bl[0][rr] = BA[rr * 32]; bl[1][rr] = BA[rr * 32 + 8]; }
        asm volatile("" ::: "memory");
#pragma unroll
        for (int dd = 0; dd < 2; ++dd) {
            float ov[64];
#pragma unroll
            for (int rr = 0; rr < 64; ++rr) ov[rr] = o[rr] * sigm_(bl[dd][rr]);
            const int taskd = td0 + (dd ? NC - 1 - kc : kc);
            bf16* base = (dd ? (bf16*)(a.ws + WS_ODN) : (bf16*)a.out + (size_t)2 * MT * 512) + ((size_t)(taskd * 2 + jw) * 2 * 64 + r) * 16;
#pragma unroll
            for (int cb = 0; cb < 2; ++cb)
#pragma unroll
                for (int hh = 0; hh < 2; ++hh) { v4u w0, w1;
#define CV(g_) ov[dd ? 63 - (32 * cb + crow((g_), hh)) : (32 * cb + crow((g_), hh))]
                    w0.x = pk2(CV(0), CV(1)); w0.y = pk2(CV(2), CV(3)); w0.z = pk2(CV(4), CV(5)); w0.w = pk2(CV(6), CV(7));
                    w1.x = pk2(CV(8), CV(9)); w1.y = pk2(CV(10), CV(11)); w1.z = pk2(CV(12), CV(13)); w1.w = pk2(CV(14), CV(15));
#undef CV
                    bf16* dp = base + (size_t)(cb * 64 + hh * 32) * 16; *(v4u*)dp = w0; *(v4u*)(dp + 8) = w1; }
        }
    }
}

__device__ __forceinline__ void phase_mix_a(const Args& a, LAS unsigned char* lds, int vcu, int G) {
    const int tid = threadIdx.x, wave = __builtin_amdgcn_readfirstlane(tid >> 6);
    LAS float* wl = (LAS float*)(lds + wave * 2048);
#define MIX_LANE() int lane = tid & 63; asm volatile("" : "+v"(lane))
    if (G == 256) {
#ifndef MIX_REP_ATTN
#define MIX_REP_ATTN 1
#endif
#ifndef MIX_REP_CONV
#define MIX_REP_CONV 1
#endif
        if (vcu < 128) { for (int rp = 0; rp < MIX_REP_ATTN; ++rp) { MIX_LANE(); attn_task<true>(a, vcu * 8 + wave, lane, wl); } for (int rp = 0; rp < MIX_REP_CONV; ++rp) { MIX_LANE(); conv_task(a, vcu * 8 + wave, lane); } }
        else { const int j = vcu - 128;
            for (int rp = 0; rp < MIX_REP_ATTN; ++rp) { { MIX_LANE(); attn_task<false>(a, j * 8 + wave, lane, wl); } { MIX_LANE(); attn_task<false>(a, (j + 128) * 8 + wave, lane, wl); } }
            for (int rp = 0; rp < MIX_REP_CONV; ++rp) for (int c = 1024 + j * 8 + wave; c < 4608; c += 1024) { MIX_LANE(); conv_task(a, c, lane); } }
    } else {
        for (int t = wave * G + vcu; t < 1024 + 2048 + 4608; t += G * NWAVES) { MIX_LANE();
            if (t < 1024) attn_task<true>(a, t, lane, wl); else if (t < 3072) attn_task<false>(a, t - 1024, lane, wl); else conv_task(a, t - 3072, lane); }
    }
#undef MIX_LANE
}

struct DnChain { int b, h, dir, T, rowbase, task0; bool lat; };
__device__ __forceinline__ DnChain dn_decode(int chain) {
    DnChain d; d.lat = chain < 64;
    if (d.lat) { d.b = chain >> 4; d.h = (chain >> 1) & 7; d.dir = chain & 1; d.T = 1024; d.rowbase = M_CTX + d.b * 1024; d.task0 = chain * 16; }
    else { const int c = chain - 64; d.b = c >> 4; d.h = (c >> 1) & 7; d.dir = c & 1; d.T = 256; d.rowbase = d.b * 256; d.task0 = 1024 + c * 4; }
    return d;
}

__device__ __forceinline__ void dn_pre_task(const Args& a, int task, LAS float* LT, LAS float* tab, int lane) {
    int chain, n;
    if (task < 1024) { chain = task >> 4; n = task & 15; } else { const int t2 = task - 1024; chain = 64 + (t2 >> 2); n = t2 & 3; }
    const DnChain d = dn_decode(chain);
    const int h = d.h, dir = d.dir;
    const bf16* DQ = (const bf16*)a.out; const bf16* DK = DQ + (size_t)MT * 512;
    const float* BA = (const float*)(a.ws + WS_BA);
    bf16* rec = (bf16*)(a.ws + WS_PA) + (size_t)task * 12288; bf16* Tm = rec; bf16* QKm = rec + 4096; bf16* Kb = rec + 8192;
    float* SC = (float*)(a.ws + WS_SC) + (size_t)task * 320;
    const int R0 = d.rowbase + (dir ? d.T - 1 - 64 * n : 64 * n), RS = dir ? -1 : 1;
    const int r = lane & 31, hh = lane >> 5;
    {
        const float* ba = BA + (size_t)(R0 + lane * RS) * 32;
        const float beta = sigm_(ba[dir * 8 + h]);
        const float xx = ba[16 + dir * 8 + h] + a.in[I_DTB][dir * 8 + h];
        const float sp = xx > 20.f ? xx : log1pf(__expf(xx));
        float gc = -__expf(a.in[I_ALOG][dir * 8 + h]) * sp;
#pragma unroll
        for (int o = 1; o < 64; o <<= 1) { const float t = __shfl_up(gc, o); if (lane >= o) gc += t; }
        const float gl = __shfl(gc, 63);
        const float eg = __expf(gc);
        SC[lane] = beta; SC[64 + lane] = beta * eg; SC[128 + lane] = 0.125f * eg; SC[192 + lane] = __expf(gl - gc); SC[256 + lane] = __expf(gl);
        LDS_WAIT();
        tab[lane] = gc; tab[64 + lane] = beta;
        LDS_WAIT();
    }
    bf16x8 kf[2][4], qf[2][4];
#pragma unroll
    for (int cb = 0; cb < 2; ++cb) { const size_t ro = (size_t)(R0 + (32 * cb + r) * RS) * 512 + h * 64 + 8 * hh;
#pragma unroll
        for (int s = 0; s < 4; ++s) { kf[cb][s] = *(const bf16x8*)(DK + ro + 16 * s); qf[cb][s] = *(const bf16x8*)(DQ + ro + 16 * s); } }
    asm volatile("" ::: "memory");
    const float gcol0 = tab[r], gcol1 = tab[32 + r];
#pragma unroll
    for (int cb = 0; cb < 2; ++cb) { const float coef = -tab[64 + 32 * cb + r] * __expf(cb ? gcol1 : gcol0);
#pragma unroll
        for (int s = 0; s < 4; ++s) { const v4u kw = __builtin_bit_cast(v4u, kf[cb][s]); v4u ow;
            ow.x = pk2(bflo(kw.x) * coef, bfhi(kw.x) * coef); ow.y = pk2(bflo(kw.y) * coef, bfhi(kw.y) * coef); ow.z = pk2(bflo(kw.z) * coef, bfhi(kw.z) * coef); ow.w = pk2(bflo(kw.w) * coef, bfhi(kw.w) * coef);
            *(v4u*)(Kb + (32 * cb + r) * 64 + 16 * s + 8 * hh) = ow; } }
#pragma unroll
    for (int tile = 0; tile < 3; ++tile) {
        const int cb = tile == 0 ? 0 : 1, cbp = tile == 2 ? 1 : 0;
        f32x16 acc = {};
#pragma unroll
        for (int s = 0; s < 4; ++s) acc = MFMA32(kf[cb][s], kf[cbp][s], acc);
        const float gcol = cbp ? gcol1 : gcol0; const int cp = 32 * cbp + r;
#pragma unroll
        for (int g = 0; g < 4; ++g) {
            const f32x4 gr = *(const LAS f32x4*)(tab + 32 * cb + 8 * g + 4 * hh), br = *(const LAS f32x4*)(tab + 64 + 32 * cb + 8 * g + 4 * hh);
            f32x4 v;
#pragma unroll
            for (int j = 0; j < 4; ++j) { const int c = 32 * cb + 8 * g + 4 * hh + j; v[j] = (cp < c) ? br[j] * acc[4 * g + j] * __expf(gr[j] - gcol) : 0.f; }
            *(LAS f32x4*)(LT + cp * 68 + 32 * cb + 8 * g + 4 * hh) = v;
        }
    }
#ifndef DN_NO_QK
#pragma unroll
    for (int tile = 0; tile < 3; ++tile) {
        const int cb = tile == 0 ? 0 : 1, cbp = tile == 2 ? 1 : 0;
        f32x16 acc = {};
#pragma unroll
        for (int s = 0; s < 4; ++s) acc = MFMA32(kf[cbp][s], qf[cb][s], acc);
        const float gcc = cb ? gcol1 : gcol0; const int c = 32 * cb + r;
#pragma unroll
        for (int g = 0; g < 4; ++g) {
            const f32x4 gr = *(const LAS f32x4*)(tab + 32 * cbp + 8 * g + 4 * hh);
#pragma unroll
            for (int j = 0; j < 4; ++j) { const int cp = 32 * cbp + 8 * g + 4 * hh + j; acc[4 * g + j] = (cp <= c) ? 0.125f * acc[4 * g + j] * __expf(gcc - gr[j]) : 0.f; }
        }
#pragma unroll
        for (int s = 0; s < 2; ++s) *(bf16x8*)(QKm + c * 64 + 32 * cbp + 16 * s + 8 * hh) = pack_regs(acc, s);
    }
    if (hh == 0) { *(v4u*)(QKm + r * 64 + 32) = (v4u){0u, 0u, 0u, 0u}; *(v4u*)(QKm + r * 64 + 40) = (v4u){0u, 0u, 0u, 0u}; *(v4u*)(QKm + r * 64 + 48) = (v4u){0u, 0u, 0u, 0u}; *(v4u*)(QKm + r * 64 + 56) = (v4u){0u, 0u, 0u, 0u}; }
#endif
    LDS_WAIT();
#ifndef DN_NO_T
    {
        float t[64]; float zero_ = 0.f; asm volatile("" : "+v"(zero_));
#pragma unroll
        for (int i = 0; i < 64; ++i) t[i] = zero_;
#pragma unroll
        for (int nn = 63; nn >= 0; --nn) {
            float a0 = (lane == nn) ? 1.f : 0.f, a1 = 0.f;
            const LAS float* lrow = LT + nn * 68;
            if (nn < 63) asm volatile("" : "+v"(lrow) : "v"(t[nn < 63 ? nn + 1 : 63]));
#pragma unroll
            for (int m4 = (nn + 1) / 4; m4 < 16; ++m4) { const f32x4 lr = *(const LAS f32x4*)(lrow + 4 * m4);
                a0 -= lr[0] * t[4 * m4]; a1 -= lr[1] * t[4 * m4 + 1]; a0 -= lr[2] * t[4 * m4 + 2]; a1 -= lr[3] * t[4 * m4 + 3]; }
            t[nn] = a0 + a1;
        }
        bf16* dst = Tm + lane * 64;
#pragma unroll
        for (int q = 0; q < 8; ++q) { v4u w;
            w.x = pk2(t[swap23(8 * q + 0)], t[swap23(8 * q + 1)]); w.y = pk2(t[swap23(8 * q + 2)], t[swap23(8 * q + 3)]);
            w.z = pk2(t[swap23(8 * q + 4)], t[swap23(8 * q + 5)]); w.w = pk2(t[swap23(8 * q + 6)], t[swap23(8 * q + 7)]);
            *(v4u*)(dst + 8 * q) = w; }
    }
#endif
    LDS_WAIT();
}
__device__ __forceinline__ void phase_dn_pre(const Args& a, LAS unsigned char* lds, int vcu, int G) {
    const int tid = threadIdx.x, lane = tid & 63, wave = __builtin_amdgcn_readfirstlane(tid >> 6);
    LAS float* LT = (LAS float*)(lds + wave * 17408); LAS float* tab = (LAS float*)(lds + 139264 + wave * 512);
    for (int t = wave * G + vcu; t < 3072; t += G * NWAVES) { int l2 = lane; asm volatile("" : "+v"(l2)); dn_pre_task(a, t, LT, tab, l2); }
}

__device__ __forceinline__ void dn_scan_task(const Args& a, int wt, int lane) {
    const int chain = wt >> 1, jw = wt & 1;
    const DnChain d = dn_decode(chain);
    const int h = d.h, dir = d.dir, NC = d.T >> 6, T = d.T;
    const int r = lane & 31, hh = lane >> 5, jcol = 32 * jw + r;
    const bf16* DQ = (const bf16*)a.out;
    const bf16* VC = dir ? (const bf16*)(a.ws + WS_ODN) : DQ + (size_t)2 * MT * 512;
    const bf16* KTs = (const bf16*)(a.ws + WS_XN) + (dir ? (size_t)MT * 512 : 0) + (d.lat ? (size_t)M_CTX * 512 + (size_t)(d.b * 8 + h) * 64 * 1024 : (size_t)(d.b * 8 + h) * 64 * 256);
    bf16* OUTO = (bf16*)(a.ws + WS_M1) + (dir ? (size_t)MT * 512 : 0);
    const int RS = dir ? -1 : 1;
    f32x16 S[2];
    if (d.lat) { const float* s0 = a.in[I_ST] + ((size_t)((d.b * 2 + dir) * 8 + h) * 64) * 64 + jcol;
#pragma unroll
        for (int ib = 0; ib < 2; ++ib)
#pragma unroll
            for (int g = 0; g < 16; ++g) S[ib][g] = s0[(32 * ib + crow(g, hh)) * 64]; }
    else { S[0] = (f32x16){}; S[1] = (f32x16){}; }
    for (int n = 0; n < NC; ++n) {
        int ln = lane; asm volatile("" : "+v"(ln));
        const int r = ln & 31, hh = ln >> 5;
        const int task = d.task0 + n;
        const int taskd = (d.lat ? (d.b * 8 + h) * 16 : 512 + (d.b * 8 + h) * 4) + n;
        const int R0 = d.rowbase + (dir ? T - 1 - 64 * n : 64 * n);
        const bf16* Tm = (const bf16*)(a.ws + WS_PA) + (size_t)task * 12288 + r * 64 + 8 * hh; const bf16* QKm = Tm + 4096; const bf16* Kb = Tm + 8192;
        const float* SC = (const float*)(a.ws + WS_SC) + (size_t)task * 320 + 4 * hh;
        const bf16* vc = VC + ((size_t)(taskd * 2 + jw) * 2 * 64 + ln) * 16;
        const bf16* kt = KTs + (size_t)r * T + 64 * n + 8 * hh;
        bf16* oo = OUTO + (size_t)(taskd * 2 + jw) * 2 * 16 * 64 + ln;
        bf16x8 fk[2][4], fq[2][4]; v4u vv[2][2]; f32x4 s2[2][4];
#pragma unroll
        for (int cb = 0; cb < 2; ++cb) {
            const bf16* qp = DQ + (size_t)(R0 + (32 * cb + r) * RS) * 512 + h * 64 + 8 * hh;
#pragma unroll
            for (int k4 = 0; k4 < 4; ++k4) { fk[cb][k4] = *(const bf16x8*)(Kb + cb * 2048 + 16 * k4); fq[cb][k4] = *(const bf16x8*)(qp + 16 * k4); }
            vv[cb][0] = *(const v4u*)(vc + cb * 1024); vv[cb][1] = *(const v4u*)(vc + cb * 1024 + 8);
#pragma unroll
            for (int g = 0; g < 4; ++g) s2[cb][g] = *(const f32x4*)(SC + 128 + 32 * cb + 8 * g);
        }
        asm volatile("" ::: "memory");
        bf16x8 sb[2][2];
#pragma unroll
        for (int ib = 0; ib < 2; ++ib)
#pragma unroll
            for (int s = 0; s < 2; ++s) sb[ib][s] = pack_regs(S[ib], s);
        f32x16 X[2], o[2];
#pragma unroll
        for (int cb = 0; cb < 2; ++cb) {
            f32x16 ax, ao = {};
            { const v4u va = vv[cb][0], vb_ = vv[cb][1];
              ax = (f32x16){bflo(va.x), bfhi(va.x), bflo(va.y), bfhi(va.y), bflo(va.z), bfhi(va.z), bflo(va.w), bfhi(va.w),
                            bflo(vb_.x), bfhi(vb_.x), bflo(vb_.y), bfhi(vb_.y), bflo(vb_.z), bfhi(vb_.z), bflo(vb_.w), bfhi(vb_.w)}; }
#pragma unroll
            for (int ib = 0; ib < 2; ++ib)
#pragma unroll
                for (int s = 0; s < 2; ++s) { ax = MFMA32(fk[cb][2 * ib + s], sb[ib][s], ax); ao = MFMA32(fq[cb][2 * ib + s], sb[ib][s], ao); }
#pragma unroll
            for (int g = 0; g < 4; ++g)
#pragma unroll
                for (int j = 0; j < 4; ++j) ao[4 * g + j] *= s2[cb][g][j];
            X[cb] = ax; o[cb] = ao;
        }
        bf16x8 ft[3][2], fm[3][2], fkt[2][4]; f32x4 s3[2][4];
#pragma unroll
        for (int bl = 0; bl < 3; ++bl) { const int cb = bl == 0 ? 0 : 1, cbp = bl == 2 ? 1 : 0;
#pragma unroll
            for (int s = 0; s < 2; ++s) { ft[bl][s] = *(const bf16x8*)(Tm + cb * 2048 + 32 * cbp + 16 * s); fm[bl][s] = *(const bf16x8*)(QKm + cb * 2048 + 32 * cbp + 16 * s); } }
#pragma unroll
        for (int ib = 0; ib < 2; ++ib)
#pragma unroll
            for (int k4 = 0; k4 < 4; ++k4) fkt[ib][k4] = *(const bf16x8*)(kt + (size_t)(32 * ib) * T + 16 * k4);
#pragma unroll
        for (int cb = 0; cb < 2; ++cb)
#pragma unroll
            for (int g = 0; g < 4; ++g) s3[cb][g] = *(const f32x4*)(SC + 192 + 32 * cb + 8 * g);
        const float egl = SC[256];
        asm volatile("" ::: "memory");
        f32x16 vn[2];
        {
            bf16x8 xb[2][2];
#pragma unroll
            for (int cb = 0; cb < 2; ++cb)
#pragma unroll
                for (int s = 0; s < 2; ++s) xb[cb][s] = pack_regs(X[cb], s);
            f32x16 a0 = {}, a1 = {};
            a0 = MFMA32(ft[0][0], xb[0][0], a0); a0 = MFMA32(ft[0][1], xb[0][1], a0);
            a1 = MFMA32(ft[1][0], xb[0][0], a1); a1 = MFMA32(ft[1][1], xb[0][1], a1); a1 = MFMA32(ft[2][0], xb[1][0], a1); a1 = MFMA32(ft[2][1], xb[1][1], a1);
            vn[0] = a0; vn[1] = a1;
        }
        {
            bf16x8 vb[2][2];
#pragma unroll
            for (int cb = 0; cb < 2; ++cb)
#pragma unroll
                for (int s = 0; s < 2; ++s) vb[cb][s] = pack_regs(vn[cb], s);
            f32x16 a0 = o[0], a1 = o[1];
            a0 = MFMA32(fm[0][0], vb[0][0], a0); a0 = MFMA32(fm[0][1], vb[0][1], a0);
            a1 = MFMA32(fm[1][0], vb[0][0], a1); a1 = MFMA32(fm[1][1], vb[0][1], a1); a1 = MFMA32(fm[2][0], vb[1][0], a1); a1 = MFMA32(fm[2][1], vb[1][1], a1);
#pragma unroll
            for (int g = 0; g < 16; ++g) { oo[g * 64] = (bf16)f2bf(a0[g]); oo[(16 + g) * 64] = (bf16)f2bf(a1[g]); }
        }
        {
#pragma unroll
            for (int cb = 0; cb < 2; ++cb)
#pragma unroll
                for (int g = 0; g < 4; ++g)
#pragma unroll
                    for (int j = 0; j < 4; ++j) vn[cb][4 * g + j] *= s3[cb][g][j];
            bf16x8 vb[2][2];
#pragma unroll
            for (int cb = 0; cb < 2; ++cb)
#pragma unroll
                for (int s = 0; s < 2; ++s) vb[cb][s] = pack_regs(vn[cb], s);
#pragma unroll
            for (int ib = 0; ib < 2; ++ib) { f32x16 acc = S[ib] * egl;
#pragma unroll
                for (int cb = 0; cb < 2; ++cb)
#pragma unroll
                    for (int s = 0; s < 2; ++s) acc = MFMA32(fkt[ib][2 * cb + s], vb[cb][s], acc);
                S[ib] = acc; }
        }
    }
    if (!d.lat) { float* so = a.out + OUT_S + ((size_t)((d.b * 2 + dir) * 8 + h) * 64) * 64 + jcol;
#pragma unroll
        for (int ib = 0; ib < 2; ++ib)
#pragma unroll
            for (int g = 0; g < 16; ++g) so[(32 * ib + crow(g, hh)) * 64] = S[ib][g]; }
}
__device__ __forceinline__ void phase_dn_scan(const Args& a, int vcu, int G) {
    const int tid = threadIdx.x, lane = tid & 63, wave = __builtin_amdgcn_readfirstlane(tid >> 6);
    for (int t = wave * G + vcu; t < 1152; t += G * NWAVES) dn_scan_task(a, t, lane);
}

__device__ __forceinline__ void phase_combine(const Args& a, int vcu, int G) {
    const int tid = threadIdx.x, lane = tid & 63, wave = tid >> 6;
    const int gw = vcu * NWAVES + wave, NGW = G * NWAVES;
    const bf16* OF = (const bf16*)(a.ws + WS_M1); const bf16* OB = OF + (size_t)MT * 512;
    const bf16* P = (const bf16*)(a.ws + WS_PB); bf16* ODN = (bf16*)(a.ws + WS_ODN);
    const f32x4 n0 = *(const f32x4*)(a.in[I_DNN] + ((8 * lane) & 63)), n1 = *(const f32x4*)(a.in[I_DNN] + ((8 * lane) & 63) + 4);
    const int hd = lane >> 3, j0 = (8 * lane) & 63, jw = j0 >> 5, r0 = j0 & 31;
    for (int m = gw; m < MT; m += NGW) {
        int tt, T_, ch0;
        if (m < M_CTX) { const int b_ = m >> 8; tt = m & 255; T_ = 256; ch0 = 64 + ((b_ * 8 + hd) << 1); }
        else { const int rl = m - M_CTX; const int b_ = rl >> 10; tt = rl & 1023; T_ = 1024; ch0 = (b_ * 8 + hd) << 1; }
        v4u w[2];
#pragma unroll
        for (int dd = 0; dd < 2; ++dd) {
            const int u = dd ? T_ - 1 - tt : tt, c = u & 63;
            const int task = (m < M_CTX ? 512 + (ch0 >> 1) * 4 - 128 : (ch0 >> 1) * 16) + (u >> 6);
            const int cb = c >> 5, hh = (c >> 2) & 1, g = ((c >> 3) & 3) * 4 + (c & 3);
            w[dd] = *(const v4u*)((dd ? OB : OF) + ((size_t)((task * 2 + jw) * 2 + cb) * 16 + g) * 64 + hh * 32 + r0);
        }
        f32x4 o0 = {bflo(w[0].x) + bflo(w[1].x), bfhi(w[0].x) + bfhi(w[1].x), bflo(w[0].y) + bflo(w[1].y), bfhi(w[0].y) + bfhi(w[1].y)};
        f32x4 o1 = {bflo(w[0].z) + bflo(w[1].z), bfhi(w[0].z) + bfhi(w[1].z), bflo(w[0].w) + bflo(w[1].w), bfhi(w[0].w) + bfhi(w[1].w)};
        float ss = (o0.x * o0.x + o0.y * o0.y) + (o0.z * o0.z + o0.w * o0.w) + (o1.x * o1.x + o1.y * o1.y) + (o1.z * o1.z + o1.w * o1.w);
        ss += __shfl_xor(ss, 1); ss += __shfl_xor(ss, 2); ss += __shfl_xor(ss, 4);
        const float rstd = rsqrtf(ss * (1.f / 64.f) + 1e-6f);
        const v4u z = *(const v4u*)(P + (size_t)m * LDB_ + CB_Z + 8 * lane);
        o0 = o0 * rstd * n0; o1 = o1 * rstd * n1;
        v4u q; q.x = pk2(o0.x * silu_(bflo(z.x)), o0.y * silu_(bfhi(z.x))); q.y = pk2(o0.z * silu_(bflo(z.y)), o0.w * silu_(bfhi(z.y)));
        q.z = pk2(o1.x * silu_(bflo(z.z)), o1.y * silu_(bfhi(z.z))); q.w = pk2(o1.z * silu_(bflo(z.w)), o1.w * silu_(bfhi(z.w)));
        *(v4u*)(ODN + (size_t)m * 512 + 8 * lane) = q;
    }
}

__device__ __forceinline__ void phase_row1(const Args& a, int vcu, int G) {
    const int tid = threadIdx.x, lane = tid & 63, wave = tid >> 6;
    const int gw = vcu * NWAVES + wave, NGW = G * NWAVES;
    const float* MOD = (const float*)(a.ws + WS_MOD); const bf16* Y = (const bf16*)(a.ws + WS_ONA); const float* RSS = (const float*)(a.ws + WS_RSS1);
    bf16* XN = (bf16*)(a.ws + WS_XN);
    for (int m = gw; m < MT; m += NGW) {
        const f32x4* xr = (const f32x4*)x_row(a, m) + lane; const float* md = MOD + mod_idx(m) * 6144;
        float rs = 0.f;
        { const float rv = lane < 16 ? RSS[((size_t)(lane >> 2) * MT + m) * 4 + (lane & 3)] : 0.f;
          rs = rv; rs += __shfl_xor(rs, 1); rs += __shfl_xor(rs, 2); rs += __shfl_xor(rs, 4); rs += __shfl_xor(rs, 8); rs = __shfl(rs, 0); }
        const float rstd1 = rsqrtf(rs * (1.f / DM) + 1e-6f);
        f32x4 x1[4]; float s = 0.f;
        const v2u* yr = (const v2u*)(Y + (size_t)m * DM) + lane;
        f32x4* orow = (f32x4*)(a.out + (size_t)m * DM) + lane;
#pragma unroll
        for (int j = 0; j < 4; ++j) { const int c = (lane + 64 * j) * 4; const v2u yy = yr[64 * j];
            const f32x4 yv = {bflo(yy.x), bfhi(yy.x), bflo(yy.y), bfhi(yy.y)};
            const f32x4 g1 = *(const f32x4*)(md + 2048 + c), pw = *(const f32x4*)(a.in[I_POST1] + c);
            x1[j] = xr[64 * j] + g1 * (yv * rstd1 * pw); orow[64 * j] = x1[j];
            s += (x1[j].x * x1[j].x + x1[j].y * x1[j].y) + (x1[j].z * x1[j].z + x1[j].w * x1[j].w); }
        const float rstd2 = rsqrtf(wave_sum(s) * (1.f / DM) + 1e-6f);
        v2u* o8 = (v2u*)(XN + (size_t)m * DM) + lane;
#pragma unroll
        for (int j = 0; j < 4; ++j) { const int c = (lane + 64 * j) * 4;
            const f32x4 w = *(const f32x4*)(a.in[I_PRE2] + c), sh = *(const f32x4*)(md + 3072 + c), sc = *(const f32x4*)(md + 4096 + c);
            const f32x4 h = x1[j] * rstd2 * w * (sc + 1.0f) + sh;
            v2u o; o.x = pk2(h.x, h.y); o.y = pk2(h.z, h.w); o8[64 * j] = o; }
    }
}
__device__ __forceinline__ void phase_row2(const Args& a, int vcu, int G) {
    const int tid = threadIdx.x, lane = tid & 63, wave = tid >> 6;
    const int gw = vcu * NWAVES + wave, NGW = G * NWAVES;
    const float* MOD = (const float*)(a.ws + WS_MOD); const bf16* Fm = (const bf16*)(a.ws + WS_ONA); const float* RSS = (const float*)(a.ws + WS_RSS2);
    for (int m = gw; m < MT; m += NGW) {
        const float* md = MOD + mod_idx(m) * 6144;
        float rs = 0.f;
        { const float rv = lane < 16 ? RSS[((size_t)(lane >> 2) * MT + m) * 4 + (lane & 3)] : 0.f;
          rs = rv; rs += __shfl_xor(rs, 1); rs += __shfl_xor(rs, 2); rs += __shfl_xor(rs, 4); rs += __shfl_xor(rs, 8); rs = __shfl(rs, 0); }
        const float rstd = rsqrtf(rs * (1.f / DM) + 1e-6f);
        const v2u* fr = (const v2u*)(Fm + (size_t)m * DM) + lane;
        f32x4* orow = (f32x4*)(a.out + (size_t)m * DM) + lane;
#pragma unroll
        for (int j = 0; j < 4; ++j) { const int c = (lane + 64 * j) * 4; const v2u ff = fr[64 * j];
            const f32x4 fv = {bflo(ff.x), bfhi(ff.x), bflo(ff.y), bfhi(ff.y)};
            const f32x4 g2 = *(const f32x4*)(md + 5120 + c), pw = *(const f32x4*)(a.in[I_POST2] + c);
            orow[64 * j] = orow[64 * j] + g2 * (fv * rstd * pw); }
    }
}

constexpr int N_PHASES = 13;
__global__ void __launch_bounds__(NWAVES * 64, 2) fwd_kernel(Args args) {
    extern __shared__ __attribute__((aligned(16))) unsigned char lds_raw[];
    LAS unsigned char* lds = (LAS unsigned char*)lds_raw;
    const int tid = threadIdx.x;
    const int G = gridDim.x; const int bx = blockIdx.x; const int vcu = (G % 8 == 0) ? (bx % 8) * (G / 8) + bx / 8 : bx;
    volatile LAS unsigned* MISC = (volatile LAS unsigned*)(lds + MISC_OFF);
    for (int u = tid; u < (LDS_BYTES - LDSCTL_OFF) / 4; u += NWAVES * 64) ((LAS unsigned*)(lds + LDSCTL_OFF))[u] = 0u;
    __syncthreads();
    const int lo = args.ph_lo, hi = args.ph_hi;
    const bool one = (hi - lo) > 1;
    unsigned* ctl = (unsigned*)(args.ws + WS_CTL);
    XcdBarrier bar; bar.bar = ctl + CW_BAR; bar.x = 0; bar.st = nullptr;
    if (one) bar = xcd_barrier_post(ctl + CW_BAR, MISC + 8);
#ifndef ONLY_PHASE
#define ONLY_PHASE -1
#endif
#ifndef SKIP_MASK
#define SKIP_MASK 0
#endif
#define IN(k) ((ONLY_PHASE < 0 || ONLY_PHASE == (k)) && !((SKIP_MASK >> (k)) & 1) && lo <= (k) && (k) < hi)
#define SEAM(k) do { if (one) xcd_barrier(bar); } while (0)
    unsigned char* ws = args.ws;
    typedef pg8::bf16_t pb;

#ifndef REPEAT_MASK
#define REPEAT_MASK 0
#endif
#define REP(k) ((REPEAT_MASK >> (k)) & 1)
#define PH_INPROJ do { pg8::Gemm g{(const pb*)(ws + WS_XN), (const pb*)(ws + WS_WIN), MT, NINP, 1024}; pg8::StaticOrder S; S.init(MT, NINP, G, bx); \
        pg8::EpiInProj E{(pb*)(ws + WS_PA), (pb*)(ws + WS_PB), args.out + OUT_K, args.out + OUT_V, (float*)(ws + WS_BA), (pb*)args.out + (size_t)3 * MT * 512, (const float*)(ws + WS_ROPE)}; \
        pg8::gemm_phase<pg8::EpiInProj, pg8::StaticOrder, true, true>(lds, g, S, E); } while (0)
#define PH_MERGE do { pg8::StaticOrder S; S.init(MT, 1024, G, bx); \
        { pg8::Gemm g{(const pb*)(ws + WS_ONA), (const pb*)(ws + WS_WAO), MT, 1024, 512}; pg8::EpiGate1 E{(const pb*)(ws + WS_PB), (pb*)(ws + WS_M1)}; \
          pg8::gemm_phase<pg8::EpiGate1, pg8::StaticOrder, true, true>(lds, g, S, E); } \
        { pg8::Gemm g{(const pb*)(ws + WS_ODN), (const pb*)(ws + WS_WDO), MT, 1024, 512}; pg8::EpiGate2 E{(const pb*)(ws + WS_PB), (const pb*)(ws + WS_M1), (pb*)(ws + WS_XN)}; \
          pg8::gemm_phase<pg8::EpiGate2, pg8::StaticOrder, true, true>(lds, g, S, E); } } while (0)
#define PH_WOUT do { pg8::Gemm g{(const pb*)(ws + WS_XN), (const pb*)(ws + WS_WOUT), MT, 1024, 1024}; pg8::StaticOrder S; S.init(MT, 1024, G, bx); \
        pg8::EpiRss E{(pb*)(ws + WS_ONA), (float*)(ws + WS_RSS1)}; pg8::gemm_phase<pg8::EpiRss, pg8::StaticOrder, true, true>(lds, g, S, E); } while (0)
#define PH_FF1 do { pg8::Gemm g{(const pb*)(ws + WS_XN), (const pb*)(ws + WS_W1), MT, FF, 1024}; pg8::StaticOrder S; S.init(MT, FF, G, bx); \
        pg8::EpiRelu2 E{(pb*)(ws + WS_PA)}; pg8::gemm_phase<pg8::EpiRelu2, pg8::StaticOrder, true, true>(lds, g, S, E); } while (0)
#define PH_FF2 do { pg8::Gemm g{(const pb*)(ws + WS_PA), (const pb*)(ws + WS_W2), MT, 1024, FF}; pg8::StaticOrder S; S.init(MT, 1024, G, bx); \
        pg8::EpiRss E{(pb*)(ws + WS_ONA), (float*)(ws + WS_RSS2)}; pg8::gemm_phase<pg8::EpiRss, pg8::StaticOrder, true, true>(lds, g, S, E); } while (0)
#define RUN(k, body) do { if (IN(k)) { body; SEAM(k); if (REP(k)) { body; SEAM(k); } } } while (0)
    RUN(0, phase_prologue(args, lds, vcu, G));
    RUN(1, phase_xn(args, vcu, G));
    RUN(2, PH_INPROJ);
    RUN(3, phase_mix_a(args, lds, vcu, G));
    RUN(4, phase_dn_pre(args, lds, vcu, G));
    RUN(5, phase_dn_scan(args, vcu, G));
    RUN(6, phase_combine(args, vcu, G));
    RUN(7, PH_MERGE);
    RUN(8, PH_WOUT);
    RUN(9, phase_row1(args, vcu, G));
    RUN(10, PH_FF1);
    RUN(11, PH_FF2);
    if (IN(12)) { phase_row2(args, vcu, G); }
#undef IN
#undef SEAM
}

#ifndef MK_ONE_LAUNCH
#define MK_ONE_LAUNCH 1
#endif
extern "C" void kernel_launch(void* const* d_in, const int* in_sizes, int n_in, void* d_out, int out_size, void* d_ws, size_t ws_size, hipStream_t stream) {
    static int grid = 0;
    if (grid == 0) {
        if (n_in != 24 || ws_size < WS_END) { fprintf(stderr, "kernel_launch: unexpected n_in %d / ws %zu\n", n_in, ws_size); grid = -1; return; }
        int dev = 0, cus = 0;
        if (hipGetDevice(&dev) != hipSuccess || hipDeviceGetAttribute(&cus, hipDeviceAttributeMultiprocessorCount, dev) != hipSuccess) { grid = -1; return; }
        if (hipFuncSetAttribute((const void*)fwd_kernel, hipFuncAttributeMaxDynamicSharedMemorySize, LDS_BYTES) != hipSuccess) { fprintf(stderr, "kernel_launch: hipFuncSetAttribute failed\n"); grid = -1; return; }
        int per_cu = 0;
        if (hipOccupancyMaxActiveBlocksPerMultiprocessor(&per_cu, (const void*)fwd_kernel, NWAVES * 64, LDS_BYTES) != hipSuccess || per_cu < 1) fprintf(stderr, "kernel_launch: occupancy query says %d\n", per_cu);
        (void)hipGetLastError();
        grid = cus;
    }
    if (grid < 0) return;
    (void)hipMemsetAsync((char*)d_ws + WS_CTL, 0, CTL_ZERO_BYTES, stream);
    Args a{};
    for (int i = 0; i < 24; ++i) a.in[i] = (const float*)d_in[i];
    a.out = (float*)d_out; a.ws = (unsigned char*)d_ws;
#if MK_ONE_LAUNCH
    a.ph_lo = 0; a.ph_hi = N_PHASES;
    hipLaunchKernelGGL(fwd_kernel, dim3(grid), dim3(NWAVES * 64), LDS_BYTES, stream, a);
#else
    for (int p = 0; p < N_PHASES; ++p) { a.ph_lo = p; a.ph_hi = p + 1; hipLaunchKernelGGL(fwd_kernel, dim3(grid), dim3(NWAVES * 64), LDS_BYTES, stream, a); }
#endif
}
```

```cpp
#include <hip/hip_runtime.h>
#include <cstdio>
#include <cstdint>

constexpr int DM = 1024, M_CTX = 8192, M_LAT = 4096, MT = 12288, NIN = 5664, NINP = 5888, FF = 4096;
constexpr int LDA_ = 1536, LDB_ = 2816;
constexpr int C_Q = 0, C_K = 512, C_V = 1024, C_DN = 0, CB_Z = 32, CB_GA = 544, CB_GD = 1568;

namespace pg8 {
#define PG8_LAS __attribute__((address_space(3)))
typedef unsigned short bf16_t;
typedef short bf16x8 __attribute__((ext_vector_type(8)));
typedef float f32x4 __attribute__((ext_vector_type(4)));
typedef unsigned u32x4 __attribute__((ext_vector_type(4)));
typedef unsigned u32x2 __attribute__((ext_vector_type(2)));
constexpr int BM = 256, BK = 64, HALF = 128, HTB = HALF * BK * 2  , STAGE_BYTES = 8 * HTB, NXCD = 8, WGM = 8;

__host__ __device__ __forceinline__ int lds_byte(int r, int c) { const int st = (r >> 4) * 2 + (c >> 5), rr = r & 15, cc = c & 31, ob = rr * 64 + cc * 2; return st * 1024 + (ob ^ (((ob >> 9) & 1) << 5)); }
__host__ __device__ __forceinline__ void stage_rc(int b, int& R, int& C) { const int st = b / 1024, sb = b % 1024, swz = sb ^ (((sb >> 9) & 1) << 5); R = (st >> 1) * 16 + swz / 64; C = (st & 1) * 32 + (swz % 64) / 2; }
__host__ __device__ __forceinline__ int perm32(int rho) { const int n = rho >> 4, i = rho & 15; return 8 * (i >> 2) + 4 * n + (i & 3); }

struct Unit { int pm, pn; int k0 = 0, nt = 0; };
struct Gemm { const bf16_t* A; const bf16_t* Bt; int M, N, K; };

struct StaticOrder {
    int nM, nN, nwg, G, c;
    __host__ __device__ void init(int M, int N, int G_, int c_) { nM = M / BM; nN = N / BM; nwg = nM * nN; G = G_; c = c_; }
    __host__ __device__ bool next(int i, Unit& u) const {
        const long L = (long)i * G + c; if (L >= nwg) return false;
        int wgid = (int)L; { const int q = nwg / NXCD, r = nwg % NXCD, xcd = wgid % NXCD, off = wgid / NXCD; wgid = (xcd < r ? xcd * (q + 1) : r * (q + 1) + (xcd - r) * q) + off; }
        const int nig = WGM * nN, gid = wgid / nig, fm = gid * WGM, gsz = (nM - fm) < WGM ? (nM - fm) : WGM;
        u.pm = fm + ((wgid % nig) % gsz); u.pn = (wgid % nig) / gsz; return true;
    }
    __device__ __forceinline__ void a_ready(const Unit&) const {}
    __device__ __forceinline__ void done(const Unit&) const {}
};

struct InProjOrder : StaticOrder { unsigned* flags;
    __device__ __forceinline__ void done(const Unit& u) const {
        if (u.pn >= 6 && u.pn <= 12) { asm volatile("s_waitcnt vmcnt(0)" ::: "memory");
            if ((threadIdx.x & 63) == 0) __hip_atomic_fetch_add(flags + u.pm * 8 + (u.pn - 6), 1u, __ATOMIC_RELAXED, __HIP_MEMORY_SCOPE_AGENT); } } };

struct LimitOrder : StaticOrder { int maxi;
    __device__ __forceinline__ bool next(int i, Unit& u) const { if (i >= maxi) return false; return StaticOrder::next(i, u); } };

__device__ __forceinline__ unsigned cvt_pk_bf16(float lo, float hi) { unsigned r; asm volatile("v_cvt_pk_bf16_f32 %0, %1, %2" : "=v"(r) : "v"(lo), "v"(hi)); return r; }
__device__ __forceinline__ float bf_lo(unsigned w) { return __uint_as_float(w << 16); }
__device__ __forceinline__ float bf_hi(unsigned w) { return __uint_as_float(w & 0xffff0000u); }
__device__ __forceinline__ float sigmoidf_(float x) { return __builtin_amdgcn_rcpf(1.0f + __expf(-x)); }
__device__ __forceinline__ u32x4 pack8(const f32x4& v0, const f32x4& v1) { u32x4 w; w.x = cvt_pk_bf16(v0[0], v0[1]); w.y = cvt_pk_bf16(v0[2], v0[3]); w.z = cvt_pk_bf16(v1[0], v1[1]); w.w = cvt_pk_bf16(v1[2], v1[3]); return w; }


__device__ __forceinline__ void store16_wt(void* p, u32x4 v) { asm volatile("global_store_dwordx4 %0, %1, off sc1\n\ts_nop 2" :: "v"(p), "v"(v) : "memory"); }
struct EpiInProj {
    static constexpr bool PERM = true, AFTER_DRAIN = false;
    bf16_t* PA; bf16_t* PB; bf16_t* QK; float* ko; float* vo; float* BA; bf16_t* VT; const float* rope;
    __device__ __forceinline__ void operator()(const f32x4 (&acc)[2][2][4][2], const Unit& u, int wr, int wc, int fr, int fq) const {
        const int pn = u.pn, pm = u.pm;
        const bool lat = pm >= 32;
        const bool do_rope = lat && pn < 4;
        const bool do_kv = (!lat) && pn >= 2 && pn < 6;
        const bool do_vt = pn == 4 || pn == 5;
        const bool do_ba = pn == 12 && wc == 0;
        const int lane_hi = fq >> 1;
#pragma unroll
        for (int ai = 0; ai < 2; ++ai)
#pragma unroll
            for (int m = 0; m < 4; ++m) {
                const int row = pm * BM + ai * HALF + wr * 64 + m * 16 + fr;
#pragma unroll
                for (int bj = 0; bj < 2; ++bj) {
                    f32x4 v0 = acc[ai][bj][m][0], v1 = acc[ai][bj][m][1];
                    const int col = pn * BM + bj * HALF + wc * 32 + 8 * fq;
                    if (do_rope) {
                        const int t = (row - M_CTX) & 1023;
                        const int pos = (wc & 1) ? (t & 63) : (t >> 6);
                        const float* cp = rope + pos * 16 + 8 * (fq & 1);
                        const f32x4 c0 = *(const f32x4*)cp, c1 = *(const f32x4*)(cp + 4), s0 = *(const f32x4*)(cp + 1024), s1 = *(const f32x4*)(cp + 1028);
                        f32x4 p0, p1;
#pragma unroll
                        for (int i = 0; i < 4; ++i) { p0[i] = __shfl_xor(v0[i], 32); p1[i] = __shfl_xor(v1[i], 32); }
                        if (lane_hi) { v0 = p0 * s0 + v0 * c0; v1 = p1 * s1 + v1 * c1; }
                        else         { v0 = v0 * c0 - p0 * s0; v1 = v1 * c1 - p1 * s1; }
                    }
                    if (pn < 4) *(u32x4*)(QK + (pn >= 2 ? (size_t)MT * 512 : 0) + (size_t)row * 512 + (col & 511)) = pack8(v0, v1);
                    else if (pn >= 6 && pn < 12) store16_wt(PA + (size_t)row * LDA_ + (col - 1536), pack8(v0, v1));
                    else if (pn >= 12) *(u32x4*)(PB + (size_t)row * LDB_ + (col - 3072)) = pack8(v0, v1);
                    if (do_kv) {
                        const int hh = ((pn & 1) * 4) + bj * 2 + (wc >> 1);
                        const int d = (wc & 1) * 32 + 8 * fq;
                        float* dst = (pn < 4 ? ko : vo) + ((size_t)(pm * 8 + hh) * 256 + (row & 255)) * 64 + d;
                        *(f32x4*)dst = v0; *(f32x4*)(dst + 4) = v1;
                    }
#ifndef VT_REP
#define VT_REP 1
#endif
                    if (do_vt) for (int vtr = 0; vtr < VT_REP; ++vtr) {
                        const int hh = ((pn & 1) * 4) + bj * 2 + (wc >> 1);
                        const int d = (wc & 1) * 32 + 8 * fq;
                        size_t base; int t, T;
                        if (!lat) { t = row & 255; T = 256; base = (size_t)(pm * 8 + hh) * 64 * 256; }
                        else { const int rl = row - M_CTX; t = rl & 1023; T = 1024; base = (size_t)M_CTX * 512 + (size_t)((rl >> 10) * 8 + hh) * 64 * 1024; }
                        const int pos = (t & ~12) | ((t & 4) << 1) | ((t & 8) >> 1);
                        bf16_t* dst = VT + base + (size_t)d * T + pos;
                        const u32x4 w = pack8(v0, v1);
                        dst[0] = (bf16_t)(w.x & 0xffff); dst[(size_t)T] = (bf16_t)(w.x >> 16); dst[(size_t)2 * T] = (bf16_t)(w.y & 0xffff); dst[(size_t)3 * T] = (bf16_t)(w.y >> 16);
                        dst[(size_t)4 * T] = (bf16_t)(w.z & 0xffff); dst[(size_t)5 * T] = (bf16_t)(w.z >> 16); dst[(size_t)6 * T] = (bf16_t)(w.w & 0xffff); dst[(size_t)7 * T] = (bf16_t)(w.w >> 16);
                    }
                    if (do_ba && bj == 0) { float* dst = BA + (size_t)row * 32 + 8 * fq; store16_wt(dst, __builtin_bit_cast(u32x4, v0)); store16_wt(dst + 4, __builtin_bit_cast(u32x4, v1)); }
                }
            }
    }
};

struct EpiGate1 {
    static constexpr bool PERM = true, AFTER_DRAIN = false;
    const bf16_t* P; bf16_t* M1;
    __device__ __forceinline__ void operator()(const f32x4 (&acc)[2][2][4][2], const Unit& u, int wr, int wc, int fr, int fq) const {
        u32x4 g[2][4][2];
#pragma unroll
        for (int ai = 0; ai < 2; ++ai)
#pragma unroll
            for (int m = 0; m < 4; ++m)
#pragma unroll
                for (int bj = 0; bj < 2; ++bj) { const int row = u.pm * BM + ai * HALF + wr * 64 + m * 16 + fr, col = u.pn * BM + bj * HALF + wc * 32 + 8 * fq;
                    g[ai][m][bj] = *(const u32x4*)(P + (size_t)row * LDB_ + CB_GA + col); }
        asm volatile("" ::: "memory");
#pragma unroll
        for (int ai = 0; ai < 2; ++ai)
#pragma unroll
            for (int m = 0; m < 4; ++m) {
                const int row = u.pm * BM + ai * HALF + wr * 64 + m * 16 + fr;
#pragma unroll
                for (int bj = 0; bj < 2; ++bj) {
                    const int col = u.pn * BM + bj * HALF + wc * 32 + 8 * fq;
                    const u32x4 gg = g[ai][m][bj];
                    f32x4 v0 = acc[ai][bj][m][0], v1 = acc[ai][bj][m][1];
                    v0[0] *= sigmoidf_(bf_lo(gg.x)); v0[1] *= sigmoidf_(bf_hi(gg.x)); v0[2] *= sigmoidf_(bf_lo(gg.y)); v0[3] *= sigmoidf_(bf_hi(gg.y));
                    v1[0] *= sigmoidf_(bf_lo(gg.z)); v1[1] *= sigmoidf_(bf_hi(gg.z)); v1[2] *= sigmoidf_(bf_lo(gg.w)); v1[3] *= sigmoidf_(bf_hi(gg.w));
                    *(u32x4*)(M1 + (size_t)row * DM + col) = pack8(v0, v1);
                }
            }
    }
};
struct EpiGate2 {
    static constexpr bool PERM = true, AFTER_DRAIN = false;
    const bf16_t* P; const bf16_t* M1; bf16_t* O;
    __device__ __forceinline__ void operator()(const f32x4 (&acc)[2][2][4][2], const Unit& u, int wr, int wc, int fr, int fq) const {
#pragma unroll
        for (int ai = 0; ai < 2; ++ai) {
            u32x4 g[4][2], q[4][2];
#pragma unroll
            for (int m = 0; m < 4; ++m)
#pragma unroll
                for (int bj = 0; bj < 2; ++bj) { const int row = u.pm * BM + ai * HALF + wr * 64 + m * 16 + fr, col = u.pn * BM + bj * HALF + wc * 32 + 8 * fq;
                    g[m][bj] = *(const u32x4*)(P + (size_t)row * LDB_ + CB_GD + col); q[m][bj] = *(const u32x4*)(M1 + (size_t)row * DM + col); }
            asm volatile("" ::: "memory");
#pragma unroll
            for (int m = 0; m < 4; ++m) {
                const int row = u.pm * BM + ai * HALF + wr * 64 + m * 16 + fr;
#pragma unroll
                for (int bj = 0; bj < 2; ++bj) {
                    const int col = u.pn * BM + bj * HALF + wc * 32 + 8 * fq;
                    const u32x4 gg = g[m][bj], qq = q[m][bj];
                    f32x4 v0 = acc[ai][bj][m][0], v1 = acc[ai][bj][m][1];
                    v0[0] = bf_lo(qq.x) + v0[0] * sigmoidf_(bf_lo(gg.x)); v0[1] = bf_hi(qq.x) + v0[1] * sigmoidf_(bf_hi(gg.x)); v0[2] = bf_lo(qq.y) + v0[2] * sigmoidf_(bf_lo(gg.y)); v0[3] = bf_hi(qq.y) + v0[3] * sigmoidf_(bf_hi(gg.y));
                    v1[0] = bf_lo(qq.z) + v1[0] * sigmoidf_(bf_lo(gg.z)); v1[1] = bf_hi(qq.z) + v1[1] * sigmoidf_(bf_hi(gg.z)); v1[2] = bf_lo(qq.w) + v1[2] * sigmoidf_(bf_lo(gg.w)); v1[3] = bf_hi(qq.w) + v1[3] * sigmoidf_(bf_hi(gg.w));
                    *(u32x4*)(O + (size_t)row * DM + col) = pack8(v0, v1);
                }
            }
        }
    }
};
struct EpiRss {
    static constexpr bool PERM = true, AFTER_DRAIN = false;
    bf16_t* O; float* RSS;
    __device__ __forceinline__ void operator()(const f32x4 (&acc)[2][2][4][2], const Unit& u, int wr, int wc, int fr, int fq) const {
#pragma unroll
        for (int ai = 0; ai < 2; ++ai)
#pragma unroll
            for (int m = 0; m < 4; ++m) {
                const int row = u.pm * BM + ai * HALF + wr * 64 + m * 16 + fr;
                float s = 0.f;
#pragma unroll
                for (int bj = 0; bj < 2; ++bj) {
                    const int col = u.pn * BM + bj * HALF + wc * 32 + 8 * fq;
                    const f32x4 v0 = acc[ai][bj][m][0], v1 = acc[ai][bj][m][1];
                    s += (v0[0] * v0[0] + v0[1] * v0[1]) + (v0[2] * v0[2] + v0[3] * v0[3]) + (v1[0] * v1[0] + v1[1] * v1[1]) + (v1[2] * v1[2] + v1[3] * v1[3]);
                    *(u32x4*)(O + (size_t)row * DM + col) = pack8(v0, v1);
                }
                s += __shfl_xor(s, 16); s += __shfl_xor(s, 32);
                if (fq == 0) RSS[((size_t)u.pn * MT + row) * 4 + wc] = s;
            }
    }
};
struct EpiRelu2 {
    static constexpr bool PERM = true, AFTER_DRAIN = false;
    bf16_t* O;
    __device__ __forceinline__ void operator()(const f32x4 (&acc)[2][2][4][2], const Unit& u, int wr, int wc, int fr, int fq) const {
#pragma unroll
        for (int ai = 0; ai < 2; ++ai)
#pragma unroll
            for (int m = 0; m < 4; ++m) {
                const int row = u.pm * BM + ai * HALF + wr * 64 + m * 16 + fr;
#pragma unroll
                for (int bj = 0; bj < 2; ++bj) {
                    const int col = u.pn * BM + bj * HALF + wc * 32 + 8 * fq;
                    f32x4 v0 = acc[ai][bj][m][0], v1 = acc[ai][bj][m][1];
#pragma unroll
                    for (int i = 0; i < 4; ++i) { const float a = fmaxf(v0[i], 0.f), b = fmaxf(v1[i], 0.f); v0[i] = a * a; v1[i] = b * b; }
                    *(u32x4*)(O + (size_t)row * FF + col) = pack8(v0, v1);
                }
            }
    }
};

struct RowStats {
    float* slots;
    unsigned* cnt;
    unsigned* tmo;
    __device__ __forceinline__ void run(const f32x4 (&v)[2][2][4][2], const Unit& u, int wr, int wc, int fr, int fq, PG8_LAS unsigned char* lds, int wid, int lane) const {
        PG8_LAS float* P = (PG8_LAS float*)lds;
        PG8_LAS float* S = (PG8_LAS float*)(lds + 8192);
#pragma unroll
        for (int ai = 0; ai < 2; ++ai)
#pragma unroll
            for (int m = 0; m < 4; ++m) {
                float s = 0.f;
#pragma unroll
                for (int bj = 0; bj < 2; ++bj)
#pragma unroll
                    for (int n = 0; n < 2; ++n) { const f32x4 x = v[ai][bj][m][n]; s += (x[0] * x[0] + x[1] * x[1]) + (x[2] * x[2] + x[3] * x[3]); }
                s += __shfl_xor(s, 16); s += __shfl_xor(s, 32);
                if (fq == 0) P[(ai * HALF + wr * 64 + m * 16 + fr) * 4 + wc] = s;
            }
        asm volatile("s_waitcnt lgkmcnt(0)" ::: "memory"); __builtin_amdgcn_s_barrier(); asm volatile("" ::: "memory");
        const int row = wid * 32 + (lane & 31);
        if (lane < 32) {
            const f32x4 p = *(const PG8_LAS f32x4*)(P + row * 4);
            const float t = (p[0] + p[1]) + (p[2] + p[3]);
            __hip_atomic_store((unsigned*)slots + ((size_t)(u.pm * BM + row) * 4 + u.pn), __float_as_uint(t), __ATOMIC_RELAXED, __HIP_MEMORY_SCOPE_AGENT);
        }
        asm volatile("s_waitcnt vmcnt(0)" ::: "memory");
        if (lane == 0) __hip_atomic_fetch_add(cnt + 64 * u.pm, 1u, __ATOMIC_RELAXED, __HIP_MEMORY_SCOPE_AGENT);
        if (wid == 0) {
            const unsigned long long t0 = __builtin_amdgcn_s_memrealtime();
            for (;;) {
                if ((unsigned)__builtin_amdgcn_readfirstlane(__hip_atomic_load(cnt + 64 * u.pm, __ATOMIC_RELAXED, __HIP_MEMORY_SCOPE_AGENT)) >= 32u) break;
                if (__builtin_amdgcn_s_memrealtime() - t0 > 2000000ull) { if (lane == 0) __hip_atomic_store(tmo, 1u, __ATOMIC_RELAXED, __HIP_MEMORY_SCOPE_AGENT); break; }
                __builtin_amdgcn_s_sleep(2);
            }
            __builtin_amdgcn_fence(__ATOMIC_ACQUIRE, "agent");
        }
        asm volatile("s_waitcnt vmcnt(0) lgkmcnt(0)" ::: "memory"); __builtin_amdgcn_s_barrier(); asm volatile("" ::: "memory");
        if (lane < 32) {
            const unsigned* sl = (const unsigned*)slots + (size_t)(u.pm * BM + row) * 4; float tot = 0.f;
#pragma unroll
            for (int t = 0; t < 4; ++t) tot += __uint_as_float(__hip_atomic_load(sl + t, __ATOMIC_RELAXED, __HIP_MEMORY_SCOPE_AGENT));
            S[row] = __builtin_amdgcn_rsqf(tot * (1.0f / 1024.0f) + 1e-6f);
        }
        asm volatile("s_waitcnt lgkmcnt(0)" ::: "memory"); __builtin_amdgcn_s_barrier(); asm volatile("" ::: "memory");
    }
};
struct EpiRow1 {
    static constexpr bool PERM = false, AFTER_DRAIN = true;
    const float* xp; const float* xs; float* out; bf16_t* XN; const float* MOD; const float* post1; const float* pre2; RowStats st1, st2;
    __device__ __forceinline__ void fused(f32x4 (&acc)[2][2][4][2], const Unit& u, int wr, int wc, int fr, int fq, PG8_LAS unsigned char* lds, int wid, int lane) const {
        const PG8_LAS float* S = (const PG8_LAS float*)(lds + 8192);
        const float* md = MOD + (u.pm < 32 ? 0 : 1 + ((u.pm - 32) >> 2)) * 6144;
        const int col0 = u.pn * BM + wc * 32 + 4 * fq;
        const int row0 = u.pm * BM + wr * 64 + fr;
        const float* xbase = (row0 < M_CTX ? xp + (size_t)row0 * DM : xs + (size_t)(row0 - M_CTX) * DM) + col0;
        st1.run(acc, u, wr, wc, fr, fq, lds, wid, lane);
        float rs[2][4];
#pragma unroll
        for (int ai = 0; ai < 2; ++ai)
#pragma unroll
            for (int m = 0; m < 4; ++m) rs[ai][m] = S[ai * HALF + wr * 64 + m * 16 + fr];
#pragma unroll
        for (int bj = 0; bj < 2; ++bj)
#pragma unroll
            for (int n = 0; n < 2; ++n) { const int co = bj * HALF + n * 16, c = col0 + co;
                const f32x4 g1 = *(const f32x4*)(md + 2048 + c), pw = *(const f32x4*)(post1 + c);
                f32x4 xv[2][4];
#pragma unroll
                for (int ai = 0; ai < 2; ++ai)
#pragma unroll
                    for (int m = 0; m < 4; ++m) xv[ai][m] = *(const f32x4*)(xbase + (size_t)(ai * HALF + m * 16) * DM + co);
                asm volatile("" ::: "memory");
#pragma unroll
                for (int ai = 0; ai < 2; ++ai)
#pragma unroll
                    for (int m = 0; m < 4; ++m) { const f32x4 x1 = xv[ai][m] + g1 * (acc[ai][bj][m][n] * rs[ai][m] * pw); acc[ai][bj][m][n] = x1;
                        *(f32x4*)(out + (size_t)(row0 + ai * HALF + m * 16) * DM + c) = x1; }
                asm volatile("" ::: "memory"); }
        st2.run(acc, u, wr, wc, fr, fq, lds, wid, lane);
#pragma unroll
        for (int ai = 0; ai < 2; ++ai)
#pragma unroll
            for (int m = 0; m < 4; ++m) rs[ai][m] = S[ai * HALF + wr * 64 + m * 16 + fr];
#pragma unroll
        for (int bj = 0; bj < 2; ++bj)
#pragma unroll
            for (int n = 0; n < 2; ++n) { const int c = col0 + bj * HALF + n * 16;
                const f32x4 w = *(const f32x4*)(pre2 + c), sh = *(const f32x4*)(md + 3072 + c), sc = *(const f32x4*)(md + 4096 + c) + 1.0f;
#pragma unroll
                for (int ai = 0; ai < 2; ++ai)
#pragma unroll
                    for (int m = 0; m < 4; ++m) { const f32x4 hv = acc[ai][bj][m][n] * rs[ai][m] * w * sc + sh;
                        u32x2 o; o.x = cvt_pk_bf16(hv[0], hv[1]); o.y = cvt_pk_bf16(hv[2], hv[3]); *(u32x2*)(XN + (size_t)(row0 + ai * HALF + m * 16) * DM + c) = o; } }
    }
};
struct EpiRow2 {
    static constexpr bool PERM = false, AFTER_DRAIN = true;
    float* out; const float* MOD; const float* post2; RowStats st;
    __device__ __forceinline__ void fused(f32x4 (&acc)[2][2][4][2], const Unit& u, int wr, int wc, int fr, int fq, PG8_LAS unsigned char* lds, int wid, int lane) const {
        const PG8_LAS float* S = (const PG8_LAS float*)(lds + 8192);
        const float* md = MOD + (u.pm < 32 ? 0 : 1 + ((u.pm - 32) >> 2)) * 6144;
        const int col0 = u.pn * BM + wc * 32 + 4 * fq;
        float* obase = out + (size_t)(u.pm * BM + wr * 64 + fr) * DM + col0;
        st.run(acc, u, wr, wc, fr, fq, lds, wid, lane);
        float rs[2][4];
#pragma unroll
        for (int ai = 0; ai < 2; ++ai)
#pragma unroll
            for (int m = 0; m < 4; ++m) rs[ai][m] = S[ai * HALF + wr * 64 + m * 16 + fr];
#pragma unroll
        for (int bj = 0; bj < 2; ++bj)
#pragma unroll
            for (int n = 0; n < 2; ++n) { const int co = bj * HALF + n * 16, c = col0 + co;
                const f32x4 g2 = *(const f32x4*)(md + 5120 + c), pw = *(const f32x4*)(post2 + c);
                f32x4 xv[2][4];
#pragma unroll
                for (int ai = 0; ai < 2; ++ai)
#pragma unroll
                    for (int m = 0; m < 4; ++m) xv[ai][m] = *(const f32x4*)(obase + (size_t)(ai * HALF + m * 16) * DM + co);
                asm volatile("" ::: "memory");
#pragma unroll
                for (int ai = 0; ai < 2; ++ai)
#pragma unroll
                    for (int m = 0; m < 4; ++m) *(f32x4*)(obase + (size_t)(ai * HALF + m * 16) * DM + co) = xv[ai][m] + g2 * (acc[ai][bj][m][n] * rs[ai][m] * pw);
                asm volatile("" ::: "memory"); }
    }
};

struct SplitOrder {
    int vcu, ntm, nte;
    __device__ __forceinline__ bool next(int i, Unit& u) const {
        const int grp = vcu >> 2, j = vcu & 3;
        if (j < 3) { if (i > 0) return false; const int ti = grp * 3 + j; u.pm = ti >> 2; u.pn = ti & 3; u.k0 = 0; u.nt = ntm; return true; }
        if (i > 2) return false; { const int ti = grp * 3 + i; u.pm = ti >> 2; u.pn = ti & 3; u.k0 = ntm * 64; u.nt = nte; return true; }
    }
    __device__ __forceinline__ void a_ready(const Unit&) const {}
    __device__ __forceinline__ void done(const Unit&) const {}
};
struct EpiSplit {
    static constexpr bool PERM = true, AFTER_DRAIN = false;
    bf16_t* Fmain; bf16_t* Fextra;
    __device__ __forceinline__ void operator()(const f32x4 (&acc)[2][2][4][2], const Unit& u, int wr, int wc, int fr, int fq) const {
        bf16_t* O = u.k0 ? Fextra : Fmain;
#pragma unroll
        for (int ai = 0; ai < 2; ++ai)
#pragma unroll
            for (int m = 0; m < 4; ++m) {
                const int row = u.pm * BM + ai * HALF + wr * 64 + m * 16 + fr;
#pragma unroll
                for (int bj = 0; bj < 2; ++bj) { const int col = u.pn * BM + bj * HALF + wc * 32 + 8 * fq; *(u32x4*)(O + (size_t)row * DM + col) = pack8(acc[ai][bj][m][0], acc[ai][bj][m][1]); }
            }
    }
};

template <class Epi, class Sched, bool ALIGN_EPI = false, bool SP2 = false>
__device__ __forceinline__ void gemm_phase(PG8_LAS unsigned char* lds, const Gemm g, const Sched& S, const Epi& E) {
    const int tid = threadIdx.x, wid = __builtin_amdgcn_readfirstlane(tid >> 6), lane = tid & 63, wr = wid >> 2, wc = wid & 3, fr = lane & 15, fq = lane >> 4;
    const int K = g.K, nt = K / BK;
    unsigned voffA[2], voffB[2];
#pragma unroll
    for (int i = 0; i < 2; ++i) { int R, C; stage_rc(tid * 16 + i * 8192, R, C); const int Rb = Epi::PERM ? ((R & ~31) + perm32(R & 31)) : R;
        voffA[i] = (unsigned)(R * K + C) * 2u; voffB[i] = (unsigned)(Rb * K + C) * 2u; }
    const size_t kstep = (size_t)(BK * 2);
    const size_t hstep = (size_t)HALF * K * 2;
    const size_t tstep = 2 * hstep;
    const unsigned ldsw = (unsigned)wid * 1024u;
    const int aoff = lds_byte(wr * 64 + fr, fq * 8), boff = lds_byte(wc * 32 + fr, fq * 8);
#define PG8_SA(b, h) (((b) * 2 + (h)) * HTB)
#define PG8_SB(b, h) ((4 + (b) * 2 + (h)) * HTB)
#define PG8_STAGE(bufoff, gbase, voff) do { _Pragma("unroll") for (int _i = 0; _i < 2; ++_i) \
        __builtin_amdgcn_global_load_lds((const unsigned*)((const char*)(gbase) + (voff)[_i]), (PG8_LAS unsigned*)(lds + (bufoff) + ldsw + _i * 8192), 16, 0, 0); } while (0)
#define PG8_LDA(dst, b, h) do { _Pragma("unroll") for (int m = 0; m < 4; ++m) _Pragma("unroll") for (int k = 0; k < 2; ++k) dst[m][k] = *(const PG8_LAS bf16x8*)(lds + PG8_SA(b, h) + aoff + m * 2048 + k * 1024); } while (0)
#define PG8_LDB(dst, b, h) do { _Pragma("unroll") for (int n = 0; n < 2; ++n) _Pragma("unroll") for (int k = 0; k < 2; ++k) dst[n][k] = *(const PG8_LAS bf16x8*)(lds + PG8_SB(b, h) + boff + n * 2048 + k * 1024); } while (0)
#define PG8_MMA(ai, bj, At, Bt) do { __builtin_amdgcn_s_setprio(1); _Pragma("unroll") for (int m = 0; m < 4; ++m) _Pragma("unroll") for (int n = 0; n < 2; ++n) _Pragma("unroll") for (int k = 0; k < 2; ++k) \
        acc[ai][bj][m][n] = __builtin_amdgcn_mfma_f32_16x16x32_bf16(Bt[n][k], At[m][k], acc[ai][bj][m][n], 0, 0, 0); __builtin_amdgcn_s_setprio(0); } while (0)
#define PG8_WAIT_V(n) asm volatile("s_waitcnt vmcnt(" #n ")" ::: "memory")
#define PG8_WAIT_L(n) asm volatile("s_waitcnt lgkmcnt(" #n ")" ::: "memory")
#define PG8_BAR __builtin_amdgcn_s_barrier()
#define PG8_SCHED __builtin_amdgcn_sched_barrier(0)
    Unit cur, nxt; int ui = 0;
    if (!S.next(0, cur)) return;
    f32x4 acc[2][2][4][2];
#pragma unroll
    for (int a = 0; a < 2; ++a)
#pragma unroll
        for (int b = 0; b < 2; ++b)
#pragma unroll
            for (int m = 0; m < 4; ++m)
#pragma unroll
                for (int n = 0; n < 2; ++n) acc[a][b][m][n] = (f32x4){0.f, 0.f, 0.f, 0.f};
    bf16x8 At[4][2], B0[2][2], B1[2][2];
    const char* cA = (const char*)g.A + (size_t)cur.pm * tstep + (size_t)cur.k0 * 2; const char* cB = (const char*)g.Bt + (size_t)cur.pn * tstep + (size_t)cur.k0 * 2;
    int ntc = cur.nt ? cur.nt : nt;
    S.a_ready(cur);
    if constexpr (SP2) {
        PG8_STAGE(PG8_SB(0, 0), cB, voffB); PG8_STAGE(PG8_SB(0, 1), cB + hstep, voffB); PG8_STAGE(PG8_SA(0, 0), cA, voffA); PG8_STAGE(PG8_SA(0, 1), cA + hstep, voffA);
        if (wr == 1) PG8_BAR;
        PG8_WAIT_V(2); PG8_BAR;
        PG8_STAGE(PG8_SB(1, 0), cB + kstep, voffB); PG8_STAGE(PG8_SA(1, 0), cA + kstep, voffA); PG8_STAGE(PG8_SB(1, 1), cB + hstep + kstep, voffB);
        PG8_WAIT_V(6); PG8_BAR;
    } else {
        PG8_STAGE(PG8_SB(0, 0), cB, voffB); PG8_STAGE(PG8_SA(0, 0), cA, voffA); PG8_STAGE(PG8_SB(0, 1), cB + hstep, voffB); PG8_STAGE(PG8_SA(0, 1), cA + hstep, voffA);
        if (wr == 1) PG8_BAR;
        PG8_WAIT_V(4); PG8_BAR;
        PG8_STAGE(PG8_SB(1, 0), cB + kstep, voffB); PG8_STAGE(PG8_SA(1, 0), cA + kstep, voffA); PG8_STAGE(PG8_SB(1, 1), cB + hstep + kstep, voffB);
        PG8_WAIT_V(6); PG8_BAR;
    }
    for (;;) {
        const bool has_next = S.next(ui + 1, nxt);
        const char* nA = has_next ? (const char*)g.A + (size_t)nxt.pm * tstep + (size_t)nxt.k0 * 2 : cA; const char* nB = has_next ? (const char*)g.Bt + (size_t)nxt.pn * tstep + (size_t)nxt.k0 * 2 : cB;
        for (int t = 0; t < ntc; t += 2) {
            const bool last = (t == ntc - 2);
            const char* a1 = cA + (size_t)(t + 1) * kstep;
            const char* a2 = last ? nA : cA + (size_t)(t + 2) * kstep; const char* b2 = last ? nB : cB + (size_t)(t + 2) * kstep;
            const char* a3 = a2 + kstep; const char* b3 = b2 + kstep;
            if (last && has_next) S.a_ready(nxt);
            if constexpr (SP2) {
            PG8_LDB(B0, 0, 0); PG8_LDB(B1, 0, 1); PG8_SCHED; PG8_LDA(At, 0, 0); PG8_STAGE(PG8_SA(1, 1), a1 + hstep, voffA);
            PG8_WAIT_V(8); PG8_WAIT_L(0); PG8_BAR; PG8_MMA(0, 0, At, B0); PG8_MMA(0, 1, At, B1); PG8_BAR; PG8_SCHED;
            PG8_LDA(At, 0, 1); PG8_STAGE(PG8_SB(0, 0), b2, voffB); PG8_STAGE(PG8_SB(0, 1), b2 + hstep, voffB); PG8_STAGE(PG8_SA(0, 0), a2, voffA);
            PG8_WAIT_V(8); PG8_WAIT_L(0); PG8_BAR; PG8_MMA(1, 0, At, B0); PG8_MMA(1, 1, At, B1); PG8_BAR; PG8_SCHED;
            PG8_LDB(B0, 1, 0); PG8_LDB(B1, 1, 1); PG8_SCHED; PG8_LDA(At, 1, 0); PG8_STAGE(PG8_SA(0, 1), a2 + hstep, voffA);
            PG8_WAIT_V(8); PG8_WAIT_L(0); PG8_BAR; PG8_MMA(0, 0, At, B0); PG8_MMA(0, 1, At, B1); PG8_BAR; PG8_SCHED;
            PG8_LDA(At, 1, 1); PG8_STAGE(PG8_SB(1, 0), b3, voffB); PG8_STAGE(PG8_SB(1, 1), b3 + hstep, voffB); PG8_STAGE(PG8_SA(1, 0), a3, voffA);
            PG8_WAIT_V(8); PG8_WAIT_L(0); PG8_BAR; PG8_MMA(1, 0, At, B0); PG8_MMA(1, 1, At, B1); PG8_BAR; PG8_SCHED;
            } else {
            PG8_LDB(B0, 0, 0); PG8_SCHED; PG8_LDA(At, 0, 0); PG8_STAGE(PG8_SA(1, 1), a1 + hstep, voffA);
            PG8_WAIT_L(8); PG8_BAR; PG8_WAIT_L(0); PG8_MMA(0, 0, At, B0); PG8_BAR; PG8_SCHED;
            PG8_LDB(B1, 0, 1); PG8_STAGE(PG8_SB(0, 0), b2, voffB);
            PG8_BAR; PG8_WAIT_L(0); PG8_MMA(0, 1, At, B1); PG8_BAR;
            PG8_LDA(At, 0, 1); PG8_STAGE(PG8_SA(0, 0), a2, voffA);
            PG8_BAR; PG8_WAIT_L(0); PG8_MMA(1, 0, At, B0); PG8_BAR; PG8_SCHED;
            PG8_STAGE(PG8_SB(0, 1), b2 + hstep, voffB);
            PG8_WAIT_V(6); PG8_BAR; PG8_MMA(1, 1, At, B1); PG8_BAR;
            PG8_LDB(B0, 1, 0); PG8_SCHED; PG8_LDA(At, 1, 0); PG8_STAGE(PG8_SA(0, 1), a2 + hstep, voffA);
            PG8_WAIT_L(8); PG8_BAR; PG8_WAIT_L(0); PG8_MMA(0, 0, At, B0); PG8_BAR; PG8_SCHED;
            PG8_LDB(B1, 1, 1); PG8_STAGE(PG8_SB(1, 0), b3, voffB);
            PG8_BAR; PG8_WAIT_L(0); PG8_MMA(0, 1, At, B1); PG8_BAR;
            PG8_LDA(At, 1, 1); PG8_STAGE(PG8_SA(1, 0), a3, voffA);
            PG8_BAR; PG8_WAIT_L(0); PG8_MMA(1, 0, At, B0); PG8_BAR; PG8_SCHED;
            PG8_STAGE(PG8_SB(1, 1), b3 + hstep, voffB);
            PG8_WAIT_V(6); PG8_BAR; PG8_MMA(1, 1, At, B1); PG8_BAR;
            }
        }
        if constexpr (ALIGN_EPI) { if (wr == 0) PG8_BAR; }
        if constexpr (!Epi::AFTER_DRAIN) { E(acc, cur, wr, wc, fr, fq); S.done(cur); }
        if (!has_next) break;
#pragma unroll
        for (int a = 0; a < 2; ++a)
#pragma unroll
            for (int b = 0; b < 2; ++b)
#pragma unroll
                for (int m = 0; m < 4; ++m)
#pragma unroll
                    for (int n = 0; n < 2; ++n) acc[a][b][m][n] = (f32x4){0.f, 0.f, 0.f, 0.f};
        cur = nxt; cA = nA; cB = nB; ++ui; ntc = cur.nt ? cur.nt : nt;
        if constexpr (ALIGN_EPI) { if (wr == 1) PG8_BAR; }
    }
    PG8_WAIT_V(0);
    if constexpr (!ALIGN_EPI) { if (wr == 0) PG8_BAR; }
    PG8_BAR;
    if constexpr (Epi::AFTER_DRAIN) { E.fused(acc, cur, wr, wc, fr, fq, lds, wid, lane); S.done(cur); }
#undef PG8_SA
#undef PG8_SB
#undef PG8_STAGE
#undef PG8_LDA
#undef PG8_LDB
#undef PG8_MMA
#undef PG8_WAIT_V
#undef PG8_WAIT_L
#undef PG8_BAR
#undef PG8_SCHED
}
}

constexpr int NWAVES = 8;
constexpr size_t MiB = 1u << 20;
constexpr size_t WS_CTL = 0, CTL_ZERO_BYTES = 128 * 1024;
constexpr size_t WS_MOD = 1 * MiB;
constexpr size_t WS_ROPE = 1 * MiB + 256 * 1024;
constexpr size_t WS_CORD = 1 * MiB + 512 * 1024;
constexpr size_t WS_BA = 2 * MiB;
constexpr size_t WS_RSS1 = 4 * MiB, WS_RSS2 = 5 * MiB;
constexpr size_t WS_WIN = 6 * MiB, WS_WAO = 18 * MiB, WS_WDO = 19 * MiB, WS_WOUT = 20 * MiB, WS_W1 = 22 * MiB, WS_W2 = 30 * MiB;
constexpr size_t WS_XN = 38 * MiB;
constexpr size_t WS_ONA = 62 * MiB, WS_ODN = 74 * MiB;
constexpr size_t WS_KT = 134 * MiB;
constexpr int REC_SPLIT = 1228;
constexpr size_t WS_PA = 86 * MiB;
constexpr size_t WS_PB = 158 * MiB;
constexpr size_t WS_SC = 250 * MiB;
constexpr size_t WS_M1 = 224 * MiB;
constexpr size_t WS_CK = 248 * MiB, WS_CVT = 249 * MiB;
constexpr size_t WS_END = 256 * MiB;
constexpr size_t OUT_YP = 0, OUT_YS = (size_t)M_CTX * DM, OUT_K = (size_t)MT * DM, OUT_V = OUT_K + (size_t)32 * 8 * 256 * 64, OUT_S = OUT_V + (size_t)32 * 8 * 256 * 64;

constexpr int CW_BAR = 1024;
constexpr int CW_TMO = 8, CW_ADA = 64, CW_CQ = 96, CW_TF = 512, CW_SEAM = 8192, SEAM_BANK = 48 * 64;
constexpr int RING_BYTES = 131072, LDS_BYTES = 147456, LDSCTL_OFF = LDS_BYTES - 1024, MISC_OFF = LDSCTL_OFF + 320;

#define GAS __attribute__((address_space(1)))
#define LAS __attribute__((address_space(3)))
typedef unsigned short bf16;
typedef unsigned v4u __attribute__((ext_vector_type(4)));
typedef unsigned v2u __attribute__((ext_vector_type(2)));
typedef float f32x4 __attribute__((ext_vector_type(4)));
typedef float f32x16 __attribute__((ext_vector_type(16)));
typedef short bf16x8 __attribute__((ext_vector_type(8)));
#define LDS_WAIT() asm volatile("s_waitcnt lgkmcnt(0)" ::: "memory")
#define VM_WAIT() asm volatile("s_waitcnt vmcnt(0)" ::: "memory")
#define MFMA32(a, b, c) __builtin_amdgcn_mfma_f32_32x32x16_bf16((a), (b), (c), 0, 0, 0)
__device__ __forceinline__ unsigned f2bf(float f) { unsigned u = __builtin_bit_cast(unsigned, f); return (u + 0x7fffu + ((u >> 16) & 1u)) >> 16; }
typedef float f32x2_t __attribute__((ext_vector_type(2))); typedef __bf16 bf16x2_t __attribute__((ext_vector_type(2)));
__device__ __forceinline__ unsigned pk2(float lo, float hi) { f32x2_t v = {lo, hi}; bf16x2_t b = __builtin_convertvector(v, bf16x2_t); return __builtin_bit_cast(unsigned, b); }
__device__ __forceinline__ float bflo(unsigned w) { return __uint_as_float(w << 16); }
__device__ __forceinline__ float bfhi(unsigned w) { return __uint_as_float(w & 0xffff0000u); }
__device__ __forceinline__ float silu_(float x) { return x * __builtin_amdgcn_rcpf(1.0f + __expf(-x)); }
__device__ __forceinline__ float sigm_(float x) { return __builtin_amdgcn_rcpf(1.0f + __expf(-x)); }
__device__ __host__ __forceinline__ constexpr int swap23(int x) { return (x & ~12) | ((x & 4) << 1) | ((x & 8) >> 1); }
__device__ __forceinline__ int crow(int reg, int h) { return (reg & 3) + 8 * (reg >> 2) + 4 * h; }
template <int CTRL, int ROWMASK> __device__ __forceinline__ float dpp_add(float v) {
    return v + __builtin_bit_cast(float, __builtin_amdgcn_update_dpp(0, __builtin_bit_cast(int, v), CTRL, ROWMASK, 0xF, false));
}
__device__ __forceinline__ float wave_sum_dpp(float v) {
    v = dpp_add<0xB1, 0xF>(v);
    v = dpp_add<0x4E, 0xF>(v);
    v = dpp_add<0x141, 0xF>(v);
    v = dpp_add<0x140, 0xF>(v);
    v = dpp_add<0x142, 0xA>(v);
    v = dpp_add<0x143, 0xC>(v);
    return __builtin_bit_cast(float, __builtin_amdgcn_readlane(__builtin_bit_cast(int, v), 63));
}
__device__ __forceinline__ float wave_sum(float v) {
#pragma unroll
    for (int o = 1; o < 64; o <<= 1) v += __shfl_xor(v, o);
    return v;
}

#define XB_TMO      128
#define XB_XCNT(j)  (256  + 64 * (j))
#define XB_XSUB(j)  (1280 + 64 * (j))
#define XB_XGEN(j)  (2304 + 64 * (j))
#define XB_TOP      3328
#define XB_TOPGEN   3392
#define XCD_BAR_WORDS 3456
#define XB_SPIN_CAP (1u << 22)

__device__ __forceinline__ unsigned xb_ld(unsigned* p)              { return __hip_atomic_load(p, __ATOMIC_RELAXED, __HIP_MEMORY_SCOPE_AGENT); }
__device__ __forceinline__ unsigned xb_add(unsigned* p, unsigned v) { return __hip_atomic_fetch_add(p, v, __ATOMIC_RELAXED, __HIP_MEMORY_SCOPE_AGENT); }
__device__ __forceinline__ unsigned xb_xcc_id() { return (unsigned)__builtin_amdgcn_s_getreg((3 << 11) | 20) & 0xFu; }
#define XB_SPIN(cond, bar) do { unsigned _sp = 0; while (cond) { __builtin_amdgcn_s_sleep(1); \
    if ((++_sp & 255u) == 0u) { if (xb_ld(&(bar)[XB_TMO])) break; if (_sp > XB_SPIN_CAP) { atomicAdd(&(bar)[XB_TMO], 1u); break; } } } } while (0)

struct XcdBarrier { unsigned* bar; unsigned x; volatile LAS unsigned* st; };

__device__ __forceinline__ XcdBarrier xcd_barrier_post(unsigned* bar, volatile LAS unsigned* st) {
    XcdBarrier b; b.bar = bar; b.x = xb_xcc_id(); b.st = st;
    if (threadIdx.x == 0) (void)xb_add(&bar[XB_XCNT(b.x)], 1u);
    return b;
}
__device__ __forceinline__ void xcd_barrier_complete(unsigned* bar, unsigned x, unsigned& nloc, unsigned& nx) {
    const unsigned G = gridDim.x * gridDim.y * gridDim.z;
    unsigned sum, cnt, mine, sp = 0u;
    for (;;) {
        sum = 0u; cnt = 0u; mine = 0u;
#pragma unroll
        for (unsigned j = 0; j < 16; ++j) { const unsigned c = xb_ld(&bar[XB_XCNT(j)]); sum += c; cnt += (c > 0u) ? 1u : 0u; mine = (j == x) ? c : mine; }
        if (sum == G) break;
        __builtin_amdgcn_s_sleep(1);
        if ((++sp & 255u) == 0u) { if (xb_ld(&bar[XB_TMO])) break; if (sp > XB_SPIN_CAP) { atomicAdd(&bar[XB_TMO], 1u); break; } }
    }
    nloc = mine > 0u ? mine : 1u; nx = cnt > 0u ? cnt : 1u;
}
__device__ __forceinline__ void xcd_barrier(const XcdBarrier& b) {
    asm volatile("s_waitcnt vmcnt(0)" ::: "memory");
    __syncthreads();
    if (threadIdx.x == 0) {
        unsigned* bar = b.bar;
        __builtin_amdgcn_s_waitcnt(0);
        unsigned nloc = b.st[0], nx = b.st[1];
        if (nloc == 0u) { xcd_barrier_complete(bar, b.x, nloc, nx); b.st[0] = nloc; b.st[1] = nx; }
        const unsigned old = xb_add(&bar[XB_XSUB(b.x)], 1u);
        const unsigned gen = old / nloc;
        if (old + 1u == (gen + 1u) * nloc) {
            __builtin_amdgcn_fence(__ATOMIC_RELEASE, "agent");
            asm volatile("s_waitcnt vmcnt(0)" ::: "memory");
            const unsigned og = xb_add(&bar[XB_TOP], 1u);
            const unsigned tg = og / nx;
            if (og + 1u == (tg + 1u) * nx) xb_add(&bar[XB_TOPGEN], 1u);
            else XB_SPIN(xb_ld(&bar[XB_TOPGEN]) == tg, bar);
            __builtin_amdgcn_fence(__ATOMIC_ACQUIRE, "agent");
            xb_add(&bar[XB_XGEN(b.x)], 1u);
            asm volatile("s_waitcnt vmcnt(0)" ::: "memory");
        } else {
            XB_SPIN(xb_ld(&bar[XB_XGEN(b.x)]) == gen, bar);
            __builtin_amdgcn_fence(__ATOMIC_ACQUIRE, "agent");
            asm volatile("s_waitcnt vmcnt(0)" ::: "memory");
        }
    }
    __syncthreads();
}

struct Args { const float* in[24]; float* out; unsigned char* ws; int ph_lo, ph_hi; };
enum { I_XP = 0, I_XS, I_C, I_CK, I_CV, I_ST, I_CCTX, I_WADA, I_BADA, I_PRE1, I_POST1, I_PRE2, I_POST2, I_WIN, I_CONVW, I_ALOG, I_DTB, I_DNN, I_RPB, I_WAO, I_WDO, I_WOUT, I_WFF1, I_WFF2 };

__device__ __forceinline__ void p0_transpose_item(const float* W, int K, int N, bf16* WT, LAS float* scr, int item, int lane) {
    const int nblk = N / 32, kb = item / nblk, nb = item % nblk, k0 = 64 * kb, n0 = 32 * nb;
#pragma unroll 8
    for (int i = 0; i < 32; ++i) { const int kk = 2 * i + (lane >> 5); scr[kk * 33 + (lane & 31)] = W[(size_t)(k0 + kk) * N + n0 + (lane & 31)]; }
    LDS_WAIT();
    const int c = lane & 7;
#pragma unroll
    for (int j = 0; j < 4; ++j) { const int n = (lane >> 3) + 8 * j; const LAS float* s = scr + (8 * c) * 33 + n;
        v4u o; o.x = pk2(s[0 * 33], s[1 * 33]); o.y = pk2(s[2 * 33], s[3 * 33]); o.z = pk2(s[4 * 33], s[5 * 33]); o.w = pk2(s[6 * 33], s[7 * 33]);
        *(v4u*)(WT + (size_t)(n0 + n) * K + k0 + 8 * c) = o; }
    LDS_WAIT();
}

__device__ __forceinline__ void phase_prologue(const Args& a, LAS unsigned char* lds, int vcu, int G) {
    const int tid = threadIdx.x, lane = tid & 63, wave = __builtin_amdgcn_readfirstlane(tid >> 6);
    unsigned char* ws = a.ws;
    if (vcu < 192) {
        LAS float* sl = (LAS float*)lds;
        LAS float* red = (LAS float*)(lds + 20480);
        for (int i = tid; i < 5 * 1024; i += 512) { const float v = i < 1024 ? a.in[I_CCTX][i] : a.in[I_C][i - 1024]; sl[i] = silu_(v); }
        __syncthreads();
        const int col = 32 * vcu + (lane & 31), rg = wave * 2 + (lane >> 5);
        const float* w = a.in[I_WADA] + (size_t)(rg * 64) * 6144 + col;
        float acc[5] = {0.f, 0.f, 0.f, 0.f, 0.f};
#pragma unroll 8
        for (int i = 0; i < 64; ++i) { const float wv = w[(size_t)i * 6144]; const int k = rg * 64 + i;
#pragma unroll
            for (int v = 0; v < 5; ++v) acc[v] += sl[v * 1024 + k] * wv; }
#pragma unroll
        for (int v = 0; v < 5; ++v) red[(rg * 5 + v) * 32 + (lane & 31)] = acc[v];
        __syncthreads();
        if (tid < 160) { const int v = tid >> 5, cl = tid & 31; float s = a.in[I_BADA][32 * vcu + cl];
            for (int r = 0; r < 16; ++r) s += red[(r * 5 + v) * 32 + cl];
            ((float*)(ws + WS_MOD))[v * 6144 + 32 * vcu + cl] = s; }
        asm volatile("s_waitcnt vmcnt(0)" ::: "memory");
        __syncthreads();
        if (tid == 0) { __builtin_amdgcn_fence(__ATOMIC_RELEASE, "agent"); asm volatile("s_waitcnt vmcnt(0)" ::: "memory");
            __hip_atomic_fetch_add((unsigned*)(ws + WS_CTL) + CW_ADA, 1u, __ATOMIC_RELAXED, __HIP_MEMORY_SCOPE_AGENT); }
    } else if (vcu == 192) {
        float* rope = (float*)(ws + WS_ROPE);
        for (int i = tid; i < 1024; i += 512) { const int pos = i >> 4, f = i & 15; const float inv = powf(10000.0f, -(float)f / 16.0f); const float ang = (float)pos * inv; rope[i] = cosf(ang); rope[1024 + i] = sinf(ang); }
    } else if (vcu < 225) {
        const int bh = vcu - 193;
        const float* ck = a.in[I_CK] + (size_t)bh * 256 * 64; const float* cv = a.in[I_CV] + (size_t)bh * 256 * 64;
        bf16* CK = (bf16*)(ws + WS_CK) + (size_t)bh * 256 * 64; bf16* CVT = (bf16*)(ws + WS_CVT) + (size_t)bh * 64 * 256;
        for (int i = tid; i < 256 * 8; i += 512) { const int key = i >> 3, c8 = i & 7;
            const f32x4 k0 = *(const f32x4*)(ck + key * 64 + c8 * 8), k1 = *(const f32x4*)(ck + key * 64 + c8 * 8 + 4);
            v4u o; o.x = pk2(k0[0], k0[1]); o.y = pk2(k0[2], k0[3]); o.z = pk2(k1[0], k1[1]); o.w = pk2(k1[2], k1[3]);
            *(v4u*)(CK + key * 64 + c8 * 8) = o;
            const f32x4 v0 = *(const f32x4*)(cv + key * 64 + c8 * 8), v1 = *(const f32x4*)(cv + key * 64 + c8 * 8 + 4);
            const int pos = (key & ~12) | ((key & 4) << 1) | ((key & 8) >> 1);
#pragma unroll
            for (int j = 0; j < 4; ++j) { CVT[(c8 * 8 + j) * 256 + pos] = (bf16)f2bf(v0[j]); CVT[(c8 * 8 + 4 + j) * 256 + pos] = (bf16)f2bf(v1[j]); }
        }
    }
    if (vcu == G - 1) {
        LAS unsigned char* late = (LAS unsigned char*)(lds + 8192); LAS unsigned char* dep = late + 512;
        for (int i = tid; i < 384; i += 512) late[i] = 0;
        __syncthreads();
        { pg8::StaticOrder S; S.init(MT, NINP, G, tid); const int lastr = (S.nwg - 1) / G; pg8::Unit u;
          if (tid < G && S.next(lastr, u) && u.pn >= 6 && u.pn <= 12) late[u.pm * 8 + u.pn - 6] = 1; }
        __syncthreads();
        for (int g = tid; g < 576; g += 512) { const int chunk = g / 3, part = g - 3 * chunk, pm = chunk >> 2;
            int dd = late[pm * 8 + 2 * part] | late[pm * 8 + 2 * part + 1];
            if (part == 2) dd |= late[pm * 8 + 6];
            if (pm >= 32) { const int kc = (chunk - 128) & 15;
                if ((chunk & 3) == 0 && kc != 0) dd |= late[(pm - 1) * 8 + 2 * part] | late[(pm - 1) * 8 + 2 * part + 1];
                if ((chunk & 3) == 3 && kc != 15) dd |= late[(pm + 1) * 8 + 2 * part] | late[(pm + 1) * 8 + 2 * part + 1]; }
            dep[g] = (unsigned char)dd; }
        __syncthreads();
        for (int g = tid; g < 576; g += 512) { int before_same = 0, n_early = 0; const int mine = dep[g];
            for (int j = 0; j < 576; ++j) { const int dj = dep[j]; n_early += (dj == 0); before_same += (j < g && dj == mine); }
            ((unsigned*)(ws + WS_CORD))[mine ? n_early + before_same : before_same] = (unsigned)g; }
        __syncthreads();
    }
    LAS float* scr = (LAS float*)(lds + 32768 + wave * 8704);
    const int gw = vcu * NWAVES + wave, NGW = G * NWAVES;
    constexpr int I_IN = 16 * 177, I_AO = 8 * 32, I_DO = 8 * 32;
    constexpr int NITEMS = I_IN + I_AO + I_DO;
    for (int it = gw; it < NITEMS; it += NGW) {
        int r = it;
        if (r < I_IN) { p0_transpose_item(a.in[I_WIN], 1024, NIN, (bf16*)(ws + WS_WIN), scr, r, lane); continue; } r -= I_IN;
        if (r < I_AO) { p0_transpose_item(a.in[I_WAO], 512, 1024, (bf16*)(ws + WS_WAO), scr, r, lane); continue; } r -= I_AO;
        p0_transpose_item(a.in[I_WDO], 512, 1024, (bf16*)(ws + WS_WDO), scr, r, lane);
    }
    { v4u* z = (v4u*)((bf16*)(ws + WS_WIN) + (size_t)NIN * 1024); const int n16 = (NINP - NIN) * 1024 * 2 / 16;
      for (int i = gw * 64 + lane; i < n16; i += NGW * 64) z[i] = (v4u){0u, 0u, 0u, 0u}; }
    if (wave == 0) {
        unsigned* cnt = (unsigned*)(ws + WS_CTL) + CW_ADA; const unsigned want = (unsigned)(G < 192 ? G : 192); unsigned sp = 0;
        while ((unsigned)__builtin_amdgcn_readfirstlane(__hip_atomic_load(cnt, __ATOMIC_RELAXED, __HIP_MEMORY_SCOPE_AGENT)) < want) { __builtin_amdgcn_s_sleep(2); if (++sp > (1u << 22)) break; }
        __builtin_amdgcn_fence(__ATOMIC_ACQUIRE, "agent");
        asm volatile("s_waitcnt vmcnt(0)" ::: "memory");
    }
    __syncthreads();
}

__device__ __forceinline__ void late_transposes(const Args& a, LAS unsigned char* lds, int idle_idx, int n_idle) {
    const int tid = threadIdx.x, lane = tid & 63, wave = __builtin_amdgcn_readfirstlane(tid >> 6);
    LAS float* scr = (LAS float*)(lds + wave * 8704);
    constexpr int I_OUT = 16 * 32, I_1 = 16 * 128, I_2 = 64 * 32;
    for (int it = idle_idx * NWAVES + wave; it < I_OUT + I_1 + I_2; it += n_idle * NWAVES) {
        int r = it;
        if (r < I_OUT) { p0_transpose_item(a.in[I_WOUT], 1024, 1024, (bf16*)(a.ws + WS_WOUT), scr, r, lane); continue; } r -= I_OUT;
        if (r < I_1) { p0_transpose_item(a.in[I_WFF1], 1024, FF, (bf16*)(a.ws + WS_W1), scr, r, lane); continue; } r -= I_1;
        p0_transpose_item(a.in[I_WFF2], FF, 1024, (bf16*)(a.ws + WS_W2), scr, r, lane);
    }
}

__device__ __forceinline__ const float* x_row(const Args& a, int m) { return m < M_CTX ? a.in[I_XP] + (size_t)m * DM : a.in[I_XS] + (size_t)(m - M_CTX) * DM; }
__device__ __forceinline__ int mod_idx(int m) { return m < M_CTX ? 0 : 1 + ((m - M_CTX) >> 10); }

__device__ __forceinline__ void phase_xn(const Args& a, int vcu, int G) {
    const int tid = threadIdx.x, lane = tid & 63, wave = tid >> 6;
    const int gw = vcu * NWAVES + wave, NGW = G * NWAVES;
    const float* MOD = (const float*)(a.ws + WS_MOD); bf16* XN = (bf16*)(a.ws + WS_XN);
    constexpr int R = 3;
    for (int mb = gw; mb < MT; mb += R * NGW) {
        f32x4 v[R][4];
#pragma unroll
        for (int r = 0; r < R; ++r) { const int m = min(mb + r * NGW, MT - 1); const f32x4* xr = (const f32x4*)x_row(a, m) + lane;
#pragma unroll
            for (int j = 0; j < 4; ++j) v[r][j] = xr[64 * j]; }
        asm volatile("" ::: "memory");
#pragma unroll
        for (int r = 0; r < R; ++r) { const int m = mb + r * NGW; if (m >= MT) break;
            const float* md = MOD + mod_idx(m) * 6144;
            float s = 0.f;
#pragma unroll
            for (int j = 0; j < 4; ++j) s += (v[r][j].x * v[r][j].x + v[r][j].y * v[r][j].y) + (v[r][j].z * v[r][j].z + v[r][j].w * v[r][j].w);
            const float rstd = rsqrtf(wave_sum(s) * (1.f / DM) + 1e-6f);
            v2u* o8 = (v2u*)(XN + (size_t)m * DM) + lane;
#pragma unroll
            for (int j = 0; j < 4; ++j) { const int c = (lane + 64 * j) * 4;
                const f32x4 w = *(const f32x4*)(a.in[I_PRE1] + c), sh = *(const f32x4*)(md + c), sc = *(const f32x4*)(md + 1024 + c);
                const f32x4 h = v[r][j] * rstd * w * (sc + 1.0f) + sh;
                v2u o; o.x = pk2(h.x, h.y); o.y = pk2(h.z, h.w); o8[64 * j] = o; }
        }
    }
}

__device__ __forceinline__ bf16x8 pack_regs(const f32x16& p, int s) {
    v4u w; w.x = pk2(p[8 * s], p[8 * s + 1]); w.y = pk2(p[8 * s + 2], p[8 * s + 3]); w.z = pk2(p[8 * s + 4], p[8 * s + 5]); w.w = pk2(p[8 * s + 6], p[8 * s + 7]);
    return __builtin_bit_cast(bf16x8, w);
}
__device__ __forceinline__ void store_o(bf16* dst, const f32x16& o0, const f32x16& o1, float inv, int hh) {
#pragma unroll
    for (int g = 0; g < 4; ++g) {
        v2u w0, w1; w0.x = pk2(o0[4 * g] * inv, o0[4 * g + 1] * inv); w0.y = pk2(o0[4 * g + 2] * inv, o0[4 * g + 3] * inv);
        w1.x = pk2(o1[4 * g] * inv, o1[4 * g + 1] * inv); w1.y = pk2(o1[4 * g + 2] * inv, o1[4 * g + 3] * inv);
        *(v2u*)(dst + 8 * g + 4 * hh) = w0; *(v2u*)(dst + 32 + 8 * g + 4 * hh) = w1;
    }
}
constexpr float LOG2E = 1.4426950408889634f;

struct AttnTile { const bf16* k; const bf16* v0; const bf16* v1; };
template <bool LAT>
__device__ __forceinline__ void attn_task(const Args& a, int task, int lane, LAS float* wl) {
    const int r = lane & 31, hh = lane >> 5;
    const bf16* Qb = (const bf16*)(a.ws + WS_M1); const bf16* Kbuf = Qb + (size_t)MT * 512; bf16* ONA = (bf16*)(a.ws + WS_ONA);
    int b, h, rowq, gr = 0, cq = 0;
    if (LAT) { const int half = task & 1; gr = (task >> 1) & 15; h = (task >> 5) & 7; b = task >> 8; cq = 32 * half + r; rowq = M_CTX + b * 1024 + gr * 64 + cq; }
    else { const int qb = task & 7; h = (task >> 3) & 7; b = task >> 6; rowq = b * 256 + qb * 32 + r; }
    constexpr int NT = LAT ? 24 : 8;
    const int rs = LAT ? min(max(gr - 4, 0), 8) : 0;
    LAS unsigned char* lk = (LAS unsigned char*)wl; LAS unsigned char* lv = lk + 4096; LAS float* rpb = wl + 2048;
    int boff[2][16];
    LDS_WAIT();
    if (LAT) {
#pragma unroll
        for (int i = 0; i < 4; ++i) { const int idx = lane + 64 * i, kk = idx >> 5, j = idx & 31; rpb[idx] = j < 31 ? a.in[I_RPB][h * 465 + (rs - gr + 7 + kk) * 31 + j] * LOG2E : -1.0e30f; }
        const int cs_ = min(max(cq - 8, 0), 48);
#pragma unroll
        for (int ct = 0; ct < 2; ++ct)
#pragma unroll
            for (int i = 0; i < 16; ++i) { const int kc = ct * 32 + crow(i, hh); boff[ct][i] = (kc >= cs_ && kc < cs_ + 16) ? kc - cq + 15 : 31; } }
    const int kro = lane >> 3, kch = lane & 7, vro = lane >> 2, vch = lane & 3;
    const bf16* gKl = Kbuf + (size_t)(LAT ? M_CTX + b * 1024 : b * 256) * 512 + h * 64 + (size_t)kro * 512 + kch * 8;
    const bf16* gVl = (const bf16*)a.out + (size_t)3 * MT * 512 + (LAT ? (size_t)M_CTX * 512 + (size_t)(b * 8 + h) * 64 * 1024 : (size_t)(b * 8 + h) * 64 * 256) + (size_t)vro * (LAT ? 1024 : 256) + vch * 8;
    const bf16* gKc = (const bf16*)(a.ws + WS_CK) + (size_t)(b * 8 + h) * 256 * 64 + kro * 64 + kch * 8;
    const bf16* gVc = (const bf16*)(a.ws + WS_CVT) + (size_t)(b * 8 + h) * 64 * 256 + vro * 256 + vch * 8;
    v4u gk[4], gv[4];
#define AT_GLOAD(t_) do { const int tt_ = (t_); \
        if (LAT && tt_ < 8) { _Pragma("unroll") for (int i_ = 0; i_ < 4; ++i_) { gk[i_] = *(const v4u*)(gKc + (size_t)(tt_ * 32 + 8 * i_) * 64); gv[i_] = *(const v4u*)(gVc + (size_t)(16 * i_) * 256 + 32 * tt_); } } \
        else { const int tk_ = LAT ? (rs + ((tt_ - 8) >> 1)) * 64 + ((tt_ - 8) & 1) * 32 : 32 * tt_; \
            _Pragma("unroll") for (int i_ = 0; i_ < 4; ++i_) { gk[i_] = *(const v4u*)(gKl + (size_t)(tk_ + 8 * i_) * 512); gv[i_] = *(const v4u*)(gVl + (size_t)(16 * i_) * (LAT ? 1024 : 256) + tk_); } } } while (0)
    const int kwoff = kro * 128 + ((kch ^ (kro & 7)) << 4);
    const int vwoff = vro * 64 + ((vch ^ ((vro >> 2) & 3)) << 4);
#define AT_LWRITE() do { _Pragma("unroll") for (int i_ = 0; i_ < 4; ++i_) { *(LAS v4u*)(lk + kwoff + i_ * 1024) = gk[i_]; *(LAS v4u*)(lv + vwoff + i_ * 1024) = gv[i_]; } } while (0)
    const int kroff = r * 128, ksw = r & 7, vsw = (r >> 2) & 3;
    bf16x8 kf[4], vf[4];
#define AT_LREAD() do { _Pragma("unroll") for (int s_ = 0; s_ < 4; ++s_) kf[s_] = *(const LAS bf16x8*)(lk + kroff + (((2 * s_ + hh) ^ ksw) << 4)); \
        _Pragma("unroll") for (int q_ = 0; q_ < 4; ++q_) vf[q_] = *(const LAS bf16x8*)(lv + (32 * (q_ >> 1) + r) * 64 + (((2 * (q_ & 1) + hh) ^ vsw) << 4)); } while (0)
    bf16x8 qf[4];
    { const bf16* Pq = Qb + (size_t)rowq * 512 + h * 64 + 8 * hh;
#pragma unroll
      for (int s = 0; s < 4; ++s) qf[s] = *(const bf16x8*)(Pq + 16 * s); }
    float m = -3.0e38f, l = 0.f; f32x16 o0 = {}, o1 = {};
    const float sc = 0.125f * LOG2E;
#define AT_SOFTPV() \
        float tm = S[0]; _Pragma("unroll") for (int i = 1; i < 16; ++i) tm = fmaxf(tm, S[i]); \
        tm = fmaxf(tm, __shfl_xor(tm, 32)); \
        if (__any(tm > m)) { const float mn = fmaxf(m, tm); const float al = __builtin_amdgcn_exp2f(m - mn); m = mn; l *= al; o0 = o0 * al; o1 = o1 * al; }     \
        float ps = 0.f; _Pragma("unroll") for (int i = 0; i < 16; ++i) { S[i] = __builtin_amdgcn_exp2f(S[i] - m); ps += S[i]; } \
        l += ps; \
        const bf16x8 p0_ = pack_regs(S, 0), p1_ = pack_regs(S, 1); \
        o0 = MFMA32(vf[0], p0_, o0); o0 = MFMA32(vf[1], p1_, o0); o1 = MFMA32(vf[2], p0_, o1); o1 = MFMA32(vf[3], p1_, o1);
#define AT_STEP(t_, LOCAL_) do { AT_LREAD(); AT_GLOAD(min((t_) + 1, NT - 1)); \
        f32x16 S = {}; _Pragma("unroll") for (int s_ = 0; s_ < 4; ++s_) S = MFMA32(kf[s_], qf[s_], S); \
        if (LOCAL_) { const int tl_ = (t_) - 8; const LAS float* rp_ = rpb + (tl_ >> 1) * 32; \
            if (tl_ & 1) { _Pragma("unroll") for (int i = 0; i < 16; ++i) S[i] = S[i] * sc + rp_[boff[1][i]]; } \
            else { _Pragma("unroll") for (int i = 0; i < 16; ++i) S[i] = S[i] * sc + rp_[boff[0][i]]; } } \
        else { _Pragma("unroll") for (int i = 0; i < 16; ++i) S[i] *= sc; } \
        AT_SOFTPV() \
        AT_LWRITE(); } while (0)
    AT_GLOAD(0); AT_LWRITE();
    if (LAT) {
        for (int t = 0; t < 8; ++t) AT_STEP(t, false);
        for (int t = 8; t < NT; ++t) AT_STEP(t, true);
    } else {
        for (int t = 0; t < NT; ++t) AT_STEP(t, false);
    }
#undef AT_GLOAD
#undef AT_LWRITE
#undef AT_LREAD
#undef AT_SOFTPV
#undef AT_STEP
    l += __shfl_xor(l, 32);
    store_o(ONA + (size_t)rowq * 512 + h * 64, o0, o1, 1.0f / l, hh);
    LDS_WAIT();
}

__device__ __forceinline__ void conv_task(const Args& a, int task, int lane, LAS unsigned char* wl) {
    const int hd = task & 7, part = (task >> 3) % 3, chunk = task / 24, r0 = chunk * 64;
    const bf16* P = (const bf16*)(a.ws + WS_PA);
    int seq0, T_, sb_;
    if (r0 < M_CTX) { seq0 = r0 & ~255; T_ = 256; sb_ = (r0 >> 8) * 8 + hd; } else { seq0 = M_CTX + ((r0 - M_CTX) & ~1023); T_ = 1024; sb_ = ((r0 - M_CTX) >> 10) * 8 + hd; }
    const int seq1 = seq0 + T_, kc = (r0 - seq0) >> 6, NC = T_ >> 6;
    const int ch = part * 512 + hd * 64 + lane;
    float w[5];
#pragma unroll
    for (int t = 0; t < 5; ++t) w[t] = a.in[I_CONVW][t * 1536 + ch];
    const bf16* src = P + C_DN + ch;
    float x[68];
    {
        unsigned raw[68];
#pragma unroll
        for (int i = 0; i < 68; ++i) { const int row = r0 - 2 + i; const int rc = min(max(row, seq0), seq1 - 1); raw[i] = src[(size_t)rc * LDA_]; }
        asm volatile("" ::: "memory");
#pragma unroll
        for (int i = 0; i < 68; ++i) { const int row = r0 - 2 + i; x[i] = (row >= seq0 && row < seq1) ? bflo(raw[i]) : 0.f; }
    }
    float o[64];
#pragma unroll
    for (int rr = 0; rr < 64; ++rr) { const float v = w[0] * x[rr] + w[1] * x[rr + 1] + w[2] * x[rr + 2] + w[3] * x[rr + 3] + w[4] * x[rr + 4]; o[rr] = silu_(v); }
    if (part < 2) {
#pragma unroll
        for (int rr = 0; rr < 64; ++rr) { const float ss = wave_sum_dpp(o[rr] * o[rr]); o[rr] *= __builtin_amdgcn_rsqf(ss + 1e-6f); }
        const int p = swap23(lane), pc = p >> 3, pe = (p & 7) * 2;
#pragma unroll
        for (int rr = 0; rr < 64; ++rr) *(LAS bf16*)(wl + rr * 128 + ((pc ^ (rr & 7)) << 4) + pe) = (bf16)f2bf(o[rr]);
        LDS_WAIT();
        const int fr_ = lane & 31, fh_ = lane >> 5;
        bf16* dst = (bf16*)a.out + (size_t)part * MT * 512 + (size_t)((r0 < M_CTX ? 512 + sb_ * 4 : sb_ * 16) + kc) * 4096 + lane * 8;
#pragma unroll
        for (int f = 0; f < 8; ++f) { const int row = 32 * (f >> 2) + fr_; *(v4u*)(dst + f * 512) = *(const LAS v4u*)(wl + row * 128 + (((2 * (f & 3) + fh_) ^ (row & 7)) << 4)); }
        LDS_WAIT();
    }
    if (part == 1) {
        const int td0 = (r0 < M_CTX ? 512 + sb_ * 4 : sb_ * 16), ib = lane >> 5, rl = lane & 31;
        bf16* ktf = (bf16*)(a.ws + WS_KT) + (size_t)(td0 + kc) * 4096 + ib * 2048 + rl * 8;
        bf16* ktb = (bf16*)(a.ws + WS_KT) + (size_t)MT * 512 + (size_t)(td0 + NC - 1 - kc) * 4096 + ib * 2048 + rl * 8;
#pragma unroll
        for (int q = 0; q < 8; ++q) { v4u wf, wb;
            wf.x = pk2(o[swap23(8 * q + 0)], o[swap23(8 * q + 1)]); wf.y = pk2(o[swap23(8 * q + 2)], o[swap23(8 * q + 3)]); wf.z = pk2(o[swap23(8 * q + 4)], o[swap23(8 * q + 5)]); wf.w = pk2(o[swap23(8 * q + 6)], o[swap23(8 * q + 7)]);
            wb.x = pk2(o[63 - swap23(8 * q + 0)], o[63 - swap23(8 * q + 1)]); wb.y = pk2(o[63 - swap23(8 * q + 2)], o[63 - swap23(8 * q + 3)]); wb.z = pk2(o[63 - swap23(8 * q + 4)], o[63 - swap23(8 * q + 5)]); wb.w = pk2(o[63 - swap23(8 * q + 6)], o[63 - swap23(8 * q + 7)]);
            const int off = (q >> 1) * 512 + (q & 1) * 256;
            *(v4u*)(ktf + off) = wf; *(v4u*)(ktb + off) = wb; }
    }
    if (part == 2) {
        const int jw = lane >> 5, r = lane & 31;
        const int td0 = (r0 < M_CTX ? 512 + sb_ * 4 : sb_ * 16);
        const float* BA = (const float*)(a.ws + WS_BA) + (size_t)(r0 + lane) * 32 + hd;
        const float bet[2] = {sigm_(BA[0]), sigm_(BA[8])};
#pragma unroll
        for (int dd = 0; dd < 2; ++dd) {
            float ov[64];
#pragma unroll
            for (int rr = 0; rr < 64; ++rr) ov[rr] = o[rr] * __builtin_bit_cast(float, __builtin_amdgcn_readlane(__builtin_bit_cast(int, bet[dd]), rr));
            const int taskd = td0 + (dd ? NC - 1 - kc : kc);
            bf16* base = (dd ? (bf16*)(a.ws + WS_ODN) : (bf16*)a.out + (size_t)2 * MT * 512) + ((size_t)(taskd * 2 + jw) * 2 * 64 + r) * 16;
#pragma unroll
            for (int cb = 0; cb < 2; ++cb)
#pragma unroll
                for (int hh = 0; hh < 2; ++hh) { v4u w0, w1;
#define CV(g_) ov[dd ? 63 - (32 * cb + crow((g_), hh)) : (32 * cb + crow((g_), hh))]
                    w0.x = pk2(CV(0), CV(1)); w0.y = pk2(CV(2), CV(3)); w0.z = pk2(CV(4), CV(5)); w0.w = pk2(CV(6), CV(7));
                    w1.x = pk2(CV(8), CV(9)); w1.y = pk2(CV(10), CV(11)); w1.z = pk2(CV(12), CV(13)); w1.w = pk2(CV(14), CV(15));
#undef CV
                    bf16* dp = base + (size_t)(cb * 64 + hh * 32) * 16; *(v4u*)dp = w0; *(v4u*)(dp + 8) = w1; }
        }
    }
}

__device__ __forceinline__ void conv_wait(const unsigned* tf, int g, int lane) {
    const int chunk = g / 3, part = g - 3 * chunk, pm = chunk >> 2;
    int pmh = -1;
    if (pm >= 32) { const int kc = (chunk - 128) & 15; if ((chunk & 3) == 0 && kc != 0) pmh = pm - 1; if ((chunk & 3) == 3 && kc != 15) pmh = pm + 1; }
    int idx = -1;
    if (lane < 2) idx = pm * 8 + 2 * part + lane;
    else if (lane < 4) idx = pmh < 0 ? -1 : pmh * 8 + 2 * part + (lane - 2);
    else if (lane == 4) idx = part == 2 ? pm * 8 + 6 : -1;
    unsigned sp = 0;
    for (;;) {
        unsigned v = 8u;
        if (idx >= 0) v = __hip_atomic_load(tf + idx, __ATOMIC_RELAXED, __HIP_MEMORY_SCOPE_AGENT);
        if (__ballot(v < 8u) == 0ull) break;
        __builtin_amdgcn_s_sleep(8); if (++sp > (1u << 20)) break;
    }
    __builtin_amdgcn_fence(__ATOMIC_ACQUIRE, "agent");
}
__device__ __forceinline__ void phase_conv(const Args& a, LAS unsigned char* lds, int vcu, int G) {
    const int tid = threadIdx.x, wave = __builtin_amdgcn_readfirstlane(tid >> 6);
    unsigned* ctl = (unsigned*)(a.ws + WS_CTL); const unsigned* tf = ctl + CW_TF; const unsigned* order = (const unsigned*)(a.ws + WS_CORD);
    LAS int* qslot = (LAS int*)(lds + 65536);
    int nx = 0;
    if (tid == 0) nx = (int)__hip_atomic_fetch_add(ctl + CW_CQ, 1u, __ATOMIC_RELAXED, __HIP_MEMORY_SCOPE_AGENT);
    for (;;) {
        if (tid == 0) *qslot = nx;
        __syncthreads();
        const int rk = *qslot;
        if (rk >= 576) break;
        const int g = __builtin_amdgcn_readfirstlane((int)order[rk]);
        if (wave == 0) conv_wait(tf, g, tid);
        __syncthreads();
        if (tid == 0) nx = (int)__hip_atomic_fetch_add(ctl + CW_CQ, 1u, __ATOMIC_RELAXED, __HIP_MEMORY_SCOPE_AGENT);
        { int lane = tid & 63; asm volatile("" : "+v"(lane)); conv_task(a, g * 8 + wave, lane, lds + wave * 8192); }
    }
}

__device__ __forceinline__ bf16* rec_ptr(unsigned char* ws, int task) { return task < REC_SPLIT ? (bf16*)(ws + WS_XN) + (size_t)task * 10240 : (bf16*)(ws + WS_PA) + (size_t)(task - REC_SPLIT) * 10240; }
struct DnChain { int b, h, dir, T, rowbase, task0; bool lat; };
__device__ __forceinline__ DnChain dn_decode(int chain) {
    DnChain d; d.lat = chain < 64;
    if (d.lat) { d.b = chain >> 4; d.h = (chain >> 1) & 7; d.dir = chain & 1; d.T = 1024; d.rowbase = M_CTX + d.b * 1024; d.task0 = chain * 16; }
    else { const int c = chain - 64; d.b = c >> 4; d.h = (c >> 1) & 7; d.dir = c & 1; d.T = 256; d.rowbase = d.b * 256; d.task0 = 1024 + c * 4; }
    return d;
}

__device__ __forceinline__ void dn_pre_task(const Args& a, int task, LAS float* LT, LAS float* tab, int lane) {
    int chain, n;
    if (task < 1024) { chain = task >> 4; n = task & 15; } else { const int t2 = task - 1024; chain = 64 + (t2 >> 2); n = t2 & 3; }
    const DnChain d = dn_decode(chain);
    const int h = d.h, dir = d.dir;
    const bf16* DQ = (const bf16*)a.out; const bf16* DK = DQ + (size_t)MT * 512;
    const float* BA = (const float*)(a.ws + WS_BA);
    bf16* rec = rec_ptr(a.ws, task); bf16* Tm = rec; bf16* QKm = rec + 3072; bf16* Kb = rec + 6144;
    float* SC = (float*)(a.ws + WS_SC) + (size_t)task * 320;
    const int R0 = d.rowbase + (dir ? d.T - 1 - 64 * n : 64 * n), RS = dir ? -1 : 1;
    const int r = lane & 31, hh = lane >> 5;
    {
        const float* ba = BA + (size_t)(R0 + lane * RS) * 32;
        const float beta = sigm_(ba[dir * 8 + h]);
        const float xx = ba[16 + dir * 8 + h] + a.in[I_DTB][dir * 8 + h];
        const float sp = xx > 20.f ? xx : log1pf(__expf(xx));
        float gc = -__expf(a.in[I_ALOG][dir * 8 + h]) * sp;
#pragma unroll
        for (int o = 1; o < 64; o <<= 1) { const float t = __shfl_up(gc, o); if (lane >= o) gc += t; }
        const float gl = __shfl(gc, 63);
        const float eg = __expf(gc);
        SC[lane] = beta; SC[64 + lane] = beta * eg; SC[128 + lane] = 0.125f * eg; SC[192 + lane] = __expf(gl - gc); SC[256 + lane] = __expf(gl);
        LDS_WAIT();
        tab[lane] = gc; tab[64 + lane] = beta;
        LDS_WAIT();
    }
    bf16x8 kf[2][4], qf[2][4];
    { const int gF = (d.lat ? (d.b * 8 + h) * 16 : 512 + (d.b * 8 + h) * 4) + (dir ? (d.T >> 6) - 1 - n : n);
      const size_t fo = (size_t)gF * 4096 + (dir ? (hh * 32 + 31 - r) : lane) * 8;
#pragma unroll
      for (int cb = 0; cb < 2; ++cb)
#pragma unroll
        for (int s = 0; s < 4; ++s) { const size_t o_ = fo + ((dir ? 1 - cb : cb) * 4 + s) * 512; kf[cb][s] = *(const bf16x8*)(DK + o_); qf[cb][s] = *(const bf16x8*)(DQ + o_); } }
    asm volatile("" ::: "memory");
    const float gcol0 = tab[r], gcol1 = tab[32 + r];
#pragma unroll
    for (int cb = 0; cb < 2; ++cb) { const float coef = -tab[64 + 32 * cb + r] * __expf(cb ? gcol1 : gcol0);
#pragma unroll
        for (int s = 0; s < 4; ++s) { const v4u kw = __builtin_bit_cast(v4u, kf[cb][s]); v4u ow;
            ow.x = pk2(bflo(kw.x) * coef, bfhi(kw.x) * coef); ow.y = pk2(bflo(kw.y) * coef, bfhi(kw.y) * coef); ow.z = pk2(bflo(kw.z) * coef, bfhi(kw.z) * coef); ow.w = pk2(bflo(kw.w) * coef, bfhi(kw.w) * coef);
            *(v4u*)(Kb + (4 * cb + s) * 512 + lane * 8) = ow; } }
#pragma unroll
    for (int tile = 0; tile < 3; tile += 2) {
        const int cb = tile == 0 ? 0 : 1, cbp = cb;
        f32x16 acc = {};
#pragma unroll
        for (int s = 0; s < 4; ++s) acc = MFMA32(kf[cb][s], kf[cbp][s], acc);
        const float gcol = cbp ? gcol1 : gcol0; const int cp = 32 * cbp + r;
#pragma unroll
        for (int g = 0; g < 4; ++g) {
            const f32x4 gr = *(const LAS f32x4*)(tab + 32 * cb + 8 * g + 4 * hh), br = *(const LAS f32x4*)(tab + 64 + 32 * cb + 8 * g + 4 * hh);
            f32x4 v;
#pragma unroll
            for (int j = 0; j < 4; ++j) { const int c = 32 * cb + 8 * g + 4 * hh + j; v[j] = (cp < c) ? br[j] * acc[4 * g + j] * __expf(gr[j] - gcol) : 0.f; }
            *(LAS f32x4*)(LT + cp * 68 + 32 * cb + 8 * g + 4 * hh) = v;
        }
    }
    bf16x8 l21[2];
    {
        f32x16 acc = {};
#pragma unroll
        for (int s = 0; s < 4; ++s) acc = MFMA32(kf[0][s], kf[1][s], acc);
        const float bb = tab[96 + r];
#pragma unroll
        for (int g = 0; g < 4; ++g) { const f32x4 ga = *(const LAS f32x4*)(tab + 8 * g + 4 * hh);
#pragma unroll
            for (int j = 0; j < 4; ++j) acc[4 * g + j] = bb * acc[4 * g + j] * __expf(gcol1 - ga[j]); }
        l21[0] = pack_regs(acc, 0); l21[1] = pack_regs(acc, 1);
    }
#pragma unroll
    for (int tile = 0; tile < 3; ++tile) {
        const int cb = tile == 0 ? 0 : 1, cbp = tile == 2 ? 1 : 0;
        f32x16 acc = {};
#pragma unroll
        for (int s = 0; s < 4; ++s) acc = MFMA32(kf[cbp][s], qf[cb][s], acc);
        const float gcc = cb ? gcol1 : gcol0; const int c = 32 * cb + r;
#pragma unroll
        for (int g = 0; g < 4; ++g) {
            const f32x4 gr = *(const LAS f32x4*)(tab + 32 * cbp + 8 * g + 4 * hh);
#pragma unroll
            for (int j = 0; j < 4; ++j) { const int cp = 32 * cbp + 8 * g + 4 * hh + j; acc[4 * g + j] = (cp <= c) ? 0.125f * acc[4 * g + j] * __expf(gcc - gr[j]) : 0.f; }
        }
#pragma unroll
        for (int s = 0; s < 2; ++s) *(bf16x8*)(QKm + (2 * tile + s) * 512 + lane * 8) = pack_regs(acc, s);
    }
    LDS_WAIT();
    {
        float tb[32]; float zero_ = 0.f; asm volatile("" : "+v"(zero_));
#pragma unroll
        for (int i = 0; i < 32; ++i) tb[i] = zero_;
        const int bI = lane >> 5, rl = lane & 31;
        const LAS float* LTb = LT + (32 * bI) * 68 + 32 * bI;
#pragma unroll
        for (int nn = 31; nn >= 0; --nn) {
            float a0 = (rl == nn) ? 1.f : 0.f, a1 = 0.f;
            const LAS float* lrow = LTb + nn * 68;
            if (nn < 30) asm volatile("" : "+v"(lrow) : "v"(tb[nn < 30 ? nn + 2 : 31]));
#pragma unroll
            for (int m4 = (nn + 1) / 4; m4 < 8; ++m4) { const f32x4 lr = *(const LAS f32x4*)(lrow + 4 * m4);
                a0 -= lr[0] * tb[4 * m4]; a1 -= lr[1] * tb[4 * m4 + 1]; a0 -= lr[2] * tb[4 * m4 + 2]; a1 -= lr[3] * tb[4 * m4 + 3]; }
            tb[nn] = a0 + a1;
        }
        { bf16* dst = Tm + (lane < 32 ? 0 : 4 * 512) + rl * 8;
#pragma unroll
          for (int q = 0; q < 4; ++q) { v4u w;
              w.x = pk2(tb[swap23(8 * q + 0)], tb[swap23(8 * q + 1)]); w.y = pk2(tb[swap23(8 * q + 2)], tb[swap23(8 * q + 3)]);
              w.z = pk2(tb[swap23(8 * q + 4)], tb[swap23(8 * q + 5)]); w.w = pk2(tb[swap23(8 * q + 6)], tb[swap23(8 * q + 7)]);
              *(v4u*)(dst + (q >> 1) * 512 + (q & 1) * 256) = w; } }
        LDS_WAIT();
        LAS float* TT = LT;
#pragma unroll
        for (int q = 0; q < 8; ++q) *(LAS f32x4*)(TT + lane * 36 + 4 * q) = (f32x4){tb[4 * q], tb[4 * q + 1], tb[4 * q + 2], tb[4 * q + 3]};
        LDS_WAIT();
        bf16x8 b11[2], t22[2];
#pragma unroll
        for (int s = 0; s < 2; ++s) {
            float c11[8];
#pragma unroll
            for (int j = 0; j < 8; ++j) c11[j] = TT[(16 * s + 8 * (j >> 2) + 4 * hh + (j & 3)) * 36 + r];
            const f32x4 ra = *(const LAS f32x4*)(TT + (32 + r) * 36 + 16 * s + 4 * hh), rb = *(const LAS f32x4*)(TT + (32 + r) * 36 + 16 * s + 8 + 4 * hh);
            v4u w1, w2;
            w1.x = pk2(c11[0], c11[1]); w1.y = pk2(c11[2], c11[3]); w1.z = pk2(c11[4], c11[5]); w1.w = pk2(c11[6], c11[7]);
            w2.x = pk2(ra[0], ra[1]); w2.y = pk2(ra[2], ra[3]); w2.z = pk2(rb[0], rb[1]); w2.w = pk2(rb[2], rb[3]);
            b11[s] = __builtin_bit_cast(bf16x8, w1); t22[s] = __builtin_bit_cast(bf16x8, w2);
        }
        f32x16 W = {};
        W = MFMA32(l21[0], b11[0], W); W = MFMA32(l21[1], b11[1], W);
        const bf16x8 wp0 = pack_regs(W, 0), wp1 = pack_regs(W, 1);
        f32x16 X = {};
        X = MFMA32(wp0, t22[0], X); X = MFMA32(wp1, t22[1], X);
#pragma unroll
        for (int g = 0; g < 16; ++g) X[g] = -X[g];
#pragma unroll
        for (int s = 0; s < 2; ++s) *(bf16x8*)(Tm + (2 + s) * 512 + lane * 8) = pack_regs(X, s);
    }
    LDS_WAIT();
}
__device__ __forceinline__ void phase_attn_pre(const Args& a, LAS unsigned char* lds, int vcu, int G) {
    const int tid = threadIdx.x, wave = __builtin_amdgcn_readfirstlane(tid >> 6);
    LAS float* LT = (LAS float*)(lds + wave * 17408); LAS float* tab = (LAS float*)(lds + 139264 + wave * 512);
#define MIX_LANE() int lane = tid & 63; asm volatile("" : "+v"(lane))
    if (G == 256) {
#ifndef AP_REP_A
#define AP_REP_A 1
#endif
#ifndef AP_REP_P
#define AP_REP_P 1
#endif
        if (vcu < 128) { for (int q = 0; q < AP_REP_A; ++q) { MIX_LANE(); attn_task<true>(a, vcu * 8 + wave, lane, LT); } for (int q = 0; q < AP_REP_P; ++q) { MIX_LANE(); dn_pre_task(a, vcu * 8 + wave, LT, tab, lane); } }
        else { const int j = vcu - 128;
            for (int q = 0; q < AP_REP_A; ++q) { MIX_LANE(); attn_task<false>(a, j * 8 + wave, lane, LT); } for (int q = 0; q < AP_REP_P; ++q) { MIX_LANE(); dn_pre_task(a, 1024 + j * 8 + wave, LT, tab, lane); }
            for (int q = 0; q < AP_REP_A; ++q) { MIX_LANE(); attn_task<false>(a, (j + 128) * 8 + wave, lane, LT); } for (int q = 0; q < AP_REP_P; ++q) { MIX_LANE(); dn_pre_task(a, 2048 + j * 8 + wave, LT, tab, lane); } }
    } else {
        for (int t = wave * G + vcu; t < 1024 + 2048 + 3072; t += G * NWAVES) { MIX_LANE();
            if (t < 1024) attn_task<true>(a, t, lane, LT); else if (t < 3072) attn_task<false>(a, t - 1024, lane, LT); else dn_pre_task(a, t - 3072, LT, tab, lane); }
    }
#undef MIX_LANE
}

__device__ __forceinline__ void dn_scan_task(const Args& a, int wt, int lane) {
    const int chain = wt >> 1, jw = wt & 1;
    const DnChain d = dn_decode(chain);
    const int h = d.h, dir = d.dir, NC = d.T >> 6, T = d.T;
    const int r = lane & 31, hh = lane >> 5, jcol = 32 * jw + r;
    const bf16* DQ = (const bf16*)a.out;
    const bf16* VC = dir ? (const bf16*)(a.ws + WS_ODN) : DQ + (size_t)2 * MT * 512;
    const bf16* KTs = (const bf16*)(a.ws + WS_KT) + (dir ? (size_t)MT * 512 : 0);
    bf16* OUTO = dir ? (bf16*)(a.ws + WS_W1) : (bf16*)a.out + (size_t)3 * MT * 512;
    const int RS = dir ? -1 : 1;
    f32x16 S[2];
    if (d.lat) { const float* s0 = a.in[I_ST] + ((size_t)((d.b * 2 + dir) * 8 + h) * 64) * 64 + jcol;
#pragma unroll
        for (int ib = 0; ib < 2; ++ib)
#pragma unroll
            for (int g = 0; g < 16; ++g) S[ib][g] = s0[(32 * ib + crow(g, hh)) * 64]; }
    else { S[0] = (f32x16){}; S[1] = (f32x16){}; }
    for (int n = 0; n < NC; ++n) {
        int ln = lane; asm volatile("" : "+v"(ln));
        const int r = ln & 31, hh = ln >> 5;
        const int task = d.task0 + n;
        const int taskd = (d.lat ? (d.b * 8 + h) * 16 : 512 + (d.b * 8 + h) * 4) + n;
        const int R0 = d.rowbase + (dir ? T - 1 - 64 * n : 64 * n);
        const bf16* rec = rec_ptr(a.ws, task) + ln * 8; const bf16* Tm = rec; const bf16* QKm = rec + 3072; const bf16* Kb = rec + 6144;
        const float* SC = (const float*)(a.ws + WS_SC) + (size_t)task * 320 + 4 * hh;
        const bf16* vc = VC + ((size_t)(taskd * 2 + jw) * 2 * 64 + ln) * 16;
        const bf16* kt = KTs + (size_t)taskd * 4096 + ln * 8;
        bf16* oo = OUTO + (size_t)(taskd * 2 + jw) * 2 * 16 * 64 + ln;
        const bf16* qbase = DQ + (size_t)((d.lat ? (d.b * 8 + h) * 16 : 512 + (d.b * 8 + h) * 4) + (dir ? NC - 1 - n : n)) * 4096 + (dir ? (hh * 32 + 31 - r) : ln) * 8;
        const int qo0 = dir ? 2048 : 0, qo1 = dir ? 0 : 2048;
        bf16x8 fk[2][4], fq[2][4]; v4u vv[2][2]; f32x4 s2[2][4];
#pragma unroll
        for (int cb = 0; cb < 2; ++cb) {
            const bf16* qp = qbase + (cb ? qo1 : qo0);
#pragma unroll
            for (int k4 = 0; k4 < 4; ++k4) { fk[cb][k4] = *(const bf16x8*)(Kb + (4 * cb + k4) * 512); fq[cb][k4] = *(const bf16x8*)(qp + k4 * 512); }
            vv[cb][0] = *(const v4u*)(vc + cb * 1024); vv[cb][1] = *(const v4u*)(vc + cb * 1024 + 8);
#pragma unroll
            for (int g = 0; g < 4; ++g) s2[cb][g] = *(const f32x4*)(SC + 128 + 32 * cb + 8 * g);
        }
        asm volatile("" ::: "memory");
        bf16x8 sb[2][2];
#pragma unroll
        for (int ib = 0; ib < 2; ++ib)
#pragma unroll
            for (int s = 0; s < 2; ++s) sb[ib][s] = pack_regs(S[ib], s);
        f32x16 X[2], o[2];
#pragma unroll
        for (int cb = 0; cb < 2; ++cb) {
            f32x16 ax, ao = {};
            { const v4u va = vv[cb][0], vb_ = vv[cb][1];
              ax = (f32x16){bflo(va.x), bfhi(va.x), bflo(va.y), bfhi(va.y), bflo(va.z), bfhi(va.z), bflo(va.w), bfhi(va.w),
                            bflo(vb_.x), bfhi(vb_.x), bflo(vb_.y), bfhi(vb_.y), bflo(vb_.z), bfhi(vb_.z), bflo(vb_.w), bfhi(vb_.w)}; }
#pragma unroll
            for (int ib = 0; ib < 2; ++ib)
#pragma unroll
                for (int s = 0; s < 2; ++s) { ax = MFMA32(fk[cb][2 * ib + s], sb[ib][s], ax); ao = MFMA32(fq[cb][2 * ib + s], sb[ib][s], ao); }
#pragma unroll
            for (int g = 0; g < 4; ++g)
#pragma unroll
                for (int j = 0; j < 4; ++j) ao[4 * g + j] *= s2[cb][g][j];
            X[cb] = ax; o[cb] = ao;
        }
        bf16x8 ft[3][2], fm[3][2], fkt[2][4]; f32x4 s3[2][4];
#pragma unroll
        for (int bl = 0; bl < 3; ++bl) { const int cb = bl == 0 ? 0 : 1, cbp = bl == 2 ? 1 : 0;
#pragma unroll
            for (int s = 0; s < 2; ++s) { ft[bl][s] = *(const bf16x8*)(Tm + (2 * bl + s) * 512); fm[bl][s] = *(const bf16x8*)(QKm + (2 * bl + s) * 512); } }
#pragma unroll
        for (int ib = 0; ib < 2; ++ib)
#pragma unroll
            for (int k4 = 0; k4 < 4; ++k4) fkt[ib][k4] = *(const bf16x8*)(kt + (4 * ib + k4) * 512);
        asm volatile("" ::: "memory");
        f32x16 vn[2];
        {
            bf16x8 xb[2][2];
#pragma unroll
            for (int cb = 0; cb < 2; ++cb)
#pragma unroll
                for (int s = 0; s < 2; ++s) xb[cb][s] = pack_regs(X[cb], s);
            f32x16 a0 = {}, a1 = {};
            a0 = MFMA32(ft[0][0], xb[0][0], a0); a0 = MFMA32(ft[0][1], xb[0][1], a0);
            a1 = MFMA32(ft[1][0], xb[0][0], a1); a1 = MFMA32(ft[1][1], xb[0][1], a1); a1 = MFMA32(ft[2][0], xb[1][0], a1); a1 = MFMA32(ft[2][1], xb[1][1], a1);
            vn[0] = a0; vn[1] = a1;
        }
        {
            bf16x8 vb[2][2];
#pragma unroll
            for (int cb = 0; cb < 2; ++cb)
#pragma unroll
                for (int s = 0; s < 2; ++s) vb[cb][s] = pack_regs(vn[cb], s);
            f32x16 a0 = o[0], a1 = o[1];
            a0 = MFMA32(fm[0][0], vb[0][0], a0); a0 = MFMA32(fm[0][1], vb[0][1], a0);
            a1 = MFMA32(fm[1][0], vb[0][0], a1); a1 = MFMA32(fm[1][1], vb[0][1], a1); a1 = MFMA32(fm[2][0], vb[1][0], a1); a1 = MFMA32(fm[2][1], vb[1][1], a1);
#pragma unroll
            for (int g = 0; g < 16; ++g) { oo[g * 64] = (bf16)f2bf(a0[g]); oo[(16 + g) * 64] = (bf16)f2bf(a1[g]); }
        }
        {
#pragma unroll
            for (int cb = 0; cb < 2; ++cb)
#pragma unroll
                for (int g = 0; g < 4; ++g) s3[cb][g] = *(const f32x4*)(SC + 192 + 32 * cb + 8 * g);
            const float egl = SC[256];
#pragma unroll
            for (int cb = 0; cb < 2; ++cb)
#pragma unroll
                for (int g = 0; g < 4; ++g)
#pragma unroll
                    for (int j = 0; j < 4; ++j) vn[cb][4 * g + j] *= s3[cb][g][j];
            bf16x8 vb[2][2];
#pragma unroll
            for (int cb = 0; cb < 2; ++cb)
#pragma unroll
                for (int s = 0; s < 2; ++s) vb[cb][s] = pack_regs(vn[cb], s);
#pragma unroll
            for (int ib = 0; ib < 2; ++ib) { f32x16 acc = S[ib] * egl;
#pragma unroll
                for (int cb = 0; cb < 2; ++cb)
#pragma unroll
                    for (int s = 0; s < 2; ++s) acc = MFMA32(fkt[ib][2 * cb + s], vb[cb][s], acc);
                S[ib] = acc; }
        }
    }
    if (!d.lat) { float* so = a.out + OUT_S + ((size_t)((d.b * 2 + dir) * 8 + h) * 64) * 64 + jcol;
#pragma unroll
        for (int ib = 0; ib < 2; ++ib)
#pragma unroll
            for (int g = 0; g < 16; ++g) so[(32 * ib + crow(g, hh)) * 64] = S[ib][g]; }
}
constexpr int SL_FK = 0, SL_FQ = 8192, SL_VV = 16384, SL_SC = 20480, SL_FT = 21504, SL_FM = 27648, SL_KT = 33792, SL_BUF = 43008;
__device__ __forceinline__ void lds_dma16(const void* gsrc, unsigned lds_dst) {
    unsigned keep;
    asm volatile("s_mov_b32 %0, m0\n\ts_mov_b32 m0, %2\n\ts_nop 0\n\tglobal_load_lds_dwordx4 %1, off\n\ts_mov_b32 m0, %0" : "=&s"(keep) : "v"(gsrc), "s"(lds_dst) : "memory");
}
__device__ __forceinline__ void dn_scan_lat(const Args& a, int wt, int lane, LAS unsigned char* L) {
    const int chain = wt >> 1, jw = wt & 1;
    const DnChain d = dn_decode(chain);
    const int h = d.h, dir = d.dir; constexpr int NC = 16;
    const int r = lane & 31, hh = lane >> 5, jcol = 32 * jw + r;
    const bf16* DQ = (const bf16*)a.out;
    const bf16* VC = dir ? (const bf16*)(a.ws + WS_ODN) : DQ + (size_t)2 * MT * 512;
    const bf16* KTs = (const bf16*)(a.ws + WS_KT) + (dir ? (size_t)MT * 512 : 0);
    bf16* OUTO = dir ? (bf16*)(a.ws + WS_W1) : (bf16*)a.out + (size_t)3 * MT * 512;
    const unsigned lbase = (unsigned)__builtin_amdgcn_readfirstlane((int)(unsigned)(uintptr_t)L);
    const int td0 = (d.b * 8 + h) * 16;
    const int qlane = dir ? (hh * 32 + 31 - r) : lane, qo0 = dir ? 2048 : 0, qo1 = dir ? 0 : 2048;
    f32x16 S[2];
    { const float* s0 = a.in[I_ST] + ((size_t)((d.b * 2 + dir) * 8 + h) * 64) * 64 + jcol;
#pragma unroll
      for (int ib = 0; ib < 2; ++ib)
#pragma unroll
          for (int g = 0; g < 16; ++g) S[ib][g] = s0[(32 * ib + crow(g, hh)) * 64]; }
#define SL_RUN(p_, cnt_, stride_, ldso_) do { const bf16* pp_ = (p_); _Pragma("unroll") for (int f = 0; f < (cnt_); ++f) { lds_dma16(pp_, lb_ + (ldso_) + f * 1024); pp_ += (stride_); asm volatile("" : "+v"(pp_)); } } while (0)
#define SL_ISSUE(n_) do { const int nn_ = (n_); const unsigned lb_ = lbase + (unsigned)((nn_ & 1) * SL_BUF); const int task_ = d.task0 + nn_, taskd_ = td0 + nn_; \
        const bf16* rec_ = rec_ptr(a.ws, task_) + lane * 8; \
        const bf16* q_ = DQ + (size_t)(td0 + (dir ? NC - 1 - nn_ : nn_)) * 4096 + qlane * 8; \
        const bf16* vc_ = VC + ((size_t)(taskd_ * 2 + jw) * 2 * 64 + lane) * 16; \
        SL_RUN(rec_ + 6144, 8, 512, SL_FK); \
        SL_RUN(q_ + qo0, 4, 512, SL_FQ); SL_RUN(q_ + qo1, 4, 512, SL_FQ + 4096); \
        lds_dma16(vc_, lb_ + SL_VV); lds_dma16(vc_ + 8, lb_ + SL_VV + 1024); lds_dma16(vc_ + 1024, lb_ + SL_VV + 2048); lds_dma16(vc_ + 1032, lb_ + SL_VV + 3072); \
        lds_dma16((const float*)(a.ws + WS_SC) + (size_t)task_ * 320 + 128 + lane * 4, lb_ + SL_SC); \
        SL_RUN(rec_, 6, 512, SL_FT); SL_RUN(rec_ + 3072, 6, 512, SL_FM); \
        SL_RUN(KTs + (size_t)taskd_ * 4096 + lane * 8, 8, 512, SL_KT); } while (0)
    SL_ISSUE(0);
    for (int n = 0; n < NC; ++n) {
        asm volatile("s_waitcnt vmcnt(0) lgkmcnt(0)" ::: "memory");
        if (n + 1 < NC) SL_ISSUE(n + 1);
        const LAS unsigned char* B = L + (n & 1) * SL_BUF + lane * 16;
        const LAS unsigned char* Bs = L + (n & 1) * SL_BUF + SL_SC + hh * 16;
#define SLF(off, f) (*(const LAS bf16x8*)(B + (off) + (f) * 1024))
        bf16x8 fk[8], fq[8]; v4u vv[4]; f32x4 s2[8];
#pragma unroll
        for (int f = 0; f < 8; ++f) { fk[f] = SLF(SL_FK, f); fq[f] = SLF(SL_FQ, f); }
#pragma unroll
        for (int f = 0; f < 4; ++f) vv[f] = *(const LAS v4u*)(B + SL_VV + f * 1024);
#pragma unroll
        for (int g = 0; g < 8; ++g) s2[g] = *(const LAS f32x4*)(Bs + (8 * g) * 4);
        asm volatile("" ::: "memory");
        bf16x8 sb[2][2];
#pragma unroll
        for (int ib = 0; ib < 2; ++ib)
#pragma unroll
            for (int s = 0; s < 2; ++s) sb[ib][s] = pack_regs(S[ib], s);
        f32x16 X[2], o[2];
#pragma unroll
        for (int cb = 0; cb < 2; ++cb) {
            f32x16 ax, ao = {};
            { const v4u va = vv[2 * cb], vb_ = vv[2 * cb + 1];
              ax = (f32x16){bflo(va.x), bfhi(va.x), bflo(va.y), bfhi(va.y), bflo(va.z), bfhi(va.z), bflo(va.w), bfhi(va.w),
                            bflo(vb_.x), bfhi(vb_.x), bflo(vb_.y), bfhi(vb_.y), bflo(vb_.z), bfhi(vb_.z), bflo(vb_.w), bfhi(vb_.w)}; }
#pragma unroll
            for (int ib = 0; ib < 2; ++ib)
#pragma unroll
                for (int s = 0; s < 2; ++s) { ax = MFMA32(fk[4 * cb + 2 * ib + s], sb[ib][s], ax); ao = MFMA32(fq[4 * cb + 2 * ib + s], sb[ib][s], ao); }
            X[cb] = ax; o[cb] = ao;
        }
        bf16x8 ft[6], fm[6];
#pragma unroll
        for (int f = 0; f < 6; ++f) { ft[f] = SLF(SL_FT, f); fm[f] = SLF(SL_FM, f); }
        asm volatile("" ::: "memory");
#pragma unroll
        for (int cb = 0; cb < 2; ++cb)
#pragma unroll
            for (int g = 0; g < 4; ++g)
#pragma unroll
                for (int j = 0; j < 4; ++j) o[cb][4 * g + j] *= s2[4 * cb + g][j];
        f32x16 vn[2];
        {
            bf16x8 xb[2][2];
#pragma unroll
            for (int cb = 0; cb < 2; ++cb)
#pragma unroll
                for (int s = 0; s < 2; ++s) xb[cb][s] = pack_regs(X[cb], s);
            f32x16 a0 = {}, a1 = {};
            a0 = MFMA32(ft[0], xb[0][0], a0); a0 = MFMA32(ft[1], xb[0][1], a0);
            a1 = MFMA32(ft[2], xb[0][0], a1); a1 = MFMA32(ft[3], xb[0][1], a1); a1 = MFMA32(ft[4], xb[1][0], a1); a1 = MFMA32(ft[5], xb[1][1], a1);
            vn[0] = a0; vn[1] = a1;
        }
        bf16x8 fkt[8]; f32x4 s3[8];
#pragma unroll
        for (int f = 0; f < 8; ++f) fkt[f] = SLF(SL_KT, f);
#pragma unroll
        for (int g = 0; g < 8; ++g) s3[g] = *(const LAS f32x4*)(Bs + (64 + 8 * g) * 4);
        const float egl = *(const LAS float*)(L + (n & 1) * SL_BUF + SL_SC + 512);
        asm volatile("" ::: "memory");
        {
            bf16x8 vb[2][2];
#pragma unroll
            for (int cb = 0; cb < 2; ++cb)
#pragma unroll
                for (int s = 0; s < 2; ++s) vb[cb][s] = pack_regs(vn[cb], s);
            f32x16 a0 = o[0], a1 = o[1];
            a0 = MFMA32(fm[0], vb[0][0], a0); a0 = MFMA32(fm[1], vb[0][1], a0);
            a1 = MFMA32(fm[2], vb[0][0], a1); a1 = MFMA32(fm[3], vb[0][1], a1); a1 = MFMA32(fm[4], vb[1][0], a1); a1 = MFMA32(fm[5], vb[1][1], a1);
            bf16* oo = OUTO + (size_t)((td0 + n) * 2 + jw) * 2 * 16 * 64 + lane;
#pragma unroll
            for (int g = 0; g < 16; ++g) { oo[g * 64] = (bf16)f2bf(a0[g]); oo[(16 + g) * 64] = (bf16)f2bf(a1[g]); }
        }
        {
#pragma unroll
            for (int cb = 0; cb < 2; ++cb)
#pragma unroll
                for (int g = 0; g < 4; ++g)
#pragma unroll
                    for (int j = 0; j < 4; ++j) vn[cb][4 * g + j] *= s3[4 * cb + g][j];
            bf16x8 vb[2][2];
#pragma unroll
            for (int cb = 0; cb < 2; ++cb)
#pragma unroll
                for (int s = 0; s < 2; ++s) vb[cb][s] = pack_regs(vn[cb], s);
#pragma unroll
            for (int ib = 0; ib < 2; ++ib) { f32x16 acc = S[ib] * egl;
#pragma unroll
                for (int cb = 0; cb < 2; ++cb)
#pragma unroll
                    for (int s = 0; s < 2; ++s) acc = MFMA32(fkt[4 * ib + 2 * cb + s], vb[cb][s], acc);
                S[ib] = acc; }
        }
#undef SLF
    }
#undef SL_ISSUE
#undef SL_RUN
    asm volatile("s_waitcnt vmcnt(0) lgkmcnt(0)" ::: "memory");
}
__device__ __forceinline__ void phase_dn_scan(const Args& a, LAS unsigned char* lds, int vcu, int G) {
    const int tid = threadIdx.x, wave = __builtin_amdgcn_readfirstlane(tid >> 6);
    if (G == 256) {
        if (vcu < 128) {
#if !defined(SCAN_NO_LAT)
            if (wave == 0) { int lane = tid & 63; asm volatile("" : "+v"(lane)); dn_scan_lat(a, vcu, lane, lds); return; }
#else
            if (wave == 0) { int lane = tid & 63; asm volatile("" : "+v"(lane)); dn_scan_task(a, vcu, lane); return; }
#endif
            if (wave <= 3 || wave == 5) { const int k = wave <= 3 ? wave - 1 : 3; int lane = tid & 63; asm volatile("" : "+v"(lane)); dn_scan_task(a, 128 + vcu * 4 + k, lane); }
            return;
        }
        const int bx = blockIdx.x, c_ = (bx % 8 - 4) + 4 * (bx / 8);
        if (c_ < 64) return;
        { int lane = tid & 63; asm volatile("" : "+v"(lane)); dn_scan_task(a, 128 + 512 + (c_ - 64) * 8 + wave, lane); }
        return;
    }
    for (int t = wave * G + vcu; t < 1152; t += G * NWAVES) { int lane = tid & 63; asm volatile("" : "+v"(lane)); dn_scan_task(a, t, lane); }
}

__device__ __forceinline__ void phase_combine(const Args& a, int vcu, int G) {
    const int tid = threadIdx.x, lane = tid & 63, wave = tid >> 6;
    const int gw = vcu * NWAVES + wave, NGW = G * NWAVES;
    const bf16* OF = (const bf16*)a.out + (size_t)3 * MT * 512; const bf16* OB = (const bf16*)(a.ws + WS_W1);
    const bf16* P = (const bf16*)(a.ws + WS_PB); bf16* ODN = (bf16*)(a.ws + WS_ODN);
    const f32x4 n0 = *(const f32x4*)(a.in[I_DNN] + ((8 * lane) & 63)), n1 = *(const f32x4*)(a.in[I_DNN] + ((8 * lane) & 63) + 4);
    const int hd = lane >> 3, j0 = (8 * lane) & 63, jw = j0 >> 5, r0 = j0 & 31;
    for (int m = gw; m < MT; m += NGW) {
        int tt, T_, ch0;
        if (m < M_CTX) { const int b_ = m >> 8; tt = m & 255; T_ = 256; ch0 = 64 + ((b_ * 8 + hd) << 1); }
        else { const int rl = m - M_CTX; const int b_ = rl >> 10; tt = rl & 1023; T_ = 1024; ch0 = (b_ * 8 + hd) << 1; }
        v4u w[2];
#pragma unroll
        for (int dd = 0; dd < 2; ++dd) {
            const int u = dd ? T_ - 1 - tt : tt, c = u & 63;
            const int task = (m < M_CTX ? 512 + (ch0 >> 1) * 4 - 128 : (ch0 >> 1) * 16) + (u >> 6);
            const int cb = c >> 5, hh = (c >> 2) & 1, g = ((c >> 3) & 3) * 4 + (c & 3);
            w[dd] = *(const v4u*)((dd ? OB : OF) + ((size_t)((task * 2 + jw) * 2 + cb) * 16 + g) * 64 + hh * 32 + r0);
        }
        f32x4 o0 = {bflo(w[0].x) + bflo(w[1].x), bfhi(w[0].x) + bfhi(w[1].x), bflo(w[0].y) + bflo(w[1].y), bfhi(w[0].y) + bfhi(w[1].y)};
        f32x4 o1 = {bflo(w[0].z) + bflo(w[1].z), bfhi(w[0].z) + bfhi(w[1].z), bflo(w[0].w) + bflo(w[1].w), bfhi(w[0].w) + bfhi(w[1].w)};
        float ss = (o0.x * o0.x + o0.y * o0.y) + (o0.z * o0.z + o0.w * o0.w) + (o1.x * o1.x + o1.y * o1.y) + (o1.z * o1.z + o1.w * o1.w);
        ss += __shfl_xor(ss, 1); ss += __shfl_xor(ss, 2); ss += __shfl_xor(ss, 4);
        const float rstd = rsqrtf(ss * (1.f / 64.f) + 1e-6f);
        const v4u z = *(const v4u*)(P + (size_t)m * LDB_ + CB_Z + 8 * lane);
        o0 = o0 * rstd * n0; o1 = o1 * rstd * n1;
        v4u q; q.x = pk2(o0.x * silu_(bflo(z.x)), o0.y * silu_(bfhi(z.x))); q.y = pk2(o0.z * silu_(bflo(z.y)), o0.w * silu_(bfhi(z.y)));
        q.z = pk2(o1.x * silu_(bflo(z.z)), o1.y * silu_(bfhi(z.z))); q.w = pk2(o1.z * silu_(bflo(z.w)), o1.w * silu_(bfhi(z.w)));
        *(v4u*)(ODN + (size_t)m * 512 + 8 * lane) = q;
    }
}

__device__ __forceinline__ void phase_row1(const Args& a, int vcu, int G) {
    const int tid = threadIdx.x, lane = tid & 63, wave = tid >> 6;
    const int gw = vcu * NWAVES + wave, NGW = G * NWAVES;
    const float* MOD = (const float*)(a.ws + WS_MOD); const bf16* Y = (const bf16*)(a.ws + WS_ONA); const float* RSS = (const float*)(a.ws + WS_RSS1);
    bf16* XN = (bf16*)(a.ws + WS_XN);
    constexpr int R = 3;
    for (int mb = gw; mb < MT; mb += R * NGW) {
        float rv[R]; v2u yy[R][4]; f32x4 xx[R][4];
#pragma unroll
        for (int r = 0; r < R; ++r) { const int m = min(mb + r * NGW, MT - 1);
            rv[r] = lane < 16 ? RSS[((size_t)(lane >> 2) * MT + m) * 4 + (lane & 3)] : 0.f;
            const f32x4* xr = (const f32x4*)x_row(a, m) + lane; const v2u* yr = (const v2u*)(Y + (size_t)m * DM) + lane;
#pragma unroll
            for (int j = 0; j < 4; ++j) { yy[r][j] = yr[64 * j]; xx[r][j] = xr[64 * j]; } }
        asm volatile("" ::: "memory");
#pragma unroll
        for (int r = 0; r < R; ++r) { const int m = mb + r * NGW; if (m >= MT) break;
            const float* md = MOD + mod_idx(m) * 6144;
            float rs = rv[r]; rs += __shfl_xor(rs, 1); rs += __shfl_xor(rs, 2); rs += __shfl_xor(rs, 4); rs += __shfl_xor(rs, 8); rs = __shfl(rs, 0);
            const float rstd1 = rsqrtf(rs * (1.f / DM) + 1e-6f);
            f32x4 x1[4]; float s = 0.f;
            v2u* x1b = (v2u*)((bf16*)(a.ws + WS_M1) + (size_t)m * DM) + lane;
#pragma unroll
            for (int j = 0; j < 4; ++j) { const int c = (lane + 64 * j) * 4; const v2u y2 = yy[r][j];
                const f32x4 yv = {bflo(y2.x), bfhi(y2.x), bflo(y2.y), bfhi(y2.y)};
                const f32x4 g1 = *(const f32x4*)(md + 2048 + c), pw = *(const f32x4*)(a.in[I_POST1] + c);
                x1[j] = xx[r][j] + g1 * (yv * rstd1 * pw); { v2u o1; o1.x = pk2(x1[j].x, x1[j].y); o1.y = pk2(x1[j].z, x1[j].w); x1b[64 * j] = o1; }
                s += (x1[j].x * x1[j].x + x1[j].y * x1[j].y) + (x1[j].z * x1[j].z + x1[j].w * x1[j].w); }
            const float rstd2 = rsqrtf(wave_sum(s) * (1.f / DM) + 1e-6f);
            v2u* o8 = (v2u*)(XN + (size_t)m * DM) + lane;
#pragma unroll
            for (int j = 0; j < 4; ++j) { const int c = (lane + 64 * j) * 4;
                const f32x4 w = *(const f32x4*)(a.in[I_PRE2] + c), sh = *(const f32x4*)(md + 3072 + c), sc = *(const f32x4*)(md + 4096 + c);
                const f32x4 h = x1[j] * rstd2 * w * (sc + 1.0f) + sh;
                v2u o; o.x = pk2(h.x, h.y); o.y = pk2(h.z, h.w); o8[64 * j] = o; }
        }
    }
}
__device__ __forceinline__ void phase_row2(const Args& a, int vcu, int G) {
    const int tid = threadIdx.x, lane = tid & 63, wave = tid >> 6;
    const int gw = vcu * NWAVES + wave, NGW = G * NWAVES;
    const float* MOD = (const float*)(a.ws + WS_MOD); const bf16* Fm = (const bf16*)(a.ws + WS_ONA); const bf16* Fe = (const bf16*)(a.ws + WS_XN); const bf16* X1 = (const bf16*)(a.ws + WS_M1);
    constexpr int R = 3;
    for (int mb = gw; mb < MT; mb += R * NGW) {
        v2u pp[R][4], qq[R][4], xw[R][4];
#pragma unroll
        for (int r = 0; r < R; ++r) { const int m = min(mb + r * NGW, MT - 1);
            const v2u* fr = (const v2u*)(Fm + (size_t)m * DM) + lane; const v2u* fe = (const v2u*)(Fe + (size_t)m * DM) + lane; const v2u* xr = (const v2u*)(X1 + (size_t)m * DM) + lane;
#pragma unroll
            for (int j = 0; j < 4; ++j) { pp[r][j] = fr[64 * j]; qq[r][j] = fe[64 * j]; xw[r][j] = xr[64 * j]; } }
        asm volatile("" ::: "memory");
#pragma unroll
        for (int r = 0; r < R; ++r) { const int m = mb + r * NGW; if (m >= MT) break;
            const float* md = MOD + mod_idx(m) * 6144;
            f32x4* orow = (f32x4*)(a.out + (size_t)m * DM) + lane;
            f32x4 fv[4], x1[4]; float s = 0.f;
#pragma unroll
            for (int j = 0; j < 4; ++j) { const v2u p = pp[r][j], q = qq[r][j], xx = xw[r][j]; x1[j] = (f32x4){bflo(xx.x), bfhi(xx.x), bflo(xx.y), bfhi(xx.y)};
                fv[j] = (f32x4){bflo(p.x) + bflo(q.x), bfhi(p.x) + bfhi(q.x), bflo(p.y) + bflo(q.y), bfhi(p.y) + bfhi(q.y)};
                s += (fv[j].x * fv[j].x + fv[j].y * fv[j].y) + (fv[j].z * fv[j].z + fv[j].w * fv[j].w); }
            const float rstd = rsqrtf(wave_sum(s) * (1.f / DM) + 1e-6f);
#pragma unroll
            for (int j = 0; j < 4; ++j) { const int c = (lane + 64 * j) * 4;
                const f32x4 g2 = *(const f32x4*)(md + 5120 + c), pw = *(const f32x4*)(a.in[I_POST2] + c);
                orow[64 * j] = x1[j] + g2 * (fv[j] * rstd * pw); }
        }
    }
}

constexpr int N_PHASES = 13;
__global__ void __launch_bounds__(NWAVES * 64, 2) fwd_kernel(Args args) {
    extern __shared__ __attribute__((aligned(16))) unsigned char lds_raw[];
    LAS unsigned char* lds = (LAS unsigned char*)lds_raw;
    const int tid = threadIdx.x;
    const int G = gridDim.x; const int bx = blockIdx.x; const int vcu = (G % 8 == 0) ? (bx % 8) * (G / 8) + bx / 8 : bx;
    volatile LAS unsigned* MISC = (volatile LAS unsigned*)(lds + MISC_OFF);
    for (int u = tid; u < (LDS_BYTES - LDSCTL_OFF) / 4; u += NWAVES * 64) ((LAS unsigned*)(lds + LDSCTL_OFF))[u] = 0u;
    __syncthreads();
    const int lo = args.ph_lo, hi = args.ph_hi;
    const bool one = (hi - lo) > 1;
    unsigned* ctl = (unsigned*)(args.ws + WS_CTL);
    XcdBarrier bar; bar.bar = ctl + CW_BAR; bar.x = 0; bar.st = nullptr;
    if (one) bar = xcd_barrier_post(ctl + CW_BAR, MISC + 8);
#ifndef ONLY_PHASE
#define ONLY_PHASE -1
#endif
#ifndef SKIP_MASK
#define SKIP_MASK 0
#endif
#define IN(k) ((ONLY_PHASE < 0 || ONLY_PHASE == (k)) && !((SKIP_MASK >> (k)) & 1) && lo <= (k) && (k) < hi)
#define SEAM(k) do { if (one) xcd_barrier(bar); } while (0)
    unsigned char* ws = args.ws;
    typedef pg8::bf16_t pb;

#ifndef REPEAT_MASK
#define REPEAT_MASK 0
#endif
#define REP(k) ((REPEAT_MASK >> (k)) & 1)
#define PH_INPROJ do { pg8::Gemm g{(const pb*)(ws + WS_XN), (const pb*)(ws + WS_WIN), MT, NINP, 1024}; pg8::InProjOrder S; S.init(MT, NINP, G, bx); S.flags = (unsigned*)(ws + WS_CTL) + CW_TF; \
        pg8::EpiInProj E{(pb*)(ws + WS_PA), (pb*)(ws + WS_PB), (pb*)(ws + WS_M1), args.out + OUT_K, args.out + OUT_V, (float*)(ws + WS_BA), (pb*)args.out + (size_t)3 * MT * 512, (const float*)(ws + WS_ROPE)}; \
        pg8::gemm_phase<pg8::EpiInProj, pg8::InProjOrder, true, true>(lds, g, S, E); } while (0)
#define PH_GATE1(G_, c_, maxi_) do { pg8::LimitOrder S; S.init(MT, 1024, (G_), (c_)); S.maxi = (maxi_); \
        pg8::Gemm g{(const pb*)(ws + WS_ONA), (const pb*)(ws + WS_WAO), MT, 1024, 512}; pg8::EpiGate1 E{(const pb*)(ws + WS_PB), (pb*)(ws + WS_M1)}; \
        pg8::gemm_phase<pg8::EpiGate1, pg8::LimitOrder, true, true>(lds, g, S, E); } while (0)
#define PH_SCAN do { phase_dn_scan(args, lds, vcu, G); \
        if (G == 256) { if (vcu >= 128) { __syncthreads(); PH_GATE1(128, (bx % 8 - 4) + 4 * (bx / 8), 2); } } } while (0)
#define PH_MERGE do { pg8::StaticOrder S; S.init(MT, 1024, G, bx); \
        if (bx >= 192) late_transposes(args, lds, bx - 192, G - 192); else if (G <= 192 && bx == 0) late_transposes(args, lds, 0, 1); \
        if (G != 256) PH_GATE1(G, bx, 1 << 20);     \
        { pg8::Gemm g{(const pb*)(ws + WS_ODN), (const pb*)(ws + WS_WDO), MT, 1024, 512}; pg8::EpiGate2 E{(const pb*)(ws + WS_PB), (const pb*)(ws + WS_M1), (pb*)(ws + WS_XN)}; \
          pg8::gemm_phase<pg8::EpiGate2, pg8::StaticOrder, true, true>(lds, g, S, E); } } while (0)
#define PH_WOUT do { pg8::Gemm g{(const pb*)(ws + WS_XN), (const pb*)(ws + WS_WOUT), MT, 1024, 1024}; pg8::StaticOrder S; S.init(MT, 1024, G, bx); \
        pg8::EpiRss E{(pb*)(ws + WS_ONA), (float*)(ws + WS_RSS1)}; pg8::gemm_phase<pg8::EpiRss, pg8::StaticOrder, true, true>(lds, g, S, E); } while (0)
#define PH_FF1 do { pg8::Gemm g{(const pb*)(ws + WS_XN), (const pb*)(ws + WS_W1), MT, FF, 1024}; pg8::StaticOrder S; S.init(MT, FF, G, bx); \
        pg8::EpiRelu2 E{(pb*)(ws + WS_PA)}; pg8::gemm_phase<pg8::EpiRelu2, pg8::StaticOrder, true, true>(lds, g, S, E); } while (0)
#define PH_FF2 do { pg8::Gemm g{(const pb*)(ws + WS_PA), (const pb*)(ws + WS_W2), MT, 1024, FF}; pg8::SplitOrder S{vcu, 48, 16}; \
        pg8::EpiSplit E{(pb*)(ws + WS_ONA), (pb*)(ws + WS_XN)}; pg8::gemm_phase<pg8::EpiSplit, pg8::SplitOrder, true, true>(lds, g, S, E); } while (0)
#define RUN(k, body) do { if (IN(k)) { body; SEAM(k); if (REP(k)) { body; SEAM(k); } } } while (0)
    RUN(0, { phase_prologue(args, lds, vcu, G); phase_xn(args, vcu, G); });
#ifdef EXP_BAR
    RUN(2, { PH_INPROJ; xcd_barrier(bar); phase_conv(args, lds, vcu, G); });
#else
    RUN(2, { PH_INPROJ; phase_conv(args, lds, vcu, G); });
#endif
    RUN(4, phase_attn_pre(args, lds, vcu, G));
#if defined(PROBE_GATE1_ONLY)
    if (IN(5)) { PH_SCAN; SEAM(5); if (vcu >= 128) { PH_GATE1(128, (bx % 8 - 4) + 4 * (bx / 8), 2); } SEAM(5); }
#elif defined(PROBE_SCAN_ONLY)
    if (IN(5)) { PH_SCAN; SEAM(5); phase_dn_scan(args, lds, vcu, G); SEAM(5); }
#else
    RUN(5, PH_SCAN);
#endif
    RUN(6, phase_combine(args, vcu, G));
    RUN(7, PH_MERGE);
    RUN(8, PH_WOUT);
    RUN(9, phase_row1(args, vcu, G));
    RUN(10, PH_FF1);
    RUN(11, PH_FF2);
    if (IN(12)) { phase_row2(args, vcu, G); }
#ifdef EXTRA_BARS
    for (int i = 0; i < EXTRA_BARS; ++i) xcd_barrier(bar);
#endif

#undef IN
#undef SEAM
}

#ifndef MK_ONE_LAUNCH
#define MK_ONE_LAUNCH 1
#endif
extern "C" void kernel_launch(void* const* d_in, const int* in_sizes, int n_in, void* d_out, int out_size, void* d_ws, size_t ws_size, hipStream_t stream) {
    static int grid = 0;
    if (grid == 0) {
        if (n_in != 24 || ws_size < WS_END) { fprintf(stderr, "kernel_launch: unexpected n_in %d / ws %zu\n", n_in, ws_size); grid = -1; return; }
        int dev = 0, cus = 0;
        if (hipGetDevice(&dev) != hipSuccess || hipDeviceGetAttribute(&cus, hipDeviceAttributeMultiprocessorCount, dev) != hipSuccess) { grid = -1; return; }
        if (hipFuncSetAttribute((const void*)fwd_kernel, hipFuncAttributeMaxDynamicSharedMemorySize, LDS_BYTES) != hipSuccess) { fprintf(stderr, "kernel_launch: hipFuncSetAttribute failed\n"); grid = -1; return; }
        int per_cu = 0;
        if (hipOccupancyMaxActiveBlocksPerMultiprocessor(&per_cu, (const void*)fwd_kernel, NWAVES * 64, LDS_BYTES) != hipSuccess || per_cu < 1) fprintf(stderr, "kernel_launch: occupancy query says %d\n", per_cu);
        (void)hipGetLastError();
        grid = cus;
    }
    if (grid < 0) return;
    (void)hipMemsetAsync((char*)d_ws + WS_CTL, 0, CTL_ZERO_BYTES, stream);
    Args a{};
    for (int i = 0; i < 24; ++i) a.in[i] = (const float*)d_in[i];
    a.out = (float*)d_out; a.ws = (unsigned char*)d_ws;
#if MK_ONE_LAUNCH
    a.ph_lo = 0; a.ph_hi = N_PHASES;
    hipLaunchKernelGGL(fwd_kernel, dim3(grid), dim3(NWAVES * 64), LDS_BYTES, stream, a);
#else
    for (int p = 0; p < N_PHASES; ++p) { a.ph_lo = p; a.ph_hi = p + 1; hipLaunchKernelGGL(fwd_kernel, dim3(grid), dim3(NWAVES * 64), LDS_BYTES, stream, a); }
#endif
}
```

```cpp
#include <hip/hip_runtime.h>
#include <cstdio>
#include <cstdint>

constexpr int DM = 1024, M_CTX = 8192, M_LAT = 4096, MT = 12288, NIN = 5664, NINP = 5888, FF = 4096;
constexpr int LDA_ = 1536, LDB_ = 2816;
constexpr int C_Q = 0, C_K = 512, C_V = 1024, C_DN = 0, CB_Z = 32, CB_GA = 544, CB_GD = 1568;

namespace pg8 {
#define PG8_LAS __attribute__((address_space(3)))
typedef unsigned short bf16_t;
typedef short bf16x8 __attribute__((ext_vector_type(8)));
typedef float f32x4 __attribute__((ext_vector_type(4)));
typedef unsigned u32x4 __attribute__((ext_vector_type(4)));
typedef unsigned u32x2 __attribute__((ext_vector_type(2)));
constexpr int BM = 256, BK = 64, HALF = 128, HTB = HALF * BK * 2  , STAGE_BYTES = 8 * HTB, NXCD = 8, WGM = 8;

__host__ __device__ __forceinline__ int lds_byte(int r, int c) { const int st = (r >> 4) * 2 + (c >> 5), rr = r & 15, cc = c & 31, ob = rr * 64 + cc * 2; return st * 1024 + (ob ^ (((ob >> 9) & 1) << 5)); }
__host__ __device__ __forceinline__ void stage_rc(int b, int& R, int& C) { const int st = b / 1024, sb = b % 1024, swz = sb ^ (((sb >> 9) & 1) << 5); R = (st >> 1) * 16 + swz / 64; C = (st & 1) * 32 + (swz % 64) / 2; }
__host__ __device__ __forceinline__ int perm32(int rho) { const int n = rho >> 4, i = rho & 15; return 8 * (i >> 2) + 4 * n + (i & 3); }

struct Unit { int pm, pn; int k0 = 0, nt = 0; };
struct Gemm { const bf16_t* A; const bf16_t* Bt; int M, N, K; };

struct StaticOrder {
    int nM, nN, nwg, G, c;
    __host__ __device__ void init(int M, int N, int G_, int c_) { nM = M / BM; nN = N / BM; nwg = nM * nN; G = G_; c = c_; }
    __host__ __device__ bool next(int i, Unit& u) const {
        const long L = (long)i * G + c; if (L >= nwg) return false;
        int wgid = (int)L; { const int q = nwg / NXCD, r = nwg % NXCD, xcd = wgid % NXCD, off = wgid / NXCD; wgid = (xcd < r ? xcd * (q + 1) : r * (q + 1) + (xcd - r) * q) + off; }
        const int nig = WGM * nN, gid = wgid / nig, fm = gid * WGM, gsz = (nM - fm) < WGM ? (nM - fm) : WGM;
        u.pm = fm + ((wgid % nig) % gsz); u.pn = (wgid % nig) / gsz; return true;
    }
    __device__ __forceinline__ void a_ready(const Unit&) const {}
    __device__ __forceinline__ void done(const Unit&) const {}
};

struct InProjOrder : StaticOrder { unsigned* flags;
    __device__ __forceinline__ void done(const Unit& u) const {
        if (u.pn >= 6 && u.pn <= 12) { asm volatile("s_waitcnt vmcnt(0)" ::: "memory");
            if ((threadIdx.x & 63) == 0) __hip_atomic_fetch_add(flags + u.pm * 8 + (u.pn - 6), 1u, __ATOMIC_RELAXED, __HIP_MEMORY_SCOPE_AGENT); } } };

struct LimitOrder : StaticOrder { int maxi;
    __device__ __forceinline__ bool next(int i, Unit& u) const { if (i >= maxi) return false; return StaticOrder::next(i, u); } };

__device__ __forceinline__ unsigned cvt_pk_bf16(float lo, float hi) { unsigned r; asm volatile("v_cvt_pk_bf16_f32 %0, %1, %2" : "=v"(r) : "v"(lo), "v"(hi)); return r; }
__device__ __forceinline__ float bf_lo(unsigned w) { return __uint_as_float(w << 16); }
__device__ __forceinline__ float bf_hi(unsigned w) { return __uint_as_float(w & 0xffff0000u); }
__device__ __forceinline__ float sigmoidf_(float x) { return __builtin_amdgcn_rcpf(1.0f + __expf(-x)); }
__device__ __forceinline__ u32x4 pack8(const f32x4& v0, const f32x4& v1) { u32x4 w; w.x = cvt_pk_bf16(v0[0], v0[1]); w.y = cvt_pk_bf16(v0[2], v0[3]); w.z = cvt_pk_bf16(v1[0], v1[1]); w.w = cvt_pk_bf16(v1[2], v1[3]); return w; }


__device__ __forceinline__ void store16_wt(void* p, u32x4 v) { asm volatile("global_store_dwordx4 %0, %1, off sc1\n\ts_nop 2" :: "v"(p), "v"(v) : "memory"); }
struct EpiInProj {
    static constexpr bool PERM = true, AFTER_DRAIN = false;
    bf16_t* PA; bf16_t* PB; bf16_t* QK; float* ko; float* vo; float* BA; bf16_t* VT; const float* rope;
    __device__ __forceinline__ void operator()(const f32x4 (&acc)[2][2][4][2], const Unit& u, int wr, int wc, int fr, int fq) const {
        const int pn = u.pn, pm = u.pm;
        const bool lat = pm >= 32;
        const bool do_rope = lat && pn < 4;
        const bool do_kv = (!lat) && pn >= 2 && pn < 6;
        const bool do_vt = pn == 4 || pn == 5;
        const bool do_ba = pn == 12 && wc == 0;
        const int lane_hi = fq >> 1;
#pragma unroll
        for (int ai = 0; ai < 2; ++ai)
#pragma unroll
            for (int m = 0; m < 4; ++m) {
                const int row = pm * BM + ai * HALF + wr * 64 + m * 16 + fr;
#pragma unroll
                for (int bj = 0; bj < 2; ++bj) {
                    f32x4 v0 = acc[ai][bj][m][0], v1 = acc[ai][bj][m][1];
                    const int col = pn * BM + bj * HALF + wc * 32 + 8 * fq;
                    if (do_rope) {
                        const int t = (row - M_CTX) & 1023;
                        const int pos = (wc & 1) ? (t & 63) : (t >> 6);
                        const float* cp = rope + pos * 16 + 8 * (fq & 1);
                        const f32x4 c0 = *(const f32x4*)cp, c1 = *(const f32x4*)(cp + 4), s0 = *(const f32x4*)(cp + 1024), s1 = *(const f32x4*)(cp + 1028);
                        f32x4 p0, p1;
#pragma unroll
                        for (int i = 0; i < 4; ++i) { p0[i] = __shfl_xor(v0[i], 32); p1[i] = __shfl_xor(v1[i], 32); }
                        if (lane_hi) { v0 = p0 * s0 + v0 * c0; v1 = p1 * s1 + v1 * c1; }
                        else         { v0 = v0 * c0 - p0 * s0; v1 = v1 * c1 - p1 * s1; }
                    }
                    if (pn < 4) *(u32x4*)(QK + (pn >= 2 ? (size_t)MT * 512 : 0) + (size_t)row * 512 + (col & 511)) = pack8(v0, v1);
                    else if (pn >= 6 && pn < 12) store16_wt(PA + (size_t)row * LDA_ + (col - 1536), pack8(v0, v1));
                    else if (pn >= 12) *(u32x4*)(PB + (size_t)row * LDB_ + (col - 3072)) = pack8(v0, v1);
                    if (do_kv) {
                        const int hh = ((pn & 1) * 4) + bj * 2 + (wc >> 1);
                        const int d = (wc & 1) * 32 + 8 * fq;
                        float* dst = (pn < 4 ? ko : vo) + ((size_t)(pm * 8 + hh) * 256 + (row & 255)) * 64 + d;
                        *(f32x4*)dst = v0; *(f32x4*)(dst + 4) = v1;
                    }
#ifndef VT_REP
#define VT_REP 1
#endif
                    if (do_vt) for (int vtr = 0; vtr < VT_REP; ++vtr) {
                        const int hh = ((pn & 1) * 4) + bj * 2 + (wc >> 1);
                        const int d = (wc & 1) * 32 + 8 * fq;
                        size_t base; int t, T;
                        if (!lat) { t = row & 255; T = 256; base = (size_t)(pm * 8 + hh) * 64 * 256; }
                        else { const int rl = row - M_CTX; t = rl & 1023; T = 1024; base = (size_t)M_CTX * 512 + (size_t)((rl >> 10) * 8 + hh) * 64 * 1024; }
                        const int pos = (t & ~12) | ((t & 4) << 1) | ((t & 8) >> 1);
                        bf16_t* dst = VT + base + (size_t)d * T + pos;
                        const u32x4 w = pack8(v0, v1);
                        dst[0] = (bf16_t)(w.x & 0xffff); dst[(size_t)T] = (bf16_t)(w.x >> 16); dst[(size_t)2 * T] = (bf16_t)(w.y & 0xffff); dst[(size_t)3 * T] = (bf16_t)(w.y >> 16);
                        dst[(size_t)4 * T] = (bf16_t)(w.z & 0xffff); dst[(size_t)5 * T] = (bf16_t)(w.z >> 16); dst[(size_t)6 * T] = (bf16_t)(w.w & 0xffff); dst[(size_t)7 * T] = (bf16_t)(w.w >> 16);
                    }
                    if (do_ba && bj == 0) { float* dst = BA + (size_t)row * 32 + 8 * fq; store16_wt(dst, __builtin_bit_cast(u32x4, v0)); store16_wt(dst + 4, __builtin_bit_cast(u32x4, v1)); }
                }
            }
    }
};

struct EpiGate1 {
    static constexpr bool PERM = true, AFTER_DRAIN = false;
    const bf16_t* P; bf16_t* M1;
    __device__ __forceinline__ void operator()(const f32x4 (&acc)[2][2][4][2], const Unit& u, int wr, int wc, int fr, int fq) const {
        u32x4 g[2][4][2];
#pragma unroll
        for (int ai = 0; ai < 2; ++ai)
#pragma unroll
            for (int m = 0; m < 4; ++m)
#pragma unroll
                for (int bj = 0; bj < 2; ++bj) { const int row = u.pm * BM + ai * HALF + wr * 64 + m * 16 + fr, col = u.pn * BM + bj * HALF + wc * 32 + 8 * fq;
                    g[ai][m][bj] = *(const u32x4*)(P + (size_t)row * LDB_ + CB_GA + col); }
        asm volatile("" ::: "memory");
#pragma unroll
        for (int ai = 0; ai < 2; ++ai)
#pragma unroll
            for (int m = 0; m < 4; ++m) {
                const int row = u.pm * BM + ai * HALF + wr * 64 + m * 16 + fr;
#pragma unroll
                for (int bj = 0; bj < 2; ++bj) {
                    const int col = u.pn * BM + bj * HALF + wc * 32 + 8 * fq;
                    const u32x4 gg = g[ai][m][bj];
                    f32x4 v0 = acc[ai][bj][m][0], v1 = acc[ai][bj][m][1];
                    v0[0] *= sigmoidf_(bf_lo(gg.x)); v0[1] *= sigmoidf_(bf_hi(gg.x)); v0[2] *= sigmoidf_(bf_lo(gg.y)); v0[3] *= sigmoidf_(bf_hi(gg.y));
                    v1[0] *= sigmoidf_(bf_lo(gg.z)); v1[1] *= sigmoidf_(bf_hi(gg.z)); v1[2] *= sigmoidf_(bf_lo(gg.w)); v1[3] *= sigmoidf_(bf_hi(gg.w));
                    *(u32x4*)(M1 + (size_t)row * DM + col) = pack8(v0, v1);
                }
            }
    }
};
struct EpiGate2 {
    static constexpr bool PERM = true, AFTER_DRAIN = false;
    const bf16_t* P; const bf16_t* M1; bf16_t* O;
    __device__ __forceinline__ void operator()(const f32x4 (&acc)[2][2][4][2], const Unit& u, int wr, int wc, int fr, int fq) const {
#pragma unroll
        for (int ai = 0; ai < 2; ++ai) {
            u32x4 g[4][2], q[4][2];
#pragma unroll
            for (int m = 0; m < 4; ++m)
#pragma unroll
                for (int bj = 0; bj < 2; ++bj) { const int row = u.pm * BM + ai * HALF + wr * 64 + m * 16 + fr, col = u.pn * BM + bj * HALF + wc * 32 + 8 * fq;
                    g[m][bj] = *(const u32x4*)(P + (size_t)row * LDB_ + CB_GD + col); q[m][bj] = *(const u32x4*)(M1 + (size_t)row * DM + col); }
            asm volatile("" ::: "memory");
#pragma unroll
            for (int m = 0; m < 4; ++m) {
                const int row = u.pm * BM + ai * HALF + wr * 64 + m * 16 + fr;
#pragma unroll
                for (int bj = 0; bj < 2; ++bj) {
                    const int col = u.pn * BM + bj * HALF + wc * 32 + 8 * fq;
                    const u32x4 gg = g[m][bj], qq = q[m][bj];
                    f32x4 v0 = acc[ai][bj][m][0], v1 = acc[ai][bj][m][1];
                    v0[0] = bf_lo(qq.x) + v0[0] * sigmoidf_(bf_lo(gg.x)); v0[1] = bf_hi(qq.x) + v0[1] * sigmoidf_(bf_hi(gg.x)); v0[2] = bf_lo(qq.y) + v0[2] * sigmoidf_(bf_lo(gg.y)); v0[3] = bf_hi(qq.y) + v0[3] * sigmoidf_(bf_hi(gg.y));
                    v1[0] = bf_lo(qq.z) + v1[0] * sigmoidf_(bf_lo(gg.z)); v1[1] = bf_hi(qq.z) + v1[1] * sigmoidf_(bf_hi(gg.z)); v1[2] = bf_lo(qq.w) + v1[2] * sigmoidf_(bf_lo(gg.w)); v1[3] = bf_hi(qq.w) + v1[3] * sigmoidf_(bf_hi(gg.w));
                    *(u32x4*)(O + (size_t)row * DM + col) = pack8(v0, v1);
                }
            }
        }
    }
};
struct EpiRss {
    static constexpr bool PERM = true, AFTER_DRAIN = false;
    bf16_t* O; float* RSS;
    __device__ __forceinline__ void operator()(const f32x4 (&acc)[2][2][4][2], const Unit& u, int wr, int wc, int fr, int fq) const {
#pragma unroll
        for (int ai = 0; ai < 2; ++ai)
#pragma unroll
            for (int m = 0; m < 4; ++m) {
                const int row = u.pm * BM + ai * HALF + wr * 64 + m * 16 + fr;
                float s = 0.f;
#pragma unroll
                for (int bj = 0; bj < 2; ++bj) {
                    const int col = u.pn * BM + bj * HALF + wc * 32 + 8 * fq;
                    const f32x4 v0 = acc[ai][bj][m][0], v1 = acc[ai][bj][m][1];
                    s += (v0[0] * v0[0] + v0[1] * v0[1]) + (v0[2] * v0[2] + v0[3] * v0[3]) + (v1[0] * v1[0] + v1[1] * v1[1]) + (v1[2] * v1[2] + v1[3] * v1[3]);
                    *(u32x4*)(O + (size_t)row * DM + col) = pack8(v0, v1);
                }
                s += __shfl_xor(s, 16); s += __shfl_xor(s, 32);
                if (fq == 0) RSS[((size_t)u.pn * MT + row) * 4 + wc] = s;
            }
    }
};
struct EpiRelu2 {
    static constexpr bool PERM = true, AFTER_DRAIN = false;
    bf16_t* O;
    __device__ __forceinline__ void operator()(const f32x4 (&acc)[2][2][4][2], const Unit& u, int wr, int wc, int fr, int fq) const {
#pragma unroll
        for (int ai = 0; ai < 2; ++ai)
#pragma unroll
            for (int m = 0; m < 4; ++m) {
                const int row = u.pm * BM + ai * HALF + wr * 64 + m * 16 + fr;
#pragma unroll
                for (int bj = 0; bj < 2; ++bj) {
                    const int col = u.pn * BM + bj * HALF + wc * 32 + 8 * fq;
                    f32x4 v0 = acc[ai][bj][m][0], v1 = acc[ai][bj][m][1];
#pragma unroll
                    for (int i = 0; i < 4; ++i) { const float a = fmaxf(v0[i], 0.f), b = fmaxf(v1[i], 0.f); v0[i] = a * a; v1[i] = b * b; }
                    *(u32x4*)(O + (size_t)row * FF + col) = pack8(v0, v1);
                }
            }
    }
};

struct RowStats {
    float* slots;
    unsigned* cnt;
    unsigned* tmo;
    __device__ __forceinline__ void run(const f32x4 (&v)[2][2][4][2], const Unit& u, int wr, int wc, int fr, int fq, PG8_LAS unsigned char* lds, int wid, int lane) const {
        PG8_LAS float* P = (PG8_LAS float*)lds;
        PG8_LAS float* S = (PG8_LAS float*)(lds + 8192);
#pragma unroll
        for (int ai = 0; ai < 2; ++ai)
#pragma unroll
            for (int m = 0; m < 4; ++m) {
                float s = 0.f;
#pragma unroll
                for (int bj = 0; bj < 2; ++bj)
#pragma unroll
                    for (int n = 0; n < 2; ++n) { const f32x4 x = v[ai][bj][m][n]; s += (x[0] * x[0] + x[1] * x[1]) + (x[2] * x[2] + x[3] * x[3]); }
                s += __shfl_xor(s, 16); s += __shfl_xor(s, 32);
                if (fq == 0) P[(ai * HALF + wr * 64 + m * 16 + fr) * 4 + wc] = s;
            }
        asm volatile("s_waitcnt lgkmcnt(0)" ::: "memory"); __builtin_amdgcn_s_barrier(); asm volatile("" ::: "memory");
        const int row = wid * 32 + (lane & 31);
        if (lane < 32) {
            const f32x4 p = *(const PG8_LAS f32x4*)(P + row * 4);
            const float t = (p[0] + p[1]) + (p[2] + p[3]);
            __hip_atomic_store((unsigned*)slots + ((size_t)(u.pm * BM + row) * 4 + u.pn), __float_as_uint(t), __ATOMIC_RELAXED, __HIP_MEMORY_SCOPE_AGENT);
        }
        asm volatile("s_waitcnt vmcnt(0)" ::: "memory");
        if (lane == 0) __hip_atomic_fetch_add(cnt + 64 * u.pm, 1u, __ATOMIC_RELAXED, __HIP_MEMORY_SCOPE_AGENT);
        if (wid == 0) {
            const unsigned long long t0 = __builtin_amdgcn_s_memrealtime();
            for (;;) {
                if ((unsigned)__builtin_amdgcn_readfirstlane(__hip_atomic_load(cnt + 64 * u.pm, __ATOMIC_RELAXED, __HIP_MEMORY_SCOPE_AGENT)) >= 32u) break;
                if (__builtin_amdgcn_s_memrealtime() - t0 > 2000000ull) { if (lane == 0) __hip_atomic_store(tmo, 1u, __ATOMIC_RELAXED, __HIP_MEMORY_SCOPE_AGENT); break; }
                __builtin_amdgcn_s_sleep(2);
            }
            __builtin_amdgcn_fence(__ATOMIC_ACQUIRE, "agent");
        }
        asm volatile("s_waitcnt vmcnt(0) lgkmcnt(0)" ::: "memory"); __builtin_amdgcn_s_barrier(); asm volatile("" ::: "memory");
        if (lane < 32) {
            const unsigned* sl = (const unsigned*)slots + (size_t)(u.pm * BM + row) * 4; float tot = 0.f;
#pragma unroll
            for (int t = 0; t < 4; ++t) tot += __uint_as_float(__hip_atomic_load(sl + t, __ATOMIC_RELAXED, __HIP_MEMORY_SCOPE_AGENT));
            S[row] = __builtin_amdgcn_rsqf(tot * (1.0f / 1024.0f) + 1e-6f);
        }
        asm volatile("s_waitcnt lgkmcnt(0)" ::: "memory"); __builtin_amdgcn_s_barrier(); asm volatile("" ::: "memory");
    }
};
struct EpiRow1 {
    static constexpr bool PERM = false, AFTER_DRAIN = true;
    const float* xp; const float* xs; float* out; bf16_t* XN; const float* MOD; const float* post1; const float* pre2; RowStats st1, st2;
    __device__ __forceinline__ void fused(f32x4 (&acc)[2][2][4][2], const Unit& u, int wr, int wc, int fr, int fq, PG8_LAS unsigned char* lds, int wid, int lane) const {
        const PG8_LAS float* S = (const PG8_LAS float*)(lds + 8192);
        const float* md = MOD + (u.pm < 32 ? 0 : 1 + ((u.pm - 32) >> 2)) * 6144;
        const int col0 = u.pn * BM + wc * 32 + 4 * fq;
        const int row0 = u.pm * BM + wr * 64 + fr;
        const float* xbase = (row0 < M_CTX ? xp + (size_t)row0 * DM : xs + (size_t)(row0 - M_CTX) * DM) + col0;
        st1.run(acc, u, wr, wc, fr, fq, lds, wid, lane);
        float rs[2][4];
#pragma unroll
        for (int ai = 0; ai < 2; ++ai)
#pragma unroll
            for (int m = 0; m < 4; ++m) rs[ai][m] = S[ai * HALF + wr * 64 + m * 16 + fr];
#pragma unroll
        for (int bj = 0; bj < 2; ++bj)
#pragma unroll
            for (int n = 0; n < 2; ++n) { const int co = bj * HALF + n * 16, c = col0 + co;
                const f32x4 g1 = *(const f32x4*)(md + 2048 + c), pw = *(const f32x4*)(post1 + c);
                f32x4 xv[2][4];
#pragma unroll
                for (int ai = 0; ai < 2; ++ai)
#pragma unroll
                    for (int m = 0; m < 4; ++m) xv[ai][m] = *(const f32x4*)(xbase + (size_t)(ai * HALF + m * 16) * DM + co);
                asm volatile("" ::: "memory");
#pragma unroll
                for (int ai = 0; ai < 2; ++ai)
#pragma unroll
                    for (int m = 0; m < 4; ++m) { const f32x4 x1 = xv[ai][m] + g1 * (acc[ai][bj][m][n] * rs[ai][m] * pw); acc[ai][bj][m][n] = x1;
                        *(f32x4*)(out + (size_t)(row0 + ai * HALF + m * 16) * DM + c) = x1; }
                asm volatile("" ::: "memory"); }
        st2.run(acc, u, wr, wc, fr, fq, lds, wid, lane);
#pragma unroll
        for (int ai = 0; ai < 2; ++ai)
#pragma unroll
            for (int m = 0; m < 4; ++m) rs[ai][m] = S[ai * HALF + wr * 64 + m * 16 + fr];
#pragma unroll
        for (int bj = 0; bj < 2; ++bj)
#pragma unroll
            for (int n = 0; n < 2; ++n) { const int c = col0 + bj * HALF + n * 16;
                const f32x4 w = *(const f32x4*)(pre2 + c), sh = *(const f32x4*)(md + 3072 + c), sc = *(const f32x4*)(md + 4096 + c) + 1.0f;
#pragma unroll
                for (int ai = 0; ai < 2; ++ai)
#pragma unroll
                    for (int m = 0; m < 4; ++m) { const f32x4 hv = acc[ai][bj][m][n] * rs[ai][m] * w * sc + sh;
                        u32x2 o; o.x = cvt_pk_bf16(hv[0], hv[1]); o.y = cvt_pk_bf16(hv[2], hv[3]); *(u32x2*)(XN + (size_t)(row0 + ai * HALF + m * 16) * DM + c) = o; } }
    }
};
struct EpiRow2 {
    static constexpr bool PERM = false, AFTER_DRAIN = true;
    float* out; const float* MOD; const float* post2; RowStats st;
    __device__ __forceinline__ void fused(f32x4 (&acc)[2][2][4][2], const Unit& u, int wr, int wc, int fr, int fq, PG8_LAS unsigned char* lds, int wid, int lane) const {
        const PG8_LAS float* S = (const PG8_LAS float*)(lds + 8192);
        const float* md = MOD + (u.pm < 32 ? 0 : 1 + ((u.pm - 32) >> 2)) * 6144;
        const int col0 = u.pn * BM + wc * 32 + 4 * fq;
        float* obase = out + (size_t)(u.pm * BM + wr * 64 + fr) * DM + col0;
        st.run(acc, u, wr, wc, fr, fq, lds, wid, lane);
        float rs[2][4];
#pragma unroll
        for (int ai = 0; ai < 2; ++ai)
#pragma unroll
            for (int m = 0; m < 4; ++m) rs[ai][m] = S[ai * HALF + wr * 64 + m * 16 + fr];
#pragma unroll
        for (int bj = 0; bj < 2; ++bj)
#pragma unroll
            for (int n = 0; n < 2; ++n) { const int co = bj * HALF + n * 16, c = col0 + co;
                const f32x4 g2 = *(const f32x4*)(md + 5120 + c), pw = *(const f32x4*)(post2 + c);
                f32x4 xv[2][4];
#pragma unroll
                for (int ai = 0; ai < 2; ++ai)
#pragma unroll
                    for (int m = 0; m < 4; ++m) xv[ai][m] = *(const f32x4*)(obase + (size_t)(ai * HALF + m * 16) * DM + co);
                asm volatile("" ::: "memory");
#pragma unroll
                for (int ai = 0; ai < 2; ++ai)
#pragma unroll
                    for (int m = 0; m < 4; ++m) *(f32x4*)(obase + (size_t)(ai * HALF + m * 16) * DM + co) = xv[ai][m] + g2 * (acc[ai][bj][m][n] * rs[ai][m] * pw);
                asm volatile("" ::: "memory"); }
    }
};

struct SplitOrder {
    int vcu, ntm, nte;
    __device__ __forceinline__ bool next(int i, Unit& u) const {
        const int grp = vcu >> 2, j = vcu & 3;
        if (j < 3) { if (i > 0) return false; const int ti = grp * 3 + j; u.pm = ti >> 2; u.pn = ti & 3; u.k0 = 0; u.nt = ntm; return true; }
        if (i > 2) return false; { const int ti = grp * 3 + i; u.pm = ti >> 2; u.pn = ti & 3; u.k0 = ntm * 64; u.nt = nte; return true; }
    }
    __device__ __forceinline__ void a_ready(const Unit&) const {}
    __device__ __forceinline__ void done(const Unit&) const {}
};
struct EpiSplit {
    static constexpr bool PERM = true, AFTER_DRAIN = false;
    bf16_t* Fmain; bf16_t* Fextra;
    __device__ __forceinline__ void operator()(const f32x4 (&acc)[2][2][4][2], const Unit& u, int wr, int wc, int fr, int fq) const {
        bf16_t* O = u.k0 ? Fextra : Fmain;
#pragma unroll
        for (int ai = 0; ai < 2; ++ai)
#pragma unroll
            for (int m = 0; m < 4; ++m) {
                const int row = u.pm * BM + ai * HALF + wr * 64 + m * 16 + fr;
#pragma unroll
                for (int bj = 0; bj < 2; ++bj) { const int col = u.pn * BM + bj * HALF + wc * 32 + 8 * fq; *(u32x4*)(O + (size_t)row * DM + col) = pack8(acc[ai][bj][m][0], acc[ai][bj][m][1]); }
            }
    }
};

template <class Epi, class Sched, bool ALIGN_EPI = false, bool SP2 = false>
__device__ __forceinline__ void gemm_phase(PG8_LAS unsigned char* lds, const Gemm g, const Sched& S, const Epi& E) {
    const int tid = threadIdx.x, wid = __builtin_amdgcn_readfirstlane(tid >> 6), lane = tid & 63, wr = wid >> 2, wc = wid & 3, fr = lane & 15, fq = lane >> 4;
    const int K = g.K, nt = K / BK;
    unsigned voffA[2], voffB[2];
#pragma unroll
    for (int i = 0; i < 2; ++i) { int R, C; stage_rc(tid * 16 + i * 8192, R, C); const int Rb = Epi::PERM ? ((R & ~31) + perm32(R & 31)) : R;
        voffA[i] = (unsigned)(R * K + C) * 2u; voffB[i] = (unsigned)(Rb * K + C) * 2u; }
    const size_t kstep = (size_t)(BK * 2);
    const size_t hstep = (size_t)HALF * K * 2;
    const size_t tstep = 2 * hstep;
    const unsigned ldsw = (unsigned)wid * 1024u;
    const int aoff = lds_byte(wr * 64 + fr, fq * 8), boff = lds_byte(wc * 32 + fr, fq * 8);
#define PG8_SA(b, h) (((b) * 2 + (h)) * HTB)
#define PG8_SB(b, h) ((4 + (b) * 2 + (h)) * HTB)
#define PG8_STAGE(bufoff, gbase, voff) do { _Pragma("unroll") for (int _i = 0; _i < 2; ++_i) \
        __builtin_amdgcn_global_load_lds((const unsigned*)((const char*)(gbase) + (voff)[_i]), (PG8_LAS unsigned*)(lds + (bufoff) + ldsw + _i * 8192), 16, 0, 0); } while (0)
#define PG8_LDA(dst, b, h) do { _Pragma("unroll") for (int m = 0; m < 4; ++m) _Pragma("unroll") for (int k = 0; k < 2; ++k) dst[m][k] = *(const PG8_LAS bf16x8*)(lds + PG8_SA(b, h) + aoff + m * 2048 + k * 1024); } while (0)
#define PG8_LDB(dst, b, h) do { _Pragma("unroll") for (int n = 0; n < 2; ++n) _Pragma("unroll") for (int k = 0; k < 2; ++k) dst[n][k] = *(const PG8_LAS bf16x8*)(lds + PG8_SB(b, h) + boff + n * 2048 + k * 1024); } while (0)
#define PG8_MMA(ai, bj, At, Bt) do { __builtin_amdgcn_s_setprio(1); _Pragma("unroll") for (int m = 0; m < 4; ++m) _Pragma("unroll") for (int n = 0; n < 2; ++n) _Pragma("unroll") for (int k = 0; k < 2; ++k) \
        acc[ai][bj][m][n] = __builtin_amdgcn_mfma_f32_16x16x32_bf16(Bt[n][k], At[m][k], acc[ai][bj][m][n], 0, 0, 0); __builtin_amdgcn_s_setprio(0); } while (0)
#define PG8_WAIT_V(n) asm volatile("s_waitcnt vmcnt(" #n ")" ::: "memory")
#define PG8_WAIT_L(n) asm volatile("s_waitcnt lgkmcnt(" #n ")" ::: "memory")
#define PG8_BAR __builtin_amdgcn_s_barrier()
#define PG8_SCHED __builtin_amdgcn_sched_barrier(0)
    Unit cur, nxt; int ui = 0;
    if (!S.next(0, cur)) return;
    f32x4 acc[2][2][4][2];
#pragma unroll
    for (int a = 0; a < 2; ++a)
#pragma unroll
        for (int b = 0; b < 2; ++b)
#pragma unroll
            for (int m = 0; m < 4; ++m)
#pragma unroll
                for (int n = 0; n < 2; ++n) acc[a][b][m][n] = (f32x4){0.f, 0.f, 0.f, 0.f};
    bf16x8 At[4][2], B0[2][2], B1[2][2];
    const char* cA = (const char*)g.A + (size_t)cur.pm * tstep + (size_t)cur.k0 * 2; const char* cB = (const char*)g.Bt + (size_t)cur.pn * tstep + (size_t)cur.k0 * 2;
    int ntc = cur.nt ? cur.nt : nt;
    S.a_ready(cur);
    if constexpr (SP2) {
        PG8_STAGE(PG8_SB(0, 0), cB, voffB); PG8_STAGE(PG8_SB(0, 1), cB + hstep, voffB); PG8_STAGE(PG8_SA(0, 0), cA, voffA); PG8_STAGE(PG8_SA(0, 1), cA + hstep, voffA);
        if (wr == 1) PG8_BAR;
        PG8_WAIT_V(2); PG8_BAR;
        PG8_STAGE(PG8_SB(1, 0), cB + kstep, voffB); PG8_STAGE(PG8_SA(1, 0), cA + kstep, voffA); PG8_STAGE(PG8_SB(1, 1), cB + hstep + kstep, voffB);
        PG8_WAIT_V(6); PG8_BAR;
    } else {
        PG8_STAGE(PG8_SB(0, 0), cB, voffB); PG8_STAGE(PG8_SA(0, 0), cA, voffA); PG8_STAGE(PG8_SB(0, 1), cB + hstep, voffB); PG8_STAGE(PG8_SA(0, 1), cA + hstep, voffA);
        if (wr == 1) PG8_BAR;
        PG8_WAIT_V(4); PG8_BAR;
        PG8_STAGE(PG8_SB(1, 0), cB + kstep, voffB); PG8_STAGE(PG8_SA(1, 0), cA + kstep, voffA); PG8_STAGE(PG8_SB(1, 1), cB + hstep + kstep, voffB);
        PG8_WAIT_V(6); PG8_BAR;
    }
    for (;;) {
        const bool has_next = S.next(ui + 1, nxt);
        const char* nA = has_next ? (const char*)g.A + (size_t)nxt.pm * tstep + (size_t)nxt.k0 * 2 : cA; const char* nB = has_next ? (const char*)g.Bt + (size_t)nxt.pn * tstep + (size_t)nxt.k0 * 2 : cB;
        for (int t = 0; t < ntc; t += 2) {
            const bool last = (t == ntc - 2);
            const char* a1 = cA + (size_t)(t + 1) * kstep;
            const char* a2 = last ? nA : cA + (size_t)(t + 2) * kstep; const char* b2 = last ? nB : cB + (size_t)(t + 2) * kstep;
            const char* a3 = a2 + kstep; const char* b3 = b2 + kstep;
            if (last && has_next) S.a_ready(nxt);
            if constexpr (SP2) {
            PG8_LDB(B0, 0, 0); PG8_LDB(B1, 0, 1); PG8_SCHED; PG8_LDA(At, 0, 0); PG8_STAGE(PG8_SA(1, 1), a1 + hstep, voffA);
            PG8_WAIT_V(8); PG8_WAIT_L(0); PG8_BAR; PG8_MMA(0, 0, At, B0); PG8_MMA(0, 1, At, B1); PG8_BAR; PG8_SCHED;
            PG8_LDA(At, 0, 1); PG8_STAGE(PG8_SB(0, 0), b2, voffB); PG8_STAGE(PG8_SB(0, 1), b2 + hstep, voffB); PG8_STAGE(PG8_SA(0, 0), a2, voffA);
            PG8_WAIT_V(8); PG8_WAIT_L(0); PG8_BAR; PG8_MMA(1, 0, At, B0); PG8_MMA(1, 1, At, B1); PG8_BAR; PG8_SCHED;
            PG8_LDB(B0, 1, 0); PG8_LDB(B1, 1, 1); PG8_SCHED; PG8_LDA(At, 1, 0); PG8_STAGE(PG8_SA(0, 1), a2 + hstep, voffA);
            PG8_WAIT_V(8); PG8_WAIT_L(0); PG8_BAR; PG8_MMA(0, 0, At, B0); PG8_MMA(0, 1, At, B1); PG8_BAR; PG8_SCHED;
            PG8_LDA(At, 1, 1); PG8_STAGE(PG8_SB(1, 0), b3, voffB); PG8_STAGE(PG8_SB(1, 1), b3 + hstep, voffB); PG8_STAGE(PG8_SA(1, 0), a3, voffA);
            PG8_WAIT_V(8); PG8_WAIT_L(0); PG8_BAR; PG8_MMA(1, 0, At, B0); PG8_MMA(1, 1, At, B1); PG8_BAR; PG8_SCHED;
            } else {
            PG8_LDB(B0, 0, 0); PG8_SCHED; PG8_LDA(At, 0, 0); PG8_STAGE(PG8_SA(1, 1), a1 + hstep, voffA);
            PG8_WAIT_L(8); PG8_BAR; PG8_WAIT_L(0); PG8_MMA(0, 0, At, B0); PG8_BAR; PG8_SCHED;
            PG8_LDB(B1, 0, 1); PG8_STAGE(PG8_SB(0, 0), b2, voffB);
            PG8_BAR; PG8_WAIT_L(0); PG8_MMA(0, 1, At, B1); PG8_BAR;
            PG8_LDA(At, 0, 1); PG8_STAGE(PG8_SA(0, 0), a2, voffA);
            PG8_BAR; PG8_WAIT_L(0); PG8_MMA(1, 0, At, B0); PG8_BAR; PG8_SCHED;
            PG8_STAGE(PG8_SB(0, 1), b2 + hstep, voffB);
            PG8_WAIT_V(6); PG8_BAR; PG8_MMA(1, 1, At, B1); PG8_BAR;
            PG8_LDB(B0, 1, 0); PG8_SCHED; PG8_LDA(At, 1, 0); PG8_STAGE(PG8_SA(0, 1), a2 + hstep, voffA);
            PG8_WAIT_L(8); PG8_BAR; PG8_WAIT_L(0); PG8_MMA(0, 0, At, B0); PG8_BAR; PG8_SCHED;
            PG8_LDB(B1, 1, 1); PG8_STAGE(PG8_SB(1, 0), b3, voffB);
            PG8_BAR; PG8_WAIT_L(0); PG8_MMA(0, 1, At, B1); PG8_BAR;
            PG8_LDA(At, 1, 1); PG8_STAGE(PG8_SA(1, 0), a3, voffA);
            PG8_BAR; PG8_WAIT_L(0); PG8_MMA(1, 0, At, B0); PG8_BAR; PG8_SCHED;
            PG8_STAGE(PG8_SB(1, 1), b3 + hstep, voffB);
            PG8_WAIT_V(6); PG8_BAR; PG8_MMA(1, 1, At, B1); PG8_BAR;
            }
        }
        if constexpr (ALIGN_EPI) { if (wr == 0) PG8_BAR; }
        if constexpr (!Epi::AFTER_DRAIN) { E(acc, cur, wr, wc, fr, fq); S.done(cur); }
        if (!has_next) break;
#pragma unroll
        for (int a = 0; a < 2; ++a)
#pragma unroll
            for (int b = 0; b < 2; ++b)
#pragma unroll
                for (int m = 0; m < 4; ++m)
#pragma unroll
                    for (int n = 0; n < 2; ++n) acc[a][b][m][n] = (f32x4){0.f, 0.f, 0.f, 0.f};
        cur = nxt; cA = nA; cB = nB; ++ui; ntc = cur.nt ? cur.nt : nt;
        if constexpr (ALIGN_EPI) { if (wr == 1) PG8_BAR; }
    }
    PG8_WAIT_V(0);
    if constexpr (!ALIGN_EPI) { if (wr == 0) PG8_BAR; }
    PG8_BAR;
    if constexpr (Epi::AFTER_DRAIN) { E.fused(acc, cur, wr, wc, fr, fq, lds, wid, lane); S.done(cur); }
#undef PG8_SA
#undef PG8_SB
#undef PG8_STAGE
#undef PG8_LDA
#undef PG8_LDB
#undef PG8_MMA
#undef PG8_WAIT_V
#undef PG8_WAIT_L
#undef PG8_BAR
#undef PG8_SCHED
}
}

constexpr int NWAVES = 8;
constexpr size_t MiB = 1u << 20;
constexpr size_t WS_CTL = 0, CTL_ZERO_BYTES = 128 * 1024;
constexpr size_t WS_MOD = 1 * MiB;
constexpr size_t WS_ROPE = 1 * MiB + 256 * 1024;
constexpr size_t WS_CORD = 1 * MiB + 512 * 1024;
constexpr size_t WS_BA = 2 * MiB;
constexpr size_t WS_RSS1 = 4 * MiB, WS_RSS2 = 5 * MiB;
constexpr size_t WS_WIN = 6 * MiB, WS_WAO = 18 * MiB, WS_WDO = 19 * MiB, WS_WOUT = 20 * MiB, WS_W1 = 22 * MiB, WS_W2 = 30 * MiB;
constexpr size_t WS_XN = 38 * MiB;
constexpr size_t WS_ONA = 62 * MiB, WS_ODN = 74 * MiB;
constexpr size_t WS_KT = 134 * MiB;
constexpr int REC_SPLIT = 1228;
constexpr size_t WS_PA = 86 * MiB;
constexpr size_t WS_PB = 158 * MiB;
constexpr size_t WS_SC = 250 * MiB;
constexpr size_t WS_M1 = 224 * MiB;
constexpr size_t WS_CK = 248 * MiB, WS_CVT = 249 * MiB;
constexpr size_t WS_END = 256 * MiB;
constexpr size_t OUT_YP = 0, OUT_YS = (size_t)M_CTX * DM, OUT_K = (size_t)MT * DM, OUT_V = OUT_K + (size_t)32 * 8 * 256 * 64, OUT_S = OUT_V + (size_t)32 * 8 * 256 * 64;

constexpr int CW_BAR = 1024;
constexpr int CW_TMO = 8, CW_ADA = 64, CW_CQ = 96, CW_TF = 512, CW_SEAM = 8192, SEAM_BANK = 48 * 64;
constexpr int RING_BYTES = 131072, LDS_BYTES = 147456, LDSCTL_OFF = LDS_BYTES - 1024, MISC_OFF = LDSCTL_OFF + 320;

#define GAS __attribute__((address_space(1)))
#define LAS __attribute__((address_space(3)))
typedef unsigned short bf16;
typedef unsigned v4u __attribute__((ext_vector_type(4)));
typedef unsigned v2u __attribute__((ext_vector_type(2)));
typedef float f32x4 __attribute__((ext_vector_type(4)));
typedef float f32x16 __attribute__((ext_vector_type(16)));
typedef short bf16x8 __attribute__((ext_vector_type(8)));
#define LDS_WAIT() asm volatile("s_waitcnt lgkmcnt(0)" ::: "memory")
#define VM_WAIT() asm volatile("s_waitcnt vmcnt(0)" ::: "memory")
#define MFMA32(a, b, c) __builtin_amdgcn_mfma_f32_32x32x16_bf16((a), (b), (c), 0, 0, 0)
__device__ __forceinline__ unsigned f2bf(float f) { unsigned u = __builtin_bit_cast(unsigned, f); return (u + 0x7fffu + ((u >> 16) & 1u)) >> 16; }
typedef float f32x2_t __attribute__((ext_vector_type(2))); typedef __bf16 bf16x2_t __attribute__((ext_vector_type(2)));
__device__ __forceinline__ unsigned pk2(float lo, float hi) { f32x2_t v = {lo, hi}; bf16x2_t b = __builtin_convertvector(v, bf16x2_t); return __builtin_bit_cast(unsigned, b); }
__device__ __forceinline__ float bflo(unsigned w) { return __uint_as_float(w << 16); }
__device__ __forceinline__ float bfhi(unsigned w) { return __uint_as_float(w & 0xffff0000u); }
__device__ __forceinline__ float silu_(float x) { return x * __builtin_amdgcn_rcpf(1.0f + __expf(-x)); }
__device__ __forceinline__ float sigm_(float x) { return __builtin_amdgcn_rcpf(1.0f + __expf(-x)); }
__device__ __host__ __forceinline__ constexpr int swap23(int x) { return (x & ~12) | ((x & 4) << 1) | ((x & 8) >> 1); }
__device__ __forceinline__ int crow(int reg, int h) { return (reg & 3) + 8 * (reg >> 2) + 4 * h; }
template <int CTRL, int ROWMASK> __device__ __forceinline__ float dpp_add(float v) {
    return v + __builtin_bit_cast(float, __builtin_amdgcn_update_dpp(0, __builtin_bit_cast(int, v), CTRL, ROWMASK, 0xF, false));
}
__device__ __forceinline__ float wave_sum_dpp(float v) {
    v = dpp_add<0xB1, 0xF>(v);
    v = dpp_add<0x4E, 0xF>(v);
    v = dpp_add<0x141, 0xF>(v);
    v = dpp_add<0x140, 0xF>(v);
    v = dpp_add<0x142, 0xA>(v);
    v = dpp_add<0x143, 0xC>(v);
    return __builtin_bit_cast(float, __builtin_amdgcn_readlane(__builtin_bit_cast(int, v), 63));
}
__device__ __forceinline__ float wave_sum(float v) {
#pragma unroll
    for (int o = 1; o < 64; o <<= 1) v += __shfl_xor(v, o);
    return v;
}

#define XB_TMO      128
#define XB_XCNT(j)  (256  + 64 * (j))
#define XB_XSUB(j)  (1280 + 64 * (j))
#define XB_XGEN(j)  (2304 + 64 * (j))
#define XB_TOP      3328
#define XB_TOPGEN   3392
#define XCD_BAR_WORDS 3456
#define XB_SPIN_CAP (1u << 22)

__device__ __forceinline__ unsigned xb_ld(unsigned* p)              { return __hip_atomic_load(p, __ATOMIC_RELAXED, __HIP_MEMORY_SCOPE_AGENT); }
__device__ __forceinline__ unsigned xb_add(unsigned* p, unsigned v) { return __hip_atomic_fetch_add(p, v, __ATOMIC_RELAXED, __HIP_MEMORY_SCOPE_AGENT); }
__device__ __forceinline__ unsigned xb_xcc_id() { return (unsigned)__builtin_amdgcn_s_getreg((3 << 11) | 20) & 0xFu; }
#define XB_SPIN(cond, bar) do { unsigned _sp = 0; while (cond) { __builtin_amdgcn_s_sleep(1); \
    if ((++_sp & 255u) == 0u) { if (xb_ld(&(bar)[XB_TMO])) break; if (_sp > XB_SPIN_CAP) { atomicAdd(&(bar)[XB_TMO], 1u); break; } } } } while (0)

struct XcdBarrier { unsigned* bar; unsigned x; volatile LAS unsigned* st; };

__device__ __forceinline__ XcdBarrier xcd_barrier_post(unsigned* bar, volatile LAS unsigned* st) {
    XcdBarrier b; b.bar = bar; b.x = xb_xcc_id(); b.st = st;
    if (threadIdx.x == 0) (void)xb_add(&bar[XB_XCNT(b.x)], 1u);
    return b;
}
__device__ __forceinline__ void xcd_barrier_complete(unsigned* bar, unsigned x, unsigned& nloc, unsigned& nx) {
    const unsigned G = gridDim.x * gridDim.y * gridDim.z;
    unsigned sum, cnt, mine, sp = 0u;
    for (;;) {
        sum = 0u; cnt = 0u; mine = 0u;
#pragma unroll
        for (unsigned j = 0; j < 16; ++j) { const unsigned c = xb_ld(&bar[XB_XCNT(j)]); sum += c; cnt += (c > 0u) ? 1u : 0u; mine = (j == x) ? c : mine; }
        if (sum == G) break;
        __builtin_amdgcn_s_sleep(1);
        if ((++sp & 255u) == 0u) { if (xb_ld(&bar[XB_TMO])) break; if (sp > XB_SPIN_CAP) { atomicAdd(&bar[XB_TMO], 1u); break; } }
    }
    nloc = mine > 0u ? mine : 1u; nx = cnt > 0u ? cnt : 1u;
}
__device__ __forceinline__ void xcd_barrier(const XcdBarrier& b) {
    asm volatile("s_waitcnt vmcnt(0)" ::: "memory");
    __syncthreads();
    if (threadIdx.x == 0) {
        unsigned* bar = b.bar;
        __builtin_amdgcn_s_waitcnt(0);
        unsigned nloc = b.st[0], nx = b.st[1];
        if (nloc == 0u) { xcd_barrier_complete(bar, b.x, nloc, nx); b.st[0] = nloc; b.st[1] = nx; }
        const unsigned old = xb_add(&bar[XB_XSUB(b.x)], 1u);
        const unsigned gen = old / nloc;
        if (old + 1u == (gen + 1u) * nloc) {
            __builtin_amdgcn_fence(__ATOMIC_RELEASE, "agent");
            asm volatile("s_waitcnt vmcnt(0)" ::: "memory");
            const unsigned og = xb_add(&bar[XB_TOP], 1u);
            const unsigned tg = og / nx;
            if (og + 1u == (tg + 1u) * nx) xb_add(&bar[XB_TOPGEN], 1u);
            else XB_SPIN(xb_ld(&bar[XB_TOPGEN]) == tg, bar);
            __builtin_amdgcn_fence(__ATOMIC_ACQUIRE, "agent");
            xb_add(&bar[XB_XGEN(b.x)], 1u);
            asm volatile("s_waitcnt vmcnt(0)" ::: "memory");
        } else {
            XB_SPIN(xb_ld(&bar[XB_XGEN(b.x)]) == gen, bar);
            __builtin_amdgcn_fence(__ATOMIC_ACQUIRE, "agent");
            asm volatile("s_waitcnt vmcnt(0)" ::: "memory");
        }
    }
    __syncthreads();
}

struct Args { const float* in[24]; float* out; unsigned char* ws; int ph_lo, ph_hi; };
enum { I_XP = 0, I_XS, I_C, I_CK, I_CV, I_ST, I_CCTX, I_WADA, I_BADA, I_PRE1, I_POST1, I_PRE2, I_POST2, I_WIN, I_CONVW, I_ALOG, I_DTB, I_DNN, I_RPB, I_WAO, I_WDO, I_WOUT, I_WFF1, I_WFF2 };

__device__ __forceinline__ void p0_transpose_item(const float* W, int K, int N, bf16* WT, LAS float* scr, int item, int lane) {
    const int nblk = N / 32, kb = item / nblk, nb = item % nblk, k0 = 64 * kb, n0 = 32 * nb;
    {
        f32x4 v[8]; const int kr = lane >> 3, nq = (lane & 7) * 4;
#pragma unroll
        for (int i = 0; i < 8; ++i) v[i] = *(const f32x4*)(W + (size_t)(k0 + 8 * i + kr) * N + n0 + nq);
        asm volatile("" ::: "memory");
#pragma unroll
        for (int i = 0; i < 8; ++i) { LAS float* d = scr + (8 * i + kr) * 33 + nq; d[0] = v[i].x; d[1] = v[i].y; d[2] = v[i].z; d[3] = v[i].w; }
    }
    LDS_WAIT();
    const int c = lane & 7;
#pragma unroll
    for (int j = 0; j < 4; ++j) { const int n = (lane >> 3) + 8 * j; const LAS float* s = scr + (8 * c) * 33 + n;
        v4u o; o.x = pk2(s[0 * 33], s[1 * 33]); o.y = pk2(s[2 * 33], s[3 * 33]); o.z = pk2(s[4 * 33], s[5 * 33]); o.w = pk2(s[6 * 33], s[7 * 33]);
        *(v4u*)(WT + (size_t)(n0 + n) * K + k0 + 8 * c) = o; }
    LDS_WAIT();
}

__device__ __forceinline__ void phase_prologue(const Args& a, LAS unsigned char* lds, int vcu, int G) {
    const int tid = threadIdx.x, lane = tid & 63, wave = __builtin_amdgcn_readfirstlane(tid >> 6);
    unsigned char* ws = a.ws;
    if (vcu < 192) {
        LAS float* sl = (LAS float*)lds;
        LAS float* red = (LAS float*)(lds + 20480);
        for (int i = tid; i < 5 * 1024; i += 512) { const float v = i < 1024 ? a.in[I_CCTX][i] : a.in[I_C][i - 1024]; sl[i] = silu_(v); }
        __syncthreads();
        const int col = 32 * vcu + (lane & 31), rg = wave * 2 + (lane >> 5);
        const float* w = a.in[I_WADA] + (size_t)(rg * 64) * 6144 + col;
        float acc[5] = {0.f, 0.f, 0.f, 0.f, 0.f};
#pragma unroll 8
        for (int i = 0; i < 64; ++i) { const float wv = w[(size_t)i * 6144]; const int k = rg * 64 + i;
#pragma unroll
            for (int v = 0; v < 5; ++v) acc[v] += sl[v * 1024 + k] * wv; }
#pragma unroll
        for (int v = 0; v < 5; ++v) red[(rg * 5 + v) * 32 + (lane & 31)] = acc[v];
        __syncthreads();
        if (tid < 160) { const int v = tid >> 5, cl = tid & 31; float s = a.in[I_BADA][32 * vcu + cl];
            for (int r = 0; r < 16; ++r) s += red[(r * 5 + v) * 32 + cl];
            ((float*)(ws + WS_MOD))[v * 6144 + 32 * vcu + cl] = s; }
        asm volatile("s_waitcnt vmcnt(0)" ::: "memory");
        __syncthreads();
        if (tid == 0) { __builtin_amdgcn_fence(__ATOMIC_RELEASE, "agent"); asm volatile("s_waitcnt vmcnt(0)" ::: "memory");
            __hip_atomic_fetch_add((unsigned*)(ws + WS_CTL) + CW_ADA, 1u, __ATOMIC_RELAXED, __HIP_MEMORY_SCOPE_AGENT); }
    } else if (vcu == 192) {
        float* rope = (float*)(ws + WS_ROPE);
        for (int i = tid; i < 1024; i += 512) { const int pos = i >> 4, f = i & 15; const float inv = powf(10000.0f, -(float)f / 16.0f); const float ang = (float)pos * inv; rope[i] = cosf(ang); rope[1024 + i] = sinf(ang); }
    } else if (vcu < 225) {
        const int bh = vcu - 193;
        const float* ck = a.in[I_CK] + (size_t)bh * 256 * 64; const float* cv = a.in[I_CV] + (size_t)bh * 256 * 64;
        bf16* CK = (bf16*)(ws + WS_CK) + (size_t)bh * 256 * 64; bf16* CVT = (bf16*)(ws + WS_CVT) + (size_t)bh * 64 * 256;
        for (int i = tid; i < 256 * 8; i += 512) { const int key = i >> 3, c8 = i & 7;
            const f32x4 k0 = *(const f32x4*)(ck + key * 64 + c8 * 8), k1 = *(const f32x4*)(ck + key * 64 + c8 * 8 + 4);
            v4u o; o.x = pk2(k0[0], k0[1]); o.y = pk2(k0[2], k0[3]); o.z = pk2(k1[0], k1[1]); o.w = pk2(k1[2], k1[3]);
            *(v4u*)(CK + key * 64 + c8 * 8) = o;
            const f32x4 v0 = *(const f32x4*)(cv + key * 64 + c8 * 8), v1 = *(const f32x4*)(cv + key * 64 + c8 * 8 + 4);
            const int pos = (key & ~12) | ((key & 4) << 1) | ((key & 8) >> 1);
#pragma unroll
            for (int j = 0; j < 4; ++j) { CVT[(c8 * 8 + j) * 256 + pos] = (bf16)f2bf(v0[j]); CVT[(c8 * 8 + 4 + j) * 256 + pos] = (bf16)f2bf(v1[j]); }
        }
    }
    if (vcu == G - 1) {
        LAS unsigned char* late = (LAS unsigned char*)(lds + 8192); LAS unsigned char* dep = late + 512;
        for (int i = tid; i < 384; i += 512) late[i] = 0;
        __syncthreads();
        { pg8::StaticOrder S; S.init(MT, NINP, G, tid); const int lastr = (S.nwg - 1) / G; pg8::Unit u;
          if (tid < G && S.next(lastr, u) && u.pn >= 6 && u.pn <= 12) late[u.pm * 8 + u.pn - 6] = 1; }
        __syncthreads();
        for (int g = tid; g < 576; g += 512) { const int chunk = g / 3, part = g - 3 * chunk, pm = chunk >> 2;
            int dd = late[pm * 8 + 2 * part] | late[pm * 8 + 2 * part + 1];
            if (part == 2) dd |= late[pm * 8 + 6];
            if (pm >= 32) { const int kc = (chunk - 128) & 15;
                if ((chunk & 3) == 0 && kc != 0) dd |= late[(pm - 1) * 8 + 2 * part] | late[(pm - 1) * 8 + 2 * part + 1];
                if ((chunk & 3) == 3 && kc != 15) dd |= late[(pm + 1) * 8 + 2 * part] | late[(pm + 1) * 8 + 2 * part + 1]; }
            dep[g] = (unsigned char)dd; }
        __syncthreads();
        for (int g = tid; g < 576; g += 512) { int before_same = 0, n_early = 0; const int mine = dep[g];
            for (int j = 0; j < 576; ++j) { const int dj = dep[j]; n_early += (dj == 0); before_same += (j < g && dj == mine); }
            ((unsigned*)(ws + WS_CORD))[mine ? n_early + before_same : before_same] = (unsigned)g; }
        __syncthreads();
    }
    LAS float* scr = (LAS float*)(lds + 32768 + wave * 8704);
    const int gw = vcu * NWAVES + wave, NGW = G * NWAVES;
    constexpr int I_IN = 16 * 177, I_AO = 8 * 32, I_DO = 8 * 32;
    constexpr int NITEMS = I_IN + I_AO + I_DO;
    for (int it = gw; it < NITEMS; it += NGW) {
        int r = it;
        if (r < I_IN) { p0_transpose_item(a.in[I_WIN], 1024, NIN, (bf16*)(ws + WS_WIN), scr, r, lane); continue; } r -= I_IN;
        if (r < I_AO) { p0_transpose_item(a.in[I_WAO], 512, 1024, (bf16*)(ws + WS_WAO), scr, r, lane); continue; } r -= I_AO;
        p0_transpose_item(a.in[I_WDO], 512, 1024, (bf16*)(ws + WS_WDO), scr, r, lane);
    }
    { v4u* z = (v4u*)((bf16*)(ws + WS_WIN) + (size_t)NIN * 1024); const int n16 = (NINP - NIN) * 1024 * 2 / 16;
      for (int i = gw * 64 + lane; i < n16; i += NGW * 64) z[i] = (v4u){0u, 0u, 0u, 0u}; }
    if (wave == 0) {
        unsigned* cnt = (unsigned*)(ws + WS_CTL) + CW_ADA; const unsigned want = (unsigned)(G < 192 ? G : 192); unsigned sp = 0;
        while ((unsigned)__builtin_amdgcn_readfirstlane(__hip_atomic_load(cnt, __ATOMIC_RELAXED, __HIP_MEMORY_SCOPE_AGENT)) < want) { __builtin_amdgcn_s_sleep(2); if (++sp > (1u << 22)) break; }
        __builtin_amdgcn_fence(__ATOMIC_ACQUIRE, "agent");
        asm volatile("s_waitcnt vmcnt(0)" ::: "memory");
    }
    __syncthreads();
}

__device__ __forceinline__ void late_transposes(const Args& a, LAS unsigned char* lds, int idle_idx, int n_idle) {
    const int tid = threadIdx.x, lane = tid & 63, wave = __builtin_amdgcn_readfirstlane(tid >> 6);
    LAS float* scr = (LAS float*)(lds + wave * 8704);
    constexpr int I_OUT = 16 * 32, I_1 = 16 * 128, I_2 = 64 * 32;
    for (int it = idle_idx * NWAVES + wave; it < I_OUT + I_1 + I_2; it += n_idle * NWAVES) {
        int r = it;
        if (r < I_OUT) { p0_transpose_item(a.in[I_WOUT], 1024, 1024, (bf16*)(a.ws + WS_WOUT), scr, r, lane); continue; } r -= I_OUT;
        if (r < I_1) { p0_transpose_item(a.in[I_WFF1], 1024, FF, (bf16*)(a.ws + WS_W1), scr, r, lane); continue; } r -= I_1;
        p0_transpose_item(a.in[I_WFF2], FF, 1024, (bf16*)(a.ws + WS_W2), scr, r, lane);
    }
}

__device__ __forceinline__ const float* x_row(const Args& a, int m) { return m < M_CTX ? a.in[I_XP] + (size_t)m * DM : a.in[I_XS] + (size_t)(m - M_CTX) * DM; }
__device__ __forceinline__ int mod_idx(int m) { return m < M_CTX ? 0 : 1 + ((m - M_CTX) >> 10); }

__device__ __forceinline__ void phase_xn(const Args& a, int vcu, int G) {
    const int tid = threadIdx.x, lane = tid & 63, wave = tid >> 6;
    const int gw = vcu * NWAVES + wave, NGW = G * NWAVES;
    const float* MOD = (const float*)(a.ws + WS_MOD); bf16* XN = (bf16*)(a.ws + WS_XN);
    for (int m = gw; m < MT; m += NGW) {
        const f32x4* xr = (const f32x4*)x_row(a, m) + lane;
        const float* md = MOD + mod_idx(m) * 6144;
        f32x4 v[4]; float s = 0.f;
#pragma unroll
        for (int j = 0; j < 4; ++j) { v[j] = xr[64 * j]; s += (v[j].x * v[j].x + v[j].y * v[j].y) + (v[j].z * v[j].z + v[j].w * v[j].w); }
        const float rstd = rsqrtf(wave_sum(s) * (1.f / DM) + 1e-6f);
        v2u* o8 = (v2u*)(XN + (size_t)m * DM) + lane;
#pragma unroll
        for (int j = 0; j < 4; ++j) { const int c = (lane + 64 * j) * 4;
            const f32x4 w = *(const f32x4*)(a.in[I_PRE1] + c), sh = *(const f32x4*)(md + c), sc = *(const f32x4*)(md + 1024 + c);
            const f32x4 h = v[j] * rstd * w * (sc + 1.0f) + sh;
            v2u o; o.x = pk2(h.x, h.y); o.y = pk2(h.z, h.w); o8[64 * j] = o; }
    }
}

__device__ __forceinline__ bf16x8 pack_regs(const f32x16& p, int s) {
    v4u w; w.x = pk2(p[8 * s], p[8 * s + 1]); w.y = pk2(p[8 * s + 2], p[8 * s + 3]); w.z = pk2(p[8 * s + 4], p[8 * s + 5]); w.w = pk2(p[8 * s + 6], p[8 * s + 7]);
    return __builtin_bit_cast(bf16x8, w);
}
__device__ __forceinline__ void store_o(bf16* dst, const f32x16& o0, const f32x16& o1, float inv, int hh) {
#pragma unroll
    for (int g = 0; g < 4; ++g) {
        v2u w0, w1; w0.x = pk2(o0[4 * g] * inv, o0[4 * g + 1] * inv); w0.y = pk2(o0[4 * g + 2] * inv, o0[4 * g + 3] * inv);
        w1.x = pk2(o1[4 * g] * inv, o1[4 * g + 1] * inv); w1.y = pk2(o1[4 * g + 2] * inv, o1[4 * g + 3] * inv);
        *(v2u*)(dst + 8 * g + 4 * hh) = w0; *(v2u*)(dst + 32 + 8 * g + 4 * hh) = w1;
    }
}
constexpr float LOG2E = 1.4426950408889634f;

struct AttnTile { const bf16* k; const bf16* v0; const bf16* v1; };
template <bool LAT>
__device__ __forceinline__ void attn_task(const Args& a, int task, int lane, LAS float* wl) {
    const int r = lane & 31, hh = lane >> 5;
    const bf16* Qb = (const bf16*)(a.ws + WS_M1); const bf16* Kbuf = Qb + (size_t)MT * 512; bf16* ONA = (bf16*)(a.ws + WS_ONA);
    int b, h, rowq, gr = 0, cq = 0;
    if (LAT) { const int half = task & 1; gr = (task >> 1) & 15; h = (task >> 5) & 7; b = task >> 8; cq = 32 * half + r; rowq = M_CTX + b * 1024 + gr * 64 + cq; }
    else { const int qb = task & 7; h = (task >> 3) & 7; b = task >> 6; rowq = b * 256 + qb * 32 + r; }
    constexpr int NT = LAT ? 24 : 8;
    const int rs = LAT ? min(max(gr - 4, 0), 8) : 0;
    LAS unsigned char* lk = (LAS unsigned char*)wl; LAS unsigned char* lv = lk + 4096; LAS float* rpb = wl + 2048;
    int boff[2][16];
    LDS_WAIT();
    if (LAT) {
#pragma unroll
        for (int i = 0; i < 4; ++i) { const int idx = lane + 64 * i, kk = idx >> 5, j = idx & 31; rpb[idx] = j < 31 ? a.in[I_RPB][h * 465 + (rs - gr + 7 + kk) * 31 + j] * LOG2E : -1.0e30f; }
        const int cs_ = min(max(cq - 8, 0), 48);
#pragma unroll
        for (int ct = 0; ct < 2; ++ct)
#pragma unroll
            for (int i = 0; i < 16; ++i) { const int kc = ct * 32 + crow(i, hh); boff[ct][i] = (kc >= cs_ && kc < cs_ + 16) ? kc - cq + 15 : 31; } }
    const int kro = lane >> 3, kch = lane & 7, vro = lane >> 2, vch = lane & 3;
    const bf16* gKl = Kbuf + (size_t)(LAT ? M_CTX + b * 1024 : b * 256) * 512 + h * 64 + (size_t)kro * 512 + kch * 8;
    const bf16* gVl = (const bf16*)a.out + (size_t)3 * MT * 512 + (LAT ? (size_t)M_CTX * 512 + (size_t)(b * 8 + h) * 64 * 1024 : (size_t)(b * 8 + h) * 64 * 256) + (size_t)vro * (LAT ? 1024 : 256) + vch * 8;
    const bf16* gKc = (const bf16*)(a.ws + WS_CK) + (size_t)(b * 8 + h) * 256 * 64 + kro * 64 + kch * 8;
    const bf16* gVc = (const bf16*)(a.ws + WS_CVT) + (size_t)(b * 8 + h) * 64 * 256 + vro * 256 + vch * 8;
    v4u gk[4], gv[4];
#define AT_GLOAD(t_) do { const int tt_ = (t_); \
        if (LAT && tt_ < 8) { _Pragma("unroll") for (int i_ = 0; i_ < 4; ++i_) { gk[i_] = *(const v4u*)(gKc + (size_t)(tt_ * 32 + 8 * i_) * 64); gv[i_] = *(const v4u*)(gVc + (size_t)(16 * i_) * 256 + 32 * tt_); } } \
        else { const int tk_ = LAT ? (rs + ((tt_ - 8) >> 1)) * 64 + ((tt_ - 8) & 1) * 32 : 32 * tt_; \
            _Pragma("unroll") for (int i_ = 0; i_ < 4; ++i_) { gk[i_] = *(const v4u*)(gKl + (size_t)(tk_ + 8 * i_) * 512); gv[i_] = *(const v4u*)(gVl + (size_t)(16 * i_) * (LAT ? 1024 : 256) + tk_); } } } while (0)
    const int kwoff = kro * 128 + ((kch ^ (kro & 7)) << 4);
    const int vwoff = vro * 64 + ((vch ^ ((vro >> 2) & 3)) << 4);
#define AT_LWRITE() do { _Pragma("unroll") for (int i_ = 0; i_ < 4; ++i_) { *(LAS v4u*)(lk + kwoff + i_ * 1024) = gk[i_]; *(LAS v4u*)(lv + vwoff + i_ * 1024) = gv[i_]; } } while (0)
    const int kroff = r * 128, ksw = r & 7, vsw = (r >> 2) & 3;
    bf16x8 kf[4], vf[4];
#define AT_LREAD() do { _Pragma("unroll") for (int s_ = 0; s_ < 4; ++s_) kf[s_] = *(const LAS bf16x8*)(lk + kroff + (((2 * s_ + hh) ^ ksw) << 4)); \
        _Pragma("unroll") for (int q_ = 0; q_ < 4; ++q_) vf[q_] = *(const LAS bf16x8*)(lv + (32 * (q_ >> 1) + r) * 64 + (((2 * (q_ & 1) + hh) ^ vsw) << 4)); } while (0)
    bf16x8 qf[4];
    { const bf16* Pq = Qb + (size_t)rowq * 512 + h * 64 + 8 * hh;
#pragma unroll
      for (int s = 0; s < 4; ++s) qf[s] = *(const bf16x8*)(Pq + 16 * s); }
    float m = -3.0e38f, l = 0.f; f32x16 o0 = {}, o1 = {};
    const float sc = 0.125f * LOG2E;
#define AT_SOFTPV() \
        float tm = S[0]; _Pragma("unroll") for (int i = 1; i < 16; ++i) tm = fmaxf(tm, S[i]); \
        tm = fmaxf(tm, __shfl_xor(tm, 32)); \
        if (__any(tm > m)) { const float mn = fmaxf(m, tm); const float al = __builtin_amdgcn_exp2f(m - mn); m = mn; l *= al; o0 = o0 * al; o1 = o1 * al; }     \
        float ps = 0.f; _Pragma("unroll") for (int i = 0; i < 16; ++i) { S[i] = __builtin_amdgcn_exp2f(S[i] - m); ps += S[i]; } \
        l += ps; \
        const bf16x8 p0_ = pack_regs(S, 0), p1_ = pack_regs(S, 1); \
        o0 = MFMA32(vf[0], p0_, o0); o0 = MFMA32(vf[1], p1_, o0); o1 = MFMA32(vf[2], p0_, o1); o1 = MFMA32(vf[3], p1_, o1);
#define AT_STEP(t_, LOCAL_) do { AT_LREAD(); AT_GLOAD(min((t_) + 1, NT - 1)); \
        f32x16 S = {}; _Pragma("unroll") for (int s_ = 0; s_ < 4; ++s_) S = MFMA32(kf[s_], qf[s_], S); \
        if (LOCAL_) { const int tl_ = (t_) - 8; const LAS float* rp_ = rpb + (tl_ >> 1) * 32; \
            if (tl_ & 1) { _Pragma("unroll") for (int i = 0; i < 16; ++i) S[i] = S[i] * sc + rp_[boff[1][i]]; } \
            else { _Pragma("unroll") for (int i = 0; i < 16; ++i) S[i] = S[i] * sc + rp_[boff[0][i]]; } } \
        else { _Pragma("unroll") for (int i = 0; i < 16; ++i) S[i] *= sc; } \
        AT_SOFTPV() \
        AT_LWRITE(); } while (0)
    AT_GLOAD(0); AT_LWRITE();
    if (LAT) {
        for (int t = 0; t < 8; ++t) AT_STEP(t, false);
        for (int t = 8; t < NT; ++t) AT_STEP(t, true);
    } else {
        for (int t = 0; t < NT; ++t) AT_STEP(t, false);
    }
#undef AT_GLOAD
#undef AT_LWRITE
#undef AT_LREAD
#undef AT_SOFTPV
#undef AT_STEP
    l += __shfl_xor(l, 32);
    store_o(ONA + (size_t)rowq * 512 + h * 64, o0, o1, 1.0f / l, hh);
    LDS_WAIT();
}

__device__ __forceinline__ void conv_task(const Args& a, int task, int lane, LAS unsigned char* wl) {
    const int hd = task & 7, part = (task >> 3) % 3, chunk = task / 24, r0 = chunk * 64;
    const bf16* P = (const bf16*)(a.ws + WS_PA);
    int seq0, T_, sb_;
    if (r0 < M_CTX) { seq0 = r0 & ~255; T_ = 256; sb_ = (r0 >> 8) * 8 + hd; } else { seq0 = M_CTX + ((r0 - M_CTX) & ~1023); T_ = 1024; sb_ = ((r0 - M_CTX) >> 10) * 8 + hd; }
    const int seq1 = seq0 + T_, kc = (r0 - seq0) >> 6, NC = T_ >> 6;
    const int ch = part * 512 + hd * 64 + lane;
    float w[5];
#pragma unroll
    for (int t = 0; t < 5; ++t) w[t] = a.in[I_CONVW][t * 1536 + ch];
    const bf16* src = P + C_DN + ch;
    float x[68];
    {
        unsigned raw[68];
#pragma unroll
        for (int i = 0; i < 68; ++i) { const int row = r0 - 2 + i; const int rc = min(max(row, seq0), seq1 - 1); raw[i] = src[(size_t)rc * LDA_]; }
        asm volatile("" ::: "memory");
#pragma unroll
        for (int i = 0; i < 68; ++i) { const int row = r0 - 2 + i; x[i] = (row >= seq0 && row < seq1) ? bflo(raw[i]) : 0.f; }
    }
    float o[64];
#pragma unroll
    for (int rr = 0; rr < 64; ++rr) { const float v = w[0] * x[rr] + w[1] * x[rr + 1] + w[2] * x[rr + 2] + w[3] * x[rr + 3] + w[4] * x[rr + 4]; o[rr] = silu_(v); }
    if (part < 2) {
#pragma unroll
        for (int rr = 0; rr < 64; ++rr) { const float ss = wave_sum_dpp(o[rr] * o[rr]); o[rr] *= __builtin_amdgcn_rsqf(ss + 1e-6f); }
        const int p = swap23(lane), pc = p >> 3, pe = (p & 7) * 2;
#pragma unroll
        for (int rr = 0; rr < 64; ++rr) *(LAS bf16*)(wl + rr * 128 + ((pc ^ (rr & 7)) << 4) + pe) = (bf16)f2bf(o[rr]);
        LDS_WAIT();
        const int fr_ = lane & 31, fh_ = lane >> 5;
        bf16* dst = (bf16*)a.out + (size_t)part * MT * 512 + (size_t)((r0 < M_CTX ? 512 + sb_ * 4 : sb_ * 16) + kc) * 4096 + lane * 8;
#pragma unroll
        for (int f = 0; f < 8; ++f) { const int row = 32 * (f >> 2) + fr_; *(v4u*)(dst + f * 512) = *(const LAS v4u*)(wl + row * 128 + (((2 * (f & 3) + fh_) ^ (row & 7)) << 4)); }
        LDS_WAIT();
    }
    if (part == 1) {
        const int td0 = (r0 < M_CTX ? 512 + sb_ * 4 : sb_ * 16), ib = lane >> 5, rl = lane & 31;
        bf16* ktf = (bf16*)(a.ws + WS_KT) + (size_t)(td0 + kc) * 4096 + ib * 2048 + rl * 8;
        bf16* ktb = (bf16*)(a.ws + WS_KT) + (size_t)MT * 512 + (size_t)(td0 + NC - 1 - kc) * 4096 + ib * 2048 + rl * 8;
#pragma unroll
        for (int q = 0; q < 8; ++q) { v4u wf, wb;
            wf.x = pk2(o[swap23(8 * q + 0)], o[swap23(8 * q + 1)]); wf.y = pk2(o[swap23(8 * q + 2)], o[swap23(8 * q + 3)]); wf.z = pk2(o[swap23(8 * q + 4)], o[swap23(8 * q + 5)]); wf.w = pk2(o[swap23(8 * q + 6)], o[swap23(8 * q + 7)]);
            wb.x = pk2(o[63 - swap23(8 * q + 0)], o[63 - swap23(8 * q + 1)]); wb.y = pk2(o[63 - swap23(8 * q + 2)], o[63 - swap23(8 * q + 3)]); wb.z = pk2(o[63 - swap23(8 * q + 4)], o[63 - swap23(8 * q + 5)]); wb.w = pk2(o[63 - swap23(8 * q + 6)], o[63 - swap23(8 * q + 7)]);
            const int off = (q >> 1) * 512 + (q & 1) * 256;
            *(v4u*)(ktf + off) = wf; *(v4u*)(ktb + off) = wb; }
    }
    if (part == 2) {
        const int jw = lane >> 5, r = lane & 31;
        const int td0 = (r0 < M_CTX ? 512 + sb_ * 4 : sb_ * 16);
        const float* BA = (const float*)(a.ws + WS_BA) + (size_t)(r0 + lane) * 32 + hd;
        const float bet[2] = {sigm_(BA[0]), sigm_(BA[8])};
#pragma unroll
        for (int dd = 0; dd < 2; ++dd) {
            float ov[64];
#pragma unroll
            for (int rr = 0; rr < 64; ++rr) ov[rr] = o[rr] * __builtin_bit_cast(float, __builtin_amdgcn_readlane(__builtin_bit_cast(int, bet[dd]), rr));
            const int taskd = td0 + (dd ? NC - 1 - kc : kc);
            bf16* base = (dd ? (bf16*)(a.ws + WS_ODN) : (bf16*)a.out + (size_t)2 * MT * 512) + ((size_t)(taskd * 2 + jw) * 2 * 64 + r) * 16;
#pragma unroll
            for (int cb = 0; cb < 2; ++cb)
#pragma unroll
                for (int hh = 0; hh < 2; ++hh) { v4u w0, w1;
#define CV(g_) ov[dd ? 63 - (32 * cb + crow((g_), hh)) : (32 * cb + crow((g_), hh))]
                    w0.x = pk2(CV(0), CV(1)); w0.y = pk2(CV(2), CV(3)); w0.z = pk2(CV(4), CV(5)); w0.w = pk2(CV(6), CV(7));
                    w1.x = pk2(CV(8), CV(9)); w1.y = pk2(CV(10), CV(11)); w1.z = pk2(CV(12), CV(13)); w1.w = pk2(CV(14), CV(15));
#undef CV
                    bf16* dp = base + (size_t)(cb * 64 + hh * 32) * 16; *(v4u*)dp = w0; *(v4u*)(dp + 8) = w1; }
        }
    }
}

__device__ __forceinline__ void conv_wait(const unsigned* tf, int g, int lane) {
    const int chunk = g / 3, part = g - 3 * chunk, pm = chunk >> 2;
    int pmh = -1;
    if (pm >= 32) { const int kc = (chunk - 128) & 15; if ((chunk & 3) == 0 && kc != 0) pmh = pm - 1; if ((chunk & 3) == 3 && kc != 15) pmh = pm + 1; }
    int idx = -1;
    if (lane < 2) idx = pm * 8 + 2 * part + lane;
    else if (lane < 4) idx = pmh < 0 ? -1 : pmh * 8 + 2 * part + (lane - 2);
    else if (lane == 4) idx = part == 2 ? pm * 8 + 6 : -1;
    unsigned sp = 0;
    for (;;) {
        unsigned v = 8u;
        if (idx >= 0) v = __hip_atomic_load(tf + idx, __ATOMIC_RELAXED, __HIP_MEMORY_SCOPE_AGENT);
        if (__ballot(v < 8u) == 0ull) break;
        __builtin_amdgcn_s_sleep(8); if (++sp > (1u << 20)) break;
    }
    __builtin_amdgcn_fence(__ATOMIC_ACQUIRE, "agent");
}
__device__ __forceinline__ void phase_conv(const Args& a, LAS unsigned char* lds, int vcu, int G) {
    const int tid = threadIdx.x, wave = __builtin_amdgcn_readfirstlane(tid >> 6);
    unsigned* ctl = (unsigned*)(a.ws + WS_CTL); const unsigned* tf = ctl + CW_TF; const unsigned* order = (const unsigned*)(a.ws + WS_CORD);
    LAS int* qslot = (LAS int*)(lds + 65536);
    int nx = 0;
    if (tid == 0) nx = (int)__hip_atomic_fetch_add(ctl + CW_CQ, 1u, __ATOMIC_RELAXED, __HIP_MEMORY_SCOPE_AGENT);
    for (;;) {
        if (tid == 0) *qslot = nx;
        __syncthreads();
        const int rk = *qslot;
        if (rk >= 576) break;
        const int g = __builtin_amdgcn_readfirstlane((int)order[rk]);
        if (wave == 0) conv_wait(tf, g, tid);
        __syncthreads();
        if (tid == 0) nx = (int)__hip_atomic_fetch_add(ctl + CW_CQ, 1u, __ATOMIC_RELAXED, __HIP_MEMORY_SCOPE_AGENT);
        { int lane = tid & 63; asm volatile("" : "+v"(lane)); conv_task(a, g * 8 + wave, lane, lds + wave * 8192); }
    }
}

__device__ __forceinline__ bf16* rec_ptr(unsigned char* ws, int task) { return task < REC_SPLIT ? (bf16*)(ws + WS_XN) + (size_t)task * 10240 : (bf16*)(ws + WS_PA) + (size_t)(task - REC_SPLIT) * 10240; }
struct DnChain { int b, h, dir, T, rowbase, task0; bool lat; };
__device__ __forceinline__ DnChain dn_decode(int chain) {
    DnChain d; d.lat = chain < 64;
    if (d.lat) { d.b = chain >> 4; d.h = (chain >> 1) & 7; d.dir = chain & 1; d.T = 1024; d.rowbase = M_CTX + d.b * 1024; d.task0 = chain * 16; }
    else { const int c = chain - 64; d.b = c >> 4; d.h = (c >> 1) & 7; d.dir = c & 1; d.T = 256; d.rowbase = d.b * 256; d.task0 = 1024 + c * 4; }
    return d;
}

__device__ __forceinline__ void dn_pre_task(const Args& a, int task, LAS float* LT, LAS float* tab, int lane) {
    int chain, n;
    if (task < 1024) { chain = task >> 4; n = task & 15; } else { const int t2 = task - 1024; chain = 64 + (t2 >> 2); n = t2 & 3; }
    const DnChain d = dn_decode(chain);
    const int h = d.h, dir = d.dir;
    const bf16* DQ = (const bf16*)a.out; const bf16* DK = DQ + (size_t)MT * 512;
    const float* BA = (const float*)(a.ws + WS_BA);
    bf16* rec = rec_ptr(a.ws, task); bf16* Tm = rec; bf16* QKm = rec + 3072; bf16* Kb = rec + 6144;
    float* SC = (float*)(a.ws + WS_SC) + (size_t)task * 320;
    const int R0 = d.rowbase + (dir ? d.T - 1 - 64 * n : 64 * n), RS = dir ? -1 : 1;
    const int r = lane & 31, hh = lane >> 5;
    {
        const float* ba = BA + (size_t)(R0 + lane * RS) * 32;
        const float beta = sigm_(ba[dir * 8 + h]);
        const float xx = ba[16 + dir * 8 + h] + a.in[I_DTB][dir * 8 + h];
        const float sp = xx > 20.f ? xx : log1pf(__expf(xx));
        float gc = -__expf(a.in[I_ALOG][dir * 8 + h]) * sp;
#pragma unroll
        for (int o = 1; o < 64; o <<= 1) { const float t = __shfl_up(gc, o); if (lane >= o) gc += t; }
        const float gl = __shfl(gc, 63);
        const float eg = __expf(gc);
        SC[lane] = beta; SC[64 + lane] = beta * eg; SC[128 + lane] = 0.125f * eg; SC[192 + lane] = __expf(gl - gc); SC[256 + lane] = __expf(gl);
        LDS_WAIT();
        tab[lane] = gc; tab[64 + lane] = beta;
        LDS_WAIT();
    }
    bf16x8 kf[2][4], qf[2][4];
    { const int gF = (d.lat ? (d.b * 8 + h) * 16 : 512 + (d.b * 8 + h) * 4) + (dir ? (d.T >> 6) - 1 - n : n);
      const size_t fo = (size_t)gF * 4096 + (dir ? (hh * 32 + 31 - r) : lane) * 8;
#pragma unroll
      for (int cb = 0; cb < 2; ++cb)
#pragma unroll
        for (int s = 0; s < 4; ++s) { const size_t o_ = fo + ((dir ? 1 - cb : cb) * 4 + s) * 512; kf[cb][s] = *(const bf16x8*)(DK + o_); qf[cb][s] = *(const bf16x8*)(DQ + o_); } }
    asm volatile("" ::: "memory");
    const float gcol0 = tab[r], gcol1 = tab[32 + r];
#pragma unroll
    for (int cb = 0; cb < 2; ++cb) { const float coef = -tab[64 + 32 * cb + r] * __expf(cb ? gcol1 : gcol0);
#pragma unroll
        for (int s = 0; s < 4; ++s) { const v4u kw = __builtin_bit_cast(v4u, kf[cb][s]); v4u ow;
            ow.x = pk2(bflo(kw.x) * coef, bfhi(kw.x) * coef); ow.y = pk2(bflo(kw.y) * coef, bfhi(kw.y) * coef); ow.z = pk2(bflo(kw.z) * coef, bfhi(kw.z) * coef); ow.w = pk2(bflo(kw.w) * coef, bfhi(kw.w) * coef);
            *(v4u*)(Kb + (4 * cb + s) * 512 + lane * 8) = ow; } }
#pragma unroll
    for (int tile = 0; tile < 3; tile += 2) {
        const int cb = tile == 0 ? 0 : 1, cbp = cb;
        f32x16 acc = {};
#pragma unroll
        for (int s = 0; s < 4; ++s) acc = MFMA32(kf[cb][s], kf[cbp][s], acc);
        const float gcol = cbp ? gcol1 : gcol0; const int cp = 32 * cbp + r;
#pragma unroll
        for (int g = 0; g < 4; ++g) {
            const f32x4 gr = *(const LAS f32x4*)(tab + 32 * cb + 8 * g + 4 * hh), br = *(const LAS f32x4*)(tab + 64 + 32 * cb + 8 * g + 4 * hh);
            f32x4 v;
#pragma unroll
            for (int j = 0; j < 4; ++j) { const int c = 32 * cb + 8 * g + 4 * hh + j; v[j] = (cp < c) ? br[j] * acc[4 * g + j] * __expf(gr[j] - gcol) : 0.f; }
            *(LAS f32x4*)(LT + cp * 68 + 32 * cb + 8 * g + 4 * hh) = v;
        }
    }
    bf16x8 l21[2];
    {
        f32x16 acc = {};
#pragma unroll
        for (int s = 0; s < 4; ++s) acc = MFMA32(kf[0][s], kf[1][s], acc);
        const float bb = tab[96 + r];
#pragma unroll
        for (int g = 0; g < 4; ++g) { const f32x4 ga = *(const LAS f32x4*)(tab + 8 * g + 4 * hh);
#pragma unroll
            for (int j = 0; j < 4; ++j) acc[4 * g + j] = bb * acc[4 * g + j] * __expf(gcol1 - ga[j]); }
        l21[0] = pack_regs(acc, 0); l21[1] = pack_regs(acc, 1);
    }
#pragma unroll
    for (int tile = 0; tile < 3; ++tile) {
        const int cb = tile == 0 ? 0 : 1, cbp = tile == 2 ? 1 : 0;
        f32x16 acc = {};
#pragma unroll
        for (int s = 0; s < 4; ++s) acc = MFMA32(kf[cbp][s], qf[cb][s], acc);
        const float gcc = cb ? gcol1 : gcol0; const int c = 32 * cb + r;
#pragma unroll
        for (int g = 0; g < 4; ++g) {
            const f32x4 gr = *(const LAS f32x4*)(tab + 32 * cbp + 8 * g + 4 * hh);
#pragma unroll
            for (int j = 0; j < 4; ++j) { const int cp = 32 * cbp + 8 * g + 4 * hh + j; acc[4 * g + j] = (cp <= c) ? 0.125f * acc[4 * g + j] * __expf(gcc - gr[j]) : 0.f; }
        }
#pragma unroll
        for (int s = 0; s < 2; ++s) *(bf16x8*)(QKm + (2 * tile + s) * 512 + lane * 8) = pack_regs(acc, s);
    }
    LDS_WAIT();
    {
        float tb[32]; float zero_ = 0.f; asm volatile("" : "+v"(zero_));
#pragma unroll
        for (int i = 0; i < 32; ++i) tb[i] = zero_;
        const int bI = lane >> 5, rl = lane & 31;
        const LAS float* LTb = LT + (32 * bI) * 68 + 32 * bI;
#pragma unroll
        for (int nn = 31; nn >= 0; --nn) {
            float a0 = (rl == nn) ? 1.f : 0.f, a1 = 0.f;
            const LAS float* lrow = LTb + nn * 68;
            if (nn < 30) asm volatile("" : "+v"(lrow) : "v"(tb[nn < 30 ? nn + 2 : 31]));
#pragma unroll
            for (int m4 = (nn + 1) / 4; m4 < 8; ++m4) { const f32x4 lr = *(const LAS f32x4*)(lrow + 4 * m4);
                a0 -= lr[0] * tb[4 * m4]; a1 -= lr[1] * tb[4 * m4 + 1]; a0 -= lr[2] * tb[4 * m4 + 2]; a1 -= lr[3] * tb[4 * m4 + 3]; }
            tb[nn] = a0 + a1;
        }
        { bf16* dst = Tm + (lane < 32 ? 0 : 4 * 512) + rl * 8;
#pragma unroll
          for (int q = 0; q < 4; ++q) { v4u w;
              w.x = pk2(tb[swap23(8 * q + 0)], tb[swap23(8 * q + 1)]); w.y = pk2(tb[swap23(8 * q + 2)], tb[swap23(8 * q + 3)]);
              w.z = pk2(tb[swap23(8 * q + 4)], tb[swap23(8 * q + 5)]); w.w = pk2(tb[swap23(8 * q + 6)], tb[swap23(8 * q + 7)]);
              *(v4u*)(dst + (q >> 1) * 512 + (q & 1) * 256) = w; } }
        LDS_WAIT();
        LAS float* TT = LT;
#pragma unroll
        for (int q = 0; q < 8; ++q) *(LAS f32x4*)(TT + lane * 36 + 4 * q) = (f32x4){tb[4 * q], tb[4 * q + 1], tb[4 * q + 2], tb[4 * q + 3]};
        LDS_WAIT();
        bf16x8 b11[2], t22[2];
#pragma unroll
        for (int s = 0; s < 2; ++s) {
            float c11[8];
#pragma unroll
            for (int j = 0; j < 8; ++j) c11[j] = TT[(16 * s + 8 * (j >> 2) + 4 * hh + (j & 3)) * 36 + r];
            const f32x4 ra = *(const LAS f32x4*)(TT + (32 + r) * 36 + 16 * s + 4 * hh), rb = *(const LAS f32x4*)(TT + (32 + r) * 36 + 16 * s + 8 + 4 * hh);
            v4u w1, w2;
            w1.x = pk2(c11[0], c11[1]); w1.y = pk2(c11[2], c11[3]); w1.z = pk2(c11[4], c11[5]); w1.w = pk2(c11[6], c11[7]);
            w2.x = pk2(ra[0], ra[1]); w2.y = pk2(ra[2], ra[3]); w2.z = pk2(rb[0], rb[1]); w2.w = pk2(rb[2], rb[3]);
            b11[s] = __builtin_bit_cast(bf16x8, w1); t22[s] = __builtin_bit_cast(bf16x8, w2);
        }
        f32x16 W = {};
        W = MFMA32(l21[0], b11[0], W); W = MFMA32(l21[1], b11[1], W);
        const bf16x8 wp0 = pack_regs(W, 0), wp1 = pack_regs(W, 1);
        f32x16 X = {};
        X = MFMA32(wp0, t22[0], X); X = MFMA32(wp1, t22[1], X);
#pragma unroll
        for (int g = 0; g < 16; ++g) X[g] = -X[g];
#pragma unroll
        for (int s = 0; s < 2; ++s) *(bf16x8*)(Tm + (2 + s) * 512 + lane * 8) = pack_regs(X, s);
    }
    LDS_WAIT();
}
__device__ __forceinline__ void phase_attn_pre(const Args& a, LAS unsigned char* lds, int vcu, int G) {
    const int tid = threadIdx.x, wave = __builtin_amdgcn_readfirstlane(tid >> 6);
    LAS float* LT = (LAS float*)(lds + wave * 17408); LAS float* tab = (LAS float*)(lds + 139264 + wave * 512);
#define MIX_LANE() int lane = tid & 63; asm volatile("" : "+v"(lane))
    if (G == 256) {
#ifndef AP_REP_A
#define AP_REP_A 1
#endif
#ifndef AP_REP_P
#define AP_REP_P 1
#endif
        if (vcu < 128) { for (int q = 0; q < AP_REP_A; ++q) { MIX_LANE(); attn_task<true>(a, vcu * 8 + wave, lane, LT); } for (int q = 0; q < AP_REP_P; ++q) { MIX_LANE(); dn_pre_task(a, vcu * 8 + wave, LT, tab, lane); } }
        else { const int j = vcu - 128;
            for (int q = 0; q < AP_REP_A; ++q) { MIX_LANE(); attn_task<false>(a, j * 8 + wave, lane, LT); } for (int q = 0; q < AP_REP_P; ++q) { MIX_LANE(); dn_pre_task(a, 1024 + j * 8 + wave, LT, tab, lane); }
            for (int q = 0; q < AP_REP_A; ++q) { MIX_LANE(); attn_task<false>(a, (j + 128) * 8 + wave, lane, LT); } for (int q = 0; q < AP_REP_P; ++q) { MIX_LANE(); dn_pre_task(a, 2048 + j * 8 + wave, LT, tab, lane); } }
    } else {
        for (int t = wave * G + vcu; t < 1024 + 2048 + 3072; t += G * NWAVES) { MIX_LANE();
            if (t < 1024) attn_task<true>(a, t, lane, LT); else if (t < 3072) attn_task<false>(a, t - 1024, lane, LT); else dn_pre_task(a, t - 3072, LT, tab, lane); }
    }
#undef MIX_LANE
}

__device__ __forceinline__ void dn_scan_task(const Args& a, int wt, int lane) {
    const int chain = wt >> 1, jw = wt & 1;
    const DnChain d = dn_decode(chain);
    const int h = d.h, dir = d.dir, NC = d.T >> 6, T = d.T;
    const int r = lane & 31, hh = lane >> 5, jcol = 32 * jw + r;
    const bf16* DQ = (const bf16*)a.out;
    const bf16* VC = dir ? (const bf16*)(a.ws + WS_ODN) : DQ + (size_t)2 * MT * 512;
    const bf16* KTs = (const bf16*)(a.ws + WS_KT) + (dir ? (size_t)MT * 512 : 0);
    bf16* OUTO = dir ? (bf16*)(a.ws + WS_W1) : (bf16*)a.out + (size_t)3 * MT * 512;
    const int RS = dir ? -1 : 1;
    f32x16 S[2];
    if (d.lat) { const float* s0 = a.in[I_ST] + ((size_t)((d.b * 2 + dir) * 8 + h) * 64) * 64 + jcol;
#pragma unroll
        for (int ib = 0; ib < 2; ++ib)
#pragma unroll
            for (int g = 0; g < 16; ++g) S[ib][g] = s0[(32 * ib + crow(g, hh)) * 64]; }
    else { S[0] = (f32x16){}; S[1] = (f32x16){}; }
    for (int n = 0; n < NC; ++n) {
        int ln = lane; asm volatile("" : "+v"(ln));
        const int r = ln & 31, hh = ln >> 5;
        const int task = d.task0 + n;
        const int taskd = (d.lat ? (d.b * 8 + h) * 16 : 512 + (d.b * 8 + h) * 4) + n;
        const int R0 = d.rowbase + (dir ? T - 1 - 64 * n : 64 * n);
        const bf16* rec = rec_ptr(a.ws, task) + ln * 8; const bf16* Tm = rec; const bf16* QKm = rec + 3072; const bf16* Kb = rec + 6144;
        const float* SC = (const float*)(a.ws + WS_SC) + (size_t)task * 320 + 4 * hh;
        const bf16* vc = VC + ((size_t)(taskd * 2 + jw) * 2 * 64 + ln) * 16;
        const bf16* kt = KTs + (size_t)taskd * 4096 + ln * 8;
        bf16* oo = OUTO + (size_t)(taskd * 2 + jw) * 2 * 16 * 64 + ln;
        const bf16* qbase = DQ + (size_t)((d.lat ? (d.b * 8 + h) * 16 : 512 + (d.b * 8 + h) * 4) + (dir ? NC - 1 - n : n)) * 4096 + (dir ? (hh * 32 + 31 - r) : ln) * 8;
        const int qo0 = dir ? 2048 : 0, qo1 = dir ? 0 : 2048;
        bf16x8 fk[2][4], fq[2][4]; v4u vv[2][2]; f32x4 s2[2][4];
#pragma unroll
        for (int cb = 0; cb < 2; ++cb) {
            const bf16* qp = qbase + (cb ? qo1 : qo0);
#pragma unroll
            for (int k4 = 0; k4 < 4; ++k4) { fk[cb][k4] = *(const bf16x8*)(Kb + (4 * cb + k4) * 512); fq[cb][k4] = *(const bf16x8*)(qp + k4 * 512); }
            vv[cb][0] = *(const v4u*)(vc + cb * 1024); vv[cb][1] = *(const v4u*)(vc + cb * 1024 + 8);
#pragma unroll
            for (int g = 0; g < 4; ++g) s2[cb][g] = *(const f32x4*)(SC + 128 + 32 * cb + 8 * g);
        }
        asm volatile("" ::: "memory");
        bf16x8 sb[2][2];
#pragma unroll
        for (int ib = 0; ib < 2; ++ib)
#pragma unroll
            for (int s = 0; s < 2; ++s) sb[ib][s] = pack_regs(S[ib], s);
        f32x16 X[2], o[2];
#pragma unroll
        for (int cb = 0; cb < 2; ++cb) {
            f32x16 ax, ao = {};
            { const v4u va = vv[cb][0], vb_ = vv[cb][1];
              ax = (f32x16){bflo(va.x), bfhi(va.x), bflo(va.y), bfhi(va.y), bflo(va.z), bfhi(va.z), bflo(va.w), bfhi(va.w),
                            bflo(vb_.x), bfhi(vb_.x), bflo(vb_.y), bfhi(vb_.y), bflo(vb_.z), bfhi(vb_.z), bflo(vb_.w), bfhi(vb_.w)}; }
#pragma unroll
            for (int ib = 0; ib < 2; ++ib)
#pragma unroll
                for (int s = 0; s < 2; ++s) { ax = MFMA32(fk[cb][2 * ib + s], sb[ib][s], ax); ao = MFMA32(fq[cb][2 * ib + s], sb[ib][s], ao); }
#pragma unroll
            for (int g = 0; g < 4; ++g)
#pragma unroll
                for (int j = 0; j < 4; ++j) ao[4 * g + j] *= s2[cb][g][j];
            X[cb] = ax; o[cb] = ao;
        }
        bf16x8 ft[3][2], fm[3][2], fkt[2][4]; f32x4 s3[2][4];
#pragma unroll
        for (int bl = 0; bl < 3; ++bl) { const int cb = bl == 0 ? 0 : 1, cbp = bl == 2 ? 1 : 0;
#pragma unroll
            for (int s = 0; s < 2; ++s) { ft[bl][s] = *(const bf16x8*)(Tm + (2 * bl + s) * 512); fm[bl][s] = *(const bf16x8*)(QKm + (2 * bl + s) * 512); } }
#pragma unroll
        for (int ib = 0; ib < 2; ++ib)
#pragma unroll
            for (int k4 = 0; k4 < 4; ++k4) fkt[ib][k4] = *(const bf16x8*)(kt + (4 * ib + k4) * 512);
        asm volatile("" ::: "memory");
        f32x16 vn[2];
        {
            bf16x8 xb[2][2];
#pragma unroll
            for (int cb = 0; cb < 2; ++cb)
#pragma unroll
                for (int s = 0; s < 2; ++s) xb[cb][s] = pack_regs(X[cb], s);
            f32x16 a0 = {}, a1 = {};
            a0 = MFMA32(ft[0][0], xb[0][0], a0); a0 = MFMA32(ft[0][1], xb[0][1], a0);
            a1 = MFMA32(ft[1][0], xb[0][0], a1); a1 = MFMA32(ft[1][1], xb[0][1], a1); a1 = MFMA32(ft[2][0], xb[1][0], a1); a1 = MFMA32(ft[2][1], xb[1][1], a1);
            vn[0] = a0; vn[1] = a1;
        }
        {
            bf16x8 vb[2][2];
#pragma unroll
            for (int cb = 0; cb < 2; ++cb)
#pragma unroll
                for (int s = 0; s < 2; ++s) vb[cb][s] = pack_regs(vn[cb], s);
            f32x16 a0 = o[0], a1 = o[1];
            a0 = MFMA32(fm[0][0], vb[0][0], a0); a0 = MFMA32(fm[0][1], vb[0][1], a0);
            a1 = MFMA32(fm[1][0], vb[0][0], a1); a1 = MFMA32(fm[1][1], vb[0][1], a1); a1 = MFMA32(fm[2][0], vb[1][0], a1); a1 = MFMA32(fm[2][1], vb[1][1], a1);
#pragma unroll
            for (int g = 0; g < 16; ++g) { oo[g * 64] = (bf16)f2bf(a0[g]); oo[(16 + g) * 64] = (bf16)f2bf(a1[g]); }
        }
        {
#pragma unroll
            for (int cb = 0; cb < 2; ++cb)
#pragma unroll
                for (int g = 0; g < 4; ++g) s3[cb][g] = *(const f32x4*)(SC + 192 + 32 * cb + 8 * g);
            const float egl = SC[256];
#pragma unroll
            for (int cb = 0; cb < 2; ++cb)
#pragma unroll
                for (int g = 0; g < 4; ++g)
#pragma unroll
                    for (int j = 0; j < 4; ++j) vn[cb][4 * g + j] *= s3[cb][g][j];
            bf16x8 vb[2][2];
#pragma unroll
            for (int cb = 0; cb < 2; ++cb)
#pragma unroll
                for (int s = 0; s < 2; ++s) vb[cb][s] = pack_regs(vn[cb], s);
#pragma unroll
            for (int ib = 0; ib < 2; ++ib) { f32x16 acc = S[ib] * egl;
#pragma unroll
                for (int cb = 0; cb < 2; ++cb)
#pragma unroll
                    for (int s = 0; s < 2; ++s) acc = MFMA32(fkt[ib][2 * cb + s], vb[cb][s], acc);
                S[ib] = acc; }
        }
    }
    if (!d.lat) { float* so = a.out + OUT_S + ((size_t)((d.b * 2 + dir) * 8 + h) * 64) * 64 + jcol;
#pragma unroll
        for (int ib = 0; ib < 2; ++ib)
#pragma unroll
            for (int g = 0; g < 16; ++g) so[(32 * ib + crow(g, hh)) * 64] = S[ib][g]; }
}
constexpr int SL_FK = 0, SL_FQ = 8192, SL_VV = 16384, SL_SC = 20480, SL_FT = 21504, SL_FM = 27648, SL_KT = 33792, SL_BUF = 43008;
__device__ __forceinline__ void lds_dma16(const void* gsrc, unsigned lds_dst) {
    unsigned keep;
    asm volatile("s_mov_b32 %0, m0\n\ts_mov_b32 m0, %2\n\ts_nop 0\n\tglobal_load_lds_dwordx4 %1, off\n\ts_mov_b32 m0, %0" : "=&s"(keep) : "v"(gsrc), "s"(lds_dst) : "memory");
}
__device__ __forceinline__ void dn_scan_lat(const Args& a, int wt, int lane, LAS unsigned char* L) {
    const int chain = wt >> 1, jw = wt & 1;
    const DnChain d = dn_decode(chain);
    const int h = d.h, dir = d.dir; constexpr int NC = 16;
    const int r = lane & 31, hh = lane >> 5, jcol = 32 * jw + r;
    const bf16* DQ = (const bf16*)a.out;
    const bf16* VC = dir ? (const bf16*)(a.ws + WS_ODN) : DQ + (size_t)2 * MT * 512;
    const bf16* KTs = (const bf16*)(a.ws + WS_KT) + (dir ? (size_t)MT * 512 : 0);
    bf16* OUTO = dir ? (bf16*)(a.ws + WS_W1) : (bf16*)a.out + (size_t)3 * MT * 512;
    const unsigned lbase = (unsigned)__builtin_amdgcn_readfirstlane((int)(unsigned)(uintptr_t)L);
    const int td0 = (d.b * 8 + h) * 16;
    const int qlane = dir ? (hh * 32 + 31 - r) : lane, qo0 = dir ? 2048 : 0, qo1 = dir ? 0 : 2048;
    f32x16 S[2];
    { const float* s0 = a.in[I_ST] + ((size_t)((d.b * 2 + dir) * 8 + h) * 64) * 64 + jcol;
#pragma unroll
      for (int ib = 0; ib < 2; ++ib)
#pragma unroll
          for (int g = 0; g < 16; ++g) S[ib][g] = s0[(32 * ib + crow(g, hh)) * 64]; }
#define SL_RUN(p_, cnt_, stride_, ldso_) do { const bf16* pp_ = (p_); _Pragma("unroll") for (int f = 0; f < (cnt_); ++f) { lds_dma16(pp_, lb_ + (ldso_) + f * 1024); pp_ += (stride_); asm volatile("" : "+v"(pp_)); } } while (0)
#define SL_ISSUE(n_) do { const int nn_ = (n_); const unsigned lb_ = lbase + (unsigned)((nn_ & 1) * SL_BUF); const int task_ = d.task0 + nn_, taskd_ = td0 + nn_; \
        const bf16* rec_ = rec_ptr(a.ws, task_) + lane * 8; \
        const bf16* q_ = DQ + (size_t)(td0 + (dir ? NC - 1 - nn_ : nn_)) * 4096 + qlane * 8; \
        const bf16* vc_ = VC + ((size_t)(taskd_ * 2 + jw) * 2 * 64 + lane) * 16; \
        SL_RUN(rec_ + 6144, 8, 512, SL_FK); \
        SL_RUN(q_ + qo0, 4, 512, SL_FQ); SL_RUN(q_ + qo1, 4, 512, SL_FQ + 4096); \
        lds_dma16(vc_, lb_ + SL_VV); lds_dma16(vc_ + 8, lb_ + SL_VV + 1024); lds_dma16(vc_ + 1024, lb_ + SL_VV + 2048); lds_dma16(vc_ + 1032, lb_ + SL_VV + 3072); \
        lds_dma16((const float*)(a.ws + WS_SC) + (size_t)task_ * 320 + 128 + lane * 4, lb_ + SL_SC); \
        SL_RUN(rec_, 6, 512, SL_FT); SL_RUN(rec_ + 3072, 6, 512, SL_FM); \
        SL_RUN(KTs + (size_t)taskd_ * 4096 + lane * 8, 8, 512, SL_KT); } while (0)
    SL_ISSUE(0);
    for (int n = 0; n < NC; ++n) {
        asm volatile("s_waitcnt vmcnt(0) lgkmcnt(0)" ::: "memory");
        if (n + 1 < NC) SL_ISSUE(n + 1);
        const LAS unsigned char* B = L + (n & 1) * SL_BUF + lane * 16;
        const LAS unsigned char* Bs = L + (n & 1) * SL_BUF + SL_SC + hh * 16;
#define SLF(off, f) (*(const LAS bf16x8*)(B + (off) + (f) * 1024))
        bf16x8 fk[8], fq[8]; v4u vv[4]; f32x4 s2[8];
#pragma unroll
        for (int f = 0; f < 8; ++f) { fk[f] = SLF(SL_FK, f); fq[f] = SLF(SL_FQ, f); }
#pragma unroll
        for (int f = 0; f < 4; ++f) vv[f] = *(const LAS v4u*)(B + SL_VV + f * 1024);
#pragma unroll
        for (int g = 0; g < 8; ++g) s2[g] = *(const LAS f32x4*)(Bs + (8 * g) * 4);
        asm volatile("" ::: "memory");
        bf16x8 sb[2][2];
#pragma unroll
        for (int ib = 0; ib < 2; ++ib)
#pragma unroll
            for (int s = 0; s < 2; ++s) sb[ib][s] = pack_regs(S[ib], s);
        f32x16 X[2], o[2];
#pragma unroll
        for (int cb = 0; cb < 2; ++cb) {
            f32x16 ax, ao = {};
            { const v4u va = vv[2 * cb], vb_ = vv[2 * cb + 1];
              ax = (f32x16){bflo(va.x), bfhi(va.x), bflo(va.y), bfhi(va.y), bflo(va.z), bfhi(va.z), bflo(va.w), bfhi(va.w),
                            bflo(vb_.x), bfhi(vb_.x), bflo(vb_.y), bfhi(vb_.y), bflo(vb_.z), bfhi(vb_.z), bflo(vb_.w), bfhi(vb_.w)}; }
#pragma unroll
            for (int ib = 0; ib < 2; ++ib)
#pragma unroll
                for (int s = 0; s < 2; ++s) { ax = MFMA32(fk[4 * cb + 2 * ib + s], sb[ib][s], ax); ao = MFMA32(fq[4 * cb + 2 * ib + s], sb[ib][s], ao); }
            X[cb] = ax; o[cb] = ao;
        }
        bf16x8 ft[6], fm[6];
#pragma unroll
        for (int f = 0; f < 6; ++f) { ft[f] = SLF(SL_FT, f); fm[f] = SLF(SL_FM, f); }
        asm volatile("" ::: "memory");
#pragma unroll
        for (int cb = 0; cb < 2; ++cb)
#pragma unroll
            for (int g = 0; g < 4; ++g)
#pragma unroll
                for (int j = 0; j < 4; ++j) o[cb][4 * g + j] *= s2[4 * cb + g][j];
        f32x16 vn[2];
        {
            bf16x8 xb[2][2];
#pragma unroll
            for (int cb = 0; cb < 2; ++cb)
#pragma unroll
                for (int s = 0; s < 2; ++s) xb[cb][s] = pack_regs(X[cb], s);
            f32x16 a0 = {}, a1 = {};
            a0 = MFMA32(ft[0], xb[0][0], a0); a0 = MFMA32(ft[1], xb[0][1], a0);
            a1 = MFMA32(ft[2], xb[0][0], a1); a1 = MFMA32(ft[3], xb[0][1], a1); a1 = MFMA32(ft[4], xb[1][0], a1); a1 = MFMA32(ft[5], xb[1][1], a1);
            vn[0] = a0; vn[1] = a1;
        }
        bf16x8 fkt[8]; f32x4 s3[8];
#pragma unroll
        for (int f = 0; f < 8; ++f) fkt[f] = SLF(SL_KT, f);
#pragma unroll
        for (int g = 0; g < 8; ++g) s3[g] = *(const LAS f32x4*)(Bs + (64 + 8 * g) * 4);
        const float egl = *(const LAS float*)(L + (n & 1) * SL_BUF + SL_SC + 512);
        asm volatile("" ::: "memory");
        {
            bf16x8 vb[2][2];
#pragma unroll
            for (int cb = 0; cb < 2; ++cb)
#pragma unroll
                for (int s = 0; s < 2; ++s) vb[cb][s] = pack_regs(vn[cb], s);
            f32x16 a0 = o[0], a1 = o[1];
            a0 = MFMA32(fm[0], vb[0][0], a0); a0 = MFMA32(fm[1], vb[0][1], a0);
            a1 = MFMA32(fm[2], vb[0][0], a1); a1 = MFMA32(fm[3], vb[0][1], a1); a1 = MFMA32(fm[4], vb[1][0], a1); a1 = MFMA32(fm[5], vb[1][1], a1);
            bf16* oo = OUTO + (size_t)((td0 + n) * 2 + jw) * 2 * 16 * 64 + lane;
#pragma unroll
            for (int g = 0; g < 16; ++g) { oo[g * 64] = (bf16)f2bf(a0[g]); oo[(16 + g) * 64] = (bf16)f2bf(a1[g]); }
        }
        {
#pragma unroll
            for (int cb = 0; cb < 2; ++cb)
#pragma unroll
                for (int g = 0; g < 4; ++g)
#pragma unroll
                    for (int j = 0; j < 4; ++j) vn[cb][4 * g + j] *= s3[4 * cb + g][j];
            bf16x8 vb[2][2];
#pragma unroll
            for (int cb = 0; cb < 2; ++cb)
#pragma unroll
                for (int s = 0; s < 2; ++s) vb[cb][s] = pack_regs(vn[cb], s);
#pragma unroll
            for (int ib = 0; ib < 2; ++ib) { f32x16 acc = S[ib] * egl;
#pragma unroll
                for (int cb = 0; cb < 2; ++cb)
#pragma unroll
                    for (int s = 0; s < 2; ++s) acc = MFMA32(fkt[4 * ib + 2 * cb + s], vb[cb][s], acc);
                S[ib] = acc; }
        }
#undef SLF
    }
#undef SL_ISSUE
#undef SL_RUN
    asm volatile("s_waitcnt vmcnt(0) lgkmcnt(0)" ::: "memory");
}
__device__ __forceinline__ void phase_dn_scan(const Args& a, LAS unsigned char* lds, int vcu, int G) {
    const int tid = threadIdx.x, wave = __builtin_amdgcn_readfirstlane(tid >> 6);
    if (G == 256) {
        if (vcu < 128) {
#if !defined(SCAN_NO_LAT)
            if (wave == 0) { int lane = tid & 63; asm volatile("" : "+v"(lane)); dn_scan_lat(a, vcu, lane, lds); return; }
#else
            if (wave == 0) { int lane = tid & 63; asm volatile("" : "+v"(lane)); dn_scan_task(a, vcu, lane); return; }
#endif
            if (wave <= 3 || wave == 5) { const int k = wave <= 3 ? wave - 1 : 3; int lane = tid & 63; asm volatile("" : "+v"(lane)); dn_scan_task(a, 128 + vcu * 4 + k, lane); }
            return;
        }
        const int bx = blockIdx.x, c_ = (bx % 8 - 4) + 4 * (bx / 8);
        if (c_ < 64) return;
        { int lane = tid & 63; asm volatile("" : "+v"(lane)); dn_scan_task(a, 128 + 512 + (c_ - 64) * 8 + wave, lane); }
        return;
    }
    for (int t = wave * G + vcu; t < 1152; t += G * NWAVES) { int lane = tid & 63; asm volatile("" : "+v"(lane)); dn_scan_task(a, t, lane); }
}

__device__ __forceinline__ void phase_combine(const Args& a, int vcu, int G) {
    const int tid = threadIdx.x, lane = tid & 63, wave = tid >> 6;
    const int gw = vcu * NWAVES + wave, NGW = G * NWAVES;
    const bf16* OF = (const bf16*)a.out + (size_t)3 * MT * 512; const bf16* OB = (const bf16*)(a.ws + WS_W1);
    const bf16* P = (const bf16*)(a.ws + WS_PB); bf16* ODN = (bf16*)(a.ws + WS_ODN);
    const f32x4 n0 = *(const f32x4*)(a.in[I_DNN] + ((8 * lane) & 63)), n1 = *(const f32x4*)(a.in[I_DNN] + ((8 * lane) & 63) + 4);
    const int hd = lane >> 3, j0 = (8 * lane) & 63, jw = j0 >> 5, r0 = j0 & 31;
    for (int m = gw; m < MT; m += NGW) {
        int tt, T_, ch0;
        if (m < M_CTX) { const int b_ = m >> 8; tt = m & 255; T_ = 256; ch0 = 64 + ((b_ * 8 + hd) << 1); }
        else { const int rl = m - M_CTX; const int b_ = rl >> 10; tt = rl & 1023; T_ = 1024; ch0 = (b_ * 8 + hd) << 1; }
        v4u w[2];
#pragma unroll
        for (int dd = 0; dd < 2; ++dd) {
            const int u = dd ? T_ - 1 - tt : tt, c = u & 63;
            const int task = (m < M_CTX ? 512 + (ch0 >> 1) * 4 - 128 : (ch0 >> 1) * 16) + (u >> 6);
            const int cb = c >> 5, hh = (c >> 2) & 1, g = ((c >> 3) & 3) * 4 + (c & 3);
            w[dd] = *(const v4u*)((dd ? OB : OF) + ((size_t)((task * 2 + jw) * 2 + cb) * 16 + g) * 64 + hh * 32 + r0);
        }
        f32x4 o0 = {bflo(w[0].x) + bflo(w[1].x), bfhi(w[0].x) + bfhi(w[1].x), bflo(w[0].y) + bflo(w[1].y), bfhi(w[0].y) + bfhi(w[1].y)};
        f32x4 o1 = {bflo(w[0].z) + bflo(w[1].z), bfhi(w[0].z) + bfhi(w[1].z), bflo(w[0].w) + bflo(w[1].w), bfhi(w[0].w) + bfhi(w[1].w)};
        float ss = (o0.x * o0.x + o0.y * o0.y) + (o0.z * o0.z + o0.w * o0.w) + (o1.x * o1.x + o1.y * o1.y) + (o1.z * o1.z + o1.w * o1.w);
        ss += __shfl_xor(ss, 1); ss += __shfl_xor(ss, 2); ss += __shfl_xor(ss, 4);
        const float rstd = rsqrtf(ss * (1.f / 64.f) + 1e-6f);
        const v4u z = *(const v4u*)(P + (size_t)m * LDB_ + CB_Z + 8 * lane);
        o0 = o0 * rstd * n0; o1 = o1 * rstd * n1;
        v4u q; q.x = pk2(o0.x * silu_(bflo(z.x)), o0.y * silu_(bfhi(z.x))); q.y = pk2(o0.z * silu_(bflo(z.y)), o0.w * silu_(bfhi(z.y)));
        q.z = pk2(o1.x * silu_(bflo(z.z)), o1.y * silu_(bfhi(z.z))); q.w = pk2(o1.z * silu_(bflo(z.w)), o1.w * silu_(bfhi(z.w)));
        *(v4u*)(ODN + (size_t)m * 512 + 8 * lane) = q;
    }
}

__device__ __forceinline__ void phase_row1(const Args& a, int vcu, int G) {
    const int tid = threadIdx.x, lane = tid & 63, wave = tid >> 6;
    const int gw = vcu * NWAVES + wave, NGW = G * NWAVES;
    const float* MOD = (const float*)(a.ws + WS_MOD); const bf16* Y = (const bf16*)(a.ws + WS_ONA); const float* RSS = (const float*)(a.ws + WS_RSS1);
    bf16* XN = (bf16*)(a.ws + WS_XN);
    for (int m = gw; m < MT; m += NGW) {
        const f32x4* xr = (const f32x4*)x_row(a, m) + lane; const float* md = MOD + mod_idx(m) * 6144;
        float rs = 0.f;
        { const float rv = lane < 16 ? RSS[((size_t)(lane >> 2) * MT + m) * 4 + (lane & 3)] : 0.f;
          rs = rv; rs += __shfl_xor(rs, 1); rs += __shfl_xor(rs, 2); rs += __shfl_xor(rs, 4); rs += __shfl_xor(rs, 8); rs = __shfl(rs, 0); }
        const float rstd1 = rsqrtf(rs * (1.f / DM) + 1e-6f);
        f32x4 x1[4]; float s = 0.f;
        const v2u* yr = (const v2u*)(Y + (size_t)m * DM) + lane;
        v2u* x1b = (v2u*)((bf16*)(a.ws + WS_M1) + (size_t)m * DM) + lane;
#pragma unroll
        for (int j = 0; j < 4; ++j) { const int c = (lane + 64 * j) * 4; const v2u yy = yr[64 * j];
            const f32x4 yv = {bflo(yy.x), bfhi(yy.x), bflo(yy.y), bfhi(yy.y)};
            const f32x4 g1 = *(const f32x4*)(md + 2048 + c), pw = *(const f32x4*)(a.in[I_POST1] + c);
            x1[j] = xr[64 * j] + g1 * (yv * rstd1 * pw); { v2u o1; o1.x = pk2(x1[j].x, x1[j].y); o1.y = pk2(x1[j].z, x1[j].w); x1b[64 * j] = o1; }
            s += (x1[j].x * x1[j].x + x1[j].y * x1[j].y) + (x1[j].z * x1[j].z + x1[j].w * x1[j].w); }
        const float rstd2 = rsqrtf(wave_sum(s) * (1.f / DM) + 1e-6f);
        v2u* o8 = (v2u*)(XN + (size_t)m * DM) + lane;
#pragma unroll
        for (int j = 0; j < 4; ++j) { const int c = (lane + 64 * j) * 4;
            const f32x4 w = *(const f32x4*)(a.in[I_PRE2] + c), sh = *(const f32x4*)(md + 3072 + c), sc = *(const f32x4*)(md + 4096 + c);
            const f32x4 h = x1[j] * rstd2 * w * (sc + 1.0f) + sh;
            v2u o; o.x = pk2(h.x, h.y); o.y = pk2(h.z, h.w); o8[64 * j] = o; }
    }
}
__device__ __forceinline__ void phase_row2(const Args& a, int vcu, int G) {
    const int tid = threadIdx.x, lane = tid & 63, wave = tid >> 6;
    const int gw = vcu * NWAVES + wave, NGW = G * NWAVES;
    const float* MOD = (const float*)(a.ws + WS_MOD); const bf16* Fm = (const bf16*)(a.ws + WS_ONA); const bf16* Fe = (const bf16*)(a.ws + WS_XN); const bf16* X1 = (const bf16*)(a.ws + WS_M1);
    for (int m = gw; m < MT; m += NGW) {
        const float* md = MOD + mod_idx(m) * 6144;
        const v2u* fr = (const v2u*)(Fm + (size_t)m * DM) + lane; const v2u* fe = (const v2u*)(Fe + (size_t)m * DM) + lane;
        f32x4* orow = (f32x4*)(a.out + (size_t)m * DM) + lane;
        f32x4 fv[4], x1[4]; float s = 0.f;
#pragma unroll
        for (int j = 0; j < 4; ++j) { const v2u p = fr[64 * j], q = fe[64 * j]; { const v2u xx = ((const v2u*)(X1 + (size_t)m * DM) + lane)[64 * j]; x1[j] = (f32x4){bflo(xx.x), bfhi(xx.x), bflo(xx.y), bfhi(xx.y)}; }
            fv[j] = (f32x4){bflo(p.x) + bflo(q.x), bfhi(p.x) + bfhi(q.x), bflo(p.y) + bflo(q.y), bfhi(p.y) + bfhi(q.y)};
            s += (fv[j].x * fv[j].x + fv[j].y * fv[j].y) + (fv[j].z * fv[j].z + fv[j].w * fv[j].w); }
        const float rstd = rsqrtf(wave_sum(s) * (1.f / DM) + 1e-6f);
#pragma unroll
        for (int j = 0; j < 4; ++j) { const int c = (lane + 64 * j) * 4;
            const f32x4 g2 = *(const f32x4*)(md + 5120 + c), pw = *(const f32x4*)(a.in[I_POST2] + c);
            orow[64 * j] = x1[j] + g2 * (fv[j] * rstd * pw); }
    }
}

constexpr int N_PHASES = 13;
__global__ void __launch_bounds__(NWAVES * 64, 2) fwd_kernel(Args args) {
    extern __shared__ __attribute__((aligned(16))) unsigned char lds_raw[];
    LAS unsigned char* lds = (LAS unsigned char*)lds_raw;
    const int tid = threadIdx.x;
    const int G = gridDim.x; const int bx = blockIdx.x; const int vcu = (G % 8 == 0) ? (bx % 8) * (G / 8) + bx / 8 : bx;
    volatile LAS unsigned* MISC = (volatile LAS unsigned*)(lds + MISC_OFF);
    for (int u = tid; u < (LDS_BYTES - LDSCTL_OFF) / 4; u += NWAVES * 64) ((LAS unsigned*)(lds + LDSCTL_OFF))[u] = 0u;
    __syncthreads();
    const int lo = args.ph_lo, hi = args.ph_hi;
    const bool one = (hi - lo) > 1;
    unsigned* ctl = (unsigned*)(args.ws + WS_CTL);
    XcdBarrier bar; bar.bar = ctl + CW_BAR; bar.x = 0; bar.st = nullptr;
    if (one) bar = xcd_barrier_post(ctl + CW_BAR, MISC + 8);
#ifndef ONLY_PHASE
#define ONLY_PHASE -1
#endif
#ifndef SKIP_MASK
#define SKIP_MASK 0
#endif
#define IN(k) ((ONLY_PHASE < 0 || ONLY_PHASE == (k)) && !((SKIP_MASK >> (k)) & 1) && lo <= (k) && (k) < hi)
#define SEAM(k) do { if (one) xcd_barrier(bar); } while (0)
    unsigned char* ws = args.ws;
    typedef pg8::bf16_t pb;

#ifndef REPEAT_MASK
#define REPEAT_MASK 0
#endif
#define REP(k) ((REPEAT_MASK >> (k)) & 1)
#define PH_INPROJ do { pg8::Gemm g{(const pb*)(ws + WS_XN), (const pb*)(ws + WS_WIN), MT, NINP, 1024}; pg8::InProjOrder S; S.init(MT, NINP, G, bx); S.flags = (unsigned*)(ws + WS_CTL) + CW_TF; \
        pg8::EpiInProj E{(pb*)(ws + WS_PA), (pb*)(ws + WS_PB), (pb*)(ws + WS_M1), args.out + OUT_K, args.out + OUT_V, (float*)(ws + WS_BA), (pb*)args.out + (size_t)3 * MT * 512, (const float*)(ws + WS_ROPE)}; \
        pg8::gemm_phase<pg8::EpiInProj, pg8::InProjOrder, true, true>(lds, g, S, E); } while (0)
#define PH_GATE1(G_, c_, maxi_) do { pg8::LimitOrder S; S.init(MT, 1024, (G_), (c_)); S.maxi = (maxi_); \
        pg8::Gemm g{(const pb*)(ws + WS_ONA), (const pb*)(ws + WS_WAO), MT, 1024, 512}; pg8::EpiGate1 E{(const pb*)(ws + WS_PB), (pb*)(ws + WS_M1)}; \
        pg8::gemm_phase<pg8::EpiGate1, pg8::LimitOrder, true, true>(lds, g, S, E); } while (0)
#define PH_SCAN do { phase_dn_scan(args, lds, vcu, G); \
        if (G == 256) { if (vcu >= 128) { __syncthreads(); PH_GATE1(128, (bx % 8 - 4) + 4 * (bx / 8), 2); } } } while (0)
#define PH_MERGE do { pg8::StaticOrder S; S.init(MT, 1024, G, bx); \
        if (bx >= 192) late_transposes(args, lds, bx - 192, G - 192); else if (G <= 192 && bx == 0) late_transposes(args, lds, 0, 1); \
        if (G != 256) PH_GATE1(G, bx, 1 << 20);     \
        { pg8::Gemm g{(const pb*)(ws + WS_ODN), (const pb*)(ws + WS_WDO), MT, 1024, 512}; pg8::EpiGate2 E{(const pb*)(ws + WS_PB), (const pb*)(ws + WS_M1), (pb*)(ws + WS_XN)}; \
          pg8::gemm_phase<pg8::EpiGate2, pg8::StaticOrder, true, true>(lds, g, S, E); } } while (0)
#define PH_WOUT do { pg8::Gemm g{(const pb*)(ws + WS_XN), (const pb*)(ws + WS_WOUT), MT, 1024, 1024}; pg8::StaticOrder S; S.init(MT, 1024, G, bx); \
        pg8::EpiRss E{(pb*)(ws + WS_ONA), (float*)(ws + WS_RSS1)}; pg8::gemm_phase<pg8::EpiRss, pg8::StaticOrder, true, true>(lds, g, S, E); } while (0)
#define PH_FF1 do { pg8::Gemm g{(const pb*)(ws + WS_XN), (const pb*)(ws + WS_W1), MT, FF, 1024}; pg8::StaticOrder S; S.init(MT, FF, G, bx); \
        pg8::EpiRelu2 E{(pb*)(ws + WS_PA)}; pg8::gemm_phase<pg8::EpiRelu2, pg8::StaticOrder, true, true>(lds, g, S, E); } while (0)
#define PH_FF2 do { pg8::Gemm g{(const pb*)(ws + WS_PA), (const pb*)(ws + WS_W2), MT, 1024, FF}; pg8::SplitOrder S{vcu, 48, 16}; \
        pg8::EpiSplit E{(pb*)(ws + WS_ONA), (pb*)(ws + WS_XN)}; pg8::gemm_phase<pg8::EpiSplit, pg8::SplitOrder, true, true>(lds, g, S, E); } while (0)
#define RUN(k, body) do { if (IN(k)) { body; SEAM(k); if (REP(k)) { body; SEAM(k); } } } while (0)
    RUN(0, { phase_prologue(args, lds, vcu, G); phase_xn(args, vcu, G); });
#ifdef EXP_BAR
    RUN(2, { PH_INPROJ; xcd_barrier(bar); phase_conv(args, lds, vcu, G); });
#else
    RUN(2, { PH_INPROJ; phase_conv(args, lds, vcu, G); });
#endif
    RUN(4, phase_attn_pre(args, lds, vcu, G));
#if defined(PROBE_GATE1_ONLY)
    if (IN(5)) { PH_SCAN; SEAM(5); if (vcu >= 128) { PH_GATE1(128, (bx % 8 - 4) + 4 * (bx / 8), 2); } SEAM(5); }
#elif defined(PROBE_SCAN_ONLY)
    if (IN(5)) { PH_SCAN; SEAM(5); phase_dn_scan(args, lds, vcu, G); SEAM(5); }
#else
    RUN(5, PH_SCAN);
#endif
    RUN(6, phase_combine(args, vcu, G));
    RUN(7, PH_MERGE);
    RUN(8, PH_WOUT);
    RUN(9, phase_row1(args, vcu, G));
    RUN(10, PH_FF1);
    RUN(11, PH_FF2);
    if (IN(12)) { phase_row2(args, vcu, G); }
#ifdef EXTRA_BARS
    for (int i = 0; i < EXTRA_BARS; ++i) xcd_barrier(bar);
#endif

#undef IN
#undef SEAM
}

#ifndef MK_ONE_LAUNCH
#define MK_ONE_LAUNCH 1
#endif
extern "C" void kernel_launch(void* const* d_in, const int* in_sizes, int n_in, void* d_out, int out_size, void* d_ws, size_t ws_size, hipStream_t stream) {
    static int grid = 0;
    if (grid == 0) {
        if (n_in != 24 || ws_size < WS_END) { fprintf(stderr, "kernel_launch: unexpected n_in %d / ws %zu\n", n_in, ws_size); grid = -1; return; }
        int dev = 0, cus = 0;
        if (hipGetDevice(&dev) != hipSuccess || hipDeviceGetAttribute(&cus, hipDeviceAttributeMultiprocessorCount, dev) != hipSuccess) { grid = -1; return; }
        if (hipFuncSetAttribute((const void*)fwd_kernel, hipFuncAttributeMaxDynamicSharedMemorySize, LDS_BYTES) != hipSuccess) { fprintf(stderr, "kernel_launch: hipFuncSetAttribute failed\n"); grid = -1; return; }
        int per_cu = 0;
        if (hipOccupancyMaxActiveBlocksPerMultiprocessor(&per_cu, (const void*)fwd_kernel, NWAVES * 64, LDS_BYTES) != hipSuccess || per_cu < 1) fprintf(stderr, "kernel_launch: occupancy query says %d\n", per_cu);
        (void)hipGetLastError();
        grid = cus;
    }
    if (grid < 0) return;
    (void)hipMemsetAsync((char*)d_ws + WS_CTL, 0, CTL_ZERO_BYTES, stream);
    Args a{};
    for (int i = 0; i < 24; ++i) a.in[i] = (const float*)d_in[i];
    a.out = (float*)d_out; a.ws = (unsigned char*)d_ws;
#if MK_ONE_LAUNCH
    a.ph_lo = 0; a.ph_hi = N_PHASES;
    hipLaunchKernelGGL(fwd_kernel, dim3(grid), dim3(NWAVES * 64), LDS_BYTES, stream, a);
#else
    for (int p = 0; p < N_PHASES; ++p) { a.ph_lo = p; a.ph_hi = p + 1; hipLaunchKernelGGL(fwd_kernel, dim3(grid), dim3(NWAVES * 64), LDS_BYTES, stream, a); }
#endif
}
```

```cpp
#include <hip/hip_runtime.h>
#include <cstdio>
#include <cstdint>

constexpr int DM = 1024, M_CTX = 8192, M_LAT = 4096, MT = 12288, NIN = 5664, NINP = 5888, FF = 4096;
constexpr int LDA_ = 1536, LDB_ = 2816;
constexpr int C_Q = 0, C_K = 512, C_V = 1024, C_DN = 0, CB_Z = 32, CB_GA = 544, CB_GD = 1568;

namespace pg8 {
#define PG8_LAS __attribute__((address_space(3)))
typedef unsigned short bf16_t;
typedef short bf16x8 __attribute__((ext_vector_type(8)));
typedef float f32x4 __attribute__((ext_vector_type(4)));
typedef unsigned u32x4 __attribute__((ext_vector_type(4)));
typedef unsigned u32x2 __attribute__((ext_vector_type(2)));
constexpr int BM = 256, BK = 64, HALF = 128, HTB = HALF * BK * 2  , STAGE_BYTES = 8 * HTB, NXCD = 8, WGM = 8;

__host__ __device__ __forceinline__ int lds_byte(int r, int c) { const int st = (r >> 4) * 2 + (c >> 5), rr = r & 15, cc = c & 31, ob = rr * 64 + cc * 2; return st * 1024 + (ob ^ (((ob >> 9) & 1) << 5)); }
__host__ __device__ __forceinline__ void stage_rc(int b, int& R, int& C) { const int st = b / 1024, sb = b % 1024, swz = sb ^ (((sb >> 9) & 1) << 5); R = (st >> 1) * 16 + swz / 64; C = (st & 1) * 32 + (swz % 64) / 2; }
__host__ __device__ __forceinline__ int perm32(int rho) { const int n = rho >> 4, i = rho & 15; return 8 * (i >> 2) + 4 * n + (i & 3); }

struct Unit { int pm, pn; int k0 = 0, nt = 0; };
struct Gemm { const bf16_t* A; const bf16_t* Bt; int M, N, K; };

struct StaticOrder {
    int nM, nN, nwg, G, c;
    __host__ __device__ void init(int M, int N, int G_, int c_) { nM = M / BM; nN = N / BM; nwg = nM * nN; G = G_; c = c_; }
    __host__ __device__ bool next(int i, Unit& u) const {
        const long L = (long)i * G + c; if (L >= nwg) return false;
        int wgid = (int)L; { const int q = nwg / NXCD, r = nwg % NXCD, xcd = wgid % NXCD, off = wgid / NXCD; wgid = (xcd < r ? xcd * (q + 1) : r * (q + 1) + (xcd - r) * q) + off; }
        const int nig = WGM * nN, gid = wgid / nig, fm = gid * WGM, gsz = (nM - fm) < WGM ? (nM - fm) : WGM;
        u.pm = fm + ((wgid % nig) % gsz); u.pn = (wgid % nig) / gsz; return true;
    }
    __device__ __forceinline__ void a_ready(const Unit&) const {}
    __device__ __forceinline__ void done(const Unit&) const {}
};

struct InProjOrder : StaticOrder { unsigned* flags;
    __device__ __forceinline__ void done(const Unit& u) const {
        if (u.pn >= 6 && u.pn <= 12) { asm volatile("s_waitcnt vmcnt(0)" ::: "memory");
            if ((threadIdx.x & 63) == 0) __hip_atomic_fetch_add(flags + u.pm * 8 + (u.pn - 6), 1u, __ATOMIC_RELAXED, __HIP_MEMORY_SCOPE_AGENT); } } };

struct LimitOrder : StaticOrder { int maxi;
    __device__ __forceinline__ bool next(int i, Unit& u) const { if (i >= maxi) return false; return StaticOrder::next(i, u); } };

__device__ __forceinline__ unsigned cvt_pk_bf16(float lo, float hi) { unsigned r; asm volatile("v_cvt_pk_bf16_f32 %0, %1, %2" : "=v"(r) : "v"(lo), "v"(hi)); return r; }
__device__ __forceinline__ float bf_lo(unsigned w) { return __uint_as_float(w << 16); }
__device__ __forceinline__ float bf_hi(unsigned w) { return __uint_as_float(w & 0xffff0000u); }
__device__ __forceinline__ float sigmoidf_(float x) { return __builtin_amdgcn_rcpf(1.0f + __expf(-x)); }
__device__ __forceinline__ u32x4 pack8(const f32x4& v0, const f32x4& v1) { u32x4 w; w.x = cvt_pk_bf16(v0[0], v0[1]); w.y = cvt_pk_bf16(v0[2], v0[3]); w.z = cvt_pk_bf16(v1[0], v1[1]); w.w = cvt_pk_bf16(v1[2], v1[3]); return w; }


__device__ __forceinline__ void store16_wt(void* p, u32x4 v) { asm volatile("global_store_dwordx4 %0, %1, off sc1\n\ts_nop 2" :: "v"(p), "v"(v) : "memory"); }
struct EpiInProj {
    static constexpr bool PERM = true, AFTER_DRAIN = false;
    bf16_t* PA; bf16_t* PB; bf16_t* QK; float* ko; float* vo; float* BA; bf16_t* VT; const float* rope;
    __device__ __forceinline__ void operator()(const f32x4 (&acc)[2][2][4][2], const Unit& u, int wr, int wc, int fr, int fq) const {
        const int pn = u.pn, pm = u.pm;
        const bool lat = pm >= 32;
        const bool do_rope = lat && pn < 4;
        const bool do_kv = (!lat) && pn >= 2 && pn < 6;
        const bool do_vt = pn == 4 || pn == 5;
        const bool do_ba = pn == 12 && wc == 0;
        const int lane_hi = fq >> 1;
#pragma unroll
        for (int ai = 0; ai < 2; ++ai)
#pragma unroll
            for (int m = 0; m < 4; ++m) {
                const int row = pm * BM + ai * HALF + wr * 64 + m * 16 + fr;
#pragma unroll
                for (int bj = 0; bj < 2; ++bj) {
                    f32x4 v0 = acc[ai][bj][m][0], v1 = acc[ai][bj][m][1];
                    const int col = pn * BM + bj * HALF + wc * 32 + 8 * fq;
                    if (do_rope) {
                        const int t = (row - M_CTX) & 1023;
                        const int pos = (wc & 1) ? (t & 63) : (t >> 6);
                        const float* cp = rope + pos * 16 + 8 * (fq & 1);
                        const f32x4 c0 = *(const f32x4*)cp, c1 = *(const f32x4*)(cp + 4), s0 = *(const f32x4*)(cp + 1024), s1 = *(const f32x4*)(cp + 1028);
                        f32x4 p0, p1;
#pragma unroll
                        for (int i = 0; i < 4; ++i) { p0[i] = __shfl_xor(v0[i], 32); p1[i] = __shfl_xor(v1[i], 32); }
                        if (lane_hi) { v0 = p0 * s0 + v0 * c0; v1 = p1 * s1 + v1 * c1; }
                        else         { v0 = v0 * c0 - p0 * s0; v1 = v1 * c1 - p1 * s1; }
                    }
                    if (pn < 4) *(u32x4*)(QK + (pn >= 2 ? (size_t)MT * 512 : 0) + (size_t)row * 512 + (col & 511)) = pack8(v0, v1);
                    else if (pn >= 6 && pn < 12) store16_wt(PA + (size_t)row * LDA_ + (col - 1536), pack8(v0, v1));
                    else if (pn >= 12) *(u32x4*)(PB + (size_t)row * LDB_ + (col - 3072)) = pack8(v0, v1);
                    if (do_kv) {
                        const int hh = ((pn & 1) * 4) + bj * 2 + (wc >> 1);
                        const int d = (wc & 1) * 32 + 8 * fq;
                        float* dst = (pn < 4 ? ko : vo) + ((size_t)(pm * 8 + hh) * 256 + (row & 255)) * 64 + d;
                        *(f32x4*)dst = v0; *(f32x4*)(dst + 4) = v1;
                    }
#ifndef VT_REP
#define VT_REP 1
#endif
                    if (do_vt) for (int vtr = 0; vtr < VT_REP; ++vtr) {
                        const int hh = ((pn & 1) * 4) + bj * 2 + (wc >> 1);
                        const int d = (wc & 1) * 32 + 8 * fq;
                        size_t base; int t, T;
                        if (!lat) { t = row & 255; T = 256; base = (size_t)(pm * 8 + hh) * 64 * 256; }
                        else { const int rl = row - M_CTX; t = rl & 1023; T = 1024; base = (size_t)M_CTX * 512 + (size_t)((rl >> 10) * 8 + hh) * 64 * 1024; }
                        const int pos = (t & ~12) | ((t & 4) << 1) | ((t & 8) >> 1);
                        bf16_t* dst = VT + base + (size_t)d * T + pos;
                        const u32x4 w = pack8(v0, v1);
                        dst[0] = (bf16_t)(w.x & 0xffff); dst[(size_t)T] = (bf16_t)(w.x >> 16); dst[(size_t)2 * T] = (bf16_t)(w.y & 0xffff); dst[(size_t)3 * T] = (bf16_t)(w.y >> 16);
                        dst[(size_t)4 * T] = (bf16_t)(w.z & 0xffff); dst[(size_t)5 * T] = (bf16_t)(w.z >> 16); dst[(size_t)6 * T] = (bf16_t)(w.w & 0xffff); dst[(size_t)7 * T] = (bf16_t)(w.w >> 16);
                    }
                    if (do_ba && bj == 0) { float* dst = BA + (size_t)row * 32 + 8 * fq; store16_wt(dst, __builtin_bit_cast(u32x4, v0)); store16_wt(dst + 4, __builtin_bit_cast(u32x4, v1)); }
                }
            }
    }
};

struct EpiGate1 {
    static constexpr bool PERM = true, AFTER_DRAIN = false;
    const bf16_t* P; bf16_t* M1;
    __device__ __forceinline__ void operator()(const f32x4 (&acc)[2][2][4][2], const Unit& u, int wr, int wc, int fr, int fq) const {
        u32x4 g[2][4][2];
#pragma unroll
        for (int ai = 0; ai < 2; ++ai)
#pragma unroll
            for (int m = 0; m < 4; ++m)
#pragma unroll
                for (int bj = 0; bj < 2; ++bj) { const int row = u.pm * BM + ai * HALF + wr * 64 + m * 16 + fr, col = u.pn * BM + bj * HALF + wc * 32 + 8 * fq;
                    g[ai][m][bj] = *(const u32x4*)(P + (size_t)row * LDB_ + CB_GA + col); }
        asm volatile("" ::: "memory");
#pragma unroll
        for (int ai = 0; ai < 2; ++ai)
#pragma unroll
            for (int m = 0; m < 4; ++m) {
                const int row = u.pm * BM + ai * HALF + wr * 64 + m * 16 + fr;
#pragma unroll
                for (int bj = 0; bj < 2; ++bj) {
                    const int col = u.pn * BM + bj * HALF + wc * 32 + 8 * fq;
                    const u32x4 gg = g[ai][m][bj];
                    f32x4 v0 = acc[ai][bj][m][0], v1 = acc[ai][bj][m][1];
                    v0[0] *= sigmoidf_(bf_lo(gg.x)); v0[1] *= sigmoidf_(bf_hi(gg.x)); v0[2] *= sigmoidf_(bf_lo(gg.y)); v0[3] *= sigmoidf_(bf_hi(gg.y));
                    v1[0] *= sigmoidf_(bf_lo(gg.z)); v1[1] *= sigmoidf_(bf_hi(gg.z)); v1[2] *= sigmoidf_(bf_lo(gg.w)); v1[3] *= sigmoidf_(bf_hi(gg.w));
                    *(u32x4*)(M1 + (size_t)row * DM + col) = pack8(v0, v1);
                }
            }
    }
};
struct EpiGate2 {
    static constexpr bool PERM = true, AFTER_DRAIN = false;
    const bf16_t* P; const bf16_t* M1; bf16_t* O;
    __device__ __forceinline__ void operator()(const f32x4 (&acc)[2][2][4][2], const Unit& u, int wr, int wc, int fr, int fq) const {
#pragma unroll
        for (int ai = 0; ai < 2; ++ai) {
            u32x4 g[4][2], q[4][2];
#pragma unroll
            for (int m = 0; m < 4; ++m)
#pragma unroll
                for (int bj = 0; bj < 2; ++bj) { const int row = u.pm * BM + ai * HALF + wr * 64 + m * 16 + fr, col = u.pn * BM + bj * HALF + wc * 32 + 8 * fq;
                    g[m][bj] = *(const u32x4*)(P + (size_t)row * LDB_ + CB_GD + col); q[m][bj] = *(const u32x4*)(M1 + (size_t)row * DM + col); }
            asm volatile("" ::: "memory");
#pragma unroll
            for (int m = 0; m < 4; ++m) {
                const int row = u.pm * BM + ai * HALF + wr * 64 + m * 16 + fr;
#pragma unroll
                for (int bj = 0; bj < 2; ++bj) {
                    const int col = u.pn * BM + bj * HALF + wc * 32 + 8 * fq;
                    const u32x4 gg = g[m][bj], qq = q[m][bj];
                    f32x4 v0 = acc[ai][bj][m][0], v1 = acc[ai][bj][m][1];
                    v0[0] = bf_lo(qq.x) + v0[0] * sigmoidf_(bf_lo(gg.x)); v0[1] = bf_hi(qq.x) + v0[1] * sigmoidf_(bf_hi(gg.x)); v0[2] = bf_lo(qq.y) + v0[2] * sigmoidf_(bf_lo(gg.y)); v0[3] = bf_hi(qq.y) + v0[3] * sigmoidf_(bf_hi(gg.y));
                    v1[0] = bf_lo(qq.z) + v1[0] * sigmoidf_(bf_lo(gg.z)); v1[1] = bf_hi(qq.z) + v1[1] * sigmoidf_(bf_hi(gg.z)); v1[2] = bf_lo(qq.w) + v1[2] * sigmoidf_(bf_lo(gg.w)); v1[3] = bf_hi(qq.w) + v1[3] * sigmoidf_(bf_hi(gg.w));
                    *(u32x4*)(O + (size_t)row * DM + col) = pack8(v0, v1);
                }
            }
        }
    }
};
struct EpiRss {
    static constexpr bool PERM = true, AFTER_DRAIN = false;
    bf16_t* O; float* RSS;
    __device__ __forceinline__ void operator()(const f32x4 (&acc)[2][2][4][2], const Unit& u, int wr, int wc, int fr, int fq) const {
#pragma unroll
        for (int ai = 0; ai < 2; ++ai)
#pragma unroll
            for (int m = 0; m < 4; ++m) {
                const int row = u.pm * BM + ai * HALF + wr * 64 + m * 16 + fr;
                float s = 0.f;
#pragma unroll
                for (int bj = 0; bj < 2; ++bj) {
                    const int col = u.pn * BM + bj * HALF + wc * 32 + 8 * fq;
                    const f32x4 v0 = acc[ai][bj][m][0], v1 = acc[ai][bj][m][1];
                    s += (v0[0] * v0[0] + v0[1] * v0[1]) + (v0[2] * v0[2] + v0[3] * v0[3]) + (v1[0] * v1[0] + v1[1] * v1[1]) + (v1[2] * v1[2] + v1[3] * v1[3]);
                    *(u32x4*)(O + (size_t)row * DM + col) = pack8(v0, v1);
                }
                s += __shfl_xor(s, 16); s += __shfl_xor(s, 32);
                if (fq == 0) RSS[((size_t)u.pn * MT + row) * 4 + wc] = s;
            }
    }
};
struct EpiRelu2 {
    static constexpr bool PERM = true, AFTER_DRAIN = false;
    bf16_t* O;
    __device__ __forceinline__ void operator()(const f32x4 (&acc)[2][2][4][2], const Unit& u, int wr, int wc, int fr, int fq) const {
#pragma unroll
        for (int ai = 0; ai < 2; ++ai)
#pragma unroll
            for (int m = 0; m < 4; ++m) {
                const int row = u.pm * BM + ai * HALF + wr * 64 + m * 16 + fr;
#pragma unroll
                for (int bj = 0; bj < 2; ++bj) {
                    const int col = u.pn * BM + bj * HALF + wc * 32 + 8 * fq;
                    f32x4 v0 = acc[ai][bj][m][0], v1 = acc[ai][bj][m][1];
#pragma unroll
                    for (int i = 0; i < 4; ++i) { const float a = fmaxf(v0[i], 0.f), b = fmaxf(v1[i], 0.f); v0[i] = a * a; v1[i] = b * b; }
                    *(u32x4*)(O + (size_t)row * FF + col) = pack8(v0, v1);
                }
            }
    }
};

struct RowStats {
    float* slots;
    unsigned* cnt;
    unsigned* tmo;
    __device__ __forceinline__ void run(const f32x4 (&v)[2][2][4][2], const Unit& u, int wr, int wc, int fr, int fq, PG8_LAS unsigned char* lds, int wid, int lane) const {
        PG8_LAS float* P = (PG8_LAS float*)lds;
        PG8_LAS float* S = (PG8_LAS float*)(lds + 8192);
#pragma unroll
        for (int ai = 0; ai < 2; ++ai)
#pragma unroll
            for (int m = 0; m < 4; ++m) {
                float s = 0.f;
#pragma unroll
                for (int bj = 0; bj < 2; ++bj)
#pragma unroll
                    for (int n = 0; n < 2; ++n) { const f32x4 x = v[ai][bj][m][n]; s += (x[0] * x[0] + x[1] * x[1]) + (x[2] * x[2] + x[3] * x[3]); }
                s += __shfl_xor(s, 16); s += __shfl_xor(s, 32);
                if (fq == 0) P[(ai * HALF + wr * 64 + m * 16 + fr) * 4 + wc] = s;
            }
        asm volatile("s_waitcnt lgkmcnt(0)" ::: "memory"); __builtin_amdgcn_s_barrier(); asm volatile("" ::: "memory");
        const int row = wid * 32 + (lane & 31);
        if (lane < 32) {
            const f32x4 p = *(const PG8_LAS f32x4*)(P + row * 4);
            const float t = (p[0] + p[1]) + (p[2] + p[3]);
            __hip_atomic_store((unsigned*)slots + ((size_t)(u.pm * BM + row) * 4 + u.pn), __float_as_uint(t), __ATOMIC_RELAXED, __HIP_MEMORY_SCOPE_AGENT);
        }
        asm volatile("s_waitcnt vmcnt(0)" ::: "memory");
        if (lane == 0) __hip_atomic_fetch_add(cnt + 64 * u.pm, 1u, __ATOMIC_RELAXED, __HIP_MEMORY_SCOPE_AGENT);
        if (wid == 0) {
            const unsigned long long t0 = __builtin_amdgcn_s_memrealtime();
            for (;;) {
                if ((unsigned)__builtin_amdgcn_readfirstlane(__hip_atomic_load(cnt + 64 * u.pm, __ATOMIC_RELAXED, __HIP_MEMORY_SCOPE_AGENT)) >= 32u) break;
                if (__builtin_amdgcn_s_memrealtime() - t0 > 2000000ull) { if (lane == 0) __hip_atomic_store(tmo, 1u, __ATOMIC_RELAXED, __HIP_MEMORY_SCOPE_AGENT); break; }
                __builtin_amdgcn_s_sleep(2);
            }
            __builtin_amdgcn_fence(__ATOMIC_ACQUIRE, "agent");
        }
        asm volatile("s_waitcnt vmcnt(0) lgkmcnt(0)" ::: "memory"); __builtin_amdgcn_s_barrier(); asm volatile("" ::: "memory");
        if (lane < 32) {
            const unsigned* sl = (const unsigned*)slots + (size_t)(u.pm * BM + row) * 4; float tot = 0.f;
#pragma unroll
            for (int t = 0; t < 4; ++t) tot += __uint_as_float(__hip_atomic_load(sl + t, __ATOMIC_RELAXED, __HIP_MEMORY_SCOPE_AGENT));
            S[row] = __builtin_amdgcn_rsqf(tot * (1.0f / 1024.0f) + 1e-6f);
        }
        asm volatile("s_waitcnt lgkmcnt(0)" ::: "memory"); __builtin_amdgcn_s_barrier(); asm volatile("" ::: "memory");
    }
};
struct EpiRow1 {
    static constexpr bool PERM = false, AFTER_DRAIN = true;
    const float* xp; const float* xs; float* out; bf16_t* XN; const float* MOD; const float* post1; const float* pre2; RowStats st1, st2;
    __device__ __forceinline__ void fused(f32x4 (&acc)[2][2][4][2], const Unit& u, int wr, int wc, int fr, int fq, PG8_LAS unsigned char* lds, int wid, int lane) const {
        const PG8_LAS float* S = (const PG8_LAS float*)(lds + 8192);
        const float* md = MOD + (u.pm < 32 ? 0 : 1 + ((u.pm - 32) >> 2)) * 6144;
        const int col0 = u.pn * BM + wc * 32 + 4 * fq;
        const int row0 = u.pm * BM + wr * 64 + fr;
        const float* xbase = (row0 < M_CTX ? xp + (size_t)row0 * DM : xs + (size_t)(row0 - M_CTX) * DM) + col0;
        st1.run(acc, u, wr, wc, fr, fq, lds, wid, lane);
        float rs[2][4];
#pragma unroll
        for (int ai = 0; ai < 2; ++ai)
#pragma unroll
            for (int m = 0; m < 4; ++m) rs[ai][m] = S[ai * HALF + wr * 64 + m * 16 + fr];
#pragma unroll
        for (int bj = 0; bj < 2; ++bj)
#pragma unroll
            for (int n = 0; n < 2; ++n) { const int co = bj * HALF + n * 16, c = col0 + co;
                const f32x4 g1 = *(const f32x4*)(md + 2048 + c), pw = *(const f32x4*)(post1 + c);
                f32x4 xv[2][4];
#pragma unroll
                for (int ai = 0; ai < 2; ++ai)
#pragma unroll
                    for (int m = 0; m < 4; ++m) xv[ai][m] = *(const f32x4*)(xbase + (size_t)(ai * HALF + m * 16) * DM + co);
                asm volatile("" ::: "memory");
#pragma unroll
                for (int ai = 0; ai < 2; ++ai)
#pragma unroll
                    for (int m = 0; m < 4; ++m) { const f32x4 x1 = xv[ai][m] + g1 * (acc[ai][bj][m][n] * rs[ai][m] * pw); acc[ai][bj][m][n] = x1;
                        *(f32x4*)(out + (size_t)(row0 + ai * HALF + m * 16) * DM + c) = x1; }
                asm volatile("" ::: "memory"); }
        st2.run(acc, u, wr, wc, fr, fq, lds, wid, lane);
#pragma unroll
        for (int ai = 0; ai < 2; ++ai)
#pragma unroll
            for (int m = 0; m < 4; ++m) rs[ai][m] = S[ai * HALF + wr * 64 + m * 16 + fr];
#pragma unroll
        for (int bj = 0; bj < 2; ++bj)
#pragma unroll
            for (int n = 0; n < 2; ++n) { const int c = col0 + bj * HALF + n * 16;
                const f32x4 w = *(const f32x4*)(pre2 + c), sh = *(const f32x4*)(md + 3072 + c), sc = *(const f32x4*)(md + 4096 + c) + 1.0f;
#pragma unroll
                for (int ai = 0; ai < 2; ++ai)
#pragma unroll
                    for (int m = 0; m < 4; ++m) { const f32x4 hv = acc[ai][bj][m][n] * rs[ai][m] * w * sc + sh;
                        u32x2 o; o.x = cvt_pk_bf16(hv[0], hv[1]); o.y = cvt_pk_bf16(hv[2], hv[3]); *(u32x2*)(XN + (size_t)(row0 + ai * HALF + m * 16) * DM + c) = o; } }
    }
};
struct EpiRow2 {
    static constexpr bool PERM = false, AFTER_DRAIN = true;
    float* out; const float* MOD; const float* post2; RowStats st;
    __device__ __forceinline__ void fused(f32x4 (&acc)[2][2][4][2], const Unit& u, int wr, int wc, int fr, int fq, PG8_LAS unsigned char* lds, int wid, int lane) const {
        const PG8_LAS float* S = (const PG8_LAS float*)(lds + 8192);
        const float* md = MOD + (u.pm < 32 ? 0 : 1 + ((u.pm - 32) >> 2)) * 6144;
        const int col0 = u.pn * BM + wc * 32 + 4 * fq;
        float* obase = out + (size_t)(u.pm * BM + wr * 64 + fr) * DM + col0;
        st.run(acc, u, wr, wc, fr, fq, lds, wid, lane);
        float rs[2][4];
#pragma unroll
        for (int ai = 0; ai < 2; ++ai)
#pragma unroll
            for (int m = 0; m < 4; ++m) rs[ai][m] = S[ai * HALF + wr * 64 + m * 16 + fr];
#pragma unroll
        for (int bj = 0; bj < 2; ++bj)
#pragma unroll
            for (int n = 0; n < 2; ++n) { const int co = bj * HALF + n * 16, c = col0 + co;
                const f32x4 g2 = *(const f32x4*)(md + 5120 + c), pw = *(const f32x4*)(post2 + c);
                f32x4 xv[2][4];
#pragma unroll
                for (int ai = 0; ai < 2; ++ai)
#pragma unroll
                    for (int m = 0; m < 4; ++m) xv[ai][m] = *(const f32x4*)(obase + (size_t)(ai * HALF + m * 16) * DM + co);
                asm volatile("" ::: "memory");
#pragma unroll
                for (int ai = 0; ai < 2; ++ai)
#pragma unroll
                    for (int m = 0; m < 4; ++m) *(f32x4*)(obase + (size_t)(ai * HALF + m * 16) * DM + co) = xv[ai][m] + g2 * (acc[ai][bj][m][n] * rs[ai][m] * pw);
                asm volatile("" ::: "memory"); }
    }
};

struct SplitOrder {
    int vcu, ntm, nte;
    __device__ __forceinline__ bool next(int i, Unit& u) const {
        const int grp = vcu >> 2, j = vcu & 3;
        if (j < 3) { if (i > 0) return false; const int ti = grp * 3 + j; u.pm = ti >> 2; u.pn = ti & 3; u.k0 = 0; u.nt = ntm; return true; }
        if (i > 2) return false; { const int ti = grp * 3 + i; u.pm = ti >> 2; u.pn = ti & 3; u.k0 = ntm * 64; u.nt = nte; return true; }
    }
    __device__ __forceinline__ void a_ready(const Unit&) const {}
    __device__ __forceinline__ void done(const Unit&) const {}
};
struct EpiSplit {
    static constexpr bool PERM = true, AFTER_DRAIN = false;
    bf16_t* Fmain; bf16_t* Fextra;
    __device__ __forceinline__ void operator()(const f32x4 (&acc)[2][2][4][2], const Unit& u, int wr, int wc, int fr, int fq) const {
        bf16_t* O = u.k0 ? Fextra : Fmain;
#pragma unroll
        for (int ai = 0; ai < 2; ++ai)
#pragma unroll
            for (int m = 0; m < 4; ++m) {
                const int row = u.pm * BM + ai * HALF + wr * 64 + m * 16 + fr;
#pragma unroll
                for (int bj = 0; bj < 2; ++bj) { const int col = u.pn * BM + bj * HALF + wc * 32 + 8 * fq; *(u32x4*)(O + (size_t)row * DM + col) = pack8(acc[ai][bj][m][0], acc[ai][bj][m][1]); }
            }
    }
};

template <class Epi, class Sched, bool ALIGN_EPI = false, bool SP2 = false>
__device__ __forceinline__ void gemm_phase(PG8_LAS unsigned char* lds, const Gemm g, const Sched& S, const Epi& E) {
    const int tid = threadIdx.x, wid = __builtin_amdgcn_readfirstlane(tid >> 6), lane = tid & 63, wr = wid >> 2, wc = wid & 3, fr = lane & 15, fq = lane >> 4;
    const int K = g.K, nt = K / BK;
    unsigned voffA[2], voffB[2];
#pragma unroll
    for (int i = 0; i < 2; ++i) { int R, C; stage_rc(tid * 16 + i * 8192, R, C); const int Rb = Epi::PERM ? ((R & ~31) + perm32(R & 31)) : R;
        voffA[i] = (unsigned)(R * K + C) * 2u; voffB[i] = (unsigned)(Rb * K + C) * 2u; }
    const size_t kstep = (size_t)(BK * 2);
    const size_t hstep = (size_t)HALF * K * 2;
    const size_t tstep = 2 * hstep;
    const unsigned ldsw = (unsigned)wid * 1024u;
    const int aoff = lds_byte(wr * 64 + fr, fq * 8), boff = lds_byte(wc * 32 + fr, fq * 8);
#define PG8_SA(b, h) (((b) * 2 + (h)) * HTB)
#define PG8_SB(b, h) ((4 + (b) * 2 + (h)) * HTB)
#define PG8_STAGE(bufoff, gbase, voff) do { _Pragma("unroll") for (int _i = 0; _i < 2; ++_i) \
        __builtin_amdgcn_global_load_lds((const unsigned*)((const char*)(gbase) + (voff)[_i]), (PG8_LAS unsigned*)(lds + (bufoff) + ldsw + _i * 8192), 16, 0, 0); } while (0)
#define PG8_LDA(dst, b, h) do { _Pragma("unroll") for (int m = 0; m < 4; ++m) _Pragma("unroll") for (int k = 0; k < 2; ++k) dst[m][k] = *(const PG8_LAS bf16x8*)(lds + PG8_SA(b, h) + aoff + m * 2048 + k * 1024); } while (0)
#define PG8_LDB(dst, b, h) do { _Pragma("unroll") for (int n = 0; n < 2; ++n) _Pragma("unroll") for (int k = 0; k < 2; ++k) dst[n][k] = *(const PG8_LAS bf16x8*)(lds + PG8_SB(b, h) + boff + n * 2048 + k * 1024); } while (0)
#define PG8_MMA(ai, bj, At, Bt) do { __builtin_amdgcn_s_setprio(1); _Pragma("unroll") for (int m = 0; m < 4; ++m) _Pragma("unroll") for (int n = 0; n < 2; ++n) _Pragma("unroll") for (int k = 0; k < 2; ++k) \
        acc[ai][bj][m][n] = __builtin_amdgcn_mfma_f32_16x16x32_bf16(Bt[n][k], At[m][k], acc[ai][bj][m][n], 0, 0, 0); __builtin_amdgcn_s_setprio(0); } while (0)
#define PG8_WAIT_V(n) asm volatile("s_waitcnt vmcnt(" #n ")" ::: "memory")
#define PG8_WAIT_L(n) asm volatile("s_waitcnt lgkmcnt(" #n ")" ::: "memory")
#define PG8_BAR __builtin_amdgcn_s_barrier()
#define PG8_SCHED __builtin_amdgcn_sched_barrier(0)
    Unit cur, nxt; int ui = 0;
    if (!S.next(0, cur)) return;
    f32x4 acc[2][2][4][2];
#pragma unroll
    for (int a = 0; a < 2; ++a)
#pragma unroll
        for (int b = 0; b < 2; ++b)
#pragma unroll
            for (int m = 0; m < 4; ++m)
#pragma unroll
                for (int n = 0; n < 2; ++n) acc[a][b][m][n] = (f32x4){0.f, 0.f, 0.f, 0.f};
    bf16x8 At[4][2], B0[2][2], B1[2][2];
    const char* cA = (const char*)g.A + (size_t)cur.pm * tstep + (size_t)cur.k0 * 2; const char* cB = (const char*)g.Bt + (size_t)cur.pn * tstep + (size_t)cur.k0 * 2;
    int ntc = cur.nt ? cur.nt : nt;
    S.a_ready(cur);
    if constexpr (SP2) {
        PG8_STAGE(PG8_SB(0, 0), cB, voffB); PG8_STAGE(PG8_SB(0, 1), cB + hstep, voffB); PG8_STAGE(PG8_SA(0, 0), cA, voffA); PG8_STAGE(PG8_SA(0, 1), cA + hstep, voffA);
        if (wr == 1) PG8_BAR;
        PG8_WAIT_V(2); PG8_BAR;
        PG8_STAGE(PG8_SB(1, 0), cB + kstep, voffB); PG8_STAGE(PG8_SA(1, 0), cA + kstep, voffA); PG8_STAGE(PG8_SB(1, 1), cB + hstep + kstep, voffB);
        PG8_WAIT_V(6); PG8_BAR;
    } else {
        PG8_STAGE(PG8_SB(0, 0), cB, voffB); PG8_STAGE(PG8_SA(0, 0), cA, voffA); PG8_STAGE(PG8_SB(0, 1), cB + hstep, voffB); PG8_STAGE(PG8_SA(0, 1), cA + hstep, voffA);
        if (wr == 1) PG8_BAR;
        PG8_WAIT_V(4); PG8_BAR;
        PG8_STAGE(PG8_SB(1, 0), cB + kstep, voffB); PG8_STAGE(PG8_SA(1, 0), cA + kstep, voffA); PG8_STAGE(PG8_SB(1, 1), cB + hstep + kstep, voffB);
        PG8_WAIT_V(6); PG8_BAR;
    }
    for (;;) {
        const bool has_next = S.next(ui + 1, nxt);
        const char* nA = has_next ? (const char*)g.A + (size_t)nxt.pm * tstep + (size_t)nxt.k0 * 2 : cA; const char* nB = has_next ? (const char*)g.Bt + (size_t)nxt.pn * tstep + (size_t)nxt.k0 * 2 : cB;
        for (int t = 0; t < ntc; t += 2) {
            const bool last = (t == ntc - 2);
            const char* a1 = cA + (size_t)(t + 1) * kstep;
            const char* a2 = last ? nA : cA + (size_t)(t + 2) * kstep; const char* b2 = last ? nB : cB + (size_t)(t + 2) * kstep;
            const char* a3 = a2 + kstep; const char* b3 = b2 + kstep;
            if (last && has_next) S.a_ready(nxt);
            if constexpr (SP2) {
            PG8_LDB(B0, 0, 0); PG8_LDB(B1, 0, 1); PG8_SCHED; PG8_LDA(At, 0, 0); PG8_STAGE(PG8_SA(1, 1), a1 + hstep, voffA);
            PG8_WAIT_V(8); PG8_WAIT_L(0); PG8_BAR; PG8_MMA(0, 0, At, B0); PG8_MMA(0, 1, At, B1); PG8_BAR; PG8_SCHED;
            PG8_LDA(At, 0, 1); PG8_STAGE(PG8_SB(0, 0), b2, voffB); PG8_STAGE(PG8_SB(0, 1), b2 + hstep, voffB); PG8_STAGE(PG8_SA(0, 0), a2, voffA);
            PG8_WAIT_V(8); PG8_WAIT_L(0); PG8_BAR; PG8_MMA(1, 0, At, B0); PG8_MMA(1, 1, At, B1); PG8_BAR; PG8_SCHED;
            PG8_LDB(B0, 1, 0); PG8_LDB(B1, 1, 1); PG8_SCHED; PG8_LDA(At, 1, 0); PG8_STAGE(PG8_SA(0, 1), a2 + hstep, voffA);
            PG8_WAIT_V(8); PG8_WAIT_L(0); PG8_BAR; PG8_MMA(0, 0, At, B0); PG8_MMA(0, 1, At, B1); PG8_BAR; PG8_SCHED;
            PG8_LDA(At, 1, 1); PG8_STAGE(PG8_SB(1, 0), b3, voffB); PG8_STAGE(PG8_SB(1, 1), b3 + hstep, voffB); PG8_STAGE(PG8_SA(1, 0), a3, voffA);
            PG8_WAIT_V(8); PG8_WAIT_L(0); PG8_BAR; PG8_MMA(1, 0, At, B0); PG8_MMA(1, 1, At, B1); PG8_BAR; PG8_SCHED;
            } else {
            PG8_LDB(B0, 0, 0); PG8_SCHED; PG8_LDA(At, 0, 0); PG8_STAGE(PG8_SA(1, 1), a1 + hstep, voffA);
            PG8_WAIT_L(8); PG8_BAR; PG8_WAIT_L(0); PG8_MMA(0, 0, At, B0); PG8_BAR; PG8_SCHED;
            PG8_LDB(B1, 0, 1); PG8_STAGE(PG8_SB(0, 0), b2, voffB);
            PG8_BAR; PG8_WAIT_L(0); PG8_MMA(0, 1, At, B1); PG8_BAR;
            PG8_LDA(At, 0, 1); PG8_STAGE(PG8_SA(0, 0), a2, voffA);
            PG8_BAR; PG8_WAIT_L(0); PG8_MMA(1, 0, At, B0); PG8_BAR; PG8_SCHED;
            PG8_STAGE(PG8_SB(0, 1), b2 + hstep, voffB);
            PG8_WAIT_V(6); PG8_BAR; PG8_MMA(1, 1, At, B1); PG8_BAR;
            PG8_LDB(B0, 1, 0); PG8_SCHED; PG8_LDA(At, 1, 0); PG8_STAGE(PG8_SA(0, 1), a2 + hstep, voffA);
            PG8_WAIT_L(8); PG8_BAR; PG8_WAIT_L(0); PG8_MMA(0, 0, At, B0); PG8_BAR; PG8_SCHED;
            PG8_LDB(B1, 1, 1); PG8_STAGE(PG8_SB(1, 0), b3, voffB);
            PG8_BAR; PG8_WAIT_L(0); PG8_MMA(0, 1, At, B1); PG8_BAR;
            PG8_LDA(At, 1, 1); PG8_STAGE(PG8_SA(1, 0), a3, voffA);
            PG8_BAR; PG8_WAIT_L(0); PG8_MMA(1, 0, At, B0); PG8_BAR; PG8_SCHED;
            PG8_STAGE(PG8_SB(1, 1), b3 + hstep, voffB);
            PG8_WAIT_V(6); PG8_BAR; PG8_MMA(1, 1, At, B1); PG8_BAR;
            }
        }
        if constexpr (ALIGN_EPI) { if (wr == 0) PG8_BAR; }
        if constexpr (!Epi::AFTER_DRAIN) { E(acc, cur, wr, wc, fr, fq); S.done(cur); }
        if (!has_next) break;
#pragma unroll
        for (int a = 0; a < 2; ++a)
#pragma unroll
            for (int b = 0; b < 2; ++b)
#pragma unroll
                for (int m = 0; m < 4; ++m)
#pragma unroll
                    for (int n = 0; n < 2; ++n) acc[a][b][m][n] = (f32x4){0.f, 0.f, 0.f, 0.f};
        cur = nxt; cA = nA; cB = nB; ++ui; ntc = cur.nt ? cur.nt : nt;
        if constexpr (ALIGN_EPI) { if (wr == 1) PG8_BAR; }
    }
    PG8_WAIT_V(0);
    if constexpr (!ALIGN_EPI) { if (wr == 0) PG8_BAR; }
    PG8_BAR;
    if constexpr (Epi::AFTER_DRAIN) { E.fused(acc, cur, wr, wc, fr, fq, lds, wid, lane); S.done(cur); }
#undef PG8_SA
#undef PG8_SB
#undef PG8_STAGE
#undef PG8_LDA
#undef PG8_LDB
#undef PG8_MMA
#undef PG8_WAIT_V
#undef PG8_WAIT_L
#undef PG8_BAR
#undef PG8_SCHED
}
}

constexpr int NWAVES = 8;
constexpr size_t MiB = 1u << 20;
constexpr size_t WS_CTL = 0, CTL_ZERO_BYTES = 128 * 1024;
constexpr size_t WS_MOD = 1 * MiB;
constexpr size_t WS_ROPE = 1 * MiB + 256 * 1024;
constexpr size_t WS_CORD = 1 * MiB + 512 * 1024;
constexpr size_t WS_BA = 2 * MiB;
constexpr size_t WS_RSS1 = 4 * MiB, WS_RSS2 = 5 * MiB;
constexpr size_t WS_WIN = 6 * MiB, WS_WAO = 18 * MiB, WS_WDO = 19 * MiB, WS_WOUT = 20 * MiB, WS_W1 = 22 * MiB, WS_W2 = 30 * MiB;
constexpr size_t WS_XN = 38 * MiB;
constexpr size_t WS_ONA = 62 * MiB, WS_ODN = 74 * MiB;
constexpr size_t WS_KT = 134 * MiB;
constexpr int REC_SPLIT = 1228;
constexpr size_t WS_PA = 86 * MiB;
constexpr size_t WS_PB = 158 * MiB;
constexpr size_t WS_SC = 250 * MiB;
constexpr size_t WS_M1 = 224 * MiB;
constexpr size_t WS_CK = 248 * MiB, WS_CVT = 249 * MiB;
constexpr size_t WS_END = 256 * MiB;
constexpr size_t OUT_YP = 0, OUT_YS = (size_t)M_CTX * DM, OUT_K = (size_t)MT * DM, OUT_V = OUT_K + (size_t)32 * 8 * 256 * 64, OUT_S = OUT_V + (size_t)32 * 8 * 256 * 64;

constexpr int CW_BAR = 1024;
constexpr int CW_TMO = 8, CW_ADA = 64, CW_CQ = 96, CW_TF = 512, CW_SEAM = 8192, SEAM_BANK = 48 * 64;
constexpr int RING_BYTES = 131072, LDS_BYTES = 147456, LDSCTL_OFF = LDS_BYTES - 1024, MISC_OFF = LDSCTL_OFF + 320;

#define GAS __attribute__((address_space(1)))
#define LAS __attribute__((address_space(3)))
typedef unsigned short bf16;
typedef unsigned v4u __attribute__((ext_vector_type(4)));
typedef unsigned v2u __attribute__((ext_vector_type(2)));
typedef float f32x4 __attribute__((ext_vector_type(4)));
typedef float f32x16 __attribute__((ext_vector_type(16)));
typedef short bf16x8 __attribute__((ext_vector_type(8)));
#define LDS_WAIT() asm volatile("s_waitcnt lgkmcnt(0)" ::: "memory")
#define VM_WAIT() asm volatile("s_waitcnt vmcnt(0)" ::: "memory")
#define MFMA32(a, b, c) __builtin_amdgcn_mfma_f32_32x32x16_bf16((a), (b), (c), 0, 0, 0)
__device__ __forceinline__ unsigned f2bf(float f) { unsigned u = __builtin_bit_cast(unsigned, f); return (u + 0x7fffu + ((u >> 16) & 1u)) >> 16; }
typedef float f32x2_t __attribute__((ext_vector_type(2))); typedef __bf16 bf16x2_t __attribute__((ext_vector_type(2)));
__device__ __forceinline__ unsigned pk2(float lo, float hi) { f32x2_t v = {lo, hi}; bf16x2_t b = __builtin_convertvector(v, bf16x2_t); return __builtin_bit_cast(unsigned, b); }
__device__ __forceinline__ float bflo(unsigned w) { return __uint_as_float(w << 16); }
__device__ __forceinline__ float bfhi(unsigned w) { return __uint_as_float(w & 0xffff0000u); }
__device__ __forceinline__ float silu_(float x) { return x * __builtin_amdgcn_rcpf(1.0f + __expf(-x)); }
__device__ __forceinline__ float sigm_(float x) { return __builtin_amdgcn_rcpf(1.0f + __expf(-x)); }
__device__ __host__ __forceinline__ constexpr int swap23(int x) { return (x & ~12) | ((x & 4) << 1) | ((x & 8) >> 1); }
__device__ __forceinline__ int crow(int reg, int h) { return (reg & 3) + 8 * (reg >> 2) + 4 * h; }
template <int CTRL, int ROWMASK> __device__ __forceinline__ float dpp_add(float v) {
    return v + __builtin_bit_cast(float, __builtin_amdgcn_update_dpp(0, __builtin_bit_cast(int, v), CTRL, ROWMASK, 0xF, false));
}
__device__ __forceinline__ float wave_sum_dpp(float v) {
    v = dpp_add<0xB1, 0xF>(v);
    v = dpp_add<0x4E, 0xF>(v);
    v = dpp_add<0x141, 0xF>(v);
    v = dpp_add<0x140, 0xF>(v);
    v = dpp_add<0x142, 0xA>(v);
    v = dpp_add<0x143, 0xC>(v);
    return __builtin_bit_cast(float, __builtin_amdgcn_readlane(__builtin_bit_cast(int, v), 63));
}
__device__ __forceinline__ float wave_sum(float v) {
#pragma unroll
    for (int o = 1; o < 64; o <<= 1) v += __shfl_xor(v, o);
    return v;
}

#define XB_TMO      128
#define XB_XCNT(j)  (256  + 64 * (j))
#define XB_XSUB(j)  (1280 + 64 * (j))
#define XB_XGEN(j)  (2304 + 64 * (j))
#define XB_TOP      3328
#define XB_TOPGEN   3392
#define XCD_BAR_WORDS 3456
#define XB_SPIN_CAP (1u << 22)

__device__ __forceinline__ unsigned xb_ld(unsigned* p)              { return __hip_atomic_load(p, __ATOMIC_RELAXED, __HIP_MEMORY_SCOPE_AGENT); }
__device__ __forceinline__ unsigned xb_add(unsigned* p, unsigned v) { return __hip_atomic_fetch_add(p, v, __ATOMIC_RELAXED, __HIP_MEMORY_SCOPE_AGENT); }
__device__ __forceinline__ unsigned xb_xcc_id() { return (unsigned)__builtin_amdgcn_s_getreg((3 << 11) | 20) & 0xFu; }
#define XB_SPIN(cond, bar) do { unsigned _sp = 0; while (cond) { __builtin_amdgcn_s_sleep(1); \
    if ((++_sp & 255u) == 0u) { if (xb_ld(&(bar)[XB_TMO])) break; if (_sp > XB_SPIN_CAP) { atomicAdd(&(bar)[XB_TMO], 1u); break; } } } } while (0)

struct XcdBarrier { unsigned* bar; unsigned x; volatile LAS unsigned* st; };

__device__ __forceinline__ XcdBarrier xcd_barrier_post(unsigned* bar, volatile LAS unsigned* st) {
    XcdBarrier b; b.bar = bar; b.x = xb_xcc_id(); b.st = st;
    if (threadIdx.x == 0) (void)xb_add(&bar[XB_XCNT(b.x)], 1u);
    return b;
}
__device__ __forceinline__ void xcd_barrier_complete(unsigned* bar, unsigned x, unsigned& nloc, unsigned& nx) {
    const unsigned G = gridDim.x * gridDim.y * gridDim.z;
    unsigned sum, cnt, mine, sp = 0u;
    for (;;) {
        sum = 0u; cnt = 0u; mine = 0u;
#pragma unroll
        for (unsigned j = 0; j < 16; ++j) { const unsigned c = xb_ld(&bar[XB_XCNT(j)]); sum += c; cnt += (c > 0u) ? 1u : 0u; mine = (j == x) ? c : mine; }
        if (sum == G) break;
        __builtin_amdgcn_s_sleep(1);
        if ((++sp & 255u) == 0u) { if (xb_ld(&bar[XB_TMO])) break; if (sp > XB_SPIN_CAP) { atomicAdd(&bar[XB_TMO], 1u); break; } }
    }
    nloc = mine > 0u ? mine : 1u; nx = cnt > 0u ? cnt : 1u;
}
__device__ __forceinline__ void xcd_barrier(const XcdBarrier& b) {
    asm volatile("s_waitcnt vmcnt(0)" ::: "memory");
    __syncthreads();
    if (threadIdx.x == 0) {
        unsigned* bar = b.bar;
        __builtin_amdgcn_s_waitcnt(0);
        unsigned nloc = b.st[0], nx = b.st[1];
        if (nloc == 0u) { xcd_barrier_complete(bar, b.x, nloc, nx); b.st[0] = nloc; b.st[1] = nx; }
        const unsigned old = xb_add(&bar[XB_XSUB(b.x)], 1u);
        const unsigned gen = old / nloc;
        if (old + 1u == (gen + 1u) * nloc) {
            __builtin_amdgcn_fence(__ATOMIC_RELEASE, "agent");
            asm volatile("s_waitcnt vmcnt(0)" ::: "memory");
            const unsigned og = xb_add(&bar[XB_TOP], 1u);
            const unsigned tg = og / nx;
            if (og + 1u == (tg + 1u) * nx) xb_add(&bar[XB_TOPGEN], 1u);
            else XB_SPIN(xb_ld(&bar[XB_TOPGEN]) == tg, bar);
            __builtin_amdgcn_fence(__ATOMIC_ACQUIRE, "agent");
            xb_add(&bar[XB_XGEN(b.x)], 1u);
            asm volatile("s_waitcnt vmcnt(0)" ::: "memory");
        } else {
            XB_SPIN(xb_ld(&bar[XB_XGEN(b.x)]) == gen, bar);
            __builtin_amdgcn_fence(__ATOMIC_ACQUIRE, "agent");
            asm volatile("s_waitcnt vmcnt(0)" ::: "memory");
        }
    }
    __syncthreads();
}

struct Args { const float* in[24]; float* out; unsigned char* ws; int ph_lo, ph_hi; };
enum { I_XP = 0, I_XS, I_C, I_CK, I_CV, I_ST, I_CCTX, I_WADA, I_BADA, I_PRE1, I_POST1, I_PRE2, I_POST2, I_WIN, I_CONVW, I_ALOG, I_DTB, I_DNN, I_RPB, I_WAO, I_WDO, I_WOUT, I_WFF1, I_WFF2 };

__device__ __forceinline__ void p0_transpose_item(const float* W, int K, int N, bf16* WT, LAS float* scr, int item, int lane) {
    const int nblk = N / 32, kb = item / nblk, nb = item % nblk, k0 = 64 * kb, n0 = 32 * nb;
    {
        f32x4 v[8]; const int kr = lane >> 3, nq = (lane & 7) * 4;
#pragma unroll
        for (int i = 0; i < 8; ++i) v[i] = *(const f32x4*)(W + (size_t)(k0 + 8 * i + kr) * N + n0 + nq);
        asm volatile("" ::: "memory");
#pragma unroll
        for (int i = 0; i < 8; ++i) { LAS float* d = scr + (8 * i + kr) * 33 + nq; d[0] = v[i].x; d[1] = v[i].y; d[2] = v[i].z; d[3] = v[i].w; }
    }
    LDS_WAIT();
    const int c = lane & 7;
#pragma unroll
    for (int j = 0; j < 4; ++j) { const int n = (lane >> 3) + 8 * j; const LAS float* s = scr + (8 * c) * 33 + n;
        v4u o; o.x = pk2(s[0 * 33], s[1 * 33]); o.y = pk2(s[2 * 33], s[3 * 33]); o.z = pk2(s[4 * 33], s[5 * 33]); o.w = pk2(s[6 * 33], s[7 * 33]);
        *(v4u*)(WT + (size_t)(n0 + n) * K + k0 + 8 * c) = o; }
    LDS_WAIT();
}

__device__ __forceinline__ void phase_prologue(const Args& a, LAS unsigned char* lds, int vcu, int G) {
    const int tid = threadIdx.x, lane = tid & 63, wave = __builtin_amdgcn_readfirstlane(tid >> 6);
    unsigned char* ws = a.ws;
    if (vcu < 192) {
        LAS float* sl = (LAS float*)lds;
        LAS float* red = (LAS float*)(lds + 20480);
        const int col = 32 * vcu + (lane & 31), rg = wave * 2 + (lane >> 5);
        const float* w = a.in[I_WADA] + (size_t)(rg * 64) * 6144 + col;
        float wv[64], cv[10];
#pragma unroll
        for (int i = 0; i < 64; ++i) wv[i] = w[(size_t)i * 6144];
#pragma unroll
        for (int q = 0; q < 10; ++q) { const int i = tid + 512 * q; cv[q] = i < 1024 ? a.in[I_CCTX][i] : a.in[I_C][i - 1024]; }
        const float bias = a.in[I_BADA][32 * vcu + (tid & 31)];
        asm volatile("" ::: "memory");
#pragma unroll
        for (int q = 0; q < 10; ++q) sl[tid + 512 * q] = silu_(cv[q]);
        __syncthreads();
        float acc[5] = {0.f, 0.f, 0.f, 0.f, 0.f};
#pragma unroll
        for (int i = 0; i < 64; ++i) { const int k = rg * 64 + i;
#pragma unroll
            for (int v = 0; v < 5; ++v) acc[v] += sl[v * 1024 + k] * wv[i]; }
#pragma unroll
        for (int v = 0; v < 5; ++v) red[(rg * 5 + v) * 32 + (lane & 31)] = acc[v];
        __syncthreads();
        if (tid < 160) { const int v = tid >> 5, cl = tid & 31; float s = bias;
            for (int r = 0; r < 16; ++r) s += red[(r * 5 + v) * 32 + cl];
            ((float*)(ws + WS_MOD))[v * 6144 + 32 * vcu + cl] = s; }
        asm volatile("s_waitcnt vmcnt(0)" ::: "memory");
        __syncthreads();
        if (tid == 0) { __builtin_amdgcn_fence(__ATOMIC_RELEASE, "agent"); asm volatile("s_waitcnt vmcnt(0)" ::: "memory");
            __hip_atomic_fetch_add((unsigned*)(ws + WS_CTL) + CW_ADA, 1u, __ATOMIC_RELAXED, __HIP_MEMORY_SCOPE_AGENT); }
    } else if (vcu == 192) {
        float* rope = (float*)(ws + WS_ROPE);
        for (int i = tid; i < 1024; i += 512) { const int pos = i >> 4, f = i & 15; const float inv = powf(10000.0f, -(float)f / 16.0f); const float ang = (float)pos * inv; rope[i] = cosf(ang); rope[1024 + i] = sinf(ang); }
    } else if (vcu < 225) {
        const int bh = vcu - 193;
        const float* ck = a.in[I_CK] + (size_t)bh * 256 * 64; const float* cv = a.in[I_CV] + (size_t)bh * 256 * 64;
        bf16* CK = (bf16*)(ws + WS_CK) + (size_t)bh * 256 * 64; bf16* CVT = (bf16*)(ws + WS_CVT) + (size_t)bh * 64 * 256;
        for (int i = tid; i < 256 * 8; i += 512) { const int key = i >> 3, c8 = i & 7;
            const f32x4 k0 = *(const f32x4*)(ck + key * 64 + c8 * 8), k1 = *(const f32x4*)(ck + key * 64 + c8 * 8 + 4);
            v4u o; o.x = pk2(k0[0], k0[1]); o.y = pk2(k0[2], k0[3]); o.z = pk2(k1[0], k1[1]); o.w = pk2(k1[2], k1[3]);
            *(v4u*)(CK + key * 64 + c8 * 8) = o;
            const f32x4 v0 = *(const f32x4*)(cv + key * 64 + c8 * 8), v1 = *(const f32x4*)(cv + key * 64 + c8 * 8 + 4);
            const int pos = (key & ~12) | ((key & 4) << 1) | ((key & 8) >> 1);
#pragma unroll
            for (int j = 0; j < 4; ++j) { CVT[(c8 * 8 + j) * 256 + pos] = (bf16)f2bf(v0[j]); CVT[(c8 * 8 + 4 + j) * 256 + pos] = (bf16)f2bf(v1[j]); }
        }
    }
    if (vcu == G - 1) {
        LAS unsigned char* late = (LAS unsigned char*)(lds + 8192); LAS unsigned char* dep = late + 512;
        for (int i = tid; i < 384; i += 512) late[i] = 0;
        __syncthreads();
        { pg8::StaticOrder S; S.init(MT, NINP, G, tid); const int lastr = (S.nwg - 1) / G; pg8::Unit u;
          if (tid < G && S.next(lastr, u) && u.pn >= 6 && u.pn <= 12) late[u.pm * 8 + u.pn - 6] = 1; }
        __syncthreads();
        for (int g = tid; g < 576; g += 512) { const int chunk = g / 3, part = g - 3 * chunk, pm = chunk >> 2;
            int dd = late[pm * 8 + 2 * part] | late[pm * 8 + 2 * part + 1];
            if (part == 2) dd |= late[pm * 8 + 6];
            if (pm >= 32) { const int kc = (chunk - 128) & 15;
                if ((chunk & 3) == 0 && kc != 0) dd |= late[(pm - 1) * 8 + 2 * part] | late[(pm - 1) * 8 + 2 * part + 1];
                if ((chunk & 3) == 3 && kc != 15) dd |= late[(pm + 1) * 8 + 2 * part] | late[(pm + 1) * 8 + 2 * part + 1]; }
            dep[g] = (unsigned char)dd; }
        __syncthreads();
        {
            LAS unsigned* cnt = (LAS unsigned*)(dep + 576);
            const int lane_ = tid & 63;
            for (int c = wave; c < 9; c += NWAVES) { const unsigned long long bal = __ballot(dep[64 * c + lane_] == 0); if (lane_ == 0) cnt[c] = (unsigned)__popcll(bal); }
            __syncthreads();
            for (int c = wave; c < 9; c += NWAVES) { const int g = 64 * c + lane_; const int mine = dep[g];
                const unsigned long long bal = __ballot(mine == 0);
                const int erank = __popcll(bal & ((1ull << lane_) - 1ull));
                int ebefore = 0, etotal = 0;
                for (int j = 0; j < 9; ++j) { const int cj = (int)cnt[j]; etotal += cj; if (j < c) ebefore += cj; }
                const int pos = mine ? etotal + (64 * c - ebefore) + (lane_ - erank) : ebefore + erank;
                ((unsigned*)(ws + WS_CORD))[pos] = (unsigned)g; }
        }
        __syncthreads();
    }
#ifdef TP_A
    if (tid == 0) ((volatile LAS unsigned*)(lds + MISC_OFF))[32 + 20] = (unsigned)__builtin_amdgcn_s_memrealtime();
#endif
    LAS float* scr = (LAS float*)(lds + 32768 + wave * 8704);
    const int gw = vcu * NWAVES + wave, NGW = G * NWAVES;
    constexpr int I_IN = 16 * 177, I_AO = 8 * 32, I_DO = 8 * 32;
    constexpr int NITEMS = I_IN + I_AO + I_DO;
    for (int it = gw; it < NITEMS; it += NGW) {
        int r = it;
        if (r < I_IN) { p0_transpose_item(a.in[I_WIN], 1024, NIN, (bf16*)(ws + WS_WIN), scr, r, lane); continue; } r -= I_IN;
        if (r < I_AO) { p0_transpose_item(a.in[I_WAO], 512, 1024, (bf16*)(ws + WS_WAO), scr, r, lane); continue; } r -= I_AO;
        p0_transpose_item(a.in[I_WDO], 512, 1024, (bf16*)(ws + WS_WDO), scr, r, lane);
    }
    { v4u* z = (v4u*)((bf16*)(ws + WS_WIN) + (size_t)NIN * 1024); const int n16 = (NINP - NIN) * 1024 * 2 / 16;
      for (int i = gw * 64 + lane; i < n16; i += NGW * 64) z[i] = (v4u){0u, 0u, 0u, 0u}; }
#ifdef TP_A
    if (tid == 0) ((volatile LAS unsigned*)(lds + MISC_OFF))[32 + 21] = (unsigned)__builtin_amdgcn_s_memrealtime();
#endif
    if (wave == 0) {
        unsigned* cnt = (unsigned*)(ws + WS_CTL) + CW_ADA; const unsigned want = (unsigned)(G < 192 ? G : 192); unsigned sp = 0;
        while ((unsigned)__builtin_amdgcn_readfirstlane(__hip_atomic_load(cnt, __ATOMIC_RELAXED, __HIP_MEMORY_SCOPE_AGENT)) < want) { __builtin_amdgcn_s_sleep(2); if (++sp > (1u << 22)) break; }
        __builtin_amdgcn_fence(__ATOMIC_ACQUIRE, "agent");
        asm volatile("s_waitcnt vmcnt(0)" ::: "memory");
    }
    __syncthreads();
#ifdef TP_A
    if (tid == 0) ((volatile LAS unsigned*)(lds + MISC_OFF))[32 + 22] = (unsigned)__builtin_amdgcn_s_memrealtime();
#endif
}

__device__ __forceinline__ void late_transposes(const Args& a, LAS unsigned char* lds, int idle_idx, int n_idle) {
    const int tid = threadIdx.x, lane = tid & 63, wave = __builtin_amdgcn_readfirstlane(tid >> 6);
    LAS float* scr = (LAS float*)(lds + wave * 8704);
    constexpr int I_OUT = 16 * 32, I_1 = 16 * 128, I_2 = 64 * 32;
    for (int it = idle_idx * NWAVES + wave; it < I_OUT + I_1 + I_2; it += n_idle * NWAVES) {
        int r = it;
        if (r < I_OUT) { p0_transpose_item(a.in[I_WOUT], 1024, 1024, (bf16*)(a.ws + WS_WOUT), scr, r, lane); continue; } r -= I_OUT;
        if (r < I_1) { p0_transpose_item(a.in[I_WFF1], 1024, FF, (bf16*)(a.ws + WS_W1), scr, r, lane); continue; } r -= I_1;
        p0_transpose_item(a.in[I_WFF2], FF, 1024, (bf16*)(a.ws + WS_W2), scr, r, lane);
    }
}

__device__ __forceinline__ const float* x_row(const Args& a, int m) { return m < M_CTX ? a.in[I_XP] + (size_t)m * DM : a.in[I_XS] + (size_t)(m - M_CTX) * DM; }
__device__ __forceinline__ int mod_idx(int m) { return m < M_CTX ? 0 : 1 + ((m - M_CTX) >> 10); }

__device__ __forceinline__ void phase_xn(const Args& a, int vcu, int G) {
    const int tid = threadIdx.x, lane = tid & 63, wave = tid >> 6;
    const int gw = vcu * NWAVES + wave, NGW = G * NWAVES;
    const float* MOD = (const float*)(a.ws + WS_MOD); bf16* XN = (bf16*)(a.ws + WS_XN);
    for (int m = gw; m < MT; m += NGW) {
        const f32x4* xr = (const f32x4*)x_row(a, m) + lane;
        const float* md = MOD + mod_idx(m) * 6144;
        f32x4 v[4]; float s = 0.f;
#pragma unroll
        for (int j = 0; j < 4; ++j) { v[j] = xr[64 * j]; s += (v[j].x * v[j].x + v[j].y * v[j].y) + (v[j].z * v[j].z + v[j].w * v[j].w); }
        const float rstd = rsqrtf(wave_sum(s) * (1.f / DM) + 1e-6f);
        v2u* o8 = (v2u*)(XN + (size_t)m * DM) + lane;
#pragma unroll
        for (int j = 0; j < 4; ++j) { const int c = (lane + 64 * j) * 4;
            const f32x4 w = *(const f32x4*)(a.in[I_PRE1] + c), sh = *(const f32x4*)(md + c), sc = *(const f32x4*)(md + 1024 + c);
            const f32x4 h = v[j] * rstd * w * (sc + 1.0f) + sh;
            v2u o; o.x = pk2(h.x, h.y); o.y = pk2(h.z, h.w); o8[64 * j] = o; }
    }
}

__device__ __forceinline__ bf16x8 pack_regs(const f32x16& p, int s) {
    v4u w; w.x = pk2(p[8 * s], p[8 * s + 1]); w.y = pk2(p[8 * s + 2], p[8 * s + 3]); w.z = pk2(p[8 * s + 4], p[8 * s + 5]); w.w = pk2(p[8 * s + 6], p[8 * s + 7]);
    return __builtin_bit_cast(bf16x8, w);
}
__device__ __forceinline__ void store_o(bf16* dst, const f32x16& o0, const f32x16& o1, float inv, int hh) {
#pragma unroll
    for (int g = 0; g < 4; ++g) {
        v2u w0, w1; w0.x = pk2(o0[4 * g] * inv, o0[4 * g + 1] * inv); w0.y = pk2(o0[4 * g + 2] * inv, o0[4 * g + 3] * inv);
        w1.x = pk2(o1[4 * g] * inv, o1[4 * g + 1] * inv); w1.y = pk2(o1[4 * g + 2] * inv, o1[4 * g + 3] * inv);
        *(v2u*)(dst + 8 * g + 4 * hh) = w0; *(v2u*)(dst + 32 + 8 * g + 4 * hh) = w1;
    }
}
constexpr float LOG2E = 1.4426950408889634f;

struct AttnTile { const bf16* k; const bf16* v0; const bf16* v1; };
template <bool LAT>
__device__ __forceinline__ void attn_task(const Args& a, int task, int lane, LAS float* wl) {
    const int r = lane & 31, hh = lane >> 5;
    const bf16* Qb = (const bf16*)(a.ws + WS_M1); const bf16* Kbuf = Qb + (size_t)MT * 512; bf16* ONA = (bf16*)(a.ws + WS_ONA);
    int b, h, rowq, gr = 0, cq = 0;
    if (LAT) { const int half = task & 1; gr = (task >> 1) & 15; h = (task >> 5) & 7; b = task >> 8; cq = 32 * half + r; rowq = M_CTX + b * 1024 + gr * 64 + cq; }
    else { const int qb = task & 7; h = (task >> 3) & 7; b = task >> 6; rowq = b * 256 + qb * 32 + r; }
    constexpr int NT = LAT ? 24 : 8;
    const int rs = LAT ? min(max(gr - 4, 0), 8) : 0;
    LAS unsigned char* lk = (LAS unsigned char*)wl; LAS unsigned char* lv = lk + 4096; LAS float* rpb = wl + 2048;
    int boff[2][16];
    LDS_WAIT();
    if (LAT) {
#pragma unroll
        for (int i = 0; i < 4; ++i) { const int idx = lane + 64 * i, kk = idx >> 5, j = idx & 31; rpb[idx] = j < 31 ? a.in[I_RPB][h * 465 + (rs - gr + 7 + kk) * 31 + j] * LOG2E : -1.0e30f; }
        const int cs_ = min(max(cq - 8, 0), 48);
#pragma unroll
        for (int ct = 0; ct < 2; ++ct)
#pragma unroll
            for (int i = 0; i < 16; ++i) { const int kc = ct * 32 + crow(i, hh); boff[ct][i] = (kc >= cs_ && kc < cs_ + 16) ? kc - cq + 15 : 31; } }
    const int kro = lane >> 3, kch = lane & 7, vro = lane >> 2, vch = lane & 3;
    const bf16* gKl = Kbuf + (size_t)(LAT ? M_CTX + b * 1024 : b * 256) * 512 + h * 64 + (size_t)kro * 512 + kch * 8;
    const bf16* gVl = (const bf16*)a.out + (size_t)3 * MT * 512 + (LAT ? (size_t)M_CTX * 512 + (size_t)(b * 8 + h) * 64 * 1024 : (size_t)(b * 8 + h) * 64 * 256) + (size_t)vro * (LAT ? 1024 : 256) + vch * 8;
    const bf16* gKc = (const bf16*)(a.ws + WS_CK) + (size_t)(b * 8 + h) * 256 * 64 + kro * 64 + kch * 8;
    const bf16* gVc = (const bf16*)(a.ws + WS_CVT) + (size_t)(b * 8 + h) * 64 * 256 + vro * 256 + vch * 8;
    v4u gk[4], gv[4];
#define AT_GLOAD(t_) do { const int tt_ = (t_); \
        if (LAT && tt_ < 8) { _Pragma("unroll") for (int i_ = 0; i_ < 4; ++i_) { gk[i_] = *(const v4u*)(gKc + (size_t)(tt_ * 32 + 8 * i_) * 64); gv[i_] = *(const v4u*)(gVc + (size_t)(16 * i_) * 256 + 32 * tt_); } } \
        else { const int tk_ = LAT ? (rs + ((tt_ - 8) >> 1)) * 64 + ((tt_ - 8) & 1) * 32 : 32 * tt_; \
            _Pragma("unroll") for (int i_ = 0; i_ < 4; ++i_) { gk[i_] = *(const v4u*)(gKl + (size_t)(tk_ + 8 * i_) * 512); gv[i_] = *(const v4u*)(gVl + (size_t)(16 * i_) * (LAT ? 1024 : 256) + tk_); } } } while (0)
    const int kwoff = kro * 128 + ((kch ^ (kro & 7)) << 4);
    const int vwoff = vro * 64 + ((vch ^ ((vro >> 2) & 3)) << 4);
#define AT_LWRITE() do { _Pragma("unroll") for (int i_ = 0; i_ < 4; ++i_) { *(LAS v4u*)(lk + kwoff + i_ * 1024) = gk[i_]; *(LAS v4u*)(lv + vwoff + i_ * 1024) = gv[i_]; } } while (0)
    const int kroff = r * 128, ksw = r & 7, vsw = (r >> 2) & 3;
    bf16x8 kf[4], vf[4];
#define AT_LREAD() do { _Pragma("unroll") for (int s_ = 0; s_ < 4; ++s_) kf[s_] = *(const LAS bf16x8*)(lk + kroff + (((2 * s_ + hh) ^ ksw) << 4)); \
        _Pragma("unroll") for (int q_ = 0; q_ < 4; ++q_) vf[q_] = *(const LAS bf16x8*)(lv + (32 * (q_ >> 1) + r) * 64 + (((2 * (q_ & 1) + hh) ^ vsw) << 4)); } while (0)
    bf16x8 qf[4];
    { const bf16* Pq = Qb + (size_t)rowq * 512 + h * 64 + 8 * hh;
#pragma unroll
      for (int s = 0; s < 4; ++s) qf[s] = *(const bf16x8*)(Pq + 16 * s); }
    float m = -3.0e38f, l = 0.f; f32x16 o0 = {}, o1 = {};
    const float sc = 0.125f * LOG2E;
#define AT_SOFTPV() \
        float tm = S[0]; _Pragma("unroll") for (int i = 1; i < 16; ++i) tm = fmaxf(tm, S[i]); \
        tm = fmaxf(tm, __shfl_xor(tm, 32)); \
        if (__any(tm > m)) { const float mn = fmaxf(m, tm); const float al = __builtin_amdgcn_exp2f(m - mn); m = mn; l *= al; o0 = o0 * al; o1 = o1 * al; }     \
        float ps = 0.f; _Pragma("unroll") for (int i = 0; i < 16; ++i) { S[i] = __builtin_amdgcn_exp2f(S[i] - m); ps += S[i]; } \
        l += ps; \
        const bf16x8 p0_ = pack_regs(S, 0), p1_ = pack_regs(S, 1); \
        o0 = MFMA32(vf[0], p0_, o0); o0 = MFMA32(vf[1], p1_, o0); o1 = MFMA32(vf[2], p0_, o1); o1 = MFMA32(vf[3], p1_, o1);
#define AT_STEP(t_, LOCAL_) do { AT_LREAD(); AT_GLOAD(min((t_) + 1, NT - 1)); \
        f32x16 S = {}; _Pragma("unroll") for (int s_ = 0; s_ < 4; ++s_) S = MFMA32(kf[s_], qf[s_], S); \
        if (LOCAL_) { const int tl_ = (t_) - 8; const LAS float* rp_ = rpb + (tl_ >> 1) * 32; \
            if (tl_ & 1) { _Pragma("unroll") for (int i = 0; i < 16; ++i) S[i] = S[i] * sc + rp_[boff[1][i]]; } \
            else { _Pragma("unroll") for (int i = 0; i < 16; ++i) S[i] = S[i] * sc + rp_[boff[0][i]]; } } \
        else { _Pragma("unroll") for (int i = 0; i < 16; ++i) S[i] *= sc; } \
        AT_SOFTPV() \
        AT_LWRITE(); } while (0)
    AT_GLOAD(0); AT_LWRITE();
    if (LAT) {
        for (int t = 0; t < 8; ++t) AT_STEP(t, false);
        for (int t = 8; t < NT; ++t) AT_STEP(t, true);
    } else {
        for (int t = 0; t < NT; ++t) AT_STEP(t, false);
    }
#undef AT_GLOAD
#undef AT_LWRITE
#undef AT_LREAD
#undef AT_SOFTPV
#undef AT_STEP
    l += __shfl_xor(l, 32);
    store_o(ONA + (size_t)rowq * 512 + h * 64, o0, o1, 1.0f / l, hh);
    LDS_WAIT();
}

__device__ __forceinline__ void conv_task(const Args& a, int task, int lane, LAS unsigned char* wl) {
    const int hd = task & 7, part = (task >> 3) % 3, chunk = task / 24, r0 = chunk * 64;
    const bf16* P = (const bf16*)(a.ws + WS_PA);
    int seq0, T_, sb_;
    if (r0 < M_CTX) { seq0 = r0 & ~255; T_ = 256; sb_ = (r0 >> 8) * 8 + hd; } else { seq0 = M_CTX + ((r0 - M_CTX) & ~1023); T_ = 1024; sb_ = ((r0 - M_CTX) >> 10) * 8 + hd; }
    const int seq1 = seq0 + T_, kc = (r0 - seq0) >> 6, NC = T_ >> 6;
    const int ch = part * 512 + hd * 64 + lane;
    float w[5];
#pragma unroll
    for (int t = 0; t < 5; ++t) w[t] = a.in[I_CONVW][t * 1536 + ch];
    const bf16* src = P + C_DN + ch;
    float x[68];
    {
        unsigned raw[68];
#pragma unroll
        for (int i = 0; i < 68; ++i) { const int row = r0 - 2 + i; const int rc = min(max(row, seq0), seq1 - 1); raw[i] = src[(size_t)rc * LDA_]; }
        asm volatile("" ::: "memory");
#pragma unroll
        for (int i = 0; i < 68; ++i) { const int row = r0 - 2 + i; x[i] = (row >= seq0 && row < seq1) ? bflo(raw[i]) : 0.f; }
    }
    float o[64];
#pragma unroll
    for (int rr = 0; rr < 64; ++rr) { const float v = w[0] * x[rr] + w[1] * x[rr + 1] + w[2] * x[rr + 2] + w[3] * x[rr + 3] + w[4] * x[rr + 4]; o[rr] = silu_(v); }
    if (part < 2) {
#pragma unroll
        for (int rr = 0; rr < 64; ++rr) { const float ss = wave_sum_dpp(o[rr] * o[rr]); o[rr] *= __builtin_amdgcn_rsqf(ss + 1e-6f); }
        const int p = swap23(lane), pc = p >> 3, pe = (p & 7) * 2;
#pragma unroll
        for (int rr = 0; rr < 64; ++rr) *(LAS bf16*)(wl + rr * 128 + ((pc ^ (rr & 7)) << 4) + pe) = (bf16)f2bf(o[rr]);
        LDS_WAIT();
        const int fr_ = lane & 31, fh_ = lane >> 5;
        bf16* dst = (bf16*)a.out + (size_t)part * MT * 512 + (size_t)((r0 < M_CTX ? 512 + sb_ * 4 : sb_ * 16) + kc) * 4096 + lane * 8;
#pragma unroll
        for (int f = 0; f < 8; ++f) { const int row = 32 * (f >> 2) + fr_; *(v4u*)(dst + f * 512) = *(const LAS v4u*)(wl + row * 128 + (((2 * (f & 3) + fh_) ^ (row & 7)) << 4)); }
        LDS_WAIT();
    }
    if (part == 1) {
        const int td0 = (r0 < M_CTX ? 512 + sb_ * 4 : sb_ * 16), ib = lane >> 5, rl = lane & 31;
        bf16* ktf = (bf16*)(a.ws + WS_KT) + (size_t)(td0 + kc) * 4096 + ib * 2048 + rl * 8;
        bf16* ktb = (bf16*)(a.ws + WS_KT) + (size_t)MT * 512 + (size_t)(td0 + NC - 1 - kc) * 4096 + ib * 2048 + rl * 8;
#pragma unroll
        for (int q = 0; q < 8; ++q) { v4u wf, wb;
            wf.x = pk2(o[swap23(8 * q + 0)], o[swap23(8 * q + 1)]); wf.y = pk2(o[swap23(8 * q + 2)], o[swap23(8 * q + 3)]); wf.z = pk2(o[swap23(8 * q + 4)], o[swap23(8 * q + 5)]); wf.w = pk2(o[swap23(8 * q + 6)], o[swap23(8 * q + 7)]);
            wb.x = pk2(o[63 - swap23(8 * q + 0)], o[63 - swap23(8 * q + 1)]); wb.y = pk2(o[63 - swap23(8 * q + 2)], o[63 - swap23(8 * q + 3)]); wb.z = pk2(o[63 - swap23(8 * q + 4)], o[63 - swap23(8 * q + 5)]); wb.w = pk2(o[63 - swap23(8 * q + 6)], o[63 - swap23(8 * q + 7)]);
            const int off = (q >> 1) * 512 + (q & 1) * 256;
            *(v4u*)(ktf + off) = wf; *(v4u*)(ktb + off) = wb; }
    }
    if (part == 2) {
        const int jw = lane >> 5, r = lane & 31;
        const int td0 = (r0 < M_CTX ? 512 + sb_ * 4 : sb_ * 16);
        const float* BA = (const float*)(a.ws + WS_BA) + (size_t)(r0 + lane) * 32 + hd;
        const float bet[2] = {sigm_(BA[0]), sigm_(BA[8])};
#pragma unroll
        for (int dd = 0; dd < 2; ++dd) {
            float ov[64];
#pragma unroll
            for (int rr = 0; rr < 64; ++rr) ov[rr] = o[rr] * __builtin_bit_cast(float, __builtin_amdgcn_readlane(__builtin_bit_cast(int, bet[dd]), rr));
            const int taskd = td0 + (dd ? NC - 1 - kc : kc);
            bf16* base = (dd ? (bf16*)(a.ws + WS_ODN) : (bf16*)a.out + (size_t)2 * MT * 512) + ((size_t)(taskd * 2 + jw) * 2 * 64 + r) * 16;
#pragma unroll
            for (int cb = 0; cb < 2; ++cb)
#pragma unroll
                for (int hh = 0; hh < 2; ++hh) { v4u w0, w1;
#define CV(g_) ov[dd ? 63 - (32 * cb + crow((g_), hh)) : (32 * cb + crow((g_), hh))]
                    w0.x = pk2(CV(0), CV(1)); w0.y = pk2(CV(2), CV(3)); w0.z = pk2(CV(4), CV(5)); w0.w = pk2(CV(6), CV(7));
                    w1.x = pk2(CV(8), CV(9)); w1.y = pk2(CV(10), CV(11)); w1.z = pk2(CV(12), CV(13)); w1.w = pk2(CV(14), CV(15));
#undef CV
                    bf16* dp = base + (size_t)(cb * 64 + hh * 32) * 16; *(v4u*)dp = w0; *(v4u*)(dp + 8) = w1; }
        }
    }
}

__device__ __forceinline__ void conv_wait(const unsigned* tf, int g, int lane) {
    const int chunk = g / 3, part = g - 3 * chunk, pm = chunk >> 2;
    int pmh = -1;
    if (pm >= 32) { const int kc = (chunk - 128) & 15; if ((chunk & 3) == 0 && kc != 0) pmh = pm - 1; if ((chunk & 3) == 3 && kc != 15) pmh = pm + 1; }
    int idx = -1;
    if (lane < 2) idx = pm * 8 + 2 * part + lane;
    else if (lane < 4) idx = pmh < 0 ? -1 : pmh * 8 + 2 * part + (lane - 2);
    else if (lane == 4) idx = part == 2 ? pm * 8 + 6 : -1;
    unsigned sp = 0;
    for (;;) {
        unsigned v = 8u;
        if (idx >= 0) v = __hip_atomic_load(tf + idx, __ATOMIC_RELAXED, __HIP_MEMORY_SCOPE_AGENT);
        if (__ballot(v < 8u) == 0ull) break;
        __builtin_amdgcn_s_sleep(8); if (++sp > (1u << 20)) break;
    }
    __builtin_amdgcn_fence(__ATOMIC_ACQUIRE, "agent");
}
__device__ __forceinline__ void phase_conv(const Args& a, LAS unsigned char* lds, int vcu, int G) {
    const int tid = threadIdx.x, wave = __builtin_amdgcn_readfirstlane(tid >> 6);
    unsigned* ctl = (unsigned*)(a.ws + WS_CTL); const unsigned* tf = ctl + CW_TF; const unsigned* order = (const unsigned*)(a.ws + WS_CORD);
    LAS int* qslot = (LAS int*)(lds + 65536);
    int nx = 0;
    if (tid == 0) nx = (int)__hip_atomic_fetch_add(ctl + CW_CQ, 1u, __ATOMIC_RELAXED, __HIP_MEMORY_SCOPE_AGENT);
    for (;;) {
        if (tid == 0) *qslot = nx;
        __syncthreads();
        const int rk = *qslot;
        if (rk >= 576) break;
        const int g = __builtin_amdgcn_readfirstlane((int)order[rk]);
        if (wave == 0) conv_wait(tf, g, tid);
        __syncthreads();
        if (tid == 0) nx = (int)__hip_atomic_fetch_add(ctl + CW_CQ, 1u, __ATOMIC_RELAXED, __HIP_MEMORY_SCOPE_AGENT);
        { int lane = tid & 63; asm volatile("" : "+v"(lane)); conv_task(a, g * 8 + wave, lane, lds + wave * 8192); }
    }
}

__device__ __forceinline__ bf16* rec_ptr(unsigned char* ws, int task) { return task < REC_SPLIT ? (bf16*)(ws + WS_XN) + (size_t)task * 10240 : (bf16*)(ws + WS_PA) + (size_t)(task - REC_SPLIT) * 10240; }
struct DnChain { int b, h, dir, T, rowbase, task0; bool lat; };
__device__ __forceinline__ DnChain dn_decode(int chain) {
    DnChain d; d.lat = chain < 64;
    if (d.lat) { d.b = chain >> 4; d.h = (chain >> 1) & 7; d.dir = chain & 1; d.T = 1024; d.rowbase = M_CTX + d.b * 1024; d.task0 = chain * 16; }
    else { const int c = chain - 64; d.b = c >> 4; d.h = (c >> 1) & 7; d.dir = c & 1; d.T = 256; d.rowbase = d.b * 256; d.task0 = 1024 + c * 4; }
    return d;
}

__device__ __forceinline__ void dn_pre_task(const Args& a, int task, LAS float* LT, LAS float* tab, int lane) {
    int chain, n;
    if (task < 1024) { chain = task >> 4; n = task & 15; } else { const int t2 = task - 1024; chain = 64 + (t2 >> 2); n = t2 & 3; }
    const DnChain d = dn_decode(chain);
    const int h = d.h, dir = d.dir;
    const bf16* DQ = (const bf16*)a.out; const bf16* DK = DQ + (size_t)MT * 512;
    const float* BA = (const float*)(a.ws + WS_BA);
    bf16* rec = rec_ptr(a.ws, task); bf16* Tm = rec; bf16* QKm = rec + 3072; bf16* Kb = rec + 6144;
    float* SC = (float*)(a.ws + WS_SC) + (size_t)task * 320;
    const int R0 = d.rowbase + (dir ? d.T - 1 - 64 * n : 64 * n), RS = dir ? -1 : 1;
    const int r = lane & 31, hh = lane >> 5;
    {
        const float* ba = BA + (size_t)(R0 + lane * RS) * 32;
        const float beta = sigm_(ba[dir * 8 + h]);
        const float xx = ba[16 + dir * 8 + h] + a.in[I_DTB][dir * 8 + h];
        const float sp = xx > 20.f ? xx : log1pf(__expf(xx));
        float gc = -__expf(a.in[I_ALOG][dir * 8 + h]) * sp;
#pragma unroll
        for (int o = 1; o < 64; o <<= 1) { const float t = __shfl_up(gc, o); if (lane >= o) gc += t; }
        const float gl = __shfl(gc, 63);
        const float eg = __expf(gc);
        SC[lane] = beta; SC[64 + lane] = beta * eg; SC[128 + lane] = 0.125f * eg; SC[192 + lane] = __expf(gl - gc); SC[256 + lane] = __expf(gl);
        LDS_WAIT();
        tab[lane] = gc; tab[64 + lane] = beta;
        LDS_WAIT();
    }
    bf16x8 kf[2][4], qf[2][4];
    { const int gF = (d.lat ? (d.b * 8 + h) * 16 : 512 + (d.b * 8 + h) * 4) + (dir ? (d.T >> 6) - 1 - n : n);
      const size_t fo = (size_t)gF * 4096 + (dir ? (hh * 32 + 31 - r) : lane) * 8;
#pragma unroll
      for (int cb = 0; cb < 2; ++cb)
#pragma unroll
        for (int s = 0; s < 4; ++s) { const size_t o_ = fo + ((dir ? 1 - cb : cb) * 4 + s) * 512; kf[cb][s] = *(const bf16x8*)(DK + o_); qf[cb][s] = *(const bf16x8*)(DQ + o_); } }
    asm volatile("" ::: "memory");
    const float gcol0 = tab[r], gcol1 = tab[32 + r];
#pragma unroll
    for (int cb = 0; cb < 2; ++cb) { const float coef = -tab[64 + 32 * cb + r] * __expf(cb ? gcol1 : gcol0);
#pragma unroll
        for (int s = 0; s < 4; ++s) { const v4u kw = __builtin_bit_cast(v4u, kf[cb][s]); v4u ow;
            ow.x = pk2(bflo(kw.x) * coef, bfhi(kw.x) * coef); ow.y = pk2(bflo(kw.y) * coef, bfhi(kw.y) * coef); ow.z = pk2(bflo(kw.z) * coef, bfhi(kw.z) * coef); ow.w = pk2(bflo(kw.w) * coef, bfhi(kw.w) * coef);
            *(v4u*)(Kb + (4 * cb + s) * 512 + lane * 8) = ow; } }
#pragma unroll
    for (int tile = 0; tile < 3; tile += 2) {
        const int cb = tile == 0 ? 0 : 1, cbp = cb;
        f32x16 acc = {};
#pragma unroll
        for (int s = 0; s < 4; ++s) acc = MFMA32(kf[cb][s], kf[cbp][s], acc);
        const float gcol = cbp ? gcol1 : gcol0; const int cp = 32 * cbp + r;
#pragma unroll
        for (int g = 0; g < 4; ++g) {
            const f32x4 gr = *(const LAS f32x4*)(tab + 32 * cb + 8 * g + 4 * hh), br = *(const LAS f32x4*)(tab + 64 + 32 * cb + 8 * g + 4 * hh);
            f32x4 v;
#pragma unroll
            for (int j = 0; j < 4; ++j) { const int c = 32 * cb + 8 * g + 4 * hh + j; v[j] = (cp < c) ? br[j] * acc[4 * g + j] * __expf(gr[j] - gcol) : 0.f; }
            *(LAS f32x4*)(LT + cp * 68 + 32 * cb + 8 * g + 4 * hh) = v;
        }
    }
    bf16x8 l21[2];
    {
        f32x16 acc = {};
#pragma unroll
        for (int s = 0; s < 4; ++s) acc = MFMA32(kf[0][s], kf[1][s], acc);
        const float bb = tab[96 + r];
#pragma unroll
        for (int g = 0; g < 4; ++g) { const f32x4 ga = *(const LAS f32x4*)(tab + 8 * g + 4 * hh);
#pragma unroll
            for (int j = 0; j < 4; ++j) acc[4 * g + j] = bb * acc[4 * g + j] * __expf(gcol1 - ga[j]); }
        l21[0] = pack_regs(acc, 0); l21[1] = pack_regs(acc, 1);
    }
#pragma unroll
    for (int tile = 0; tile < 3; ++tile) {
        const int cb = tile == 0 ? 0 : 1, cbp = tile == 2 ? 1 : 0;
        f32x16 acc = {};
#pragma unroll
        for (int s = 0; s < 4; ++s) acc = MFMA32(kf[cbp][s], qf[cb][s], acc);
        const float gcc = cb ? gcol1 : gcol0; const int c = 32 * cb + r;
#pragma unroll
        for (int g = 0; g < 4; ++g) {
            const f32x4 gr = *(const LAS f32x4*)(tab + 32 * cbp + 8 * g + 4 * hh);
#pragma unroll
            for (int j = 0; j < 4; ++j) { const int cp = 32 * cbp + 8 * g + 4 * hh + j; acc[4 * g + j] = (cp <= c) ? 0.125f * acc[4 * g + j] * __expf(gcc - gr[j]) : 0.f; }
        }
#pragma unroll
        for (int s = 0; s < 2; ++s) *(bf16x8*)(QKm + (2 * tile + s) * 512 + lane * 8) = pack_regs(acc, s);
    }
    LDS_WAIT();
    {
        float tb[32]; float zero_ = 0.f; asm volatile("" : "+v"(zero_));
#pragma unroll
        for (int i = 0; i < 32; ++i) tb[i] = zero_;
        const int bI = lane >> 5, rl = lane & 31;
        const LAS float* LTb = LT + (32 * bI) * 68 + 32 * bI;
#pragma unroll
        for (int nn = 31; nn >= 0; --nn) {
            float a0 = (rl == nn) ? 1.f : 0.f, a1 = 0.f;
            const LAS float* lrow = LTb + nn * 68;
            if (nn < 30) asm volatile("" : "+v"(lrow) : "v"(tb[nn < 30 ? nn + 2 : 31]));
#pragma unroll
            for (int m4 = (nn + 1) / 4; m4 < 8; ++m4) { const f32x4 lr = *(const LAS f32x4*)(lrow + 4 * m4);
                a0 -= lr[0] * tb[4 * m4]; a1 -= lr[1] * tb[4 * m4 + 1]; a0 -= lr[2] * tb[4 * m4 + 2]; a1 -= lr[3] * tb[4 * m4 + 3]; }
            tb[nn] = a0 + a1;
        }
        { bf16* dst = Tm + (lane < 32 ? 0 : 4 * 512) + rl * 8;
#pragma unroll
          for (int q = 0; q < 4; ++q) { v4u w;
              w.x = pk2(tb[swap23(8 * q + 0)], tb[swap23(8 * q + 1)]); w.y = pk2(tb[swap23(8 * q + 2)], tb[swap23(8 * q + 3)]);
              w.z = pk2(tb[swap23(8 * q + 4)], tb[swap23(8 * q + 5)]); w.w = pk2(tb[swap23(8 * q + 6)], tb[swap23(8 * q + 7)]);
              *(v4u*)(dst + (q >> 1) * 512 + (q & 1) * 256) = w; } }
        LDS_WAIT();
        LAS float* TT = LT;
#pragma unroll
        for (int q = 0; q < 8; ++q) *(LAS f32x4*)(TT + lane * 36 + 4 * q) = (f32x4){tb[4 * q], tb[4 * q + 1], tb[4 * q + 2], tb[4 * q + 3]};
        LDS_WAIT();
        bf16x8 b11[2], t22[2];
#pragma unroll
        for (int s = 0; s < 2; ++s) {
            float c11[8];
#pragma unroll
            for (int j = 0; j < 8; ++j) c11[j] = TT[(16 * s + 8 * (j >> 2) + 4 * hh + (j & 3)) * 36 + r];
            const f32x4 ra = *(const LAS f32x4*)(TT + (32 + r) * 36 + 16 * s + 4 * hh), rb = *(const LAS f32x4*)(TT + (32 + r) * 36 + 16 * s + 8 + 4 * hh);
            v4u w1, w2;
            w1.x = pk2(c11[0], c11[1]); w1.y = pk2(c11[2], c11[3]); w1.z = pk2(c11[4], c11[5]); w1.w = pk2(c11[6], c11[7]);
            w2.x = pk2(ra[0], ra[1]); w2.y = pk2(ra[2], ra[3]); w2.z = pk2(rb[0], rb[1]); w2.w = pk2(rb[2], rb[3]);
            b11[s] = __builtin_bit_cast(bf16x8, w1); t22[s] = __builtin_bit_cast(bf16x8, w2);
        }
        f32x16 W = {};
        W = MFMA32(l21[0], b11[0], W); W = MFMA32(l21[1], b11[1], W);
        const bf16x8 wp0 = pack_regs(W, 0), wp1 = pack_regs(W, 1);
        f32x16 X = {};
        X = MFMA32(wp0, t22[0], X); X = MFMA32(wp1, t22[1], X);
#pragma unroll
        for (int g = 0; g < 16; ++g) X[g] = -X[g];
#pragma unroll
        for (int s = 0; s < 2; ++s) *(bf16x8*)(Tm + (2 + s) * 512 + lane * 8) = pack_regs(X, s);
    }
    LDS_WAIT();
}
__device__ __forceinline__ void phase_attn_pre(const Args& a, LAS unsigned char* lds, int vcu, int G) {
    const int tid = threadIdx.x, wave = __builtin_amdgcn_readfirstlane(tid >> 6);
    LAS float* LT = (LAS float*)(lds + wave * 17408); LAS float* tab = (LAS float*)(lds + 139264 + wave * 512);
#define MIX_LANE() int lane = tid & 63; asm volatile("" : "+v"(lane))
    if (G == 256) {
#ifndef AP_REP_A
#define AP_REP_A 1
#endif
#ifndef AP_REP_P
#define AP_REP_P 1
#endif
        if (vcu < 128) { for (int q = 0; q < AP_REP_A; ++q) { MIX_LANE(); attn_task<true>(a, vcu * 8 + wave, lane, LT); } for (int q = 0; q < AP_REP_P; ++q) { MIX_LANE(); dn_pre_task(a, vcu * 8 + wave, LT, tab, lane); } }
        else { const int j = vcu - 128;
            for (int q = 0; q < AP_REP_A; ++q) { MIX_LANE(); attn_task<false>(a, j * 8 + wave, lane, LT); } for (int q = 0; q < AP_REP_P; ++q) { MIX_LANE(); dn_pre_task(a, 1024 + j * 8 + wave, LT, tab, lane); }
            for (int q = 0; q < AP_REP_A; ++q) { MIX_LANE(); attn_task<false>(a, (j + 128) * 8 + wave, lane, LT); } for (int q = 0; q < AP_REP_P; ++q) { MIX_LANE(); dn_pre_task(a, 2048 + j * 8 + wave, LT, tab, lane); } }
    } else {
        for (int t = wave * G + vcu; t < 1024 + 2048 + 3072; t += G * NWAVES) { MIX_LANE();
            if (t < 1024) attn_task<true>(a, t, lane, LT); else if (t < 3072) attn_task<false>(a, t - 1024, lane, LT); else dn_pre_task(a, t - 3072, LT, tab, lane); }
    }
#undef MIX_LANE
}

__device__ __forceinline__ void dn_scan_task(const Args& a, int wt, int lane) {
    const int chain = wt >> 1, jw = wt & 1;
    const DnChain d = dn_decode(chain);
    const int h = d.h, dir = d.dir, NC = d.T >> 6, T = d.T;
    const int r = lane & 31, hh = lane >> 5, jcol = 32 * jw + r;
    const bf16* DQ = (const bf16*)a.out;
    const bf16* VC = dir ? (const bf16*)(a.ws + WS_ODN) : DQ + (size_t)2 * MT * 512;
    const bf16* KTs = (const bf16*)(a.ws + WS_KT) + (dir ? (size_t)MT * 512 : 0);
    bf16* OUTO = dir ? (bf16*)(a.ws + WS_W1) : (bf16*)a.out + (size_t)3 * MT * 512;
    const int RS = dir ? -1 : 1;
    f32x16 S[2];
    if (d.lat) { const float* s0 = a.in[I_ST] + ((size_t)((d.b * 2 + dir) * 8 + h) * 64) * 64 + jcol;
#pragma unroll
        for (int ib = 0; ib < 2; ++ib)
#pragma unroll
            for (int g = 0; g < 16; ++g) S[ib][g] = s0[(32 * ib + crow(g, hh)) * 64]; }
    else { S[0] = (f32x16){}; S[1] = (f32x16){}; }
    for (int n = 0; n < NC; ++n) {
        int ln = lane; asm volatile("" : "+v"(ln));
        const int r = ln & 31, hh = ln >> 5;
        const int task = d.task0 + n;
        const int taskd = (d.lat ? (d.b * 8 + h) * 16 : 512 + (d.b * 8 + h) * 4) + n;
        const int R0 = d.rowbase + (dir ? T - 1 - 64 * n : 64 * n);
        const bf16* rec = rec_ptr(a.ws, task) + ln * 8; const bf16* Tm = rec; const bf16* QKm = rec + 3072; const bf16* Kb = rec + 6144;
        const float* SC = (const float*)(a.ws + WS_SC) + (size_t)task * 320 + 4 * hh;
        const bf16* vc = VC + ((size_t)(taskd * 2 + jw) * 2 * 64 + ln) * 16;
        const bf16* kt = KTs + (size_t)taskd * 4096 + ln * 8;
        bf16* oo = OUTO + (size_t)(taskd * 2 + jw) * 2 * 16 * 64 + ln;
        const bf16* qbase = DQ + (size_t)((d.lat ? (d.b * 8 + h) * 16 : 512 + (d.b * 8 + h) * 4) + (dir ? NC - 1 - n : n)) * 4096 + (dir ? (hh * 32 + 31 - r) : ln) * 8;
        const int qo0 = dir ? 2048 : 0, qo1 = dir ? 0 : 2048;
        bf16x8 fk[2][4], fq[2][4]; v4u vv[2][2]; f32x4 s2[2][4];
#pragma unroll
        for (int cb = 0; cb < 2; ++cb) {
            const bf16* qp = qbase + (cb ? qo1 : qo0);
#pragma unroll
            for (int k4 = 0; k4 < 4; ++k4) { fk[cb][k4] = *(const bf16x8*)(Kb + (4 * cb + k4) * 512); fq[cb][k4] = *(const bf16x8*)(qp + k4 * 512); }
            vv[cb][0] = *(const v4u*)(vc + cb * 1024); vv[cb][1] = *(const v4u*)(vc + cb * 1024 + 8);
#pragma unroll
            for (int g = 0; g < 4; ++g) s2[cb][g] = *(const f32x4*)(SC + 128 + 32 * cb + 8 * g);
        }
        asm volatile("" ::: "memory");
        bf16x8 sb[2][2];
#pragma unroll
        for (int ib = 0; ib < 2; ++ib)
#pragma unroll
            for (int s = 0; s < 2; ++s) sb[ib][s] = pack_regs(S[ib], s);
        f32x16 X[2], o[2];
#pragma unroll
        for (int cb = 0; cb < 2; ++cb) {
            f32x16 ax, ao = {};
            { const v4u va = vv[cb][0], vb_ = vv[cb][1];
              ax = (f32x16){bflo(va.x), bfhi(va.x), bflo(va.y), bfhi(va.y), bflo(va.z), bfhi(va.z), bflo(va.w), bfhi(va.w),
                            bflo(vb_.x), bfhi(vb_.x), bflo(vb_.y), bfhi(vb_.y), bflo(vb_.z), bfhi(vb_.z), bflo(vb_.w), bfhi(vb_.w)}; }
#pragma unroll
            for (int ib = 0; ib < 2; ++ib)
#pragma unroll
                for (int s = 0; s < 2; ++s) { ax = MFMA32(fk[cb][2 * ib + s], sb[ib][s], ax); ao = MFMA32(fq[cb][2 * ib + s], sb[ib][s], ao); }
#pragma unroll
            for (int g = 0; g < 4; ++g)
#pragma unroll
                for (int j = 0; j < 4; ++j) ao[4 * g + j] *= s2[cb][g][j];
            X[cb] = ax; o[cb] = ao;
        }
        bf16x8 ft[3][2], fm[3][2], fkt[2][4]; f32x4 s3[2][4];
#pragma unroll
        for (int bl = 0; bl < 3; ++bl) { const int cb = bl == 0 ? 0 : 1, cbp = bl == 2 ? 1 : 0;
#pragma unroll
            for (int s = 0; s < 2; ++s) { ft[bl][s] = *(const bf16x8*)(Tm + (2 * bl + s) * 512); fm[bl][s] = *(const bf16x8*)(QKm + (2 * bl + s) * 512); } }
#pragma unroll
        for (int ib = 0; ib < 2; ++ib)
#pragma unroll
            for (int k4 = 0; k4 < 4; ++k4) fkt[ib][k4] = *(const bf16x8*)(kt + (4 * ib + k4) * 512);
        asm volatile("" ::: "memory");
        f32x16 vn[2];
        {
            bf16x8 xb[2][2];
#pragma unroll
            for (int cb = 0; cb < 2; ++cb)
#pragma unroll
                for (int s = 0; s < 2; ++s) xb[cb][s] = pack_regs(X[cb], s);
            f32x16 a0 = {}, a1 = {};
            a0 = MFMA32(ft[0][0], xb[0][0], a0); a0 = MFMA32(ft[0][1], xb[0][1], a0);
            a1 = MFMA32(ft[1][0], xb[0][0], a1); a1 = MFMA32(ft[1][1], xb[0][1], a1); a1 = MFMA32(ft[2][0], xb[1][0], a1); a1 = MFMA32(ft[2][1], xb[1][1], a1);
            vn[0] = a0; vn[1] = a1;
        }
        {
            bf16x8 vb[2][2];
#pragma unroll
            for (int cb = 0; cb < 2; ++cb)
#pragma unroll
                for (int s = 0; s < 2; ++s) vb[cb][s] = pack_regs(vn[cb], s);
            f32x16 a0 = o[0], a1 = o[1];
            a0 = MFMA32(fm[0][0], vb[0][0], a0); a0 = MFMA32(fm[0][1], vb[0][1], a0);
            a1 = MFMA32(fm[1][0], vb[0][0], a1); a1 = MFMA32(fm[1][1], vb[0][1], a1); a1 = MFMA32(fm[2][0], vb[1][0], a1); a1 = MFMA32(fm[2][1], vb[1][1], a1);
#pragma unroll
            for (int g = 0; g < 16; ++g) { oo[g * 64] = (bf16)f2bf(a0[g]); oo[(16 + g) * 64] = (bf16)f2bf(a1[g]); }
        }
        {
#pragma unroll
            for (int cb = 0; cb < 2; ++cb)
#pragma unroll
                for (int g = 0; g < 4; ++g) s3[cb][g] = *(const f32x4*)(SC + 192 + 32 * cb + 8 * g);
            const float egl = SC[256];
#pragma unroll
            for (int cb = 0; cb < 2; ++cb)
#pragma unroll
                for (int g = 0; g < 4; ++g)
#pragma unroll
                    for (int j = 0; j < 4; ++j) vn[cb][4 * g + j] *= s3[cb][g][j];
            bf16x8 vb[2][2];
#pragma unroll
            for (int cb = 0; cb < 2; ++cb)
#pragma unroll
                for (int s = 0; s < 2; ++s) vb[cb][s] = pack_regs(vn[cb], s);
#pragma unroll
            for (int ib = 0; ib < 2; ++ib) { f32x16 acc = S[ib] * egl;
#pragma unroll
                for (int cb = 0; cb < 2; ++cb)
#pragma unroll
                    for (int s = 0; s < 2; ++s) acc = MFMA32(fkt[ib][2 * cb + s], vb[cb][s], acc);
                S[ib] = acc; }
        }
    }
    if (!d.lat) { float* so = a.out + OUT_S + ((size_t)((d.b * 2 + dir) * 8 + h) * 64) * 64 + jcol;
#pragma unroll
        for (int ib = 0; ib < 2; ++ib)
#pragma unroll
            for (int g = 0; g < 16; ++g) so[(32 * ib + crow(g, hh)) * 64] = S[ib][g]; }
}
constexpr int SL_FK = 0, SL_FQ = 8192, SL_VV = 16384, SL_SC = 20480, SL_FT = 21504, SL_FM = 27648, SL_KT = 33792, SL_BUF = 43008;
__device__ __forceinline__ void lds_dma16(const void* gsrc, unsigned lds_dst) {
    unsigned keep;
    asm volatile("s_mov_b32 %0, m0\n\ts_mov_b32 m0, %2\n\ts_nop 0\n\tglobal_load_lds_dwordx4 %1, off\n\ts_mov_b32 m0, %0" : "=&s"(keep) : "v"(gsrc), "s"(lds_dst) : "memory");
}
__device__ __forceinline__ void dn_scan_lat(const Args& a, int wt, int lane, LAS unsigned char* L) {
    const int chain = wt >> 1, jw = wt & 1;
    const DnChain d = dn_decode(chain);
    const int h = d.h, dir = d.dir; constexpr int NC = 16;
    const int r = lane & 31, hh = lane >> 5, jcol = 32 * jw + r;
    const bf16* DQ = (const bf16*)a.out;
    const bf16* VC = dir ? (const bf16*)(a.ws + WS_ODN) : DQ + (size_t)2 * MT * 512;
    const bf16* KTs = (const bf16*)(a.ws + WS_KT) + (dir ? (size_t)MT * 512 : 0);
    bf16* OUTO = dir ? (bf16*)(a.ws + WS_W1) : (bf16*)a.out + (size_t)3 * MT * 512;
    const unsigned lbase = (unsigned)__builtin_amdgcn_readfirstlane((int)(unsigned)(uintptr_t)L);
    const int td0 = (d.b * 8 + h) * 16;
    const int qlane = dir ? (hh * 32 + 31 - r) : lane, qo0 = dir ? 2048 : 0, qo1 = dir ? 0 : 2048;
    f32x16 S[2];
    { const float* s0 = a.in[I_ST] + ((size_t)((d.b * 2 + dir) * 8 + h) * 64) * 64 + jcol;
#pragma unroll
      for (int ib = 0; ib < 2; ++ib)
#pragma unroll
          for (int g = 0; g < 16; ++g) S[ib][g] = s0[(32 * ib + crow(g, hh)) * 64]; }
#define SL_RUN(p_, cnt_, stride_, ldso_) do { const bf16* pp_ = (p_); _Pragma("unroll") for (int f = 0; f < (cnt_); ++f) { lds_dma16(pp_, lb_ + (ldso_) + f * 1024); pp_ += (stride_); asm volatile("" : "+v"(pp_)); } } while (0)
#define SL_ISSUE(n_) do { const int nn_ = (n_); const unsigned lb_ = lbase + (unsigned)((nn_ & 1) * SL_BUF); const int task_ = d.task0 + nn_, taskd_ = td0 + nn_; \
        const bf16* rec_ = rec_ptr(a.ws, task_) + lane * 8; \
        const bf16* q_ = DQ + (size_t)(td0 + (dir ? NC - 1 - nn_ : nn_)) * 4096 + qlane * 8; \
        const bf16* vc_ = VC + ((size_t)(taskd_ * 2 + jw) * 2 * 64 + lane) * 16; \
        SL_RUN(rec_ + 6144, 8, 512, SL_FK); \
        SL_RUN(q_ + qo0, 4, 512, SL_FQ); SL_RUN(q_ + qo1, 4, 512, SL_FQ + 4096); \
        lds_dma16(vc_, lb_ + SL_VV); lds_dma16(vc_ + 8, lb_ + SL_VV + 1024); lds_dma16(vc_ + 1024, lb_ + SL_VV + 2048); lds_dma16(vc_ + 1032, lb_ + SL_VV + 3072); \
        lds_dma16((const float*)(a.ws + WS_SC) + (size_t)task_ * 320 + 128 + lane * 4, lb_ + SL_SC); \
        SL_RUN(rec_, 6, 512, SL_FT); SL_RUN(rec_ + 3072, 6, 512, SL_FM); \
        SL_RUN(KTs + (size_t)taskd_ * 4096 + lane * 8, 8, 512, SL_KT); } while (0)
    SL_ISSUE(0);
    for (int n = 0; n < NC; ++n) {
        asm volatile("s_waitcnt vmcnt(0) lgkmcnt(0)" ::: "memory");
        if (n + 1 < NC) SL_ISSUE(n + 1);
        const LAS unsigned char* B = L + (n & 1) * SL_BUF + lane * 16;
        const LAS unsigned char* Bs = L + (n & 1) * SL_BUF + SL_SC + hh * 16;
#define SLF(off, f) (*(const LAS bf16x8*)(B + (off) + (f) * 1024))
        bf16x8 fk[8], fq[8]; v4u vv[4]; f32x4 s2[8];
#pragma unroll
        for (int f = 0; f < 8; ++f) { fk[f] = SLF(SL_FK, f); fq[f] = SLF(SL_FQ, f); }
#pragma unroll
        for (int f = 0; f < 4; ++f) vv[f] = *(const LAS v4u*)(B + SL_VV + f * 1024);
#pragma unroll
        for (int g = 0; g < 8; ++g) s2[g] = *(const LAS f32x4*)(Bs + (8 * g) * 4);
        asm volatile("" ::: "memory");
        bf16x8 sb[2][2];
#pragma unroll
        for (int ib = 0; ib < 2; ++ib)
#pragma unroll
            for (int s = 0; s < 2; ++s) sb[ib][s] = pack_regs(S[ib], s);
        f32x16 X[2], o[2];
#pragma unroll
        for (int cb = 0; cb < 2; ++cb) {
            f32x16 ax, ao = {};
            { const v4u va = vv[2 * cb], vb_ = vv[2 * cb + 1];
              ax = (f32x16){bflo(va.x), bfhi(va.x), bflo(va.y), bfhi(va.y), bflo(va.z), bfhi(va.z), bflo(va.w), bfhi(va.w),
                            bflo(vb_.x), bfhi(vb_.x), bflo(vb_.y), bfhi(vb_.y), bflo(vb_.z), bfhi(vb_.z), bflo(vb_.w), bfhi(vb_.w)}; }
#pragma unroll
            for (int ib = 0; ib < 2; ++ib)
#pragma unroll
                for (int s = 0; s < 2; ++s) { ax = MFMA32(fk[4 * cb + 2 * ib + s], sb[ib][s], ax); ao = MFMA32(fq[4 * cb + 2 * ib + s], sb[ib][s], ao); }
            X[cb] = ax; o[cb] = ao;
        }
        bf16x8 ft[6], fm[6];
#pragma unroll
        for (int f = 0; f < 6; ++f) { ft[f] = SLF(SL_FT, f); fm[f] = SLF(SL_FM, f); }
        asm volatile("" ::: "memory");
#pragma unroll
        for (int cb = 0; cb < 2; ++cb)
#pragma unroll
            for (int g = 0; g < 4; ++g)
#pragma unroll
                for (int j = 0; j < 4; ++j) o[cb][4 * g + j] *= s2[4 * cb + g][j];
        f32x16 vn[2];
        {
            bf16x8 xb[2][2];
#pragma unroll
            for (int cb = 0; cb < 2; ++cb)
#pragma unroll
                for (int s = 0; s < 2; ++s) xb[cb][s] = pack_regs(X[cb], s);
            f32x16 a0 = {}, a1 = {};
            a0 = MFMA32(ft[0], xb[0][0], a0); a0 = MFMA32(ft[1], xb[0][1], a0);
            a1 = MFMA32(ft[2], xb[0][0], a1); a1 = MFMA32(ft[3], xb[0][1], a1); a1 = MFMA32(ft[4], xb[1][0], a1); a1 = MFMA32(ft[5], xb[1][1], a1);
            vn[0] = a0; vn[1] = a1;
        }
        bf16x8 fkt[8]; f32x4 s3[8];
#pragma unroll
        for (int f = 0; f < 8; ++f) fkt[f] = SLF(SL_KT, f);
#pragma unroll
        for (int g = 0; g < 8; ++g) s3[g] = *(const LAS f32x4*)(Bs + (64 + 8 * g) * 4);
        const float egl = *(const LAS float*)(L + (n & 1) * SL_BUF + SL_SC + 512);
        asm volatile("" ::: "memory");
        {
            bf16x8 vb[2][2];
#pragma unroll
            for (int cb = 0; cb < 2; ++cb)
#pragma unroll
                for (int s = 0; s < 2; ++s) vb[cb][s] = pack_regs(vn[cb], s);
            f32x16 a0 = o[0], a1 = o[1];
            a0 = MFMA32(fm[0], vb[0][0], a0); a0 = MFMA32(fm[1], vb[0][1], a0);
            a1 = MFMA32(fm[2], vb[0][0], a1); a1 = MFMA32(fm[3], vb[0][1], a1); a1 = MFMA32(fm[4], vb[1][0], a1); a1 = MFMA32(fm[5], vb[1][1], a1);
            bf16* oo = OUTO + (size_t)((td0 + n) * 2 + jw) * 2 * 16 * 64 + lane;
#pragma unroll
            for (int g = 0; g < 16; ++g) { oo[g * 64] = (bf16)f2bf(a0[g]); oo[(16 + g) * 64] = (bf16)f2bf(a1[g]); }
        }
        {
#pragma unroll
            for (int cb = 0; cb < 2; ++cb)
#pragma unroll
                for (int g = 0; g < 4; ++g)
#pragma unroll
                    for (int j = 0; j < 4; ++j) vn[cb][4 * g + j] *= s3[4 * cb + g][j];
            bf16x8 vb[2][2];
#pragma unroll
            for (int cb = 0; cb < 2; ++cb)
#pragma unroll
                for (int s = 0; s < 2; ++s) vb[cb][s] = pack_regs(vn[cb], s);
#pragma unroll
            for (int ib = 0; ib < 2; ++ib) { f32x16 acc = S[ib] * egl;
#pragma unroll
                for (int cb = 0; cb < 2; ++cb)
#pragma unroll
                    for (int s = 0; s < 2; ++s) acc = MFMA32(fkt[4 * ib + 2 * cb + s], vb[cb][s], acc);
                S[ib] = acc; }
        }
#undef SLF
    }
#undef SL_ISSUE
#undef SL_RUN
    asm volatile("s_waitcnt vmcnt(0) lgkmcnt(0)" ::: "memory");
}
__device__ __forceinline__ void phase_dn_scan(const Args& a, LAS unsigned char* lds, int vcu, int G) {
    const int tid = threadIdx.x, wave = __builtin_amdgcn_readfirstlane(tid >> 6);
    if (G == 256) {
        if (vcu < 128) {
#if !defined(SCAN_NO_LAT)
            if (wave == 0) { int lane = tid & 63; asm volatile("" : "+v"(lane)); dn_scan_lat(a, vcu, lane, lds); return; }
#else
            if (wave == 0) { int lane = tid & 63; asm volatile("" : "+v"(lane)); dn_scan_task(a, vcu, lane); return; }
#endif
            if (wave <= 3 || wave == 5) { const int k = wave <= 3 ? wave - 1 : 3; int lane = tid & 63; asm volatile("" : "+v"(lane)); dn_scan_task(a, 128 + vcu * 4 + k, lane); }
            return;
        }
        const int bx = blockIdx.x, c_ = (bx % 8 - 4) + 4 * (bx / 8);
        if (c_ < 64) return;
        { int lane = tid & 63; asm volatile("" : "+v"(lane)); dn_scan_task(a, 128 + 512 + (c_ - 64) * 8 + wave, lane); }
        return;
    }
    for (int t = wave * G + vcu; t < 1152; t += G * NWAVES) { int lane = tid & 63; asm volatile("" : "+v"(lane)); dn_scan_task(a, t, lane); }
}

__device__ __forceinline__ void phase_combine(const Args& a, int vcu, int G) {
    const int tid = threadIdx.x, lane = tid & 63, wave = tid >> 6;
    const int gw = vcu * NWAVES + wave, NGW = G * NWAVES;
    const bf16* OF = (const bf16*)a.out + (size_t)3 * MT * 512; const bf16* OB = (const bf16*)(a.ws + WS_W1);
    const bf16* P = (const bf16*)(a.ws + WS_PB); bf16* ODN = (bf16*)(a.ws + WS_ODN);
    const f32x4 n0 = *(const f32x4*)(a.in[I_DNN] + ((8 * lane) & 63)), n1 = *(const f32x4*)(a.in[I_DNN] + ((8 * lane) & 63) + 4);
    const int hd = lane >> 3, j0 = (8 * lane) & 63, jw = j0 >> 5, r0 = j0 & 31;
    for (int m = gw; m < MT; m += NGW) {
        int tt, T_, ch0;
        if (m < M_CTX) { const int b_ = m >> 8; tt = m & 255; T_ = 256; ch0 = 64 + ((b_ * 8 + hd) << 1); }
        else { const int rl = m - M_CTX; const int b_ = rl >> 10; tt = rl & 1023; T_ = 1024; ch0 = (b_ * 8 + hd) << 1; }
        v4u w[2];
#pragma unroll
        for (int dd = 0; dd < 2; ++dd) {
            const int u = dd ? T_ - 1 - tt : tt, c = u & 63;
            const int task = (m < M_CTX ? 512 + (ch0 >> 1) * 4 - 128 : (ch0 >> 1) * 16) + (u >> 6);
            const int cb = c >> 5, hh = (c >> 2) & 1, g = ((c >> 3) & 3) * 4 + (c & 3);
            w[dd] = *(const v4u*)((dd ? OB : OF) + ((size_t)((task * 2 + jw) * 2 + cb) * 16 + g) * 64 + hh * 32 + r0);
        }
        f32x4 o0 = {bflo(w[0].x) + bflo(w[1].x), bfhi(w[0].x) + bfhi(w[1].x), bflo(w[0].y) + bflo(w[1].y), bfhi(w[0].y) + bfhi(w[1].y)};
        f32x4 o1 = {bflo(w[0].z) + bflo(w[1].z), bfhi(w[0].z) + bfhi(w[1].z), bflo(w[0].w) + bflo(w[1].w), bfhi(w[0].w) + bfhi(w[1].w)};
        float ss = (o0.x * o0.x + o0.y * o0.y) + (o0.z * o0.z + o0.w * o0.w) + (o1.x * o1.x + o1.y * o1.y) + (o1.z * o1.z + o1.w * o1.w);
        ss += __shfl_xor(ss, 1); ss += __shfl_xor(ss, 2); ss += __shfl_xor(ss, 4);
        const float rstd = rsqrtf(ss * (1.f / 64.f) + 1e-6f);
        const v4u z = *(const v4u*)(P + (size_t)m * LDB_ + CB_Z + 8 * lane);
        o0 = o0 * rstd * n0; o1 = o1 * rstd * n1;
        v4u q; q.x = pk2(o0.x * silu_(bflo(z.x)), o0.y * silu_(bfhi(z.x))); q.y = pk2(o0.z * silu_(bflo(z.y)), o0.w * silu_(bfhi(z.y)));
        q.z = pk2(o1.x * silu_(bflo(z.z)), o1.y * silu_(bfhi(z.z))); q.w = pk2(o1.z * silu_(bflo(z.w)), o1.w * silu_(bfhi(z.w)));
        *(v4u*)(ODN + (size_t)m * 512 + 8 * lane) = q;
    }
}

__device__ __forceinline__ void phase_row1(const Args& a, int vcu, int G) {
    const int tid = threadIdx.x, lane = tid & 63, wave = tid >> 6;
    const int gw = vcu * NWAVES + wave, NGW = G * NWAVES;
    const float* MOD = (const float*)(a.ws + WS_MOD); const bf16* Y = (const bf16*)(a.ws + WS_ONA); const float* RSS = (const float*)(a.ws + WS_RSS1);
    bf16* XN = (bf16*)(a.ws + WS_XN);
    for (int m = gw; m < MT; m += NGW) {
        const f32x4* xr = (const f32x4*)x_row(a, m) + lane; const float* md = MOD + mod_idx(m) * 6144;
        float rs = 0.f;
        { const float rv = lane < 16 ? RSS[((size_t)(lane >> 2) * MT + m) * 4 + (lane & 3)] : 0.f;
          rs = rv; rs += __shfl_xor(rs, 1); rs += __shfl_xor(rs, 2); rs += __shfl_xor(rs, 4); rs += __shfl_xor(rs, 8); rs = __shfl(rs, 0); }
        const float rstd1 = rsqrtf(rs * (1.f / DM) + 1e-6f);
        f32x4 x1[4]; float s = 0.f;
        const v2u* yr = (const v2u*)(Y + (size_t)m * DM) + lane;
        v2u* x1b = (v2u*)((bf16*)(a.ws + WS_M1) + (size_t)m * DM) + lane;
#pragma unroll
        for (int j = 0; j < 4; ++j) { const int c = (lane + 64 * j) * 4; const v2u yy = yr[64 * j];
            const f32x4 yv = {bflo(yy.x), bfhi(yy.x), bflo(yy.y), bfhi(yy.y)};
            const f32x4 g1 = *(const f32x4*)(md + 2048 + c), pw = *(const f32x4*)(a.in[I_POST1] + c);
            x1[j] = xr[64 * j] + g1 * (yv * rstd1 * pw); { v2u o1; o1.x = pk2(x1[j].x, x1[j].y); o1.y = pk2(x1[j].z, x1[j].w); x1b[64 * j] = o1; }
            s += (x1[j].x * x1[j].x + x1[j].y * x1[j].y) + (x1[j].z * x1[j].z + x1[j].w * x1[j].w); }
        const float rstd2 = rsqrtf(wave_sum(s) * (1.f / DM) + 1e-6f);
        v2u* o8 = (v2u*)(XN + (size_t)m * DM) + lane;
#pragma unroll
        for (int j = 0; j < 4; ++j) { const int c = (lane + 64 * j) * 4;
            const f32x4 w = *(const f32x4*)(a.in[I_PRE2] + c), sh = *(const f32x4*)(md + 3072 + c), sc = *(const f32x4*)(md + 4096 + c);
            const f32x4 h = x1[j] * rstd2 * w * (sc + 1.0f) + sh;
            v2u o; o.x = pk2(h.x, h.y); o.y = pk2(h.z, h.w); o8[64 * j] = o; }
    }
}
__device__ __forceinline__ void phase_row2(const Args& a, int vcu, int G) {
    const int tid = threadIdx.x, lane = tid & 63, wave = tid >> 6;
    const int gw = vcu * NWAVES + wave, NGW = G * NWAVES;
    const float* MOD = (const float*)(a.ws + WS_MOD); const bf16* Fm = (const bf16*)(a.ws + WS_ONA); const bf16* Fe = (const bf16*)(a.ws + WS_XN); const bf16* X1 = (const bf16*)(a.ws + WS_M1);
    for (int m = gw; m < MT; m += NGW) {
        const float* md = MOD + mod_idx(m) * 6144;
        const v2u* fr = (const v2u*)(Fm + (size_t)m * DM) + lane; const v2u* fe = (const v2u*)(Fe + (size_t)m * DM) + lane;
        f32x4* orow = (f32x4*)(a.out + (size_t)m * DM) + lane;
        f32x4 fv[4], x1[4]; float s = 0.f;
#pragma unroll
        for (int j = 0; j < 4; ++j) { const v2u p = fr[64 * j], q = fe[64 * j]; { const v2u xx = ((const v2u*)(X1 + (size_t)m * DM) + lane)[64 * j]; x1[j] = (f32x4){bflo(xx.x), bfhi(xx.x), bflo(xx.y), bfhi(xx.y)}; }
            fv[j] = (f32x4){bflo(p.x) + bflo(q.x), bfhi(p.x) + bfhi(q.x), bflo(p.y) + bflo(q.y), bfhi(p.y) + bfhi(q.y)};
            s += (fv[j].x * fv[j].x + fv[j].y * fv[j].y) + (fv[j].z * fv[j].z + fv[j].w * fv[j].w); }
        const float rstd = rsqrtf(wave_sum(s) * (1.f / DM) + 1e-6f);
#pragma unroll
        for (int j = 0; j < 4; ++j) { const int c = (lane + 64 * j) * 4;
            const f32x4 g2 = *(const f32x4*)(md + 5120 + c), pw = *(const f32x4*)(a.in[I_POST2] + c);
            orow[64 * j] = x1[j] + g2 * (fv[j] * rstd * pw); }
    }
}

constexpr int N_PHASES = 13;
__global__ void __launch_bounds__(NWAVES * 64, 2) fwd_kernel(Args args) {
    extern __shared__ __attribute__((aligned(16))) unsigned char lds_raw[];
    LAS unsigned char* lds = (LAS unsigned char*)lds_raw;
    const int tid = threadIdx.x;
    const int G = gridDim.x; const int bx = blockIdx.x; const int vcu = (G % 8 == 0) ? (bx % 8) * (G / 8) + bx / 8 : bx;
    volatile LAS unsigned* MISC = (volatile LAS unsigned*)(lds + MISC_OFF);
    for (int u = tid; u < (LDS_BYTES - LDSCTL_OFF) / 4; u += NWAVES * 64) ((LAS unsigned*)(lds + LDSCTL_OFF))[u] = 0u;
    __syncthreads();
    const int lo = args.ph_lo, hi = args.ph_hi;
    const bool one = (hi - lo) > 1;
    unsigned* ctl = (unsigned*)(args.ws + WS_CTL);
    XcdBarrier bar; bar.bar = ctl + CW_BAR; bar.x = 0; bar.st = nullptr;
    if (one) bar = xcd_barrier_post(ctl + CW_BAR, MISC + 8);
#ifndef ONLY_PHASE
#define ONLY_PHASE -1
#endif
#ifndef SKIP_MASK
#define SKIP_MASK 0
#endif
#define IN(k) ((ONLY_PHASE < 0 || ONLY_PHASE == (k)) && !((SKIP_MASK >> (k)) & 1) && lo <= (k) && (k) < hi)
#ifdef TP_A
#define TSTAMP(s) do { if (tid == 0) MISC[32 + (s)] = (unsigned)__builtin_amdgcn_s_memrealtime(); } while (0)
#else
#define TSTAMP(s) do { } while (0)
#endif
#define SEAM(k) do { if (one) xcd_barrier(bar); TSTAMP((k) + 1); } while (0)
    TSTAMP(0);
    unsigned char* ws = args.ws;
    typedef pg8::bf16_t pb;

#ifndef REPEAT_MASK
#define REPEAT_MASK 0
#endif
#define REP(k) ((REPEAT_MASK >> (k)) & 1)
#define PH_INPROJ do { pg8::Gemm g{(const pb*)(ws + WS_XN), (const pb*)(ws + WS_WIN), MT, NINP, 1024}; pg8::InProjOrder S; S.init(MT, NINP, G, bx); S.flags = (unsigned*)(ws + WS_CTL) + CW_TF; \
        pg8::EpiInProj E{(pb*)(ws + WS_PA), (pb*)(ws + WS_PB), (pb*)(ws + WS_M1), args.out + OUT_K, args.out + OUT_V, (float*)(ws + WS_BA), (pb*)args.out + (size_t)3 * MT * 512, (const float*)(ws + WS_ROPE)}; \
        pg8::gemm_phase<pg8::EpiInProj, pg8::InProjOrder, true, true>(lds, g, S, E); } while (0)
#define PH_GATE1(G_, c_, maxi_) do { pg8::LimitOrder S; S.init(MT, 1024, (G_), (c_)); S.maxi = (maxi_); \
        pg8::Gemm g{(const pb*)(ws + WS_ONA), (const pb*)(ws + WS_WAO), MT, 1024, 512}; pg8::EpiGate1 E{(const pb*)(ws + WS_PB), (pb*)(ws + WS_M1)}; \
        pg8::gemm_phase<pg8::EpiGate1, pg8::LimitOrder, true, true>(lds, g, S, E); } while (0)
#define PH_SCAN do { phase_dn_scan(args, lds, vcu, G); \
        if (G == 256) { if (vcu >= 128) { __syncthreads(); PH_GATE1(128, (bx % 8 - 4) + 4 * (bx / 8), 2); } } } while (0)
#define PH_MERGE do { pg8::StaticOrder S; S.init(MT, 1024, G, bx); \
        if (bx >= 192) late_transposes(args, lds, bx - 192, G - 192); else if (G <= 192 && bx == 0) late_transposes(args, lds, 0, 1); \
        if (G != 256) PH_GATE1(G, bx, 1 << 20);     \
        { pg8::Gemm g{(const pb*)(ws + WS_ODN), (const pb*)(ws + WS_WDO), MT, 1024, 512}; pg8::EpiGate2 E{(const pb*)(ws + WS_PB), (const pb*)(ws + WS_M1), (pb*)(ws + WS_XN)}; \
          pg8::gemm_phase<pg8::EpiGate2, pg8::StaticOrder, true, true>(lds, g, S, E); } } while (0)
#define PH_WOUT do { pg8::Gemm g{(const pb*)(ws + WS_XN), (const pb*)(ws + WS_WOUT), MT, 1024, 1024}; pg8::StaticOrder S; S.init(MT, 1024, G, bx); \
        pg8::EpiRss E{(pb*)(ws + WS_ONA), (float*)(ws + WS_RSS1)}; pg8::gemm_phase<pg8::EpiRss, pg8::StaticOrder, true, true>(lds, g, S, E); } while (0)
#define PH_FF1 do { pg8::Gemm g{(const pb*)(ws + WS_XN), (const pb*)(ws + WS_W1), MT, FF, 1024}; pg8::StaticOrder S; S.init(MT, FF, G, bx); \
        pg8::EpiRelu2 E{(pb*)(ws + WS_PA)}; pg8::gemm_phase<pg8::EpiRelu2, pg8::StaticOrder, true, true>(lds, g, S, E); } while (0)
#define PH_FF2 do { pg8::Gemm g{(const pb*)(ws + WS_PA), (const pb*)(ws + WS_W2), MT, 1024, FF}; pg8::SplitOrder S{vcu, 48, 16}; \
        pg8::EpiSplit E{(pb*)(ws + WS_ONA), (pb*)(ws + WS_XN)}; pg8::gemm_phase<pg8::EpiSplit, pg8::SplitOrder, true, true>(lds, g, S, E); } while (0)
#define RUN(k, body) do { if (IN(k)) { body; SEAM(k); if (REP(k)) { body; SEAM(k); } } } while (0)
    RUN(0, { phase_prologue(args, lds, vcu, G); phase_xn(args, vcu, G); TSTAMP(23); });
#ifdef EXP_BAR
    RUN(2, { PH_INPROJ; xcd_barrier(bar); phase_conv(args, lds, vcu, G); });
#else
    RUN(2, { PH_INPROJ; phase_conv(args, lds, vcu, G); });
#endif
    RUN(4, phase_attn_pre(args, lds, vcu, G));
#if defined(PROBE_GATE1_ONLY)
    if (IN(5)) { PH_SCAN; SEAM(5); if (vcu >= 128) { PH_GATE1(128, (bx % 8 - 4) + 4 * (bx / 8), 2); } SEAM(5); }
#elif defined(PROBE_SCAN_ONLY)
    if (IN(5)) { PH_SCAN; SEAM(5); phase_dn_scan(args, lds, vcu, G); SEAM(5); }
#else
    RUN(5, PH_SCAN);
#endif
    RUN(6, phase_combine(args, vcu, G));
    RUN(7, PH_MERGE);
    RUN(8, PH_WOUT);
    RUN(9, phase_row1(args, vcu, G));
    RUN(10, PH_FF1);
    RUN(11, PH_FF2);
    if (IN(12)) { phase_row2(args, vcu, G); }
#ifdef TP_A
    TSTAMP(13);
    if (bx == 0 && tid == 0) {
        const unsigned dt = (MISC[32 + TP_B] - MISC[32 + TP_A]) * TP_MUL; const unsigned t0 = (unsigned)__builtin_amdgcn_s_memrealtime();
        while ((unsigned)__builtin_amdgcn_s_memrealtime() - t0 < dt) __builtin_amdgcn_s_sleep(8); }
#endif
#ifdef EXTRA_BARS
    for (int i = 0; i < EXTRA_BARS; ++i) xcd_barrier(bar);
#endif

#undef IN
#undef SEAM
}

#ifndef MK_ONE_LAUNCH
#define MK_ONE_LAUNCH 1
#endif
extern "C" void kernel_launch(void* const* d_in, const int* in_sizes, int n_in, void* d_out, int out_size, void* d_ws, size_t ws_size, hipStream_t stream) {
    static int grid = 0;
    if (grid == 0) {
        if (n_in != 24 || ws_size < WS_END) { fprintf(stderr, "kernel_launch: unexpected n_in %d / ws %zu\n", n_in, ws_size); grid = -1; return; }
        int dev = 0, cus = 0;
        if (hipGetDevice(&dev) != hipSuccess || hipDeviceGetAttribute(&cus, hipDeviceAttributeMultiprocessorCount, dev) != hipSuccess) { grid = -1; return; }
        if (hipFuncSetAttribute((const void*)fwd_kernel, hipFuncAttributeMaxDynamicSharedMemorySize, LDS_BYTES) != hipSuccess) { fprintf(stderr, "kernel_launch: hipFuncSetAttribute failed\n"); grid = -1; return; }
        int per_cu = 0;
        if (hipOccupancyMaxActiveBlocksPerMultiprocessor(&per_cu, (const void*)fwd_kernel, NWAVES * 64, LDS_BYTES) != hipSuccess || per_cu < 1) fprintf(stderr, "kernel_launch: occupancy query says %d\n", per_cu);
        (void)hipGetLastError();
        grid = cus;
    }
    if (grid < 0) return;
    (void)hipMemsetAsync((char*)d_ws + WS_CTL, 0, CTL_ZERO_BYTES, stream);
    Args a{};
    for (int i = 0; i < 24; ++i) a.in[i] = (const float*)d_in[i];
    a.out = (float*)d_out; a.ws = (unsigned char*)d_ws;
#if MK_ONE_LAUNCH
    a.ph_lo = 0; a.ph_hi = N_PHASES;
    hipLaunchKernelGGL(fwd_kernel, dim3(grid), dim3(NWAVES * 64), LDS_BYTES, stream, a);
#else
    for (int p = 0; p < N_PHASES; ++p) { a.ph_lo = p; a.ph_hi = p + 1; hipLaunchKernelGGL(fwd_kernel, dim3(grid), dim3(NWAVES * 64), LDS_BYTES, stream, a); }
#endif
}
```

```cpp
#include <hip/hip_runtime.h>
#include <cstdio>
#include <cstdint>

constexpr int DM = 1024, M_CTX = 8192, M_LAT = 4096, MT = 12288, NIN = 5664, NINP = 5888, FF = 4096;
constexpr int LDA_ = 1536, LDB_ = 512;
__host__ __device__ constexpr int win_dst(int n0) {
    return n0 < 3072 ? n0 : n0 < 3104 ? 5632 : n0 < 3616 ? n0 - 32 : n0 < 4640 ? 3584 + 256 * ((n0 - 3616) / 128) + (n0 - 3616) % 128 : 3584 + 256 * ((n0 - 4640) / 128) + 128 + (n0 - 4640) % 128; }
__device__ __forceinline__ size_t gate_frag(int pm, int pn_m, int wr, int wc, int piece, int lane) { return (((((size_t)(pm * 4 + pn_m) * 8 + (wr * 4 + wc)) * 16 + piece) * 64) + lane) * 8; }
__host__ __device__ constexpr int inproj_flag(int pn) { return (pn >= 6 && pn <= 11) ? pn - 6 : pn == 22 ? 6 : -1; }
constexpr int C_Q = 0, C_K = 512, C_V = 1024, C_DN = 0, CB_Z = 0, CB_GA = 544, CB_GD = 1568;

namespace pg8 {
#define PG8_LAS __attribute__((address_space(3)))
typedef unsigned short bf16_t;
typedef short bf16x8 __attribute__((ext_vector_type(8)));
typedef float f32x4 __attribute__((ext_vector_type(4)));
typedef unsigned u32x4 __attribute__((ext_vector_type(4)));
typedef unsigned u32x2 __attribute__((ext_vector_type(2)));
constexpr int BM = 256, BK = 64, HALF = 128, HTB = HALF * BK * 2  , STAGE_BYTES = 8 * HTB, NXCD = 8, WGM = 8;

__host__ __device__ __forceinline__ int lds_byte(int r, int c) { const int st = (r >> 4) * 2 + (c >> 5), rr = r & 15, cc = c & 31, ob = rr * 64 + cc * 2; return st * 1024 + (ob ^ (((ob >> 9) & 1) << 5)); }
__host__ __device__ __forceinline__ void stage_rc(int b, int& R, int& C) { const int st = b / 1024, sb = b % 1024, swz = sb ^ (((sb >> 9) & 1) << 5); R = (st >> 1) * 16 + swz / 64; C = (st & 1) * 32 + (swz % 64) / 2; }
__host__ __device__ __forceinline__ int perm32(int rho) { const int n = rho >> 4, i = rho & 15; return 8 * (i >> 2) + 4 * n + (i & 3); }

struct Unit { int pm, pn; int k0 = 0, nt = 0; };
struct Gemm { const bf16_t* A; const bf16_t* Bt; int M, N, K; };

struct StaticOrder {
    int nM, nN, nwg, G, c;
    __host__ __device__ void init(int M, int N, int G_, int c_) { nM = M / BM; nN = N / BM; nwg = nM * nN; G = G_; c = c_; }
    __host__ __device__ bool next(int i, Unit& u) const {
        const long L = (long)i * G + c; if (L >= nwg) return false;
        int wgid = (int)L; { const int q = nwg / NXCD, r = nwg % NXCD, xcd = wgid % NXCD, off = wgid / NXCD; wgid = (xcd < r ? xcd * (q + 1) : r * (q + 1) + (xcd - r) * q) + off; }
        const int nig = WGM * nN, gid = wgid / nig, fm = gid * WGM, gsz = (nM - fm) < WGM ? (nM - fm) : WGM;
        u.pm = fm + ((wgid % nig) % gsz); u.pn = (wgid % nig) / gsz; return true;
    }
    __device__ __forceinline__ void a_ready(const Unit&) const {}
    __device__ __forceinline__ void done(const Unit&) const {}
};

struct InProjOrder : StaticOrder { unsigned* flags;
    __device__ __forceinline__ void done(const Unit& u) const {
        const int fi = inproj_flag(u.pn);
        if (fi >= 0) { asm volatile("s_waitcnt vmcnt(0)" ::: "memory");
            if ((threadIdx.x & 63) == 0) __hip_atomic_fetch_add(flags + u.pm * 8 + fi, 1u, __ATOMIC_RELAXED, __HIP_MEMORY_SCOPE_AGENT); } } };

struct PanelOrder : StaticOrder { unsigned* cnt;
    __device__ __forceinline__ void done(const Unit& u) const {
        asm volatile("s_waitcnt vmcnt(0)" ::: "memory");
        if ((threadIdx.x & 63) == 0) __hip_atomic_fetch_add(cnt + 64 * u.pm, 1u, __ATOMIC_RELAXED, __HIP_MEMORY_SCOPE_AGENT); } };

struct LimitOrder : StaticOrder { int maxi;
    __device__ __forceinline__ bool next(int i, Unit& u) const { if (i >= maxi) return false; return StaticOrder::next(i, u); } };

__device__ __forceinline__ unsigned cvt_pk_bf16(float lo, float hi) { unsigned r; asm volatile("v_cvt_pk_bf16_f32 %0, %1, %2" : "=v"(r) : "v"(lo), "v"(hi)); return r; }
__device__ __forceinline__ float bf_lo(unsigned w) { return __uint_as_float(w << 16); }
__device__ __forceinline__ float bf_hi(unsigned w) { return __uint_as_float(w & 0xffff0000u); }
__device__ __forceinline__ float sigmoidf_(float x) { return __builtin_amdgcn_rcpf(1.0f + __expf(-x)); }
__device__ __forceinline__ u32x4 pack8(const f32x4& v0, const f32x4& v1) { u32x4 w; w.x = cvt_pk_bf16(v0[0], v0[1]); w.y = cvt_pk_bf16(v0[2], v0[3]); w.z = cvt_pk_bf16(v1[0], v1[1]); w.w = cvt_pk_bf16(v1[2], v1[3]); return w; }


__device__ __forceinline__ void store16_wt(void* p, u32x4 v) { asm volatile("global_store_dwordx4 %0, %1, off sc1\n\ts_nop 2" :: "v"(p), "v"(v) : "memory"); }
struct EpiInProj {
    static constexpr bool PERM = true, AFTER_DRAIN = false, HAS_MID = false;
    bf16_t* PA; bf16_t* PB; bf16_t* QK; float* ko; float* vo; float* BA; bf16_t* VT; const float* rope; bf16_t* RF; bf16_t* SF;
    __device__ __forceinline__ void operator()(const f32x4 (&acc)[2][2][4][2], const Unit& u, int wr, int wc, int fr, int fq) const {
        const int pn = u.pn, pm = u.pm;
        const bool lat = pm >= 32;
        const bool do_rope = lat && pn < 4;
        const bool do_kv = (!lat) && pn >= 2 && pn < 6;
        const bool do_vt = pn == 4 || pn == 5;
        const bool do_ba = pn == 22 && wc == 0;
        const bool do_gate = pn >= 14 && pn < 22;
        const int lane_hi = fq >> 1;
#pragma unroll
        for (int ai = 0; ai < 2; ++ai)
#pragma unroll
            for (int m = 0; m < 4; ++m) {
                const int row = pm * BM + ai * HALF + wr * 64 + m * 16 + fr;
                if (do_gate) {
                    const int j = pn - 14;
                    const f32x4 a0 = acc[ai][0][m][0], a1 = acc[ai][0][m][1], d0 = acc[ai][1][m][0], d1 = acc[ai][1][m][1];
                    f32x4 r0, r1, s0, s1;
#pragma unroll
                    for (int i = 0; i < 4; ++i) { const float ea0 = 1.0f + __expf(-a0[i]), ed0 = 1.0f + __expf(-fmaxf(d0[i], -80.f)), ea1 = 1.0f + __expf(-a1[i]), ed1 = 1.0f + __expf(-fmaxf(d1[i], -80.f));
                        s0[i] = __builtin_amdgcn_rcpf(ed0); r0[i] = ed0 * __builtin_amdgcn_rcpf(ea0); s1[i] = __builtin_amdgcn_rcpf(ed1); r1[i] = ed1 * __builtin_amdgcn_rcpf(ea1); }
                    const size_t go = gate_frag(pm, j >> 1, wr, wc, ai * 8 + m * 2 + (j & 1), fq * 16 + fr);
                    *(u32x4*)(RF + go) = pack8(r0, r1); *(u32x4*)(SF + go) = pack8(s0, s1);
                    continue;
                }
#pragma unroll
                for (int bj = 0; bj < 2; ++bj) {
                    f32x4 v0 = acc[ai][bj][m][0], v1 = acc[ai][bj][m][1];
                    const int col = pn * BM + bj * HALF + wc * 32 + 8 * fq;
                    if (do_rope) {
                        const int t = (row - M_CTX) & 1023;
                        const int pos = (wc & 1) ? (t & 63) : (t >> 6);
                        const float* cp = rope + pos * 16 + 8 * (fq & 1);
                        const f32x4 c0 = *(const f32x4*)cp, c1 = *(const f32x4*)(cp + 4), s0 = *(const f32x4*)(cp + 1024), s1 = *(const f32x4*)(cp + 1028);
                        f32x4 p0, p1;
#pragma unroll
                        for (int i = 0; i < 4; ++i) { p0[i] = __shfl_xor(v0[i], 32); p1[i] = __shfl_xor(v1[i], 32); }
                        if (lane_hi) { v0 = p0 * s0 + v0 * c0; v1 = p1 * s1 + v1 * c1; }
                        else         { v0 = v0 * c0 - p0 * s0; v1 = v1 * c1 - p1 * s1; }
                    }
                    if (pn < 4) *(u32x4*)(QK + (pn >= 2 ? (size_t)MT * 512 : 0) + (size_t)row * 512 + (col & 511)) = pack8(v0, v1);
                    else if (pn >= 6 && pn < 12) store16_wt(PA + (size_t)row * LDA_ + (col - 1536), pack8(v0, v1));
                    else if (pn == 12 || pn == 13) *(u32x4*)(PB + (size_t)row * LDB_ + (col - 3072)) = pack8(v0, v1);
                    if (do_kv) {
                        const int hh = ((pn & 1) * 4) + bj * 2 + (wc >> 1);
                        const int d = (wc & 1) * 32 + 8 * fq;
                        float* dst = (pn < 4 ? ko : vo) + ((size_t)(pm * 8 + hh) * 256 + (row & 255)) * 64 + d;
                        *(f32x4*)dst = v0; *(f32x4*)(dst + 4) = v1;
                    }
#ifndef VT_REP
#define VT_REP 1
#endif
                    if (do_vt) for (int vtr = 0; vtr < VT_REP; ++vtr) {
                        const int hh = ((pn & 1) * 4) + bj * 2 + (wc >> 1);
                        const int d = (wc & 1) * 32 + 8 * fq;
                        size_t base; int t, T;
                        if (!lat) { t = row & 255; T = 256; base = (size_t)(pm * 8 + hh) * 64 * 256; }
                        else { const int rl = row - M_CTX; t = rl & 1023; T = 1024; base = (size_t)M_CTX * 512 + (size_t)((rl >> 10) * 8 + hh) * 64 * 1024; }
                        const int pos = (t & ~12) | ((t & 4) << 1) | ((t & 8) >> 1);
                        bf16_t* dst = VT + base + (size_t)d * T + pos;
                        const u32x4 w = pack8(v0, v1);
                        dst[0] = (bf16_t)(w.x & 0xffff); dst[(size_t)T] = (bf16_t)(w.x >> 16); dst[(size_t)2 * T] = (bf16_t)(w.y & 0xffff); dst[(size_t)3 * T] = (bf16_t)(w.y >> 16);
                        dst[(size_t)4 * T] = (bf16_t)(w.z & 0xffff); dst[(size_t)5 * T] = (bf16_t)(w.z >> 16); dst[(size_t)6 * T] = (bf16_t)(w.w & 0xffff); dst[(size_t)7 * T] = (bf16_t)(w.w >> 16);
                    }
                    if (do_ba && bj == 0) { float* dst = BA + (size_t)row * 32 + 8 * fq; store16_wt(dst, __builtin_bit_cast(u32x4, v0)); store16_wt(dst + 4, __builtin_bit_cast(u32x4, v1)); }
                }
            }
    }
};

struct EpiGate1 {
    static constexpr bool PERM = true, AFTER_DRAIN = false, HAS_MID = false;
    const bf16_t* P; bf16_t* M1;
    __device__ __forceinline__ void operator()(const f32x4 (&acc)[2][2][4][2], const Unit& u, int wr, int wc, int fr, int fq) const {
        u32x4 g[2][4][2];
#pragma unroll
        for (int ai = 0; ai < 2; ++ai)
#pragma unroll
            for (int m = 0; m < 4; ++m)
#pragma unroll
                for (int bj = 0; bj < 2; ++bj) { const int row = u.pm * BM + ai * HALF + wr * 64 + m * 16 + fr, col = u.pn * BM + bj * HALF + wc * 32 + 8 * fq;
                    g[ai][m][bj] = *(const u32x4*)(P + (size_t)row * LDB_ + CB_GA + col); }
        asm volatile("" ::: "memory");
#pragma unroll
        for (int ai = 0; ai < 2; ++ai)
#pragma unroll
            for (int m = 0; m < 4; ++m) {
                const int row = u.pm * BM + ai * HALF + wr * 64 + m * 16 + fr;
#pragma unroll
                for (int bj = 0; bj < 2; ++bj) {
                    const int col = u.pn * BM + bj * HALF + wc * 32 + 8 * fq;
                    const u32x4 gg = g[ai][m][bj];
                    f32x4 v0 = acc[ai][bj][m][0], v1 = acc[ai][bj][m][1];
                    v0[0] *= sigmoidf_(bf_lo(gg.x)); v0[1] *= sigmoidf_(bf_hi(gg.x)); v0[2] *= sigmoidf_(bf_lo(gg.y)); v0[3] *= sigmoidf_(bf_hi(gg.y));
                    v1[0] *= sigmoidf_(bf_lo(gg.z)); v1[1] *= sigmoidf_(bf_hi(gg.z)); v1[2] *= sigmoidf_(bf_lo(gg.w)); v1[3] *= sigmoidf_(bf_hi(gg.w));
                    *(u32x4*)(M1 + (size_t)row * DM + col) = pack8(v0, v1);
                }
            }
    }
};
struct EpiGate2 {
    static constexpr bool PERM = true, AFTER_DRAIN = false, HAS_MID = false;
    const bf16_t* P; const bf16_t* M1; bf16_t* O;
    __device__ __forceinline__ void operator()(const f32x4 (&acc)[2][2][4][2], const Unit& u, int wr, int wc, int fr, int fq) const {
#pragma unroll
        for (int ai = 0; ai < 2; ++ai) {
            u32x4 g[4][2], q[4][2];
#pragma unroll
            for (int m = 0; m < 4; ++m)
#pragma unroll
                for (int bj = 0; bj < 2; ++bj) { const int row = u.pm * BM + ai * HALF + wr * 64 + m * 16 + fr, col = u.pn * BM + bj * HALF + wc * 32 + 8 * fq;
                    g[m][bj] = *(const u32x4*)(P + (size_t)row * LDB_ + CB_GD + col); q[m][bj] = *(const u32x4*)(M1 + (size_t)row * DM + col); }
            asm volatile("" ::: "memory");
#pragma unroll
            for (int m = 0; m < 4; ++m) {
                const int row = u.pm * BM + ai * HALF + wr * 64 + m * 16 + fr;
#pragma unroll
                for (int bj = 0; bj < 2; ++bj) {
                    const int col = u.pn * BM + bj * HALF + wc * 32 + 8 * fq;
                    const u32x4 gg = g[m][bj], qq = q[m][bj];
                    f32x4 v0 = acc[ai][bj][m][0], v1 = acc[ai][bj][m][1];
                    v0[0] = bf_lo(qq.x) + v0[0] * sigmoidf_(bf_lo(gg.x)); v0[1] = bf_hi(qq.x) + v0[1] * sigmoidf_(bf_hi(gg.x)); v0[2] = bf_lo(qq.y) + v0[2] * sigmoidf_(bf_lo(gg.y)); v0[3] = bf_hi(qq.y) + v0[3] * sigmoidf_(bf_hi(gg.y));
                    v1[0] = bf_lo(qq.z) + v1[0] * sigmoidf_(bf_lo(gg.z)); v1[1] = bf_hi(qq.z) + v1[1] * sigmoidf_(bf_hi(gg.z)); v1[2] = bf_lo(qq.w) + v1[2] * sigmoidf_(bf_lo(gg.w)); v1[3] = bf_hi(qq.w) + v1[3] * sigmoidf_(bf_hi(gg.w));
                    *(u32x4*)(O + (size_t)row * DM + col) = pack8(v0, v1);
                }
            }
        }
    }
};
struct EpiMerge {
    static constexpr bool PERM = true, AFTER_DRAIN = false, HAS_MID = true;
    static constexpr int MID_T = 8;
    const bf16_t* RF; const bf16_t* SF; bf16_t* O;
    __device__ __forceinline__ void mid(f32x4 (&acc)[2][2][4][2], const Unit& u, int wr, int wc, int fr, int fq) const {
        const bf16_t* rp = RF + gate_frag(u.pm, u.pn, wr, wc, 0, fq * 16 + fr);
#pragma unroll
        for (int ai = 0; ai < 2; ++ai) {
            u32x4 g[4][2];
#pragma unroll
            for (int m = 0; m < 4; ++m)
#pragma unroll
                for (int bj = 0; bj < 2; ++bj) g[m][bj] = *(const u32x4*)(rp + (size_t)(ai * 8 + m * 2 + bj) * 512);
            asm volatile("" ::: "memory");
#pragma unroll
            for (int m = 0; m < 4; ++m)
#pragma unroll
                for (int bj = 0; bj < 2; ++bj) { const u32x4 x = g[m][bj]; f32x4& v0 = acc[ai][bj][m][0]; f32x4& v1 = acc[ai][bj][m][1];
                    v0[0] *= bf_lo(x.x); v0[1] *= bf_hi(x.x); v0[2] *= bf_lo(x.y); v0[3] *= bf_hi(x.y); v1[0] *= bf_lo(x.z); v1[1] *= bf_hi(x.z); v1[2] *= bf_lo(x.w); v1[3] *= bf_hi(x.w); }
        }
    }
    __device__ __forceinline__ void operator()(const f32x4 (&acc)[2][2][4][2], const Unit& u, int wr, int wc, int fr, int fq) const {
        const bf16_t* sp = SF + gate_frag(u.pm, u.pn, wr, wc, 0, fq * 16 + fr);
#pragma unroll
        for (int ai = 0; ai < 2; ++ai) {
            u32x4 g[4][2];
#pragma unroll
            for (int m = 0; m < 4; ++m)
#pragma unroll
                for (int bj = 0; bj < 2; ++bj) g[m][bj] = *(const u32x4*)(sp + (size_t)(ai * 8 + m * 2 + bj) * 512);
            asm volatile("" ::: "memory");
#pragma unroll
            for (int m = 0; m < 4; ++m) {
                const int row = u.pm * BM + ai * HALF + wr * 64 + m * 16 + fr;
#pragma unroll
                for (int bj = 0; bj < 2; ++bj) { const int col = u.pn * BM + bj * HALF + wc * 32 + 8 * fq; const u32x4 x = g[m][bj];
                    f32x4 v0 = acc[ai][bj][m][0], v1 = acc[ai][bj][m][1];
                    v0[0] *= bf_lo(x.x); v0[1] *= bf_hi(x.x); v0[2] *= bf_lo(x.y); v0[3] *= bf_hi(x.y); v1[0] *= bf_lo(x.z); v1[1] *= bf_hi(x.z); v1[2] *= bf_lo(x.w); v1[3] *= bf_hi(x.w);
                    store16_wt(O + (size_t)row * DM + col, pack8(v0, v1)); }
            }
        }
    }
};
struct EpiRss {
    static constexpr bool PERM = true, AFTER_DRAIN = false, HAS_MID = false;
    bf16_t* O; float* RSS;
    __device__ __forceinline__ void operator()(const f32x4 (&acc)[2][2][4][2], const Unit& u, int wr, int wc, int fr, int fq) const {
#pragma unroll
        for (int ai = 0; ai < 2; ++ai)
#pragma unroll
            for (int m = 0; m < 4; ++m) {
                const int row = u.pm * BM + ai * HALF + wr * 64 + m * 16 + fr;
                float s = 0.f;
#pragma unroll
                for (int bj = 0; bj < 2; ++bj) {
                    const int col = u.pn * BM + bj * HALF + wc * 32 + 8 * fq;
                    const f32x4 v0 = acc[ai][bj][m][0], v1 = acc[ai][bj][m][1];
                    s += (v0[0] * v0[0] + v0[1] * v0[1]) + (v0[2] * v0[2] + v0[3] * v0[3]) + (v1[0] * v1[0] + v1[1] * v1[1]) + (v1[2] * v1[2] + v1[3] * v1[3]);
                    *(u32x4*)(O + (size_t)row * DM + col) = pack8(v0, v1);
                }
                s += __shfl_xor(s, 16); s += __shfl_xor(s, 32);
                if (fq == 0) RSS[((size_t)u.pn * MT + row) * 4 + wc] = s;
            }
    }
};
struct EpiRelu2 {
    static constexpr bool PERM = true, AFTER_DRAIN = false, HAS_MID = false;
    bf16_t* O;
    __device__ __forceinline__ void operator()(const f32x4 (&acc)[2][2][4][2], const Unit& u, int wr, int wc, int fr, int fq) const {
#pragma unroll
        for (int ai = 0; ai < 2; ++ai)
#pragma unroll
            for (int m = 0; m < 4; ++m) {
                const int row = u.pm * BM + ai * HALF + wr * 64 + m * 16 + fr;
#pragma unroll
                for (int bj = 0; bj < 2; ++bj) {
                    const int col = u.pn * BM + bj * HALF + wc * 32 + 8 * fq;
                    f32x4 v0 = acc[ai][bj][m][0], v1 = acc[ai][bj][m][1];
#pragma unroll
                    for (int i = 0; i < 4; ++i) { const float a = fmaxf(v0[i], 0.f), b = fmaxf(v1[i], 0.f); v0[i] = a * a; v1[i] = b * b; }
                    store16_wt(O + (size_t)row * FF + col, pack8(v0, v1));
                }
            }
    }
};

struct RowStats {
    float* slots;
    unsigned* cnt;
    unsigned* tmo;
    __device__ __forceinline__ void run(const f32x4 (&v)[2][2][4][2], const Unit& u, int wr, int wc, int fr, int fq, PG8_LAS unsigned char* lds, int wid, int lane) const {
        PG8_LAS float* P = (PG8_LAS float*)lds;
        PG8_LAS float* S = (PG8_LAS float*)(lds + 8192);
#pragma unroll
        for (int ai = 0; ai < 2; ++ai)
#pragma unroll
            for (int m = 0; m < 4; ++m) {
                float s = 0.f;
#pragma unroll
                for (int bj = 0; bj < 2; ++bj)
#pragma unroll
                    for (int n = 0; n < 2; ++n) { const f32x4 x = v[ai][bj][m][n]; s += (x[0] * x[0] + x[1] * x[1]) + (x[2] * x[2] + x[3] * x[3]); }
                s += __shfl_xor(s, 16); s += __shfl_xor(s, 32);
                if (fq == 0) P[(ai * HALF + wr * 64 + m * 16 + fr) * 4 + wc] = s;
            }
        asm volatile("s_waitcnt lgkmcnt(0)" ::: "memory"); __builtin_amdgcn_s_barrier(); asm volatile("" ::: "memory");
        const int row = wid * 32 + (lane & 31);
        if (lane < 32) {
            const f32x4 p = *(const PG8_LAS f32x4*)(P + row * 4);
            const float t = (p[0] + p[1]) + (p[2] + p[3]);
            __hip_atomic_store((unsigned*)slots + ((size_t)(u.pm * BM + row) * 4 + u.pn), __float_as_uint(t), __ATOMIC_RELAXED, __HIP_MEMORY_SCOPE_AGENT);
        }
        asm volatile("s_waitcnt vmcnt(0)" ::: "memory");
        if (lane == 0) __hip_atomic_fetch_add(cnt + 64 * u.pm, 1u, __ATOMIC_RELAXED, __HIP_MEMORY_SCOPE_AGENT);
        if (wid == 0) {
            const unsigned long long t0 = __builtin_amdgcn_s_memrealtime();
            for (;;) {
                if ((unsigned)__builtin_amdgcn_readfirstlane(__hip_atomic_load(cnt + 64 * u.pm, __ATOMIC_RELAXED, __HIP_MEMORY_SCOPE_AGENT)) >= 32u) break;
                if (__builtin_amdgcn_s_memrealtime() - t0 > 2000000ull) { if (lane == 0) __hip_atomic_store(tmo, 1u, __ATOMIC_RELAXED, __HIP_MEMORY_SCOPE_AGENT); break; }
                __builtin_amdgcn_s_sleep(2);
            }
            __builtin_amdgcn_fence(__ATOMIC_ACQUIRE, "agent");
        }
        asm volatile("s_waitcnt vmcnt(0) lgkmcnt(0)" ::: "memory"); __builtin_amdgcn_s_barrier(); asm volatile("" ::: "memory");
        if (lane < 32) {
            const unsigned* sl = (const unsigned*)slots + (size_t)(u.pm * BM + row) * 4; float tot = 0.f;
#pragma unroll
            for (int t = 0; t < 4; ++t) tot += __uint_as_float(__hip_atomic_load(sl + t, __ATOMIC_RELAXED, __HIP_MEMORY_SCOPE_AGENT));
            S[row] = __builtin_amdgcn_rsqf(tot * (1.0f / 1024.0f) + 1e-6f);
        }
        asm volatile("s_waitcnt lgkmcnt(0)" ::: "memory"); __builtin_amdgcn_s_barrier(); asm volatile("" ::: "memory");
    }
};
struct EpiRow1 {
    static constexpr bool PERM = false, AFTER_DRAIN = true;
    const float* xp; const float* xs; float* out; bf16_t* XN; const float* MOD; const float* post1; const float* pre2; RowStats st1, st2;
    __device__ __forceinline__ void fused(f32x4 (&acc)[2][2][4][2], const Unit& u, int wr, int wc, int fr, int fq, PG8_LAS unsigned char* lds, int wid, int lane) const {
        const PG8_LAS float* S = (const PG8_LAS float*)(lds + 8192);
        const float* md = MOD + (u.pm < 32 ? 0 : 1 + ((u.pm - 32) >> 2)) * 6144;
        const int col0 = u.pn * BM + wc * 32 + 4 * fq;
        const int row0 = u.pm * BM + wr * 64 + fr;
        const float* xbase = (row0 < M_CTX ? xp + (size_t)row0 * DM : xs + (size_t)(row0 - M_CTX) * DM) + col0;
        st1.run(acc, u, wr, wc, fr, fq, lds, wid, lane);
        float rs[2][4];
#pragma unroll
        for (int ai = 0; ai < 2; ++ai)
#pragma unroll
            for (int m = 0; m < 4; ++m) rs[ai][m] = S[ai * HALF + wr * 64 + m * 16 + fr];
#pragma unroll
        for (int bj = 0; bj < 2; ++bj)
#pragma unroll
            for (int n = 0; n < 2; ++n) { const int co = bj * HALF + n * 16, c = col0 + co;
                const f32x4 g1 = *(const f32x4*)(md + 2048 + c), pw = *(const f32x4*)(post1 + c);
                f32x4 xv[2][4];
#pragma unroll
                for (int ai = 0; ai < 2; ++ai)
#pragma unroll
                    for (int m = 0; m < 4; ++m) xv[ai][m] = *(const f32x4*)(xbase + (size_t)(ai * HALF + m * 16) * DM + co);
                asm volatile("" ::: "memory");
#pragma unroll
                for (int ai = 0; ai < 2; ++ai)
#pragma unroll
                    for (int m = 0; m < 4; ++m) { const f32x4 x1 = xv[ai][m] + g1 * (acc[ai][bj][m][n] * rs[ai][m] * pw); acc[ai][bj][m][n] = x1;
                        *(f32x4*)(out + (size_t)(row0 + ai * HALF + m * 16) * DM + c) = x1; }
                asm volatile("" ::: "memory"); }
        st2.run(acc, u, wr, wc, fr, fq, lds, wid, lane);
#pragma unroll
        for (int ai = 0; ai < 2; ++ai)
#pragma unroll
            for (int m = 0; m < 4; ++m) rs[ai][m] = S[ai * HALF + wr * 64 + m * 16 + fr];
#pragma unroll
        for (int bj = 0; bj < 2; ++bj)
#pragma unroll
            for (int n = 0; n < 2; ++n) { const int c = col0 + bj * HALF + n * 16;
                const f32x4 w = *(const f32x4*)(pre2 + c), sh = *(const f32x4*)(md + 3072 + c), sc = *(const f32x4*)(md + 4096 + c) + 1.0f;
#pragma unroll
                for (int ai = 0; ai < 2; ++ai)
#pragma unroll
                    for (int m = 0; m < 4; ++m) { const f32x4 hv = acc[ai][bj][m][n] * rs[ai][m] * w * sc + sh;
                        u32x2 o; o.x = cvt_pk_bf16(hv[0], hv[1]); o.y = cvt_pk_bf16(hv[2], hv[3]); *(u32x2*)(XN + (size_t)(row0 + ai * HALF + m * 16) * DM + c) = o; } }
    }
};
struct EpiRow2 {
    static constexpr bool PERM = false, AFTER_DRAIN = true;
    float* out; const float* MOD; const float* post2; RowStats st;
    __device__ __forceinline__ void fused(f32x4 (&acc)[2][2][4][2], const Unit& u, int wr, int wc, int fr, int fq, PG8_LAS unsigned char* lds, int wid, int lane) const {
        const PG8_LAS float* S = (const PG8_LAS float*)(lds + 8192);
        const float* md = MOD + (u.pm < 32 ? 0 : 1 + ((u.pm - 32) >> 2)) * 6144;
        const int col0 = u.pn * BM + wc * 32 + 4 * fq;
        float* obase = out + (size_t)(u.pm * BM + wr * 64 + fr) * DM + col0;
        st.run(acc, u, wr, wc, fr, fq, lds, wid, lane);
        float rs[2][4];
#pragma unroll
        for (int ai = 0; ai < 2; ++ai)
#pragma unroll
            for (int m = 0; m < 4; ++m) rs[ai][m] = S[ai * HALF + wr * 64 + m * 16 + fr];
#pragma unroll
        for (int bj = 0; bj < 2; ++bj)
#pragma unroll
            for (int n = 0; n < 2; ++n) { const int co = bj * HALF + n * 16, c = col0 + co;
                const f32x4 g2 = *(const f32x4*)(md + 5120 + c), pw = *(const f32x4*)(post2 + c);
                f32x4 xv[2][4];
#pragma unroll
                for (int ai = 0; ai < 2; ++ai)
#pragma unroll
                    for (int m = 0; m < 4; ++m) xv[ai][m] = *(const f32x4*)(obase + (size_t)(ai * HALF + m * 16) * DM + co);
                asm volatile("" ::: "memory");
#pragma unroll
                for (int ai = 0; ai < 2; ++ai)
#pragma unroll
                    for (int m = 0; m < 4; ++m) *(f32x4*)(obase + (size_t)(ai * HALF + m * 16) * DM + co) = xv[ai][m] + g2 * (acc[ai][bj][m][n] * rs[ai][m] * pw);
                asm volatile("" ::: "memory"); }
    }
};

struct SplitOrder {
    int vcu, ntm, nte;
    __device__ __forceinline__ bool next(int i, Unit& u) const {
        const int grp = vcu >> 2, j = vcu & 3;
        if (j < 3) { if (i > 0) return false; const int ti = grp * 3 + j; u.pm = ti >> 2; u.pn = ti & 3; u.k0 = 0; u.nt = ntm; return true; }
        if (i > 2) return false; { const int ti = grp * 3 + i; u.pm = ti >> 2; u.pn = ti & 3; u.k0 = ntm * 64; u.nt = nte; return true; }
    }
    __device__ __forceinline__ void a_ready(const Unit&) const {}
    __device__ __forceinline__ void done(const Unit&) const {}
};
struct EpiSplit {
    static constexpr bool PERM = true, AFTER_DRAIN = false, HAS_MID = false;
    bf16_t* Fmain; bf16_t* Fextra;
    __device__ __forceinline__ void operator()(const f32x4 (&acc)[2][2][4][2], const Unit& u, int wr, int wc, int fr, int fq) const {
        bf16_t* O = u.k0 ? Fextra : Fmain;
#pragma unroll
        for (int ai = 0; ai < 2; ++ai)
#pragma unroll
            for (int m = 0; m < 4; ++m) {
                const int row = u.pm * BM + ai * HALF + wr * 64 + m * 16 + fr;
#pragma unroll
                for (int bj = 0; bj < 2; ++bj) { const int col = u.pn * BM + bj * HALF + wc * 32 + 8 * fq; *(u32x4*)(O + (size_t)row * DM + col) = pack8(acc[ai][bj][m][0], acc[ai][bj][m][1]); }
            }
    }
};

template <class Epi, class Sched, bool ALIGN_EPI = false, bool SP2 = false>
__device__ __forceinline__ void gemm_phase(PG8_LAS unsigned char* lds, const Gemm g, const Sched& S, const Epi& E) {
    int tid_ = threadIdx.x; asm volatile("" : "+v"(tid_));
    const int tid = tid_, wid = __builtin_amdgcn_readfirstlane(tid >> 6), lane = tid & 63, wr = wid >> 2, wc = wid & 3, fr = lane & 15, fq = lane >> 4;
    const int K = g.K, nt = K / BK;
    unsigned voffA[2], voffB[2];
#pragma unroll
    for (int i = 0; i < 2; ++i) { int R, C; stage_rc(tid * 16 + i * 8192, R, C); const int Rb = Epi::PERM ? ((R & ~31) + perm32(R & 31)) : R;
        voffA[i] = (unsigned)(R * K + C) * 2u; voffB[i] = (unsigned)(Rb * K + C) * 2u; }
    const size_t kstep = (size_t)(BK * 2);
    const size_t hstep = (size_t)HALF * K * 2;
    const size_t tstep = 2 * hstep;
    const unsigned ldsw = (unsigned)wid * 1024u;
    const int aoff = lds_byte(wr * 64 + fr, fq * 8), boff = lds_byte(wc * 32 + fr, fq * 8);
#define PG8_SA(b, h) (((b) * 2 + (h)) * HTB)
#define PG8_SB(b, h) ((4 + (b) * 2 + (h)) * HTB)
#define PG8_STAGE(bufoff, gbase, voff) do { _Pragma("unroll") for (int _i = 0; _i < 2; ++_i) \
        __builtin_amdgcn_global_load_lds((const unsigned*)((const char*)(gbase) + (voff)[_i]), (PG8_LAS unsigned*)(lds + (bufoff) + ldsw + _i * 8192), 16, 0, 0); } while (0)
#define PG8_LDA(dst, b, h) do { _Pragma("unroll") for (int m = 0; m < 4; ++m) _Pragma("unroll") for (int k = 0; k < 2; ++k) dst[m][k] = *(const PG8_LAS bf16x8*)(lds + PG8_SA(b, h) + aoff + m * 2048 + k * 1024); } while (0)
#define PG8_LDB(dst, b, h) do { _Pragma("unroll") for (int n = 0; n < 2; ++n) _Pragma("unroll") for (int k = 0; k < 2; ++k) dst[n][k] = *(const PG8_LAS bf16x8*)(lds + PG8_SB(b, h) + boff + n * 2048 + k * 1024); } while (0)
#define PG8_MMA(ai, bj, At, Bt) do { __builtin_amdgcn_s_setprio(1); _Pragma("unroll") for (int m = 0; m < 4; ++m) _Pragma("unroll") for (int n = 0; n < 2; ++n) _Pragma("unroll") for (int k = 0; k < 2; ++k) \
        acc[ai][bj][m][n] = __builtin_amdgcn_mfma_f32_16x16x32_bf16(Bt[n][k], At[m][k], acc[ai][bj][m][n], 0, 0, 0); __builtin_amdgcn_s_setprio(0); } while (0)
#define PG8_WAIT_V(n) asm volatile("s_waitcnt vmcnt(" #n ")" ::: "memory")
#define PG8_WAIT_L(n) asm volatile("s_waitcnt lgkmcnt(" #n ")" ::: "memory")
#define PG8_BAR __builtin_amdgcn_s_barrier()
#define PG8_SCHED __builtin_amdgcn_sched_barrier(0)
    Unit cur, nxt; int ui = 0;
    if (!S.next(0, cur)) return;
    f32x4 acc[2][2][4][2];
#pragma unroll
    for (int a = 0; a < 2; ++a)
#pragma unroll
        for (int b = 0; b < 2; ++b)
#pragma unroll
            for (int m = 0; m < 4; ++m)
#pragma unroll
                for (int n = 0; n < 2; ++n) acc[a][b][m][n] = (f32x4){0.f, 0.f, 0.f, 0.f};
    bf16x8 At[4][2], B0[2][2], B1[2][2];
    const char* cA = (const char*)g.A + (size_t)cur.pm * tstep + (size_t)cur.k0 * 2; const char* cB = (const char*)g.Bt + (size_t)cur.pn * tstep + (size_t)cur.k0 * 2;
    int ntc = cur.nt ? cur.nt : nt;
    S.a_ready(cur);
    if constexpr (SP2) {
        PG8_STAGE(PG8_SB(0, 0), cB, voffB); PG8_STAGE(PG8_SB(0, 1), cB + hstep, voffB); PG8_STAGE(PG8_SA(0, 0), cA, voffA); PG8_STAGE(PG8_SA(0, 1), cA + hstep, voffA);
        if (wr == 1) PG8_BAR;
        PG8_WAIT_V(2); PG8_BAR;
        PG8_STAGE(PG8_SB(1, 0), cB + kstep, voffB); PG8_STAGE(PG8_SA(1, 0), cA + kstep, voffA); PG8_STAGE(PG8_SB(1, 1), cB + hstep + kstep, voffB);
        PG8_WAIT_V(6); PG8_BAR;
    } else {
        PG8_STAGE(PG8_SB(0, 0), cB, voffB); PG8_STAGE(PG8_SA(0, 0), cA, voffA); PG8_STAGE(PG8_SB(0, 1), cB + hstep, voffB); PG8_STAGE(PG8_SA(0, 1), cA + hstep, voffA);
        if (wr == 1) PG8_BAR;
        PG8_WAIT_V(4); PG8_BAR;
        PG8_STAGE(PG8_SB(1, 0), cB + kstep, voffB); PG8_STAGE(PG8_SA(1, 0), cA + kstep, voffA); PG8_STAGE(PG8_SB(1, 1), cB + hstep + kstep, voffB);
        PG8_WAIT_V(6); PG8_BAR;
    }
    for (;;) {
        const bool has_next = S.next(ui + 1, nxt);
        const char* nA = has_next ? (const char*)g.A + (size_t)nxt.pm * tstep + (size_t)nxt.k0 * 2 : cA; const char* nB = has_next ? (const char*)g.Bt + (size_t)nxt.pn * tstep + (size_t)nxt.k0 * 2 : cB;
        for (int t = 0; t < ntc; t += 2) {
            const bool last = (t == ntc - 2);
            if constexpr (Epi::HAS_MID) { if (t == Epi::MID_T) E.mid(acc, cur, wr, wc, fr, fq); }
            const char* a1 = cA + (size_t)(t + 1) * kstep;
            const char* a2 = last ? nA : cA + (size_t)(t + 2) * kstep; const char* b2 = last ? nB : cB + (size_t)(t + 2) * kstep;
            const char* a3 = a2 + kstep; const char* b3 = b2 + kstep;
            if (last && has_next) S.a_ready(nxt);
            if constexpr (SP2) {
            PG8_LDB(B0, 0, 0); PG8_LDB(B1, 0, 1); PG8_SCHED; PG8_LDA(At, 0, 0); PG8_STAGE(PG8_SA(1, 1), a1 + hstep, voffA);
            PG8_WAIT_V(8); PG8_WAIT_L(0); PG8_BAR; PG8_MMA(0, 0, At, B0); PG8_MMA(0, 1, At, B1); PG8_BAR; PG8_SCHED;
            PG8_LDA(At, 0, 1); PG8_STAGE(PG8_SB(0, 0), b2, voffB); PG8_STAGE(PG8_SB(0, 1), b2 + hstep, voffB); PG8_STAGE(PG8_SA(0, 0), a2, voffA);
            PG8_WAIT_V(8); PG8_WAIT_L(0); PG8_BAR; PG8_MMA(1, 0, At, B0); PG8_MMA(1, 1, At, B1); PG8_BAR; PG8_SCHED;
            PG8_LDB(B0, 1, 0); PG8_LDB(B1, 1, 1); PG8_SCHED; PG8_LDA(At, 1, 0); PG8_STAGE(PG8_SA(0, 1), a2 + hstep, voffA);
            PG8_WAIT_V(8); PG8_WAIT_L(0); PG8_BAR; PG8_MMA(0, 0, At, B0); PG8_MMA(0, 1, At, B1); PG8_BAR; PG8_SCHED;
            PG8_LDA(At, 1, 1); PG8_STAGE(PG8_SB(1, 0), b3, voffB); PG8_STAGE(PG8_SB(1, 1), b3 + hstep, voffB); PG8_STAGE(PG8_SA(1, 0), a3, voffA);
            PG8_WAIT_V(8); PG8_WAIT_L(0); PG8_BAR; PG8_MMA(1, 0, At, B0); PG8_MMA(1, 1, At, B1); PG8_BAR; PG8_SCHED;
            } else {
            PG8_LDB(B0, 0, 0); PG8_SCHED; PG8_LDA(At, 0, 0); PG8_STAGE(PG8_SA(1, 1), a1 + hstep, voffA);
            PG8_WAIT_L(8); PG8_BAR; PG8_WAIT_L(0); PG8_MMA(0, 0, At, B0); PG8_BAR; PG8_SCHED;
            PG8_LDB(B1, 0, 1); PG8_STAGE(PG8_SB(0, 0), b2, voffB);
            PG8_BAR; PG8_WAIT_L(0); PG8_MMA(0, 1, At, B1); PG8_BAR;
            PG8_LDA(At, 0, 1); PG8_STAGE(PG8_SA(0, 0), a2, voffA);
            PG8_BAR; PG8_WAIT_L(0); PG8_MMA(1, 0, At, B0); PG8_BAR; PG8_SCHED;
            PG8_STAGE(PG8_SB(0, 1), b2 + hstep, voffB);
            PG8_WAIT_V(6); PG8_BAR; PG8_MMA(1, 1, At, B1); PG8_BAR;
            PG8_LDB(B0, 1, 0); PG8_SCHED; PG8_LDA(At, 1, 0); PG8_STAGE(PG8_SA(0, 1), a2 + hstep, voffA);
            PG8_WAIT_L(8); PG8_BAR; PG8_WAIT_L(0); PG8_MMA(0, 0, At, B0); PG8_BAR; PG8_SCHED;
            PG8_LDB(B1, 1, 1); PG8_STAGE(PG8_SB(1, 0), b3, voffB);
            PG8_BAR; PG8_WAIT_L(0); PG8_MMA(0, 1, At, B1); PG8_BAR;
            PG8_LDA(At, 1, 1); PG8_STAGE(PG8_SA(1, 0), a3, voffA);
            PG8_BAR; PG8_WAIT_L(0); PG8_MMA(1, 0, At, B0); PG8_BAR; PG8_SCHED;
            PG8_STAGE(PG8_SB(1, 1), b3 + hstep, voffB);
            PG8_WAIT_V(6); PG8_BAR; PG8_MMA(1, 1, At, B1); PG8_BAR;
            }
        }
        if constexpr (ALIGN_EPI) { if (wr == 0) PG8_BAR; }
        if constexpr (!Epi::AFTER_DRAIN) { E(acc, cur, wr, wc, fr, fq); S.done(cur); }
        if (!has_next) break;
#pragma unroll
        for (int a = 0; a < 2; ++a)
#pragma unroll
            for (int b = 0; b < 2; ++b)
#pragma unroll
                for (int m = 0; m < 4; ++m)
#pragma unroll
                    for (int n = 0; n < 2; ++n) acc[a][b][m][n] = (f32x4){0.f, 0.f, 0.f, 0.f};
        cur = nxt; cA = nA; cB = nB; ++ui; ntc = cur.nt ? cur.nt : nt;
        if constexpr (ALIGN_EPI) { if (wr == 1) PG8_BAR; }
    }
    PG8_WAIT_V(0);
    if constexpr (!ALIGN_EPI) { if (wr == 0) PG8_BAR; }
    PG8_BAR;
    if constexpr (Epi::AFTER_DRAIN) { E.fused(acc, cur, wr, wc, fr, fq, lds, wid, lane); S.done(cur); }
#undef PG8_SA
#undef PG8_SB
#undef PG8_STAGE
#undef PG8_LDA
#undef PG8_LDB
#undef PG8_MMA
#undef PG8_WAIT_V
#undef PG8_WAIT_L
#undef PG8_BAR
#undef PG8_SCHED
}
}

constexpr int NWAVES = 8;
constexpr size_t MiB = 1u << 20;
constexpr size_t WS_CTL = 0, CTL_ZERO_BYTES = 128 * 1024;
constexpr size_t WS_MOD = 1 * MiB;
constexpr size_t WS_ROPE = 1 * MiB + 256 * 1024;
constexpr size_t WS_CORD = 1 * MiB + 512 * 1024;
constexpr size_t WS_BA = 2 * MiB;
constexpr size_t WS_RSS1 = 4 * MiB, WS_RSS2 = 5 * MiB;
constexpr size_t WS_WIN = 6 * MiB, WS_WAO = 18 * MiB, WS_WDO = 19 * MiB, WS_WOUT = 20 * MiB, WS_W1 = 22 * MiB, WS_W2 = 30 * MiB;
constexpr size_t WS_XN = 38 * MiB;
constexpr size_t WS_ONA = 62 * MiB;
constexpr size_t WS_VCB = 122 * MiB;
constexpr size_t WS_KT = 134 * MiB;
constexpr int REC_SPLIT = 1433;
constexpr size_t WS_REC0 = 34 * MiB;
constexpr size_t WS_PA = 86 * MiB;
constexpr size_t WS_RF = 170 * MiB, WS_SF = 194 * MiB;
constexpr size_t WS_FE = 194 * MiB;
constexpr size_t WS_PB = 158 * MiB;
constexpr size_t WS_SC = 250 * MiB;
constexpr size_t WS_M1 = 224 * MiB;
constexpr size_t WS_CK = 248 * MiB, WS_CVT = 249 * MiB;
constexpr size_t WS_END = 256 * MiB;
constexpr size_t OUT_YP = 0, OUT_YS = (size_t)M_CTX * DM, OUT_K = (size_t)MT * DM, OUT_V = OUT_K + (size_t)32 * 8 * 256 * 64, OUT_S = OUT_V + (size_t)32 * 8 * 256 * 64;

constexpr int CW_BAR = 1024;
constexpr int CW_MW = 20480;
constexpr int CW_FF = 16384;
constexpr int CW_TMO = 8, CW_ADA = 64, CW_CQ = 96, CW_TF = 512, CW_SEAM = 8192, SEAM_BANK = 48 * 64;
constexpr int RING_BYTES = 131072, LDS_BYTES = 147456, LDSCTL_OFF = LDS_BYTES - 1024, MISC_OFF = LDSCTL_OFF + 320;

#define GAS __attribute__((address_space(1)))
#define LAS __attribute__((address_space(3)))
typedef unsigned short bf16;
typedef unsigned v4u __attribute__((ext_vector_type(4)));
typedef unsigned v2u __attribute__((ext_vector_type(2)));
typedef float f32x4 __attribute__((ext_vector_type(4)));
typedef float f32x16 __attribute__((ext_vector_type(16)));
typedef short bf16x8 __attribute__((ext_vector_type(8)));
#define LDS_WAIT() asm volatile("s_waitcnt lgkmcnt(0)" ::: "memory")
#define VM_WAIT() asm volatile("s_waitcnt vmcnt(0)" ::: "memory")
#define MFMA32(a, b, c) __builtin_amdgcn_mfma_f32_32x32x16_bf16((a), (b), (c), 0, 0, 0)
__device__ __forceinline__ unsigned f2bf(float f) { unsigned u = __builtin_bit_cast(unsigned, f); return (u + 0x7fffu + ((u >> 16) & 1u)) >> 16; }
typedef float f32x2_t __attribute__((ext_vector_type(2))); typedef __bf16 bf16x2_t __attribute__((ext_vector_type(2)));
__device__ __forceinline__ unsigned pk2(float lo, float hi) { f32x2_t v = {lo, hi}; bf16x2_t b = __builtin_convertvector(v, bf16x2_t); return __builtin_bit_cast(unsigned, b); }
__device__ __forceinline__ float bflo(unsigned w) { return __uint_as_float(w << 16); }
__device__ __forceinline__ float bfhi(unsigned w) { return __uint_as_float(w & 0xffff0000u); }
__device__ __forceinline__ float silu_(float x) { return x * __builtin_amdgcn_rcpf(1.0f + __expf(-x)); }
__device__ __forceinline__ float sigm_(float x) { return __builtin_amdgcn_rcpf(1.0f + __expf(-x)); }
__device__ __host__ __forceinline__ constexpr int swap23(int x) { return (x & ~12) | ((x & 4) << 1) | ((x & 8) >> 1); }
__device__ __forceinline__ int crow(int reg, int h) { return (reg & 3) + 8 * (reg >> 2) + 4 * h; }
template <int CTRL, int ROWMASK> __device__ __forceinline__ float dpp_add(float v) {
    return v + __builtin_bit_cast(float, __builtin_amdgcn_update_dpp(0, __builtin_bit_cast(int, v), CTRL, ROWMASK, 0xF, false));
}
__device__ __forceinline__ float wave_sum_dpp(float v) {
    v = dpp_add<0xB1, 0xF>(v);
    v = dpp_add<0x4E, 0xF>(v);
    v = dpp_add<0x141, 0xF>(v);
    v = dpp_add<0x140, 0xF>(v);
    v = dpp_add<0x142, 0xA>(v);
    v = dpp_add<0x143, 0xC>(v);
    return __builtin_bit_cast(float, __builtin_amdgcn_readlane(__builtin_bit_cast(int, v), 63));
}
__device__ __forceinline__ float wave_sum(float v) {
#pragma unroll
    for (int o = 1; o < 64; o <<= 1) v += __shfl_xor(v, o);
    return v;
}

#define XB_TMO      128
#define XB_XCNT(j)  (256  + 64 * (j))
#define XB_XSUB(j)  (1280 + 64 * (j))
#define XB_XGEN(j)  (2304 + 64 * (j))
#define XB_TOP      3328
#define XB_TOPGEN   3392
#define XCD_BAR_WORDS 3456
#define XB_SPIN_CAP (1u << 22)

__device__ __forceinline__ unsigned xb_ld(unsigned* p)              { return __hip_atomic_load(p, __ATOMIC_RELAXED, __HIP_MEMORY_SCOPE_AGENT); }
__device__ __forceinline__ unsigned xb_add(unsigned* p, unsigned v) { return __hip_atomic_fetch_add(p, v, __ATOMIC_RELAXED, __HIP_MEMORY_SCOPE_AGENT); }
__device__ __forceinline__ unsigned xb_xcc_id() { return (unsigned)__builtin_amdgcn_s_getreg((3 << 11) | 20) & 0xFu; }
#define XB_SPIN(cond, bar) do { unsigned _sp = 0; while (cond) { __builtin_amdgcn_s_sleep(1); \
    if ((++_sp & 255u) == 0u) { if (xb_ld(&(bar)[XB_TMO])) break; if (_sp > XB_SPIN_CAP) { atomicAdd(&(bar)[XB_TMO], 1u); break; } } } } while (0)

struct XcdBarrier { unsigned* bar; unsigned x; volatile LAS unsigned* st; };

__device__ __forceinline__ XcdBarrier xcd_barrier_post(unsigned* bar, volatile LAS unsigned* st) {
    XcdBarrier b; b.bar = bar; b.x = xb_xcc_id(); b.st = st;
    if (threadIdx.x == 0) (void)xb_add(&bar[XB_XCNT(b.x)], 1u);
    return b;
}
__device__ __forceinline__ void xcd_barrier_complete(unsigned* bar, unsigned x, unsigned& nloc, unsigned& nx) {
    const unsigned G = gridDim.x * gridDim.y * gridDim.z;
    unsigned sum, cnt, mine, sp = 0u;
    for (;;) {
        sum = 0u; cnt = 0u; mine = 0u;
#pragma unroll
        for (unsigned j = 0; j < 16; ++j) { const unsigned c = xb_ld(&bar[XB_XCNT(j)]); sum += c; cnt += (c > 0u) ? 1u : 0u; mine = (j == x) ? c : mine; }
        if (sum == G) break;
        __builtin_amdgcn_s_sleep(1);
        if ((++sp & 255u) == 0u) { if (xb_ld(&bar[XB_TMO])) break; if (sp > XB_SPIN_CAP) { atomicAdd(&bar[XB_TMO], 1u); break; } }
    }
    nloc = mine > 0u ? mine : 1u; nx = cnt > 0u ? cnt : 1u;
}
__device__ __forceinline__ void xcd_barrier(const XcdBarrier& b) {
    asm volatile("s_waitcnt vmcnt(0)" ::: "memory");
    __syncthreads();
    if (threadIdx.x == 0) {
        unsigned* bar = b.bar;
        __builtin_amdgcn_s_waitcnt(0);
        unsigned nloc = b.st[0], nx = b.st[1];
        if (nloc == 0u) { xcd_barrier_complete(bar, b.x, nloc, nx); b.st[0] = nloc; b.st[1] = nx; }
        const unsigned old = xb_add(&bar[XB_XSUB(b.x)], 1u);
        const unsigned gen = old / nloc;
        if (old + 1u == (gen + 1u) * nloc) {
            __builtin_amdgcn_fence(__ATOMIC_RELEASE, "agent");
            asm volatile("s_waitcnt vmcnt(0)" ::: "memory");
            const unsigned og = xb_add(&bar[XB_TOP], 1u);
            const unsigned tg = og / nx;
            if (og + 1u == (tg + 1u) * nx) xb_add(&bar[XB_TOPGEN], 1u);
            else XB_SPIN(xb_ld(&bar[XB_TOPGEN]) == tg, bar);
            __builtin_amdgcn_fence(__ATOMIC_ACQUIRE, "agent");
            xb_add(&bar[XB_XGEN(b.x)], 1u);
            asm volatile("s_waitcnt vmcnt(0)" ::: "memory");
        } else {
            XB_SPIN(xb_ld(&bar[XB_XGEN(b.x)]) == gen, bar);
            __builtin_amdgcn_fence(__ATOMIC_ACQUIRE, "agent");
            asm volatile("s_waitcnt vmcnt(0)" ::: "memory");
        }
    }
    __syncthreads();
}

struct Args { const float* in[24]; float* out; unsigned char* ws; int ph_lo, ph_hi; };
enum { I_XP = 0, I_XS, I_C, I_CK, I_CV, I_ST, I_CCTX, I_WADA, I_BADA, I_PRE1, I_POST1, I_PRE2, I_POST2, I_WIN, I_CONVW, I_ALOG, I_DTB, I_DNN, I_RPB, I_WAO, I_WDO, I_WOUT, I_WFF1, I_WFF2 };

__device__ __forceinline__ void p0_transpose_item(const float* W, int K, int N, bf16* WT, LAS float* scr, int item, int lane, int ldo = 0, bool win_order = false) {
    if (ldo == 0) ldo = K;
    const int nblk = N / 32, kb = item / nblk, nb = item % nblk, k0 = 64 * kb, n0 = 32 * nb;
    {
        f32x4 v[8]; const int kr = lane >> 3, nq = (lane & 7) * 4;
#pragma unroll
        for (int i = 0; i < 8; ++i) v[i] = *(const f32x4*)(W + (size_t)(k0 + 8 * i + kr) * N + n0 + nq);
        asm volatile("" ::: "memory");
#pragma unroll
        for (int i = 0; i < 8; ++i) { LAS float* d = scr + (8 * i + kr) * 33 + nq; d[0] = v[i].x; d[1] = v[i].y; d[2] = v[i].z; d[3] = v[i].w; }
    }
    LDS_WAIT();
    const int c = lane & 7;
#pragma unroll
    for (int j = 0; j < 4; ++j) { const int n = (lane >> 3) + 8 * j; const LAS float* s = scr + (8 * c) * 33 + n;
        v4u o; o.x = pk2(s[0 * 33], s[1 * 33]); o.y = pk2(s[2 * 33], s[3 * 33]); o.z = pk2(s[4 * 33], s[5 * 33]); o.w = pk2(s[6 * 33], s[7 * 33]);
        *(v4u*)(WT + (size_t)((win_order ? win_dst(n0) : n0) + n) * ldo + k0 + 8 * c) = o; }
    LDS_WAIT();
}

__device__ __forceinline__ void phase_prologue(const Args& a, LAS unsigned char* lds, int vcu, int G) {
    const int tid = threadIdx.x, lane = tid & 63, wave = __builtin_amdgcn_readfirstlane(tid >> 6);
    unsigned char* ws = a.ws;
    if (vcu < 192) {
        LAS float* sl = (LAS float*)lds;
        LAS float* red = (LAS float*)(lds + 20480);
        const int col = 32 * vcu + (lane & 31), rg = wave * 2 + (lane >> 5);
        const float* w = a.in[I_WADA] + (size_t)(rg * 64) * 6144 + col;
        float wv[64], cv[10];
#pragma unroll
        for (int i = 0; i < 64; ++i) wv[i] = w[(size_t)i * 6144];
#pragma unroll
        for (int q = 0; q < 10; ++q) { const int i = tid + 512 * q; cv[q] = i < 1024 ? a.in[I_CCTX][i] : a.in[I_C][i - 1024]; }
        const float bias = a.in[I_BADA][32 * vcu + (tid & 31)];
        asm volatile("" ::: "memory");
#pragma unroll
        for (int q = 0; q < 10; ++q) sl[tid + 512 * q] = silu_(cv[q]);
        __syncthreads();
        float acc[5] = {0.f, 0.f, 0.f, 0.f, 0.f};
#pragma unroll
        for (int i = 0; i < 64; ++i) { const int k = rg * 64 + i;
#pragma unroll
            for (int v = 0; v < 5; ++v) acc[v] += sl[v * 1024 + k] * wv[i]; }
#pragma unroll
        for (int v = 0; v < 5; ++v) red[(rg * 5 + v) * 32 + (lane & 31)] = acc[v];
        __syncthreads();
        if (tid < 160) { const int v = tid >> 5, cl = tid & 31; float s = bias;
            for (int r = 0; r < 16; ++r) s += red[(r * 5 + v) * 32 + cl];
            ((float*)(ws + WS_MOD))[v * 6144 + 32 * vcu + cl] = s; }
        asm volatile("s_waitcnt vmcnt(0)" ::: "memory");
        __syncthreads();
        if (tid == 0) { __builtin_amdgcn_fence(__ATOMIC_RELEASE, "agent"); asm volatile("s_waitcnt vmcnt(0)" ::: "memory");
            __hip_atomic_fetch_add((unsigned*)(ws + WS_CTL) + CW_ADA, 1u, __ATOMIC_RELAXED, __HIP_MEMORY_SCOPE_AGENT); }
    } else if (vcu == 192) {
        float* rope = (float*)(ws + WS_ROPE);
        for (int i = tid; i < 1024; i += 512) { const int pos = i >> 4, f = i & 15; const float inv = powf(10000.0f, -(float)f / 16.0f); const float ang = (float)pos * inv; rope[i] = cosf(ang); rope[1024 + i] = sinf(ang); }
    } else if (vcu < 225) {
        const int bh = vcu - 193;
        const float* ck = a.in[I_CK] + (size_t)bh * 256 * 64; const float* cv = a.in[I_CV] + (size_t)bh * 256 * 64;
        bf16* CK = (bf16*)(ws + WS_CK) + (size_t)bh * 256 * 64; bf16* CVT = (bf16*)(ws + WS_CVT) + (size_t)bh * 64 * 256;
        for (int i = tid; i < 256 * 8; i += 512) { const int key = i >> 3, c8 = i & 7;
            const f32x4 k0 = *(const f32x4*)(ck + key * 64 + c8 * 8), k1 = *(const f32x4*)(ck + key * 64 + c8 * 8 + 4);
            v4u o; o.x = pk2(k0[0], k0[1]); o.y = pk2(k0[2], k0[3]); o.z = pk2(k1[0], k1[1]); o.w = pk2(k1[2], k1[3]);
            *(v4u*)(CK + key * 64 + c8 * 8) = o;
            const f32x4 v0 = *(const f32x4*)(cv + key * 64 + c8 * 8), v1 = *(const f32x4*)(cv + key * 64 + c8 * 8 + 4);
            const int pos = (key & ~12) | ((key & 4) << 1) | ((key & 8) >> 1);
#pragma unroll
            for (int j = 0; j < 4; ++j) { CVT[(c8 * 8 + j) * 256 + pos] = (bf16)f2bf(v0[j]); CVT[(c8 * 8 + 4 + j) * 256 + pos] = (bf16)f2bf(v1[j]); }
        }
    }
    if (vcu == G - 1) {
        LAS unsigned char* late = (LAS unsigned char*)(lds + 8192); LAS unsigned char* dep = late + 512;
        for (int i = tid; i < 384; i += 512) late[i] = 0;
        __syncthreads();
        { pg8::StaticOrder S; S.init(MT, NINP, G, tid); const int lastr = (S.nwg - 1) / G; pg8::Unit u;
          if (tid < G && S.next(lastr, u) && inproj_flag(u.pn) >= 0) late[u.pm * 8 + inproj_flag(u.pn)] = 1; }
        __syncthreads();
        for (int g = tid; g < 576; g += 512) { const int chunk = g / 3, part = g - 3 * chunk, pm = chunk >> 2;
            int dd = late[pm * 8 + 2 * part] | late[pm * 8 + 2 * part + 1];
            if (part == 2) dd |= late[pm * 8 + 6];
            if (pm >= 32) { const int kc = (chunk - 128) & 15;
                if ((chunk & 3) == 0 && kc != 0) dd |= late[(pm - 1) * 8 + 2 * part] | late[(pm - 1) * 8 + 2 * part + 1];
                if ((chunk & 3) == 3 && kc != 15) dd |= late[(pm + 1) * 8 + 2 * part] | late[(pm + 1) * 8 + 2 * part + 1]; }
            dep[g] = (unsigned char)dd; }
        __syncthreads();
        {
            LAS unsigned* cnt = (LAS unsigned*)(dep + 576);
            const int lane_ = tid & 63;
            for (int c = wave; c < 9; c += NWAVES) { const unsigned long long bal = __ballot(dep[64 * c + lane_] == 0); if (lane_ == 0) cnt[c] = (unsigned)__popcll(bal); }
            __syncthreads();
            for (int c = wave; c < 9; c += NWAVES) { const int g = 64 * c + lane_; const int mine = dep[g];
                const unsigned long long bal = __ballot(mine == 0);
                const int erank = __popcll(bal & ((1ull << lane_) - 1ull));
                int ebefore = 0, etotal = 0;
                for (int j = 0; j < 9; ++j) { const int cj = (int)cnt[j]; etotal += cj; if (j < c) ebefore += cj; }
                const int pos = mine ? etotal + (64 * c - ebefore) + (lane_ - erank) : ebefore + erank;
                ((unsigned*)(ws + WS_CORD))[pos] = (unsigned)g; }
        }
        __syncthreads();
    }
#ifdef TP_A
    if (tid == 0) ((volatile LAS unsigned*)(lds + MISC_OFF))[32 + 20] = (unsigned)__builtin_amdgcn_s_memrealtime();
#endif
    LAS float* scr = (LAS float*)(lds + 32768 + wave * 8704);
    const int gw = vcu * NWAVES + wave, NGW = G * NWAVES;
    constexpr int I_IN = 16 * 177, I_AO = 8 * 32, I_DO = 8 * 32, I_WO = 16 * 32;
    constexpr int NITEMS = I_IN + I_AO + I_DO + I_WO;
    for (int it = gw; it < NITEMS; it += NGW) {
        int r = it;
        if (r < I_IN) { p0_transpose_item(a.in[I_WIN], 1024, NIN, (bf16*)(ws + WS_WIN), scr, r, lane, 0, true); continue; } r -= I_IN;
        if (r < I_AO) { p0_transpose_item(a.in[I_WAO], 512, 1024, (bf16*)(ws + WS_WAO), scr, r, lane, 1024); continue; } r -= I_AO;
        if (r < I_DO) { p0_transpose_item(a.in[I_WDO], 512, 1024, (bf16*)(ws + WS_WAO) + 512, scr, r, lane, 1024); continue; } r -= I_DO;
        p0_transpose_item(a.in[I_WOUT], 1024, 1024, (bf16*)(ws + WS_WOUT), scr, r, lane);
    }
    { v4u* z = (v4u*)((bf16*)(ws + WS_WIN) + (size_t)NIN * 1024); const int n16 = (NINP - NIN) * 1024 * 2 / 16;
      for (int i = gw * 64 + lane; i < n16; i += NGW * 64) z[i] = (v4u){0u, 0u, 0u, 0u}; }
#ifdef TP_A
    if (tid == 0) ((volatile LAS unsigned*)(lds + MISC_OFF))[32 + 21] = (unsigned)__builtin_amdgcn_s_memrealtime();
#endif
    if (wave == 0) {
        unsigned* cnt = (unsigned*)(ws + WS_CTL) + CW_ADA; const unsigned want = (unsigned)(G < 192 ? G : 192); unsigned sp = 0;
        while ((unsigned)__builtin_amdgcn_readfirstlane(__hip_atomic_load(cnt, __ATOMIC_RELAXED, __HIP_MEMORY_SCOPE_AGENT)) < want) { __builtin_amdgcn_s_sleep(2); if (++sp > (1u << 22)) break; }
        __builtin_amdgcn_fence(__ATOMIC_ACQUIRE, "agent");
        asm volatile("s_waitcnt vmcnt(0)" ::: "memory");
    }
    __syncthreads();
#ifdef TP_A
    if (tid == 0) ((volatile LAS unsigned*)(lds + MISC_OFF))[32 + 22] = (unsigned)__builtin_amdgcn_s_memrealtime();
#endif
}

__device__ __forceinline__ void late_transposes(const Args& a, LAS unsigned char* lds, int idle_idx, int n_idle, int lo_part, int hi_part) {
    const int tid = threadIdx.x, lane = tid & 63, wave = __builtin_amdgcn_readfirstlane(tid >> 6);
    LAS float* scr = (LAS float*)(lds + wave * 8704);
    constexpr int I_OUT = 16 * 32, I_1 = 16 * 128, I_2 = 64 * 32;
    const int it0 = lo_part == 0 ? 0 : lo_part == 1 ? I_OUT : I_OUT + I_1, it1 = hi_part == 0 ? I_OUT : hi_part == 1 ? I_OUT + I_1 : I_OUT + I_1 + I_2;
    for (int it = it0 + idle_idx * NWAVES + wave; it < it1; it += n_idle * NWAVES) {
        int r = it;
        if (r < I_OUT) { p0_transpose_item(a.in[I_WOUT], 1024, 1024, (bf16*)(a.ws + WS_WOUT), scr, r, lane); continue; } r -= I_OUT;
        if (r < I_1) { p0_transpose_item(a.in[I_WFF1], 1024, FF, (bf16*)(a.ws + WS_W1), scr, r, lane); continue; } r -= I_1;
        p0_transpose_item(a.in[I_WFF2], FF, 1024, (bf16*)(a.ws + WS_W2), scr, r, lane);
    }
}

#ifdef NO_NT
#define NT_LD(p) (*(p))
#else
#define NT_LD(p) __builtin_nontemporal_load(p)
#endif
__device__ __forceinline__ const float* x_row(const Args& a, int m) { return m < M_CTX ? a.in[I_XP] + (size_t)m * DM : a.in[I_XS] + (size_t)(m - M_CTX) * DM; }
__device__ __forceinline__ int mod_idx(int m) { return m < M_CTX ? 0 : 1 + ((m - M_CTX) >> 10); }

__device__ __forceinline__ void phase_xn(const Args& a, int vcu, int G) {
    const int tid = threadIdx.x, lane = tid & 63, wave = tid >> 6;
    const int gw = vcu * NWAVES + wave, NGW = G * NWAVES;
    const float* MOD = (const float*)(a.ws + WS_MOD); bf16* XN = (bf16*)(a.ws + WS_XN);
    for (int m = gw; m < MT; m += NGW) {
        const f32x4* xr = (const f32x4*)x_row(a, m) + lane;
        const float* md = MOD + mod_idx(m) * 6144;
        f32x4 v[4]; float s = 0.f;
#pragma unroll
        for (int j = 0; j < 4; ++j) { v[j] = NT_LD(xr + 64 * j); s += (v[j].x * v[j].x + v[j].y * v[j].y) + (v[j].z * v[j].z + v[j].w * v[j].w); }
        const float rstd = rsqrtf(wave_sum(s) * (1.f / DM) + 1e-6f);
        v2u* o8 = (v2u*)(XN + (size_t)m * DM) + lane;
#pragma unroll
        for (int j = 0; j < 4; ++j) { const int c = (lane + 64 * j) * 4;
            const f32x4 w = *(const f32x4*)(a.in[I_PRE1] + c), sh = *(const f32x4*)(md + c), sc = *(const f32x4*)(md + 1024 + c);
            const f32x4 h = v[j] * rstd * w * (sc + 1.0f) + sh;
            v2u o; o.x = pk2(h.x, h.y); o.y = pk2(h.z, h.w); o8[64 * j] = o; }
    }
}

__device__ __forceinline__ bf16x8 pack_regs(const f32x16& p, int s) {
    v4u w; w.x = pk2(p[8 * s], p[8 * s + 1]); w.y = pk2(p[8 * s + 2], p[8 * s + 3]); w.z = pk2(p[8 * s + 4], p[8 * s + 5]); w.w = pk2(p[8 * s + 6], p[8 * s + 7]);
    return __builtin_bit_cast(bf16x8, w);
}
__device__ __forceinline__ void store_o(bf16* dst, const f32x16& o0, const f32x16& o1, float inv, int hh) {
#pragma unroll
    for (int g = 0; g < 4; ++g) {
        v2u w0, w1; w0.x = pk2(o0[4 * g] * inv, o0[4 * g + 1] * inv); w0.y = pk2(o0[4 * g + 2] * inv, o0[4 * g + 3] * inv);
        w1.x = pk2(o1[4 * g] * inv, o1[4 * g + 1] * inv); w1.y = pk2(o1[4 * g + 2] * inv, o1[4 * g + 3] * inv);
        *(v2u*)(dst + 8 * g + 4 * hh) = w0; *(v2u*)(dst + 32 + 8 * g + 4 * hh) = w1;
    }
}
constexpr float LOG2E = 1.4426950408889634f;

struct AttnTile { const bf16* k; const bf16* v0; const bf16* v1; };
template <bool LAT>
__device__ __forceinline__ void attn_task(const Args& a, int task, int lane, LAS float* wl) {
    const int r = lane & 31, hh = lane >> 5;
    const bf16* Qb = (const bf16*)(a.ws + WS_M1); const bf16* Kbuf = Qb + (size_t)MT * 512; bf16* ONA = (bf16*)(a.ws + WS_ONA);
    int b, h, rowq, gr = 0, cq = 0;
    if (LAT) { const int half = task & 1; gr = (task >> 1) & 15; h = (task >> 5) & 7; b = task >> 8; cq = 32 * half + r; rowq = M_CTX + b * 1024 + gr * 64 + cq; }
    else { const int qb = task & 7; h = (task >> 3) & 7; b = task >> 6; rowq = b * 256 + qb * 32 + r; }
    constexpr int NT = LAT ? 24 : 8;
    const int rs = LAT ? min(max(gr - 4, 0), 8) : 0;
    LAS unsigned char* lk = (LAS unsigned char*)wl; LAS unsigned char* lv = lk + 4096; LAS float* rpb = wl + 2048;
    int boff[2][16];
    LDS_WAIT();
    if (LAT) {
#pragma unroll
        for (int i = 0; i < 4; ++i) { const int idx = lane + 64 * i, kk = idx >> 5, j = idx & 31; rpb[idx] = j < 31 ? a.in[I_RPB][h * 465 + (rs - gr + 7 + kk) * 31 + j] * LOG2E : -1.0e30f; }
        const int cs_ = min(max(cq - 8, 0), 48);
#pragma unroll
        for (int ct = 0; ct < 2; ++ct)
#pragma unroll
            for (int i = 0; i < 16; ++i) { const int kc = ct * 32 + crow(i, hh); boff[ct][i] = (kc >= cs_ && kc < cs_ + 16) ? kc - cq + 15 : 31; } }
    const int kro = lane >> 3, kch = lane & 7, vro = lane >> 2, vch = lane & 3;
    const bf16* gKl = Kbuf + (size_t)(LAT ? M_CTX + b * 1024 : b * 256) * 512 + h * 64 + (size_t)kro * 512 + kch * 8;
    const bf16* gVl = (const bf16*)a.out + (size_t)3 * MT * 512 + (LAT ? (size_t)M_CTX * 512 + (size_t)(b * 8 + h) * 64 * 1024 : (size_t)(b * 8 + h) * 64 * 256) + (size_t)vro * (LAT ? 1024 : 256) + vch * 8;
    const bf16* gKc = (const bf16*)(a.ws + WS_CK) + (size_t)(b * 8 + h) * 256 * 64 + kro * 64 + kch * 8;
    const bf16* gVc = (const bf16*)(a.ws + WS_CVT) + (size_t)(b * 8 + h) * 64 * 256 + vro * 256 + vch * 8;
    v4u gk[4], gv[4];
#define AT_GLOAD(t_) do { const int tt_ = (t_); \
        if (LAT && tt_ < 8) { _Pragma("unroll") for (int i_ = 0; i_ < 4; ++i_) { gk[i_] = *(const v4u*)(gKc + (size_t)(tt_ * 32 + 8 * i_) * 64); gv[i_] = *(const v4u*)(gVc + (size_t)(16 * i_) * 256 + 32 * tt_); } } \
        else { const int tk_ = LAT ? (rs + ((tt_ - 8) >> 1)) * 64 + ((tt_ - 8) & 1) * 32 : 32 * tt_; \
            _Pragma("unroll") for (int i_ = 0; i_ < 4; ++i_) { gk[i_] = *(const v4u*)(gKl + (size_t)(tk_ + 8 * i_) * 512); gv[i_] = *(const v4u*)(gVl + (size_t)(16 * i_) * (LAT ? 1024 : 256) + tk_); } } } while (0)
    const int kwoff = kro * 128 + ((kch ^ (kro & 7)) << 4);
    const int vwoff = vro * 64 + ((vch ^ ((vro >> 2) & 3)) << 4);
#define AT_LWRITE() do { _Pragma("unroll") for (int i_ = 0; i_ < 4; ++i_) { *(LAS v4u*)(lk + kwoff + i_ * 1024) = gk[i_]; *(LAS v4u*)(lv + vwoff + i_ * 1024) = gv[i_]; } } while (0)
    const int kroff = r * 128, ksw = r & 7, vsw = (r >> 2) & 3;
    bf16x8 kf[4], vf[4];
#define AT_LREAD() do { _Pragma("unroll") for (int s_ = 0; s_ < 4; ++s_) kf[s_] = *(const LAS bf16x8*)(lk + kroff + (((2 * s_ + hh) ^ ksw) << 4)); \
        _Pragma("unroll") for (int q_ = 0; q_ < 4; ++q_) vf[q_] = *(const LAS bf16x8*)(lv + (32 * (q_ >> 1) + r) * 64 + (((2 * (q_ & 1) + hh) ^ vsw) << 4)); } while (0)
    bf16x8 qf[4];
    { const bf16* Pq = Qb + (size_t)rowq * 512 + h * 64 + 8 * hh;
#pragma unroll
      for (int s = 0; s < 4; ++s) qf[s] = *(const bf16x8*)(Pq + 16 * s); }
    float m = -3.0e38f, l = 0.f; f32x16 o0 = {}, o1 = {};
    const float sc = 0.125f * LOG2E;
#define AT_SOFTPV() \
        float tm = S[0]; _Pragma("unroll") for (int i = 1; i < 16; ++i) tm = fmaxf(tm, S[i]); \
        tm = fmaxf(tm, __shfl_xor(tm, 32)); \
        if (__any(tm > m)) { const float mn = fmaxf(m, tm); const float al = __builtin_amdgcn_exp2f(m - mn); m = mn; l *= al; o0 = o0 * al; o1 = o1 * al; }     \
        float ps = 0.f; _Pragma("unroll") for (int i = 0; i < 16; ++i) { S[i] = __builtin_amdgcn_exp2f(S[i] - m); ps += S[i]; } \
        l += ps; \
        const bf16x8 p0_ = pack_regs(S, 0), p1_ = pack_regs(S, 1); \
        o0 = MFMA32(vf[0], p0_, o0); o0 = MFMA32(vf[1], p1_, o0); o1 = MFMA32(vf[2], p0_, o1); o1 = MFMA32(vf[3], p1_, o1);
#define AT_STEP(t_, LOCAL_) do { AT_LREAD(); AT_GLOAD(min((t_) + 1, NT - 1)); \
        f32x16 S = {}; _Pragma("unroll") for (int s_ = 0; s_ < 4; ++s_) S = MFMA32(kf[s_], qf[s_], S); \
        if (LOCAL_) { const int tl_ = (t_) - 8; const LAS float* rp_ = rpb + (tl_ >> 1) * 32; \
            if (tl_ & 1) { _Pragma("unroll") for (int i = 0; i < 16; ++i) S[i] = S[i] * sc + rp_[boff[1][i]]; } \
            else { _Pragma("unroll") for (int i = 0; i < 16; ++i) S[i] = S[i] * sc + rp_[boff[0][i]]; } } \
        else { _Pragma("unroll") for (int i = 0; i < 16; ++i) S[i] *= sc; } \
        AT_SOFTPV() \
        AT_LWRITE(); } while (0)
    AT_GLOAD(0); AT_LWRITE();
    if (LAT) {
        for (int t = 0; t < 8; ++t) AT_STEP(t, false);
        for (int t = 8; t < NT; ++t) AT_STEP(t, true);
    } else {
        for (int t = 0; t < NT; ++t) AT_STEP(t, false);
    }
#undef AT_GLOAD
#undef AT_LWRITE
#undef AT_LREAD
#undef AT_SOFTPV
#undef AT_STEP
    l += __shfl_xor(l, 32);
    store_o(ONA + (size_t)rowq * 1024 + h * 64, o0, o1, 1.0f / l, hh);
    LDS_WAIT();
}

__device__ __forceinline__ void conv_task(const Args& a, int task, int lane, LAS unsigned char* wl) {
    const int hd = task & 7, part = (task >> 3) % 3, chunk = task / 24, r0 = chunk * 64;
    const bf16* P = (const bf16*)(a.ws + WS_PA);
    int seq0, T_, sb_;
    if (r0 < M_CTX) { seq0 = r0 & ~255; T_ = 256; sb_ = (r0 >> 8) * 8 + hd; } else { seq0 = M_CTX + ((r0 - M_CTX) & ~1023); T_ = 1024; sb_ = ((r0 - M_CTX) >> 10) * 8 + hd; }
    const int seq1 = seq0 + T_, kc = (r0 - seq0) >> 6, NC = T_ >> 6;
    const int ch = part * 512 + hd * 64 + lane;
    float w[5];
#pragma unroll
    for (int t = 0; t < 5; ++t) w[t] = a.in[I_CONVW][t * 1536 + ch];
    const bf16* src = P + C_DN + ch;
    float x[68];
    {
        unsigned raw[68];
#pragma unroll
        for (int i = 0; i < 68; ++i) { const int row = r0 - 2 + i; const int rc = min(max(row, seq0), seq1 - 1); raw[i] = src[(size_t)rc * LDA_]; }
        asm volatile("" ::: "memory");
#pragma unroll
        for (int i = 0; i < 68; ++i) { const int row = r0 - 2 + i; x[i] = (row >= seq0 && row < seq1) ? bflo(raw[i]) : 0.f; }
    }
    float o[64];
#pragma unroll
    for (int rr = 0; rr < 64; ++rr) { const float v = w[0] * x[rr] + w[1] * x[rr + 1] + w[2] * x[rr + 2] + w[3] * x[rr + 3] + w[4] * x[rr + 4]; o[rr] = silu_(v); }
    if (part < 2) {
#pragma unroll
        for (int rr = 0; rr < 64; ++rr) { const float ss = wave_sum_dpp(o[rr] * o[rr]); o[rr] *= __builtin_amdgcn_rsqf(ss + 1e-6f); }
        const int p = swap23(lane), pc = p >> 3, pe = (p & 7) * 2;
#pragma unroll
        for (int rr = 0; rr < 64; ++rr) *(LAS bf16*)(wl + rr * 128 + ((pc ^ (rr & 7)) << 4) + pe) = (bf16)f2bf(o[rr]);
        LDS_WAIT();
        const int fr_ = lane & 31, fh_ = lane >> 5;
        bf16* dst = (bf16*)a.out + (size_t)part * MT * 512 + (size_t)((r0 < M_CTX ? 512 + sb_ * 4 : sb_ * 16) + kc) * 4096 + lane * 8;
#pragma unroll
        for (int f = 0; f < 8; ++f) { const int row = 32 * (f >> 2) + fr_; *(v4u*)(dst + f * 512) = *(const LAS v4u*)(wl + row * 128 + (((2 * (f & 3) + fh_) ^ (row & 7)) << 4)); }
        LDS_WAIT();
    }
    if (part == 1) {
        const int td0 = (r0 < M_CTX ? 512 + sb_ * 4 : sb_ * 16), ib = lane >> 5, rl = lane & 31;
        bf16* ktf = (bf16*)(a.ws + WS_KT) + (size_t)(td0 + kc) * 4096 + ib * 2048 + rl * 8;
        bf16* ktb = (bf16*)(a.ws + WS_KT) + (size_t)MT * 512 + (size_t)(td0 + NC - 1 - kc) * 4096 + ib * 2048 + rl * 8;
#pragma unroll
        for (int q = 0; q < 8; ++q) { v4u wf, wb;
            wf.x = pk2(o[swap23(8 * q + 0)], o[swap23(8 * q + 1)]); wf.y = pk2(o[swap23(8 * q + 2)], o[swap23(8 * q + 3)]); wf.z = pk2(o[swap23(8 * q + 4)], o[swap23(8 * q + 5)]); wf.w = pk2(o[swap23(8 * q + 6)], o[swap23(8 * q + 7)]);
            wb.x = pk2(o[63 - swap23(8 * q + 0)], o[63 - swap23(8 * q + 1)]); wb.y = pk2(o[63 - swap23(8 * q + 2)], o[63 - swap23(8 * q + 3)]); wb.z = pk2(o[63 - swap23(8 * q + 4)], o[63 - swap23(8 * q + 5)]); wb.w = pk2(o[63 - swap23(8 * q + 6)], o[63 - swap23(8 * q + 7)]);
            const int off = (q >> 1) * 512 + (q & 1) * 256;
            *(v4u*)(ktf + off) = wf; *(v4u*)(ktb + off) = wb; }
    }
    if (part == 2) {
        const int jw = lane >> 5, r = lane & 31;
        const int td0 = (r0 < M_CTX ? 512 + sb_ * 4 : sb_ * 16);
        const float* BA = (const float*)(a.ws + WS_BA) + (size_t)(r0 + lane) * 32 + hd;
        const float bet[2] = {sigm_(BA[0]), sigm_(BA[8])};
#pragma unroll
        for (int dd = 0; dd < 2; ++dd) {
            float ov[64];
#pragma unroll
            for (int rr = 0; rr < 64; ++rr) ov[rr] = o[rr] * __builtin_bit_cast(float, __builtin_amdgcn_readlane(__builtin_bit_cast(int, bet[dd]), rr));
            const int taskd = td0 + (dd ? NC - 1 - kc : kc);
            bf16* base = (dd ? (bf16*)(a.ws + WS_VCB) : (bf16*)a.out + (size_t)2 * MT * 512) + ((size_t)(taskd * 2 + jw) * 2 * 64 + r) * 16;
#pragma unroll
            for (int cb = 0; cb < 2; ++cb)
#pragma unroll
                for (int hh = 0; hh < 2; ++hh) { v4u w0, w1;
#define CV(g_) ov[dd ? 63 - (32 * cb + crow((g_), hh)) : (32 * cb + crow((g_), hh))]
                    w0.x = pk2(CV(0), CV(1)); w0.y = pk2(CV(2), CV(3)); w0.z = pk2(CV(4), CV(5)); w0.w = pk2(CV(6), CV(7));
                    w1.x = pk2(CV(8), CV(9)); w1.y = pk2(CV(10), CV(11)); w1.z = pk2(CV(12), CV(13)); w1.w = pk2(CV(14), CV(15));
#undef CV
                    bf16* dp = base + (size_t)(cb * 64 + hh * 32) * 16; *(v4u*)dp = w0; *(v4u*)(dp + 8) = w1; }
        }
    }
}

__device__ __forceinline__ void conv_wait(const unsigned* tf, int g, int lane) {
    const int chunk = g / 3, part = g - 3 * chunk, pm = chunk >> 2;
    int pmh = -1;
    if (pm >= 32) { const int kc = (chunk - 128) & 15; if ((chunk & 3) == 0 && kc != 0) pmh = pm - 1; if ((chunk & 3) == 3 && kc != 15) pmh = pm + 1; }
    int idx = -1;
    if (lane < 2) idx = pm * 8 + 2 * part + lane;
    else if (lane < 4) idx = pmh < 0 ? -1 : pmh * 8 + 2 * part + (lane - 2);
    else if (lane == 4) idx = part == 2 ? pm * 8 + 6 : -1;
    unsigned sp = 0;
    for (;;) {
        unsigned v = 8u;
        if (idx >= 0) v = __hip_atomic_load(tf + idx, __ATOMIC_RELAXED, __HIP_MEMORY_SCOPE_AGENT);
        if (__ballot(v < 8u) == 0ull) break;
        __builtin_amdgcn_s_sleep(8); if (++sp > (1u << 20)) break;
    }
    __builtin_amdgcn_fence(__ATOMIC_ACQUIRE, "agent");
}
__device__ __forceinline__ void phase_conv(const Args& a, LAS unsigned char* lds, int vcu, int G) {
    const int tid = threadIdx.x, wave = __builtin_amdgcn_readfirstlane(tid >> 6);
    unsigned* ctl = (unsigned*)(a.ws + WS_CTL); const unsigned* tf = ctl + CW_TF; const unsigned* order = (const unsigned*)(a.ws + WS_CORD);
    LAS int* qslot = (LAS int*)(lds + 65536);
    int nx = 0;
    if (tid == 0) nx = (int)__hip_atomic_fetch_add(ctl + CW_CQ, 1u, __ATOMIC_RELAXED, __HIP_MEMORY_SCOPE_AGENT);
    for (;;) {
        if (tid == 0) *qslot = nx;
        __syncthreads();
        const int rk = *qslot;
        if (rk >= 576) break;
        const int g = __builtin_amdgcn_readfirstlane((int)order[rk]);
        if (wave == 0) conv_wait(tf, g, tid);
        __syncthreads();
        if (tid == 0) nx = (int)__hip_atomic_fetch_add(ctl + CW_CQ, 1u, __ATOMIC_RELAXED, __HIP_MEMORY_SCOPE_AGENT);
        { int lane = tid & 63; asm volatile("" : "+v"(lane)); conv_task(a, g * 8 + wave, lane, lds + wave * 8192); }
    }
}

__device__ __forceinline__ bf16* rec_ptr(unsigned char* ws, int task) { return task < REC_SPLIT ? (bf16*)(ws + WS_REC0) + (size_t)task * 10240 : (bf16*)(ws + WS_PA) + (size_t)(task - REC_SPLIT) * 10240; }
struct DnChain { int b, h, dir, T, rowbase, task0; bool lat; };
__device__ __forceinline__ DnChain dn_decode(int chain) {
    DnChain d; d.lat = chain < 64;
    if (d.lat) { d.b = chain >> 4; d.h = (chain >> 1) & 7; d.dir = chain & 1; d.T = 1024; d.rowbase = M_CTX + d.b * 1024; d.task0 = chain * 16; }
    else { const int c = chain - 64; d.b = c >> 4; d.h = (c >> 1) & 7; d.dir = c & 1; d.T = 256; d.rowbase = d.b * 256; d.task0 = 1024 + c * 4; }
    return d;
}

__device__ __forceinline__ void dn_pre_task(const Args& a, int task, LAS float* LT, LAS float* tab, int lane) {
    int chain, n;
    if (task < 1024) { chain = task >> 4; n = task & 15; } else { const int t2 = task - 1024; chain = 64 + (t2 >> 2); n = t2 & 3; }
    const DnChain d = dn_decode(chain);
    const int h = d.h, dir = d.dir;
    const bf16* DQ = (const bf16*)a.out; const bf16* DK = DQ + (size_t)MT * 512;
    const float* BA = (const float*)(a.ws + WS_BA);
    bf16* rec = rec_ptr(a.ws, task); bf16* Tm = rec; bf16* QKm = rec + 3072; bf16* Kb = rec + 6144;
    float* SC = (float*)(a.ws + WS_SC) + (size_t)task * 320;
    const int R0 = d.rowbase + (dir ? d.T - 1 - 64 * n : 64 * n), RS = dir ? -1 : 1;
    const int r = lane & 31, hh = lane >> 5;
    {
        const float* ba = BA + (size_t)(R0 + lane * RS) * 32;
        const float beta = sigm_(ba[dir * 8 + h]);
        const float xx = ba[16 + dir * 8 + h] + a.in[I_DTB][dir * 8 + h];
        const float sp = xx > 20.f ? xx : log1pf(__expf(xx));
        float gc = -__expf(a.in[I_ALOG][dir * 8 + h]) * sp;
#pragma unroll
        for (int o = 1; o < 64; o <<= 1) { const float t = __shfl_up(gc, o); if (lane >= o) gc += t; }
        const float gl = __shfl(gc, 63);
        const float eg = __expf(gc);
        SC[lane] = beta; SC[64 + lane] = beta * eg; SC[128 + lane] = 0.125f * eg; SC[192 + lane] = __expf(gl - gc); SC[256 + lane] = __expf(gl);
        LDS_WAIT();
        tab[lane] = gc; tab[64 + lane] = beta;
        LDS_WAIT();
    }
    bf16x8 kf[2][4], qf[2][4];
    { const int gF = (d.lat ? (d.b * 8 + h) * 16 : 512 + (d.b * 8 + h) * 4) + (dir ? (d.T >> 6) - 1 - n : n);
      const size_t fo = (size_t)gF * 4096 + (dir ? (hh * 32 + 31 - r) : lane) * 8;
#pragma unroll
      for (int cb = 0; cb < 2; ++cb)
#pragma unroll
        for (int s = 0; s < 4; ++s) { const size_t o_ = fo + ((dir ? 1 - cb : cb) * 4 + s) * 512; kf[cb][s] = *(const bf16x8*)(DK + o_); qf[cb][s] = *(const bf16x8*)(DQ + o_); } }
    asm volatile("" ::: "memory");
    const float gcol0 = tab[r], gcol1 = tab[32 + r];
#pragma unroll
    for (int cb = 0; cb < 2; ++cb) { const float coef = -tab[64 + 32 * cb + r] * __expf(cb ? gcol1 : gcol0);
#pragma unroll
        for (int s = 0; s < 4; ++s) { const v4u kw = __builtin_bit_cast(v4u, kf[cb][s]); v4u ow;
            ow.x = pk2(bflo(kw.x) * coef, bfhi(kw.x) * coef); ow.y = pk2(bflo(kw.y) * coef, bfhi(kw.y) * coef); ow.z = pk2(bflo(kw.z) * coef, bfhi(kw.z) * coef); ow.w = pk2(bflo(kw.w) * coef, bfhi(kw.w) * coef);
            *(v4u*)(Kb + (4 * cb + s) * 512 + lane * 8) = ow; } }
#pragma unroll
    for (int tile = 0; tile < 3; tile += 2) {
        const int cb = tile == 0 ? 0 : 1, cbp = cb;
        f32x16 acc = {};
#pragma unroll
        for (int s = 0; s < 4; ++s) acc = MFMA32(kf[cb][s], kf[cbp][s], acc);
        const float gcol = cbp ? gcol1 : gcol0; const int cp = 32 * cbp + r;
#pragma unroll
        for (int g = 0; g < 4; ++g) {
            const f32x4 gr = *(const LAS f32x4*)(tab + 32 * cb + 8 * g + 4 * hh), br = *(const LAS f32x4*)(tab + 64 + 32 * cb + 8 * g + 4 * hh);
            f32x4 v;
#pragma unroll
            for (int j = 0; j < 4; ++j) { const int c = 32 * cb + 8 * g + 4 * hh + j; v[j] = (cp < c) ? br[j] * acc[4 * g + j] * __expf(gr[j] - gcol) : 0.f; }
            *(LAS f32x4*)(LT + cp * 68 + 32 * cb + 8 * g + 4 * hh) = v;
        }
    }
    bf16x8 l21[2];
    {
        f32x16 acc = {};
#pragma unroll
        for (int s = 0; s < 4; ++s) acc = MFMA32(kf[0][s], kf[1][s], acc);
        const float bb = tab[96 + r];
#pragma unroll
        for (int g = 0; g < 4; ++g) { const f32x4 ga = *(const LAS f32x4*)(tab + 8 * g + 4 * hh);
#pragma unroll
            for (int j = 0; j < 4; ++j) acc[4 * g + j] = bb * acc[4 * g + j] * __expf(gcol1 - ga[j]); }
        l21[0] = pack_regs(acc, 0); l21[1] = pack_regs(acc, 1);
    }
#pragma unroll
    for (int tile = 0; tile < 3; ++tile) {
        const int cb = tile == 0 ? 0 : 1, cbp = tile == 2 ? 1 : 0;
        f32x16 acc = {};
#pragma unroll
        for (int s = 0; s < 4; ++s) acc = MFMA32(kf[cbp][s], qf[cb][s], acc);
        const float gcc = cb ? gcol1 : gcol0; const int c = 32 * cb + r;
#pragma unroll
        for (int g = 0; g < 4; ++g) {
            const f32x4 gr = *(const LAS f32x4*)(tab + 32 * cbp + 8 * g + 4 * hh);
#pragma unroll
            for (int j = 0; j < 4; ++j) { const int cp = 32 * cbp + 8 * g + 4 * hh + j; acc[4 * g + j] = (cp <= c) ? 0.125f * acc[4 * g + j] * __expf(gcc - gr[j]) : 0.f; }
        }
#pragma unroll
        for (int s = 0; s < 2; ++s) *(bf16x8*)(QKm + (2 * tile + s) * 512 + lane * 8) = pack_regs(acc, s);
    }
    LDS_WAIT();
    {
        float tb[32]; float zero_ = 0.f; asm volatile("" : "+v"(zero_));
#pragma unroll
        for (int i = 0; i < 32; ++i) tb[i] = zero_;
        const int bI = lane >> 5, rl = lane & 31;
        const LAS float* LTb = LT + (32 * bI) * 68 + 32 * bI;
#pragma unroll
        for (int nn = 31; nn >= 0; --nn) {
            float a0 = (rl == nn) ? 1.f : 0.f, a1 = 0.f;
            const LAS float* lrow = LTb + nn * 68;
            if (nn < 30) asm volatile("" : "+v"(lrow) : "v"(tb[nn < 30 ? nn + 2 : 31]));
#pragma unroll
            for (int m4 = (nn + 1) / 4; m4 < 8; ++m4) { const f32x4 lr = *(const LAS f32x4*)(lrow + 4 * m4);
                a0 -= lr[0] * tb[4 * m4]; a1 -= lr[1] * tb[4 * m4 + 1]; a0 -= lr[2] * tb[4 * m4 + 2]; a1 -= lr[3] * tb[4 * m4 + 3]; }
            tb[nn] = a0 + a1;
        }
        { bf16* dst = Tm + (lane < 32 ? 0 : 4 * 512) + rl * 8;
#pragma unroll
          for (int q = 0; q < 4; ++q) { v4u w;
              w.x = pk2(tb[swap23(8 * q + 0)], tb[swap23(8 * q + 1)]); w.y = pk2(tb[swap23(8 * q + 2)], tb[swap23(8 * q + 3)]);
              w.z = pk2(tb[swap23(8 * q + 4)], tb[swap23(8 * q + 5)]); w.w = pk2(tb[swap23(8 * q + 6)], tb[swap23(8 * q + 7)]);
              *(v4u*)(dst + (q >> 1) * 512 + (q & 1) * 256) = w; } }
        LDS_WAIT();
        LAS float* TT = LT;
#pragma unroll
        for (int q = 0; q < 8; ++q) *(LAS f32x4*)(TT + lane * 36 + 4 * q) = (f32x4){tb[4 * q], tb[4 * q + 1], tb[4 * q + 2], tb[4 * q + 3]};
        LDS_WAIT();
        bf16x8 b11[2], t22[2];
#pragma unroll
        for (int s = 0; s < 2; ++s) {
            float c11[8];
#pragma unroll
            for (int j = 0; j < 8; ++j) c11[j] = TT[(16 * s + 8 * (j >> 2) + 4 * hh + (j & 3)) * 36 + r];
            const f32x4 ra = *(const LAS f32x4*)(TT + (32 + r) * 36 + 16 * s + 4 * hh), rb = *(const LAS f32x4*)(TT + (32 + r) * 36 + 16 * s + 8 + 4 * hh);
            v4u w1, w2;
            w1.x = pk2(c11[0], c11[1]); w1.y = pk2(c11[2], c11[3]); w1.z = pk2(c11[4], c11[5]); w1.w = pk2(c11[6], c11[7]);
            w2.x = pk2(ra[0], ra[1]); w2.y = pk2(ra[2], ra[3]); w2.z = pk2(rb[0], rb[1]); w2.w = pk2(rb[2], rb[3]);
            b11[s] = __builtin_bit_cast(bf16x8, w1); t22[s] = __builtin_bit_cast(bf16x8, w2);
        }
        f32x16 W = {};
        W = MFMA32(l21[0], b11[0], W); W = MFMA32(l21[1], b11[1], W);
        const bf16x8 wp0 = pack_regs(W, 0), wp1 = pack_regs(W, 1);
        f32x16 X = {};
        X = MFMA32(wp0, t22[0], X); X = MFMA32(wp1, t22[1], X);
#pragma unroll
        for (int g = 0; g < 16; ++g) X[g] = -X[g];
#pragma unroll
        for (int s = 0; s < 2; ++s) *(bf16x8*)(Tm + (2 + s) * 512 + lane * 8) = pack_regs(X, s);
    }
    LDS_WAIT();
}
__device__ __forceinline__ void phase_attn_pre(const Args& a, LAS unsigned char* lds, int vcu, int G) {
    const int tid = threadIdx.x, wave = __builtin_amdgcn_readfirstlane(tid >> 6);
    LAS float* LT = (LAS float*)(lds + wave * 17408); LAS float* tab = (LAS float*)(lds + 139264 + wave * 512);
#define MIX_LANE() int lane = tid & 63; asm volatile("" : "+v"(lane))
    if (G == 256) {
#ifndef AP_REP_A
#define AP_REP_A 1
#endif
#ifndef AP_REP_P
#define AP_REP_P 1
#endif
        if (vcu < 128) { for (int q = 0; q < AP_REP_A; ++q) { MIX_LANE(); attn_task<true>(a, vcu * 8 + wave, lane, LT); } for (int q = 0; q < AP_REP_P; ++q) { MIX_LANE(); dn_pre_task(a, vcu * 8 + wave, LT, tab, lane); } }
        else { const int j = vcu - 128;
            for (int q = 0; q < AP_REP_A; ++q) { MIX_LANE(); attn_task<false>(a, j * 8 + wave, lane, LT); } for (int q = 0; q < AP_REP_P; ++q) { MIX_LANE(); dn_pre_task(a, 1024 + j * 8 + wave, LT, tab, lane); }
            for (int q = 0; q < AP_REP_P; ++q) { MIX_LANE(); dn_pre_task(a, 2048 + j * 8 + wave, LT, tab, lane); } }
    } else {
        for (int t = wave * G + vcu; t < 1024 + 2048 + 3072; t += G * NWAVES) { MIX_LANE();
            if (t < 1024) attn_task<true>(a, t, lane, LT); else if (t < 3072) attn_task<false>(a, t - 1024, lane, LT); else dn_pre_task(a, t - 3072, LT, tab, lane); }
    }
#undef MIX_LANE
}

__device__ __forceinline__ void dn_scan_task(const Args& a, int wt, int lane) {
    const int chain = wt >> 1, jw = wt & 1;
    const DnChain d = dn_decode(chain);
    const int h = d.h, dir = d.dir, NC = d.T >> 6, T = d.T;
    const int r = lane & 31, hh = lane >> 5, jcol = 32 * jw + r;
    const bf16* DQ = (const bf16*)a.out;
    const bf16* VC = dir ? (const bf16*)(a.ws + WS_VCB) : DQ + (size_t)2 * MT * 512;
    const bf16* KTs = (const bf16*)(a.ws + WS_KT) + (dir ? (size_t)MT * 512 : 0);
    bf16* OUTO = dir ? (bf16*)(a.ws + WS_W1) : (bf16*)a.out + (size_t)MT * 512;
    const int RS = dir ? -1 : 1;
    f32x16 S[2];
    if (d.lat) { const float* s0 = a.in[I_ST] + ((size_t)((d.b * 2 + dir) * 8 + h) * 64) * 64 + jcol;
#pragma unroll
        for (int ib = 0; ib < 2; ++ib)
#pragma unroll
            for (int g = 0; g < 16; ++g) S[ib][g] = s0[(32 * ib + crow(g, hh)) * 64]; }
    else { S[0] = (f32x16){}; S[1] = (f32x16){}; }
    for (int n = 0; n < NC; ++n) {
        int ln = lane; asm volatile("" : "+v"(ln));
        const int r = ln & 31, hh = ln >> 5;
        const int task = d.task0 + n;
        const int taskd = (d.lat ? (d.b * 8 + h) * 16 : 512 + (d.b * 8 + h) * 4) + n;
        const int R0 = d.rowbase + (dir ? T - 1 - 64 * n : 64 * n);
        const bf16* rec = rec_ptr(a.ws, task) + ln * 8; const bf16* Tm = rec; const bf16* QKm = rec + 3072; const bf16* Kb = rec + 6144;
        const float* SC = (const float*)(a.ws + WS_SC) + (size_t)task * 320 + 4 * hh;
        const bf16* vc = VC + ((size_t)(taskd * 2 + jw) * 2 * 64 + ln) * 16;
        const bf16* kt = KTs + (size_t)taskd * 4096 + ln * 8;
        bf16* oo = OUTO + (size_t)(taskd * 2 + jw) * 2 * 16 * 64 + ln;
        const bf16* qbase = DQ + (size_t)((d.lat ? (d.b * 8 + h) * 16 : 512 + (d.b * 8 + h) * 4) + (dir ? NC - 1 - n : n)) * 4096 + (dir ? (hh * 32 + 31 - r) : ln) * 8;
        const int qo0 = dir ? 2048 : 0, qo1 = dir ? 0 : 2048;
        bf16x8 fk[2][4], fq[2][4]; v4u vv[2][2]; f32x4 s2[2][4];
#pragma unroll
        for (int cb = 0; cb < 2; ++cb) {
            const bf16* qp = qbase + (cb ? qo1 : qo0);
#pragma unroll
            for (int k4 = 0; k4 < 4; ++k4) { fk[cb][k4] = *(const bf16x8*)(Kb + (4 * cb + k4) * 512); fq[cb][k4] = *(const bf16x8*)(qp + k4 * 512); }
            vv[cb][0] = *(const v4u*)(vc + cb * 1024); vv[cb][1] = *(const v4u*)(vc + cb * 1024 + 8);
#pragma unroll
            for (int g = 0; g < 4; ++g) s2[cb][g] = *(const f32x4*)(SC + 128 + 32 * cb + 8 * g);
        }
        asm volatile("" ::: "memory");
        bf16x8 sb[2][2];
#pragma unroll
        for (int ib = 0; ib < 2; ++ib)
#pragma unroll
            for (int s = 0; s < 2; ++s) sb[ib][s] = pack_regs(S[ib], s);
        f32x16 X[2], o[2];
#pragma unroll
        for (int cb = 0; cb < 2; ++cb) {
            f32x16 ax, ao = {};
            { const v4u va = vv[cb][0], vb_ = vv[cb][1];
              ax = (f32x16){bflo(va.x), bfhi(va.x), bflo(va.y), bfhi(va.y), bflo(va.z), bfhi(va.z), bflo(va.w), bfhi(va.w),
                            bflo(vb_.x), bfhi(vb_.x), bflo(vb_.y), bfhi(vb_.y), bflo(vb_.z), bfhi(vb_.z), bflo(vb_.w), bfhi(vb_.w)}; }
#pragma unroll
            for (int ib = 0; ib < 2; ++ib)
#pragma unroll
                for (int s = 0; s < 2; ++s) { ax = MFMA32(fk[cb][2 * ib + s], sb[ib][s], ax); ao = MFMA32(fq[cb][2 * ib + s], sb[ib][s], ao); }
#pragma unroll
            for (int g = 0; g < 4; ++g)
#pragma unroll
                for (int j = 0; j < 4; ++j) ao[4 * g + j] *= s2[cb][g][j];
            X[cb] = ax; o[cb] = ao;
        }
        bf16x8 ft[3][2], fm[3][2], fkt[2][4]; f32x4 s3[2][4];
#pragma unroll
        for (int bl = 0; bl < 3; ++bl) { const int cb = bl == 0 ? 0 : 1, cbp = bl == 2 ? 1 : 0;
#pragma unroll
            for (int s = 0; s < 2; ++s) { ft[bl][s] = *(const bf16x8*)(Tm + (2 * bl + s) * 512); fm[bl][s] = *(const bf16x8*)(QKm + (2 * bl + s) * 512); } }
#pragma unroll
        for (int ib = 0; ib < 2; ++ib)
#pragma unroll
            for (int k4 = 0; k4 < 4; ++k4) fkt[ib][k4] = *(const bf16x8*)(kt + (4 * ib + k4) * 512);
        asm volatile("" ::: "memory");
        f32x16 vn[2];
        {
            bf16x8 xb[2][2];
#pragma unroll
            for (int cb = 0; cb < 2; ++cb)
#pragma unroll
                for (int s = 0; s < 2; ++s) xb[cb][s] = pack_regs(X[cb], s);
            f32x16 a0 = {}, a1 = {};
            a0 = MFMA32(ft[0][0], xb[0][0], a0); a0 = MFMA32(ft[0][1], xb[0][1], a0);
            a1 = MFMA32(ft[1][0], xb[0][0], a1); a1 = MFMA32(ft[1][1], xb[0][1], a1); a1 = MFMA32(ft[2][0], xb[1][0], a1); a1 = MFMA32(ft[2][1], xb[1][1], a1);
            vn[0] = a0; vn[1] = a1;
        }
        {
            bf16x8 vb[2][2];
#pragma unroll
            for (int cb = 0; cb < 2; ++cb)
#pragma unroll
                for (int s = 0; s < 2; ++s) vb[cb][s] = pack_regs(vn[cb], s);
            f32x16 a0 = o[0], a1 = o[1];
            a0 = MFMA32(fm[0][0], vb[0][0], a0); a0 = MFMA32(fm[0][1], vb[0][1], a0);
            a1 = MFMA32(fm[1][0], vb[0][0], a1); a1 = MFMA32(fm[1][1], vb[0][1], a1); a1 = MFMA32(fm[2][0], vb[1][0], a1); a1 = MFMA32(fm[2][1], vb[1][1], a1);
#pragma unroll
            for (int g = 0; g < 16; ++g) { oo[g * 64] = (bf16)f2bf(a0[g]); oo[(16 + g) * 64] = (bf16)f2bf(a1[g]); }
        }
        {
#pragma unroll
            for (int cb = 0; cb < 2; ++cb)
#pragma unroll
                for (int g = 0; g < 4; ++g) s3[cb][g] = *(const f32x4*)(SC + 192 + 32 * cb + 8 * g);
            const float egl = SC[256];
#pragma unroll
            for (int cb = 0; cb < 2; ++cb)
#pragma unroll
                for (int g = 0; g < 4; ++g)
#pragma unroll
                    for (int j = 0; j < 4; ++j) vn[cb][4 * g + j] *= s3[cb][g][j];
            bf16x8 vb[2][2];
#pragma unroll
            for (int cb = 0; cb < 2; ++cb)
#pragma unroll
                for (int s = 0; s < 2; ++s) vb[cb][s] = pack_regs(vn[cb], s);
#pragma unroll
            for (int ib = 0; ib < 2; ++ib) { f32x16 acc = S[ib] * egl;
#pragma unroll
                for (int cb = 0; cb < 2; ++cb)
#pragma unroll
                    for (int s = 0; s < 2; ++s) acc = MFMA32(fkt[ib][2 * cb + s], vb[cb][s], acc);
                S[ib] = acc; }
        }
    }
    if (!d.lat) { float* so = a.out + OUT_S + ((size_t)((d.b * 2 + dir) * 8 + h) * 64) * 64 + jcol;
#pragma unroll
        for (int ib = 0; ib < 2; ++ib)
#pragma unroll
            for (int g = 0; g < 16; ++g) so[(32 * ib + crow(g, hh)) * 64] = S[ib][g]; }
}
constexpr int SL_FK = 0, SL_FQ = 8192, SL_VV = 16384, SL_SC = 20480, SL_FT = 21504, SL_FM = 27648, SL_KT = 33792, SL_BUF = 43008;
__device__ __forceinline__ void lds_dma16(const void* gsrc, unsigned lds_dst) {
    unsigned keep;
    asm volatile("s_mov_b32 %0, m0\n\ts_mov_b32 m0, %2\n\ts_nop 0\n\tglobal_load_lds_dwordx4 %1, off\n\ts_mov_b32 m0, %0" : "=&s"(keep) : "v"(gsrc), "s"(lds_dst) : "memory");
}
__device__ __forceinline__ void dn_scan_lat(const Args& a, int wt, int lane, LAS unsigned char* L) {
    const int chain = wt >> 1, jw = wt & 1;
    const DnChain d = dn_decode(chain);
    const int h = d.h, dir = d.dir; constexpr int NC = 16;
    const int r = lane & 31, hh = lane >> 5, jcol = 32 * jw + r;
    const bf16* DQ = (const bf16*)a.out;
    const bf16* VC = dir ? (const bf16*)(a.ws + WS_VCB) : DQ + (size_t)2 * MT * 512;
    const bf16* KTs = (const bf16*)(a.ws + WS_KT) + (dir ? (size_t)MT * 512 : 0);
    bf16* OUTO = dir ? (bf16*)(a.ws + WS_W1) : (bf16*)a.out + (size_t)MT * 512;
    const unsigned lbase = (unsigned)__builtin_amdgcn_readfirstlane((int)(unsigned)(uintptr_t)L);
    const int td0 = (d.b * 8 + h) * 16;
    const int qlane = dir ? (hh * 32 + 31 - r) : lane, qo0 = dir ? 2048 : 0, qo1 = dir ? 0 : 2048;
    f32x16 S[2];
    { const float* s0 = a.in[I_ST] + ((size_t)((d.b * 2 + dir) * 8 + h) * 64) * 64 + jcol;
#pragma unroll
      for (int ib = 0; ib < 2; ++ib)
#pragma unroll
          for (int g = 0; g < 16; ++g) S[ib][g] = s0[(32 * ib + crow(g, hh)) * 64]; }
#define SL_RUN(p_, cnt_, stride_, ldso_) do { const bf16* pp_ = (p_); _Pragma("unroll") for (int f = 0; f < (cnt_); ++f) { lds_dma16(pp_, lb_ + (ldso_) + f * 1024); pp_ += (stride_); asm volatile("" : "+v"(pp_)); } } while (0)
#define SL_ISSUE(n_) do { const int nn_ = (n_); const unsigned lb_ = lbase + (unsigned)((nn_ & 1) * SL_BUF); const int task_ = d.task0 + nn_, taskd_ = td0 + nn_; \
        const bf16* rec_ = rec_ptr(a.ws, task_) + lane * 8; \
        const bf16* q_ = DQ + (size_t)(td0 + (dir ? NC - 1 - nn_ : nn_)) * 4096 + qlane * 8; \
        const bf16* vc_ = VC + ((size_t)(taskd_ * 2 + jw) * 2 * 64 + lane) * 16; \
        SL_RUN(rec_ + 6144, 8, 512, SL_FK); \
        SL_RUN(q_ + qo0, 4, 512, SL_FQ); SL_RUN(q_ + qo1, 4, 512, SL_FQ + 4096); \
        lds_dma16(vc_, lb_ + SL_VV); lds_dma16(vc_ + 8, lb_ + SL_VV + 1024); lds_dma16(vc_ + 1024, lb_ + SL_VV + 2048); lds_dma16(vc_ + 1032, lb_ + SL_VV + 3072); \
        lds_dma16((const float*)(a.ws + WS_SC) + (size_t)task_ * 320 + 128 + lane * 4, lb_ + SL_SC); \
        SL_RUN(rec_, 6, 512, SL_FT); SL_RUN(rec_ + 3072, 6, 512, SL_FM); \
        SL_RUN(KTs + (size_t)taskd_ * 4096 + lane * 8, 8, 512, SL_KT); } while (0)
    SL_ISSUE(0);
    for (int n = 0; n < NC; ++n) {
        asm volatile("s_waitcnt vmcnt(0) lgkmcnt(0)" ::: "memory");
        if (n + 1 < NC) SL_ISSUE(n + 1);
        const LAS unsigned char* B = L + (n & 1) * SL_BUF + lane * 16;
        const LAS unsigned char* Bs = L + (n & 1) * SL_BUF + SL_SC + hh * 16;
#define SLF(off, f) (*(const LAS bf16x8*)(B + (off) + (f) * 1024))
        bf16x8 fk[8], fq[8]; v4u vv[4]; f32x4 s2[8];
#pragma unroll
        for (int f = 0; f < 8; ++f) { fk[f] = SLF(SL_FK, f); fq[f] = SLF(SL_FQ, f); }
#pragma unroll
        for (int f = 0; f < 4; ++f) vv[f] = *(const LAS v4u*)(B + SL_VV + f * 1024);
#pragma unroll
        for (int g = 0; g < 8; ++g) s2[g] = *(const LAS f32x4*)(Bs + (8 * g) * 4);
        asm volatile("" ::: "memory");
        bf16x8 sb[2][2];
#pragma unroll
        for (int ib = 0; ib < 2; ++ib)
#pragma unroll
            for (int s = 0; s < 2; ++s) sb[ib][s] = pack_regs(S[ib], s);
        f32x16 X[2], o[2];
#pragma unroll
        for (int cb = 0; cb < 2; ++cb) {
            f32x16 ax, ao = {};
            { const v4u va = vv[2 * cb], vb_ = vv[2 * cb + 1];
              ax = (f32x16){bflo(va.x), bfhi(va.x), bflo(va.y), bfhi(va.y), bflo(va.z), bfhi(va.z), bflo(va.w), bfhi(va.w),
                            bflo(vb_.x), bfhi(vb_.x), bflo(vb_.y), bfhi(vb_.y), bflo(vb_.z), bfhi(vb_.z), bflo(vb_.w), bfhi(vb_.w)}; }
#pragma unroll
            for (int ib = 0; ib < 2; ++ib)
#pragma unroll
                for (int s = 0; s < 2; ++s) { ax = MFMA32(fk[4 * cb + 2 * ib + s], sb[ib][s], ax); ao = MFMA32(fq[4 * cb + 2 * ib + s], sb[ib][s], ao); }
            X[cb] = ax; o[cb] = ao;
        }
        bf16x8 ft[6], fm[6];
#pragma unroll
        for (int f = 0; f < 6; ++f) { ft[f] = SLF(SL_FT, f); fm[f] = SLF(SL_FM, f); }
        asm volatile("" ::: "memory");
#pragma unroll
        for (int cb = 0; cb < 2; ++cb)
#pragma unroll
            for (int g = 0; g < 4; ++g)
#pragma unroll
                for (int j = 0; j < 4; ++j) o[cb][4 * g + j] *= s2[4 * cb + g][j];
        f32x16 vn[2];
        {
            bf16x8 xb[2][2];
#pragma unroll
            for (int cb = 0; cb < 2; ++cb)
#pragma unroll
                for (int s = 0; s < 2; ++s) xb[cb][s] = pack_regs(X[cb], s);
            f32x16 a0 = {}, a1 = {};
            a0 = MFMA32(ft[0], xb[0][0], a0); a0 = MFMA32(ft[1], xb[0][1], a0);
            a1 = MFMA32(ft[2], xb[0][0], a1); a1 = MFMA32(ft[3], xb[0][1], a1); a1 = MFMA32(ft[4], xb[1][0], a1); a1 = MFMA32(ft[5], xb[1][1], a1);
            vn[0] = a0; vn[1] = a1;
        }
        bf16x8 fkt[8]; f32x4 s3[8];
#pragma unroll
        for (int f = 0; f < 8; ++f) fkt[f] = SLF(SL_KT, f);
#pragma unroll
        for (int g = 0; g < 8; ++g) s3[g] = *(const LAS f32x4*)(Bs + (64 + 8 * g) * 4);
        const float egl = *(const LAS float*)(L + (n & 1) * SL_BUF + SL_SC + 512);
        asm volatile("" ::: "memory");
        {
            bf16x8 vb[2][2];
#pragma unroll
            for (int cb = 0; cb < 2; ++cb)
#pragma unroll
                for (int s = 0; s < 2; ++s) vb[cb][s] = pack_regs(vn[cb], s);
            f32x16 a0 = o[0], a1 = o[1];
            a0 = MFMA32(fm[0], vb[0][0], a0); a0 = MFMA32(fm[1], vb[0][1], a0);
            a1 = MFMA32(fm[2], vb[0][0], a1); a1 = MFMA32(fm[3], vb[0][1], a1); a1 = MFMA32(fm[4], vb[1][0], a1); a1 = MFMA32(fm[5], vb[1][1], a1);
            bf16* oo = OUTO + (size_t)((td0 + n) * 2 + jw) * 2 * 16 * 64 + lane;
#pragma unroll
            for (int g = 0; g < 16; ++g) { oo[g * 64] = (bf16)f2bf(a0[g]); oo[(16 + g) * 64] = (bf16)f2bf(a1[g]); }
        }
        {
#pragma unroll
            for (int cb = 0; cb < 2; ++cb)
#pragma unroll
                for (int g = 0; g < 4; ++g)
#pragma unroll
                    for (int j = 0; j < 4; ++j) vn[cb][4 * g + j] *= s3[4 * cb + g][j];
            bf16x8 vb[2][2];
#pragma unroll
            for (int cb = 0; cb < 2; ++cb)
#pragma unroll
                for (int s = 0; s < 2; ++s) vb[cb][s] = pack_regs(vn[cb], s);
#pragma unroll
            for (int ib = 0; ib < 2; ++ib) { f32x16 acc = S[ib] * egl;
#pragma unroll
                for (int cb = 0; cb < 2; ++cb)
#pragma unroll
                    for (int s = 0; s < 2; ++s) acc = MFMA32(fkt[4 * ib + 2 * cb + s], vb[cb][s], acc);
                S[ib] = acc; }
        }
#undef SLF
    }
#undef SL_ISSUE
#undef SL_RUN
    asm volatile("s_waitcnt vmcnt(0) lgkmcnt(0)" ::: "memory");
}
__device__ __forceinline__ void phase_dn_scan(const Args& a, LAS unsigned char* lds, int vcu, int G) {
    const int tid = threadIdx.x, wave = __builtin_amdgcn_readfirstlane(tid >> 6);
    if (G == 256) {
#if !defined(SCAN_NO_LAT)
        if (vcu < 128 && wave == 0) { int lane = tid & 63; asm volatile("" : "+v"(lane)); dn_scan_lat(a, vcu, lane, lds); return; }
#else
        if (vcu < 128 && wave == 0) { int lane = tid & 63; asm volatile("" : "+v"(lane)); dn_scan_task(a, vcu, lane); return; }
#endif
        if ((wave >= 1 && wave <= 3) || wave == 5) { const int k = wave <= 3 ? wave - 1 : 3; int lane = tid & 63; asm volatile("" : "+v"(lane)); dn_scan_task(a, 128 + vcu * 4 + k, lane); }
        if (vcu >= 128) { int lane = tid & 63; asm volatile("" : "+v"(lane)); attn_task<false>(a, (vcu - 128 + 128) * 8 + wave, lane, (LAS float*)(lds + wave * 17408)); }
        return;
    }
    for (int t = wave * G + vcu; t < 1152; t += G * NWAVES) { int lane = tid & 63; asm volatile("" : "+v"(lane)); dn_scan_task(a, t, lane); }
}

__device__ __forceinline__ void phase_combine(const Args& a, int vcu, int G) {
    const int tid = threadIdx.x, lane = tid & 63, wave = tid >> 6;
    const int gw = vcu * NWAVES + wave, NGW = G * NWAVES;
    const bf16* OF = (const bf16*)a.out + (size_t)MT * 512;     const bf16* OB = (const bf16*)(a.ws + WS_W1);
    const bf16* P = (const bf16*)(a.ws + WS_PB); bf16* ODN = (bf16*)(a.ws + WS_ONA) + 512;
    const f32x4 n0 = *(const f32x4*)(a.in[I_DNN] + ((8 * lane) & 63)), n1 = *(const f32x4*)(a.in[I_DNN] + ((8 * lane) & 63) + 4);
    const int hd = lane >> 3, j0 = (8 * lane) & 63, jw = j0 >> 5, r0 = j0 & 31;
    for (int m = gw; m < MT; m += NGW) {
        int tt, T_, ch0;
        if (m < M_CTX) { const int b_ = m >> 8; tt = m & 255; T_ = 256; ch0 = 64 + ((b_ * 8 + hd) << 1); }
        else { const int rl = m - M_CTX; const int b_ = rl >> 10; tt = rl & 1023; T_ = 1024; ch0 = (b_ * 8 + hd) << 1; }
        v4u w[2];
#pragma unroll
        for (int dd = 0; dd < 2; ++dd) {
            const int u = dd ? T_ - 1 - tt : tt, c = u & 63;
            const int task = (m < M_CTX ? 512 + (ch0 >> 1) * 4 - 128 : (ch0 >> 1) * 16) + (u >> 6);
            const int cb = c >> 5, hh = (c >> 2) & 1, g = ((c >> 3) & 3) * 4 + (c & 3);
            w[dd] = *(const v4u*)((dd ? OB : OF) + ((size_t)((task * 2 + jw) * 2 + cb) * 16 + g) * 64 + hh * 32 + r0);
        }
        f32x4 o0 = {bflo(w[0].x) + bflo(w[1].x), bfhi(w[0].x) + bfhi(w[1].x), bflo(w[0].y) + bflo(w[1].y), bfhi(w[0].y) + bfhi(w[1].y)};
        f32x4 o1 = {bflo(w[0].z) + bflo(w[1].z), bfhi(w[0].z) + bfhi(w[1].z), bflo(w[0].w) + bflo(w[1].w), bfhi(w[0].w) + bfhi(w[1].w)};
        float ss = (o0.x * o0.x + o0.y * o0.y) + (o0.z * o0.z + o0.w * o0.w) + (o1.x * o1.x + o1.y * o1.y) + (o1.z * o1.z + o1.w * o1.w);
        ss += __shfl_xor(ss, 1); ss += __shfl_xor(ss, 2); ss += __shfl_xor(ss, 4);
        const float rstd = rsqrtf(ss * (1.f / 64.f) + 1e-6f);
        const v4u z = *(const v4u*)(P + (size_t)m * LDB_ + CB_Z + 8 * lane);
        o0 = o0 * rstd * n0; o1 = o1 * rstd * n1;
        v4u q; q.x = pk2(o0.x * silu_(bflo(z.x)), o0.y * silu_(bfhi(z.x))); q.y = pk2(o0.z * silu_(bflo(z.y)), o0.w * silu_(bfhi(z.y)));
        q.z = pk2(o1.x * silu_(bflo(z.z)), o1.y * silu_(bfhi(z.z))); q.w = pk2(o1.z * silu_(bflo(z.w)), o1.w * silu_(bfhi(z.w)));
        *(v4u*)(ODN + (size_t)m * 1024 + 8 * lane) = q;
    }
}

__device__ __forceinline__ void phase_row1(const Args& a, int vcu, int G) {
    const int tid = threadIdx.x, lane = tid & 63, wave = tid >> 6;
    const int gw = vcu * NWAVES + wave, NGW = G * NWAVES;
    const float* MOD = (const float*)(a.ws + WS_MOD); const bf16* Y = (const bf16*)(a.ws + WS_ONA); const float* RSS = (const float*)(a.ws + WS_RSS1);
    bf16* XN = (bf16*)(a.ws + WS_XN);
    for (int m = gw; m < MT; m += NGW) {
        const f32x4* xr = (const f32x4*)x_row(a, m) + lane; const float* md = MOD + mod_idx(m) * 6144;
        float rs = 0.f;
        { const float rv = lane < 16 ? RSS[((size_t)(lane >> 2) * MT + m) * 4 + (lane & 3)] : 0.f;
          rs = rv; rs += __shfl_xor(rs, 1); rs += __shfl_xor(rs, 2); rs += __shfl_xor(rs, 4); rs += __shfl_xor(rs, 8); rs = __shfl(rs, 0); }
        const float rstd1 = rsqrtf(rs * (1.f / DM) + 1e-6f);
        f32x4 x1[4]; float s = 0.f;
        const v2u* yr = (const v2u*)(Y + (size_t)m * DM) + lane;
        v2u* x1b = (v2u*)((bf16*)(a.ws + WS_M1) + (size_t)m * DM) + lane;
#pragma unroll
        for (int j = 0; j < 4; ++j) { const int c = (lane + 64 * j) * 4; const v2u yy = NT_LD(yr + 64 * j);
            const f32x4 yv = {bflo(yy.x), bfhi(yy.x), bflo(yy.y), bfhi(yy.y)};
            const f32x4 g1 = *(const f32x4*)(md + 2048 + c), pw = *(const f32x4*)(a.in[I_POST1] + c);
            x1[j] = NT_LD(xr + 64 * j) + g1 * (yv * rstd1 * pw); { v2u o1; o1.x = pk2(x1[j].x, x1[j].y); o1.y = pk2(x1[j].z, x1[j].w); x1b[64 * j] = o1; }
            s += (x1[j].x * x1[j].x + x1[j].y * x1[j].y) + (x1[j].z * x1[j].z + x1[j].w * x1[j].w); }
        const float rstd2 = rsqrtf(wave_sum(s) * (1.f / DM) + 1e-6f);
        v2u* o8 = (v2u*)(XN + (size_t)m * DM) + lane;
#pragma unroll
        for (int j = 0; j < 4; ++j) { const int c = (lane + 64 * j) * 4;
            const f32x4 w = *(const f32x4*)(a.in[I_PRE2] + c), sh = *(const f32x4*)(md + 3072 + c), sc = *(const f32x4*)(md + 4096 + c);
            const f32x4 h = x1[j] * rstd2 * w * (sc + 1.0f) + sh;
            v2u o; o.x = pk2(h.x, h.y); o.y = pk2(h.z, h.w); o8[64 * j] = o; }
    }
}
__device__ __forceinline__ void phase_row2(const Args& a, int vcu, int G) {
    const int tid = threadIdx.x, lane = tid & 63, wave = tid >> 6;
    const int gw = vcu * NWAVES + wave, NGW = G * NWAVES;
    const float* MOD = (const float*)(a.ws + WS_MOD); const bf16* Fm = (const bf16*)(a.ws + WS_ONA); const bf16* Fe = (const bf16*)(a.ws + WS_FE); const bf16* X1 = (const bf16*)(a.ws + WS_M1);
    for (int m = gw; m < MT; m += NGW) {
        const float* md = MOD + mod_idx(m) * 6144;
        const v2u* fr = (const v2u*)(Fm + (size_t)m * DM) + lane; const v2u* fe = (const v2u*)(Fe + (size_t)m * DM) + lane;
        f32x4* orow = (f32x4*)(a.out + (size_t)m * DM) + lane;
        f32x4 fv[4], x1[4]; float s = 0.f;
#pragma unroll
        for (int j = 0; j < 4; ++j) { const v2u p = NT_LD(fr + 64 * j), q = NT_LD(fe + 64 * j); { const v2u xx = NT_LD((const v2u*)(X1 + (size_t)m * DM) + lane + 64 * j); x1[j] = (f32x4){bflo(xx.x), bfhi(xx.x), bflo(xx.y), bfhi(xx.y)}; }
            fv[j] = (f32x4){bflo(p.x) + bflo(q.x), bfhi(p.x) + bfhi(q.x), bflo(p.y) + bflo(q.y), bfhi(p.y) + bfhi(q.y)};
            s += (fv[j].x * fv[j].x + fv[j].y * fv[j].y) + (fv[j].z * fv[j].z + fv[j].w * fv[j].w); }
        const float rstd = rsqrtf(wave_sum(s) * (1.f / DM) + 1e-6f);
#pragma unroll
        for (int j = 0; j < 4; ++j) { const int c = (lane + 64 * j) * 4;
            const f32x4 g2 = *(const f32x4*)(md + 5120 + c), pw = *(const f32x4*)(a.in[I_POST2] + c);
            orow[64 * j] = x1[j] + g2 * (fv[j] * rstd * pw); }
    }
}

__device__ __forceinline__ void panel_wait(const unsigned* c, unsigned need) {
    if (threadIdx.x < 64) { unsigned sp = 0;
        while ((unsigned)__builtin_amdgcn_readfirstlane((int)__hip_atomic_load(c, __ATOMIC_RELAXED, __HIP_MEMORY_SCOPE_AGENT)) < need) { __builtin_amdgcn_s_sleep(4); if (++sp > (1u << 21)) break; }
        __builtin_amdgcn_fence(__ATOMIC_ACQUIRE, "agent");
        asm volatile("s_waitcnt vmcnt(0)" ::: "memory"); }
    __syncthreads();
}
__device__ __forceinline__ void ff2_wait(const Args& a, int vcu) {
    const int tid = threadIdx.x;
    if (tid < 64) {
        const int grp = vcu >> 2, j = vcu & 3, t0 = j < 3 ? grp * 3 + j : grp * 3, t1 = j < 3 ? t0 : grp * 3 + 2;
        const unsigned* c = (const unsigned*)(a.ws + WS_CTL) + CW_FF + 64 * ((tid & 1) ? (t1 >> 2) : (t0 >> 2));
        unsigned sp = 0;
        for (;;) { const unsigned v = tid < 2 ? __hip_atomic_load(c, __ATOMIC_RELAXED, __HIP_MEMORY_SCOPE_AGENT) : 128u;
            if (__ballot(v < 128u) == 0ull) break;
            __builtin_amdgcn_s_sleep(4); if (++sp > (1u << 21)) break; }
        __builtin_amdgcn_fence(__ATOMIC_ACQUIRE, "agent");
        asm volatile("s_waitcnt vmcnt(0)" ::: "memory");
    }
    __syncthreads();
}

constexpr int N_PHASES = 13;
__global__ void __launch_bounds__(NWAVES * 64, 2) fwd_kernel(Args args) {
    extern __shared__ __attribute__((aligned(16))) unsigned char lds_raw[];
    LAS unsigned char* lds = (LAS unsigned char*)lds_raw;
    const int tid = threadIdx.x;
    const int G = gridDim.x; const int bx = blockIdx.x; const int vcu = (G % 8 == 0) ? (bx % 8) * (G / 8) + bx / 8 : bx;
    volatile LAS unsigned* MISC = (volatile LAS unsigned*)(lds + MISC_OFF);
    for (int u = tid; u < (LDS_BYTES - LDSCTL_OFF) / 4; u += NWAVES * 64) ((LAS unsigned*)(lds + LDSCTL_OFF))[u] = 0u;
    __syncthreads();
    const int lo = args.ph_lo, hi = args.ph_hi;
    const bool one = (hi - lo) > 1;
    unsigned* ctl = (unsigned*)(args.ws + WS_CTL);
    XcdBarrier bar; bar.bar = ctl + CW_BAR; bar.x = 0; bar.st = nullptr;
    if (one) bar = xcd_barrier_post(ctl + CW_BAR, MISC + 8);
#ifndef ONLY_PHASE
#define ONLY_PHASE -1
#endif
#ifndef SKIP_MASK
#define SKIP_MASK 0
#endif
#define IN(k) ((ONLY_PHASE < 0 || ONLY_PHASE == (k)) && !((SKIP_MASK >> (k)) & 1) && lo <= (k) && (k) < hi)
#ifdef TP_A
#define TSTAMP(s) do { if (tid == 0) MISC[32 + (s)] = (unsigned)__builtin_amdgcn_s_memrealtime(); } while (0)
#else
#define TSTAMP(s) do { } while (0)
#endif
#define SEAM(k) do { if (one) xcd_barrier(bar); TSTAMP((k) + 1); } while (0)
    TSTAMP(0);
    unsigned char* ws = args.ws;
    typedef pg8::bf16_t pb;

#ifndef REPEAT_MASK
#define REPEAT_MASK 0
#endif
#define REP(k) ((REPEAT_MASK >> (k)) & 1)
#define PH_INPROJ do { pg8::Gemm g{(const pb*)(ws + WS_XN), (const pb*)(ws + WS_WIN), MT, NINP, 1024}; pg8::InProjOrder S; S.init(MT, NINP, G, bx); S.flags = (unsigned*)(ws + WS_CTL) + CW_TF; \
        pg8::EpiInProj E{(pb*)(ws + WS_PA), (pb*)(ws + WS_PB), (pb*)(ws + WS_M1), args.out + OUT_K, args.out + OUT_V, (float*)(ws + WS_BA), (pb*)args.out + (size_t)3 * MT * 512, (const float*)(ws + WS_ROPE), (pb*)(ws + WS_RF), (pb*)(ws + WS_SF)}; \
        pg8::gemm_phase<pg8::EpiInProj, pg8::InProjOrder, true, true>(lds, g, S, E); } while (0)
#define PH_GATE1(G_, c_, maxi_) do { pg8::LimitOrder S; S.init(MT, 1024, (G_), (c_)); S.maxi = (maxi_); \
        pg8::Gemm g{(const pb*)(ws + WS_ONA), (const pb*)(ws + WS_WAO), MT, 1024, 512}; pg8::EpiGate1 E{(const pb*)(ws + WS_PB), (pb*)(ws + WS_M1)}; \
        pg8::gemm_phase<pg8::EpiGate1, pg8::LimitOrder, true, true>(lds, g, S, E); } while (0)
#define PH_SCAN do { phase_dn_scan(args, lds, vcu, G); } while (0)
#define PH_MERGE do { pg8::PanelOrder S; S.init(MT, 1024, G, bx); S.cnt = (unsigned*)(ws + WS_CTL) + CW_MW; \
        if (bx >= 192) late_transposes(args, lds, bx - 192, G - 192, G == 256 ? 1 : 0, G == 256 ? 1 : 2); else if (G <= 192 && bx == 0) late_transposes(args, lds, 0, 1, 0, 2);     \
        { pg8::Gemm g{(const pb*)(ws + WS_ONA), (const pb*)(ws + WS_WAO), MT, 1024, 1024}; pg8::EpiMerge E{(const pb*)(ws + WS_RF), (const pb*)(ws + WS_SF), (pb*)(ws + WS_XN)}; \
          pg8::gemm_phase<pg8::EpiMerge, pg8::PanelOrder, true, true>(lds, g, S, E); } } while (0)
#define PH_WOUT do { pg8::Gemm g{(const pb*)(ws + WS_XN), (const pb*)(ws + WS_WOUT), MT, 1024, 1024}; pg8::StaticOrder S; S.init(MT, 1024, G, bx); \
        if (G == 256 && bx >= 192) late_transposes(args, lds, bx - 192, 64, 2, 2); \
        { pg8::Unit u0; if (S.next(0, u0)) panel_wait((const unsigned*)(ws + WS_CTL) + CW_MW + 64 * u0.pm, 32u); } \
        pg8::EpiRss E{(pb*)(ws + WS_ONA), (float*)(ws + WS_RSS1)}; pg8::gemm_phase<pg8::EpiRss, pg8::StaticOrder, true, true>(lds, g, S, E); } while (0)
#define PH_FF1 do { pg8::Gemm g{(const pb*)(ws + WS_XN), (const pb*)(ws + WS_W1), MT, FF, 1024}; pg8::PanelOrder S; S.init(MT, FF, G, bx); S.cnt = (unsigned*)(ws + WS_CTL) + CW_FF; \
        pg8::EpiRelu2 E{(pb*)(ws + WS_PA)}; pg8::gemm_phase<pg8::EpiRelu2, pg8::PanelOrder, true, true>(lds, g, S, E); } while (0)
#define PH_FF2 do { pg8::Gemm g{(const pb*)(ws + WS_PA), (const pb*)(ws + WS_W2), MT, 1024, FF}; pg8::SplitOrder S{vcu, 50, 14}; \
        pg8::EpiSplit E{(pb*)(ws + WS_ONA), (pb*)(ws + WS_FE)}; pg8::gemm_phase<pg8::EpiSplit, pg8::SplitOrder, true, true>(lds, g, S, E); } while (0)
#define RUN(k, body) do { if (IN(k)) { body; SEAM(k); if (REP(k)) { body; SEAM(k); } } } while (0)
    RUN(0, { phase_prologue(args, lds, vcu, G); phase_xn(args, vcu, G); TSTAMP(23); });
#ifdef EXP_BAR
    RUN(2, { PH_INPROJ; xcd_barrier(bar); phase_conv(args, lds, vcu, G); });
#else
    RUN(2, { PH_INPROJ; phase_conv(args, lds, vcu, G); });
#endif
    RUN(4, phase_attn_pre(args, lds, vcu, G));
#if defined(PROBE_GATE1_ONLY)
    if (IN(5)) { PH_SCAN; SEAM(5); if (vcu >= 128) { PH_GATE1(128, (bx % 8 - 4) + 4 * (bx / 8), 2); } SEAM(5); }
#elif defined(PROBE_SCAN_ONLY)
    if (IN(5)) { PH_SCAN; SEAM(5); phase_dn_scan(args, lds, vcu, G); SEAM(5); }
#else
    RUN(5, PH_SCAN);
#endif
    RUN(6, phase_combine(args, vcu, G));
    RUN(7, { PH_MERGE; PH_WOUT; });
    RUN(9, phase_row1(args, vcu, G));
    RUN(10, { PH_FF1; ff2_wait(args, vcu); PH_FF2; });
    if (IN(12)) { phase_row2(args, vcu, G); }
#ifdef TP_A
    TSTAMP(13);
    if (bx == 0 && tid == 0) {
        const unsigned dt = (MISC[32 + TP_B] - MISC[32 + TP_A]) * TP_MUL; const unsigned t0 = (unsigned)__builtin_amdgcn_s_memrealtime();
        while ((unsigned)__builtin_amdgcn_s_memrealtime() - t0 < dt) __builtin_amdgcn_s_sleep(8); }
#endif
#ifdef EXTRA_BARS
    for (int i = 0; i < EXTRA_BARS; ++i) xcd_barrier(bar);
#endif

#undef IN
#undef SEAM
}

#ifndef MK_ONE_LAUNCH
#define MK_ONE_LAUNCH 1
#endif
extern "C" void kernel_launch(void* const* d_in, const int* in_sizes, int n_in, void* d_out, int out_size, void* d_ws, size_t ws_size, hipStream_t stream) {
    static int grid = 0;
    if (grid == 0) {
        if (n_in != 24 || ws_size < WS_END) { fprintf(stderr, "kernel_launch: unexpected n_in %d / ws %zu\n", n_in, ws_size); grid = -1; return; }
        int dev = 0, cus = 0;
        if (hipGetDevice(&dev) != hipSuccess || hipDeviceGetAttribute(&cus, hipDeviceAttributeMultiprocessorCount, dev) != hipSuccess) { grid = -1; return; }
        if (hipFuncSetAttribute((const void*)fwd_kernel, hipFuncAttributeMaxDynamicSharedMemorySize, LDS_BYTES) != hipSuccess) { fprintf(stderr, "kernel_launch: hipFuncSetAttribute failed\n"); grid = -1; return; }
        int per_cu = 0;
        if (hipOccupancyMaxActiveBlocksPerMultiprocessor(&per_cu, (const void*)fwd_kernel, NWAVES * 64, LDS_BYTES) != hipSuccess || per_cu < 1) fprintf(stderr, "kernel_launch: occupancy query says %d\n", per_cu);
        (void)hipGetLastError();
        grid = cus;
    }
    if (grid < 0) return;
    (void)hipMemsetAsync((char*)d_ws + WS_CTL, 0, CTL_ZERO_BYTES, stream);
    Args a{};
    for (int i = 0; i < 24; ++i) a.in[i] = (const float*)d_in[i];
    a.out = (float*)d_out; a.ws = (unsigned char*)d_ws;
#if MK_ONE_LAUNCH
    a.ph_lo = 0; a.ph_hi = N_PHASES;
    hipLaunchKernelGGL(fwd_kernel, dim3(grid), dim3(NWAVES * 64), LDS_BYTES, stream, a);
#else
    for (int p = 0; p < N_PHASES; ++p) { a.ph_lo = p; a.ph_hi = p + 1; hipLaunchKernelGGL(fwd_kernel, dim3(grid), dim3(NWAVES * 64), LDS_BYTES, stream, a); }
#endif
}
```
